# Optimizing an MI355X kernel written in HIP

```python
import math
import jax, jax.numpy as jnp
from jax import lax
import numpy as np

D_MODEL = 1024
BATCH = 8
SEQ = 2048
DEPTH = 2

GRID_W = 64
CTX_LEN = 256
EPS = 1e-6
A_HEADS = 4
A_HEAD_DIM = 64
A_WIDTH = 2 * A_HEADS * A_HEAD_DIM
ROPE_THETA = 10000.0
ATTN_Q_BLOCK = 128
B_HEADS = 4
B_KEY_DIM = 128
B_VAL_DIM = 128
B_KEY_TOT = B_HEADS * B_KEY_DIM
B_WIDTH = B_HEADS * B_VAL_DIM
HGRN_CHUNK = 64
C_GROUPS = 4
C_GROUP_DIM = 128
C_WIDTH = C_GROUPS * C_GROUP_DIM
C_CHUNK = 128
D_WIDTH = 512
CONV_W = 3

EVEN_SPLITS = (A_WIDTH, A_WIDTH, A_WIDTH, A_WIDTH, B_KEY_TOT, B_WIDTH, B_KEY_TOT, B_KEY_TOT, B_WIDTH)
ODD_SPLITS = (C_WIDTH, C_WIDTH, C_WIDTH, D_WIDTH, D_WIDTH, D_WIDTH, D_WIDTH)
EVEN_IN = sum(EVEN_SPLITS)
ODD_IN = sum(ODD_SPLITS)
N_EVEN = (DEPTH + 1) // 2
N_ODD = DEPTH // 2

kernel_name = "hybrid_diffattn_hgrn2_gmlp_shortconv_prefix"


def rms_norm(t, gain):
    tf = t.astype(jnp.float32)
    y = tf * lax.rsqrt(jnp.mean(tf * tf, axis=-1, keepdims=True) + EPS)
    return (y * gain.astype(jnp.float32)).astype(t.dtype)


def split_cols(p, sizes):
    return jnp.split(p, np.cumsum(sizes)[:-1].tolist(), axis=-1)


def adaln(cond, w, b):
    m = jnp.matmul(jax.nn.silu(cond), w) + b
    return jnp.split(m, 3, axis=-1)


def modulate(t, gain, shift, scale):
    return rms_norm(t, gain) * (1 + scale) + shift


def axial_rope(rows):
    row = jnp.repeat(jnp.arange(rows, dtype=jnp.float32), GRID_W)
    col = jnp.tile(jnp.arange(GRID_W, dtype=jnp.float32), rows)
    n_freq = A_HEAD_DIM // 4
    inv = ROPE_THETA ** (-jnp.arange(n_freq, dtype=jnp.float32) / n_freq)
    ang = jnp.concatenate([row[:, None] * inv, col[:, None] * inv], axis=-1)
    return jnp.cos(ang), jnp.sin(ang)


def apply_rope(t, cos, sin):
    t1, t2 = jnp.split(t, 2, axis=-1)
    cs = cos[None, :, None, :].astype(t.dtype)
    sn = sin[None, :, None, :].astype(t.dtype)
    return jnp.concatenate([t1 * cs - t2 * sn, t1 * sn + t2 * cs], axis=-1)


def attn_heads(t, gain, rope=None):
    bn, n, _ = t.shape
    t = rms_norm(t.reshape(bn, n, 2 * A_HEADS, A_HEAD_DIM), gain)
    if rope is not None:
        t = apply_rope(t, rope[0], rope[1])
    return t.reshape(bn, n, A_HEADS, 2, A_HEAD_DIM)


def diff_softmax_mix(q, k, v, lam):
    s = jnp.einsum('bqhmd,bkhmd->bhmqk', q, k, preferred_element_type=jnp.float32)
    p = jax.nn.softmax(s, axis=-1)
    w = p[:, :, 0] - lam * p[:, :, 1]
    return jnp.einsum('bhqk,bkhe->bqhe', w.astype(v.dtype), v)


def hgrn2_scan(q, k, v, log_f, s0):
    bn, n, h, _ = q.shape
    L = HGRN_CHUNK
    nc = n // L

    def to_chunks(t):
        return t.reshape(bn, nc, L, h, t.shape[-1]).transpose(1, 0, 3, 2, 4)

    mask = jnp.tril(jnp.ones((L, L), dtype=bool))[:, :, None]

    def step(S, inp):
        qb, kb, vb, gb = inp
        G = jnp.cumsum(gb, axis=2)
        diff = G[:, :, :, None, :] - G[:, :, None, :, :]
        decay = jnp.exp(jnp.where(mask, diff, -jnp.inf))
        A = jnp.einsum('bhtk,bhsk,bhtsk->bhts', qb, kb, decay)
        o = jnp.einsum('bhts,bhsv->bhtv', A, vb) + jnp.einsum('bhtk,bhkv->bhtv', qb * jnp.exp(G), S)
        G_last = G[:, :, -1:, :]
        S_new = jnp.exp(G_last[:, :, 0, :])[..., None] * S + jnp.einsum('bhsk,bhsv->bhkv', kb * jnp.exp(G_last - G), vb)
        return S_new, o

    S_fin, oc = lax.scan(step, s0, (to_chunks(q), to_chunks(k), to_chunks(v), to_chunks(log_f)))
    return oc.transpose(1, 0, 3, 2, 4).reshape(bn, n, h, v.shape[-1]), S_fin


def hgrn_gates(f_raw, lb):
    f = lb + (1.0 - lb) * jax.nn.sigmoid(f_raw.astype(jnp.float32))
    return 1.0 - f, jnp.log(f)


def hgrn2_bidir(q, i_val, f_fwd, f_bwd, lb, s0_fwd, s0_bwd):
    bn, n, _ = q.shape
    heads = lambda t, d: t.astype(jnp.float32).reshape(bn, n, B_HEADS, d)
    flip = lambda t: jnp.flip(t, axis=1)
    qh = heads(q, B_KEY_DIM)
    vh = heads(i_val, B_VAL_DIM)
    k_f, g_f = hgrn_gates(f_fwd, lb[0])
    k_b, g_b = hgrn_gates(f_bwd, lb[1])
    o_f, S_f = hgrn2_scan(qh, heads(k_f, B_KEY_DIM), vh, heads(g_f, B_KEY_DIM), s0_fwd)
    o_b, S_b = hgrn2_scan(flip(qh), flip(heads(k_b, B_KEY_DIM)), flip(vh), flip(heads(g_b, B_KEY_DIM)), s0_bwd)
    return o_f + flip(o_b), S_f, S_b


def short_conv(t, w):
    return lax.conv_general_dilated(t, w[:, None, :].astype(t.dtype), window_strides=(1,),
                                    padding=((CONV_W // 2, CONV_W // 2),),
                                    dimension_numbers=('NWC', 'WIO', 'NWC'),
                                    feature_group_count=t.shape[-1])


def even_layer(x, ctx, c, c_ctx, layer_idx, need_ctx_out, rope, norm_g, ada_w, ada_b,
               w_in, w_out, qk_gain, lam_p, subln_g, lb, hgrn_g):
    shift, scale, gate = adaln(c[:, None, :], ada_w, ada_b)
    shift_c, scale_c, gate_c = adaln(c_ctx, ada_w, ada_b)
    bn, n, _ = x.shape
    pl = split_cols(jnp.matmul(modulate(x, norm_g, shift, scale), w_in), EVEN_SPLITS)
    pc = split_cols(jnp.matmul(modulate(ctx, norm_g, shift_c, scale_c), w_in), EVEN_SPLITS)
    q_scale = A_HEAD_DIM ** -0.5

    lam_init = 0.8 - 0.6 * math.exp(-0.3 * layer_idx)
    lp = lam_p.astype(jnp.float32)
    lam = jnp.exp(jnp.sum(lp[0] * lp[1])) - jnp.exp(jnp.sum(lp[2] * lp[3])) + lam_init
    k_c = attn_heads(pc[1], qk_gain[1])
    v_c = pc[2].reshape(bn, ctx.shape[1], A_HEADS, 2 * A_HEAD_DIM)
    q_l = attn_heads(pl[0], qk_gain[0], rope) * q_scale
    k_l = attn_heads(pl[1], qk_gain[1], rope)
    v_l = pl[2].reshape(bn, n, A_HEADS, 2 * A_HEAD_DIM)
    k_all = jnp.concatenate([k_c, k_l], axis=1)
    v_all = jnp.concatenate([v_c, v_l], axis=1)
    qb = q_l.reshape(bn, n // ATTN_Q_BLOCK, ATTN_Q_BLOCK, A_HEADS, 2, A_HEAD_DIM).transpose(1, 0, 2, 3, 4, 5)
    o_al = lax.map(lambda qq: diff_softmax_mix(qq, k_all, v_all, lam), qb)
    o_al = o_al.transpose(1, 0, 2, 3, 4).reshape(bn, n, A_HEADS, 2 * A_HEAD_DIM)

    def attn_out(o):
        return (rms_norm(o, subln_g) * (1.0 - lam_init)).reshape(o.shape[0], o.shape[1], A_WIDTH)

    s0 = jnp.zeros((bn, B_HEADS, B_KEY_DIM, B_VAL_DIM), jnp.float32)
    o_bc, S_f, S_b = hgrn2_bidir(pc[4], pc[5], pc[6], pc[7], lb, s0, s0)
    o_bl, _, _ = hgrn2_bidir(pl[4], pl[5], pl[6], pl[7], lb, S_f, S_b)

    def hgrn_out(o):
        return rms_norm(o, hgrn_g).reshape(o.shape[0], o.shape[1], B_WIDTH).astype(x.dtype)

    y = jnp.concatenate([attn_out(o_al) * jax.nn.silu(pl[3]), hgrn_out(o_bl) * jax.nn.silu(pl[8])], axis=-1)
    x_new = x + gate * jnp.matmul(y, w_out)
    if need_ctx_out:
        q_c = attn_heads(pc[0], qk_gain[0]) * q_scale
        o_ac = diff_softmax_mix(q_c, k_c, v_c, lam)
        yc = jnp.concatenate([attn_out(o_ac) * jax.nn.silu(pc[3]), hgrn_out(o_bc) * jax.nn.silu(pc[8])], axis=-1)
        ctx = ctx + gate_c * jnp.matmul(yc, w_out)
    return x_new, ctx


def odd_mix(p, v_g, w_s, b_s, conv_w, w_out):
    u, v, g_c, b_gate, c_gate, h_d, g_d = p
    bn, n, _ = u.shape
    u = jax.nn.gelu(u, approximate=False)
    v = rms_norm(jax.nn.gelu(v, approximate=False), v_g)
    vc = v.reshape(bn, n // C_CHUNK, C_CHUNK, C_GROUPS, C_GROUP_DIM)
    s = jnp.einsum('gts,bcsgd->bctgd', w_s, vc) + b_s.T[:, :, None]
    o_c = u * s.reshape(bn, n, C_WIDTH) * jax.nn.silu(g_c)
    o_d = b_gate * short_conv(c_gate * h_d, conv_w) * jax.nn.silu(g_d)
    return jnp.matmul(jnp.concatenate([o_c, o_d], axis=-1), w_out)


def odd_layer(x, ctx, c, c_ctx, need_ctx_out, norm_g, ada_w, ada_b, w_in, w_out, v_g, w_s, b_s, conv_w):
    shift, scale, gate = adaln(c[:, None, :], ada_w, ada_b)
    p = split_cols(jnp.matmul(modulate(x, norm_g, shift, scale), w_in), ODD_SPLITS)
    x_new = x + gate * odd_mix(p, v_g, w_s, b_s, conv_w, w_out)
    if need_ctx_out:
        shift_c, scale_c, gate_c = adaln(c_ctx, ada_w, ada_b)
        pc = split_cols(jnp.matmul(modulate(ctx, norm_g, shift_c, scale_c), w_in), ODD_SPLITS)
        ctx = ctx + gate_c * odd_mix(pc, v_g, w_s, b_s, conv_w, w_out)
    return x_new, ctx


def setup_inputs(seed: int = 0) -> dict:
    key = jax.random.key(seed)
    ks = jax.random.split(key, 20)
    nrm = lambda k, shape, s: jax.random.normal(k, shape, jnp.float32) * s
    return {
        "x": nrm(ks[0], (BATCH, SEQ, D_MODEL), 1.0),
        "c": nrm(ks[1], (BATCH, D_MODEL), 1.0),
        "ctx": nrm(ks[2], (BATCH, CTX_LEN, D_MODEL), 1.0),
        "c_ctx": nrm(ks[3], (D_MODEL,), 1.0),
        "norm_gain": 1.0 + nrm(ks[4], (DEPTH, D_MODEL), 0.02),
        "ada_w": nrm(ks[5], (DEPTH, D_MODEL, 3 * D_MODEL), D_MODEL ** -0.5),
        "ada_b": nrm(ks[6], (DEPTH, 3 * D_MODEL), 0.02),
        "even_w_in": nrm(ks[7], (N_EVEN, D_MODEL, EVEN_IN), D_MODEL ** -0.5),
        "even_w_out": nrm(ks[8], (N_EVEN, A_WIDTH + B_WIDTH, D_MODEL), (A_WIDTH + B_WIDTH) ** -0.5),
        "attn_qk_gain": 1.0 + nrm(ks[9], (N_EVEN, 2, A_HEAD_DIM), 0.02),
        "attn_lambda": nrm(ks[10], (N_EVEN, 4, A_HEAD_DIM), 0.1),
        "attn_subln_gain": 1.0 + nrm(ks[11], (N_EVEN, 2 * A_HEAD_DIM), 0.02),
        "hgrn_lb_logits": nrm(ks[12], (2, N_EVEN + 1, B_KEY_TOT), 0.5),
        "hgrn_norm_gain": 1.0 + nrm(ks[13], (N_EVEN, B_VAL_DIM), 0.02),
        "odd_w_in": nrm(ks[14], (N_ODD, D_MODEL, ODD_IN), D_MODEL ** -0.5),
        "odd_w_out": nrm(ks[15], (N_ODD, C_WIDTH + D_WIDTH, D_MODEL), (C_WIDTH + D_WIDTH) ** -0.5),
        "gmlp_v_gain": 1.0 + nrm(ks[16], (N_ODD, C_WIDTH), 0.02),
        "gmlp_w_s": nrm(ks[17], (N_ODD, C_GROUPS, C_CHUNK, C_CHUNK), C_CHUNK ** -0.5),
        "gmlp_b_s": 1.0 + nrm(ks[18], (N_ODD, C_GROUPS, C_CHUNK), 0.02),
        "conv_w": nrm(ks[19], (N_ODD, CONV_W, D_WIDTH), CONV_W ** -0.5),
    }


def reference(x, c, ctx, c_ctx, norm_gain, ada_w, ada_b, even_w_in, even_w_out, attn_qk_gain,
              attn_lambda, attn_subln_gain, hgrn_lb_logits, hgrn_norm_gain, odd_w_in, odd_w_out,
              gmlp_v_gain, gmlp_w_s, gmlp_b_s, conv_w):
    n = x.shape[1]
    ROWS = n // GRID_W
    rope = axial_rope(ROWS)
    lb_all = jnp.cumsum(jax.nn.softmax(hgrn_lb_logits.astype(jnp.float32), axis=1), axis=1)
    for i in range(DEPTH):
        need_ctx_out = any(j % 2 == 0 for j in range(i + 1, DEPTH))
        if i % 2 == 0:
            e = i // 2
            x, ctx = even_layer(x, ctx, c, c_ctx, i, need_ctx_out, rope, norm_gain[i], ada_w[i], ada_b[i],
                                even_w_in[e], even_w_out[e], attn_qk_gain[e], attn_lambda[e],
                                attn_subln_gain[e], lb_all[:, e], hgrn_norm_gain[e])
        else:
            o = i // 2
            x, ctx = odd_layer(x, ctx, c, c_ctx, need_ctx_out, norm_gain[i], ada_w[i], ada_b[i],
                               odd_w_in[o], odd_w_out[o], gmlp_v_gain[o], gmlp_w_s[o], gmlp_b_s[o], conv_w[o])
    return x
```

```cpp
#include <hip/hip_runtime.h>
#include <math.h>
#include <stdint.h>

namespace nv {
constexpr int D = 1024, NB = 8, S = 2048, CL = 256, EIN = 4608, OIN = 3584;

__device__ __forceinline__ float silu_f(float v) { return v / (1.f + expf(-v)); }
__device__ __forceinline__ float gelu_f(float v) { return 0.5f * v * (1.f + erff(v * 0.70710678118654752f)); }

__device__ __forceinline__ float block_sum(float v, float* red) {
#pragma unroll
  for (int o = 32; o > 0; o >>= 1) v += __shfl_xor(v, o);
  const int w = threadIdx.x >> 6, nw = (blockDim.x + 63) >> 6;
  __syncthreads();
  if ((threadIdx.x & 63) == 0) red[w] = v;
  __syncthreads();
  float t = 0.f;
  for (int i = 0; i < nw; ++i) t += red[i];
  return t;
}
__device__ __forceinline__ float block_max(float v, float* red) {
#pragma unroll
  for (int o = 32; o > 0; o >>= 1) v = fmaxf(v, __shfl_xor(v, o));
  const int w = threadIdx.x >> 6, nw = (blockDim.x + 63) >> 6;
  __syncthreads();
  if ((threadIdx.x & 63) == 0) red[w] = v;
  __syncthreads();
  float t = red[0];
  for (int i = 1; i < nw; ++i) t = fmaxf(t, red[i]);
  return t;
}

__global__ void adaln_k(const float* c, const float* cctx, const float* ada_w, const float* ada_b, float* mod) {
  const int col = blockIdx.x * 256 + threadIdx.x, r = blockIdx.y, l = blockIdx.z;
  const float* cond = (r < 8) ? c + r * 1024 : cctx;
  const float* w = ada_w + (size_t)l * 1024 * 3072;
  float acc = ada_b[l * 3072 + col];
  for (int k = 0; k < 1024; ++k) { const float v = cond[k]; acc += silu_f(v) * w[(size_t)k * 3072 + col]; }
  mod[(l * 9 + r) * 3072 + col] = acc;
}

__global__ void modulate_k(const float* xin, const float* gain, const float* modrow, float* out) {
  __shared__ float red[16];
  const int row = blockIdx.x;
  const float* xr = xin + (size_t)row * 1024;
  float v[4]; float ss = 0.f;
  for (int i = 0; i < 4; ++i) { v[i] = xr[threadIdx.x + 256 * i]; ss += v[i] * v[i]; }
  ss = block_sum(ss, red);
  const float rstd = rsqrtf(ss * (1.f / 1024.f) + 1e-6f);
  for (int i = 0; i < 4; ++i) { const int col = threadIdx.x + 256 * i;
    out[(size_t)row * 1024 + col] = v[i] * rstd * gain[col] * (1.f + modrow[1024 + col]) + modrow[col]; }
}

__global__ void sgemm_k(const float* A, const float* W, float* C, int M, int N, int K) {
  __shared__ float As[16][65];
  __shared__ float Bs[16][64];
  const int tx = threadIdx.x, ty = threadIdx.y, tid = ty * 16 + tx;
  const int m0 = blockIdx.y * 64, n0 = blockIdx.x * 64;
  float acc[4][4];
  for (int i = 0; i < 4; ++i) for (int j = 0; j < 4; ++j) acc[i][j] = 0.f;
  for (int k0 = 0; k0 < K; k0 += 16) {
    for (int i = 0; i < 4; ++i) { const int idx = tid + 256 * i; const int m = idx >> 4, k = idx & 15; As[k][m] = A[(size_t)(m0 + m) * K + k0 + k]; }
    for (int i = 0; i < 4; ++i) { const int idx = tid + 256 * i; const int k = idx >> 6, n = idx & 63; Bs[k][n] = W[(size_t)(k0 + k) * N + n0 + n]; }
    __syncthreads();
#pragma unroll
    for (int k = 0; k < 16; ++k) {
      float a[4], b[4];
      for (int i = 0; i < 4; ++i) a[i] = As[k][ty * 4 + i];
      for (int j = 0; j < 4; ++j) b[j] = Bs[k][tx * 4 + j];
      for (int i = 0; i < 4; ++i) for (int j = 0; j < 4; ++j) acc[i][j] += a[i] * b[j];
    }
    __syncthreads();
  }
  for (int i = 0; i < 4; ++i) for (int j = 0; j < 4; ++j) C[(size_t)(m0 + ty * 4 + i) * N + n0 + tx * 4 + j] = acc[i][j];
}

__global__ void qknorm_rope_k(float* P, const float* qk_gain, int latent) {
  const int t = blockIdx.x, seg = threadIdx.x >> 6, d = threadIdx.x & 63;
  float* p = P + (size_t)t * EIN + seg * 64 + d;
  const float v = *p;
  float ss = v * v;
#pragma unroll
  for (int o = 32; o > 0; o >>= 1) ss += __shfl_xor(ss, o);
  const float rstd = rsqrtf(ss * (1.f / 64.f) + 1e-6f);
  float vn = v * rstd * qk_gain[(seg < 8 ? 0 : 1) * 64 + d];
  if (latent) {
    const float other = __shfl_xor(vn, 32);
    const int j = d & 31;
    const float pos = (j < 16) ? (float)(t >> 6) : (float)(t & 63);
    const float inv = powf(10000.f, -(float)(j & 15) / 16.f);
    const float ang = pos * inv;
    const float cs = cosf(ang), sn = sinf(ang);
    vn = (d < 32) ? (vn * cs - other * sn) : (other * sn + vn * cs);
  }
  if (seg < 8) vn *= 0.125f;
  *p = vn;
}

__global__ void __launch_bounds__(256) attn_k(const float* P, const float* PC, const float* lam_p, const float* subln_g, float* y) {
  __shared__ float w0[2304], w1[2304];
  __shared__ float q[128];
  __shared__ float red[16];
  __shared__ float part[128];
  __shared__ float lam_s;
  const int t = blockIdx.x, h = blockIdx.y, tid = threadIdx.x;
  const float* prow = P + (size_t)t * EIN;
  if (tid < 128) q[tid] = prow[h * 128 + tid];
  if (tid == 0) {
    float a = 0.f, b = 0.f;
    for (int i = 0; i < 64; ++i) { a += lam_p[i] * lam_p[64 + i]; b += lam_p[128 + i] * lam_p[192 + i]; }
    lam_s = expf(a) - expf(b) + 0.2f;
  }
  __syncthreads();
  float m0 = -1e30f, m1 = -1e30f;
  for (int kk = tid; kk < 2304; kk += 256) {
    const float* kr = (kk < 256 ? PC + (size_t)kk * EIN : P + (size_t)(kk - 256) * EIN) + 512 + h * 128;
    float s0 = 0.f, s1 = 0.f;
#pragma unroll 8
    for (int d2 = 0; d2 < 64; ++d2) { s0 += q[d2] * kr[d2]; s1 += q[64 + d2] * kr[64 + d2]; }
    w0[kk] = s0; w1[kk] = s1; m0 = fmaxf(m0, s0); m1 = fmaxf(m1, s1);
  }
  m0 = block_max(m0, red); m1 = block_max(m1, red);
  float l0 = 0.f, l1 = 0.f;
  for (int kk = tid; kk < 2304; kk += 256) { const float p0 = expf(w0[kk] - m0), p1 = expf(w1[kk] - m1); w0[kk] = p0; w1[kk] = p1; l0 += p0; l1 += p1; }
  l0 = block_sum(l0, red); l1 = block_sum(l1, red);
  const float lam = lam_s;
  for (int kk = tid; kk < 2304; kk += 256) w0[kk] = w0[kk] / l0 - lam * (w1[kk] / l1);
  __syncthreads();
  const int dv = tid & 127, half = tid >> 7;
  float acc = 0.f;
  for (int kk = half; kk < 2304; kk += 2) {
    const float* vr = (kk < 256 ? PC + (size_t)kk * EIN : P + (size_t)(kk - 256) * EIN) + 1024 + h * 128;
    acc += w0[kk] * vr[dv];
  }
  if (half == 1) part[dv] = acc;
  __syncthreads();
  if (half == 0) acc += part[dv];
  float ss = (half == 0) ? acc * acc : 0.f;
  ss = block_sum(ss, red);
  if (half == 0) {
    const float rstd = rsqrtf(ss * (1.f / 128.f) + 1e-6f);
    const float g = prow[1536 + h * 128 + dv];
    y[(size_t)t * 1024 + h * 128 + dv] = acc * rstd * subln_g[dv] * 0.8f * silu_f(g);
  }
}

__global__ void hgrn_k(const float* P, const float* PC, const float* lb_logits, float* of, float* ob) {
  __shared__ float sm[2][4][8];
  const int vs = blockIdx.x, h = blockIdx.y, dir = blockIdx.z, tid = threadIdx.x;
  const int k = tid & 127, vh = tid >> 7, wave = tid >> 6, lane = tid & 63;
  const float l0 = lb_logits[(dir * 2 + 0) * 512 + h * 128 + k], l1 = lb_logits[(dir * 2 + 1) * 512 + h * 128 + k];
  const float mx = fmaxf(l0, l1);
  const float e0 = expf(l0 - mx), e1 = expf(l1 - mx);
  const float lb = e0 / (e0 + e1);
  float* odst = dir ? ob : of;
  float Sreg[8];
  for (int j = 0; j < 8; ++j) Sreg[j] = 0.f;
  const int vcol = 2560 + h * 128 + vs * 16 + vh * 8;
  for (int step = 0; step < 2304; ++step) {
    const bool lat = step >= 256;
    int tok; const float* row;
    if (!lat) { tok = dir ? (255 - step) : step; row = PC + (size_t)tok * EIN; }
    else { const int s2 = step - 256; tok = dir ? (2047 - s2) : s2; row = P + (size_t)tok * EIN; }
    const float z = row[3072 + dir * 512 + h * 128 + k];
    const float f = lb + (1.f - lb) / (1.f + expf(-z));
    const float kk = 1.f - f;
    float pr[8];
    const float qv = lat ? row[2048 + h * 128 + k] : 0.f;
#pragma unroll
    for (int j = 0; j < 8; ++j) { Sreg[j] = f * Sreg[j] + kk * row[vcol + j]; pr[j] = Sreg[j] * qv; }
    if (lat) {
#pragma unroll
      for (int j = 0; j < 8; ++j) {
#pragma unroll
        for (int o = 32; o > 0; o >>= 1) pr[j] += __shfl_xor(pr[j], o);
      }
      const int par = step & 1;
      if (lane == 0) { for (int j = 0; j < 8; ++j) sm[par][wave][j] = pr[j]; }
      __syncthreads();
      if (tid < 16) { const int vh2 = tid >> 3, j = tid & 7;
        odst[(size_t)tok * 512 + h * 128 + vs * 16 + vh2 * 8 + j] = sm[par][2 * vh2][j] + sm[par][2 * vh2 + 1][j]; }
    }
  }
}

__global__ void hgrn_out_k(const float* P, const float* of, const float* ob, const float* hg, float* y) {
  __shared__ float red[16];
  const int t = blockIdx.x, h = blockIdx.y, v = threadIdx.x;
  const float o = of[(size_t)t * 512 + h * 128 + v] + ob[(size_t)t * 512 + h * 128 + v];
  const float ss = block_sum(o * o, red);
  const float rstd = rsqrtf(ss * (1.f / 128.f) + 1e-6f);
  const float g = P[(size_t)t * EIN + 4096 + h * 128 + v];
  y[(size_t)t * 1024 + 512 + h * 128 + v] = o * rstd * hg[v] * silu_f(g);
}

__global__ void resid_k(const float* x, const float* T, const float* gate, float* out) {
  const int row = blockIdx.x;
  for (int i = 0; i < 4; ++i) { const int col = threadIdx.x + 256 * i; const size_t o = (size_t)row * 1024 + col; out[o] = x[o] + gate[col] * T[o]; }
}

__global__ void gmlp_prep_k(const float* P1, const float* v_g, float* GV) {
  __shared__ float red[16];
  const int t = blockIdx.x, c = threadIdx.x;
  const float gv = gelu_f(P1[(size_t)t * OIN + 512 + c]);
  const float ss = block_sum(gv * gv, red);
  const float rstd = rsqrtf(ss * (1.f / 512.f) + 1e-6f);
  GV[(size_t)t * 512 + c] = gv * rstd * v_g[c];
}
__global__ void gmlp_k(const float* P1, const float* GV, const float* w_s, const float* b_s, float* y1) {
  const int t = blockIdx.x, c = threadIdx.x, g = c >> 7, ch = t >> 7, tt = t & 127;
  const float* wr = w_s + ((size_t)g * 128 + tt) * 128;
  float s = b_s[g * 128 + tt];
  for (int s2 = 0; s2 < 128; ++s2) s += wr[s2] * GV[(size_t)(ch * 128 + s2) * 512 + c];
  const float* pr = P1 + (size_t)t * OIN;
  y1[(size_t)t * 1024 + c] = gelu_f(pr[c]) * s * silu_f(pr[1024 + c]);
}
__global__ void conv_k(const float* P1, const float* cw, float* y1) {
  const int t = blockIdx.x, c = threadIdx.x;
  float acc = 0.f;
  for (int j = 0; j < 3; ++j) { const int tt = t - 1 + j; if (tt < 0 || tt >= 2048) continue; const float* pr = P1 + (size_t)tt * OIN; acc += cw[j * 512 + c] * pr[2048 + c] * pr[2560 + c]; }
  const float* pr = P1 + (size_t)t * OIN;
  y1[(size_t)t * 1024 + 512 + c] = pr[1536 + c] * acc * silu_f(pr[3072 + c]);
}
}

extern "C" void kernel_launch(void* const* d_in, const int* in_sizes, int n_in,
                              void* d_out, int out_size, void* d_ws, size_t ws_size,
                              hipStream_t stream) {
  using namespace nv;
  const float* x = (const float*)d_in[0];
  const float* c = (const float*)d_in[1];
  const float* ctx = (const float*)d_in[2];
  const float* c_ctx = (const float*)d_in[3];
  const float* norm_gain = (const float*)d_in[4];
  const float* ada_w = (const float*)d_in[5];
  const float* ada_b = (const float*)d_in[6];
  const float* even_w_in = (const float*)d_in[7];
  const float* even_w_out = (const float*)d_in[8];
  const float* qk_gain = (const float*)d_in[9];
  const float* lam_p = (const float*)d_in[10];
  const float* subln_g = (const float*)d_in[11];
  const float* lb_logits = (const float*)d_in[12];
  const float* hgrn_g = (const float*)d_in[13];
  const float* odd_w_in = (const float*)d_in[14];
  const float* odd_w_out = (const float*)d_in[15];
  const float* v_g = (const float*)d_in[16];
  const float* w_s = (const float*)d_in[17];
  const float* b_s = (const float*)d_in[18];
  const float* conv_w = (const float*)d_in[19];
  float* out = (float*)d_out;

  float* ws = (float*)d_ws;
  size_t off = 0;
  auto take = [&](size_t n) { float* p = ws + off; off += (n + 63) & ~(size_t)63; return p; };
  float* mod = take(2 * 9 * 3072);
  float* XN = take((size_t)S * D);
  float* CN = take((size_t)CL * D);
  float* P = take((size_t)S * EIN);
  float* PC = take((size_t)CL * EIN);
  float* of = take((size_t)S * 512);
  float* ob = take((size_t)S * 512);
  float* y = take((size_t)S * D);
  float* T = take((size_t)S * D);
  float* x1 = take((size_t)S * D);
  float* P1 = take((size_t)S * OIN);
  float* GV = take((size_t)S * 512);

  adaln_k<<<dim3(12, 9, 2), 256, 0, stream>>>(c, c_ctx, ada_w, ada_b, mod);
  for (int b = 0; b < NB; ++b) {
    const float* xb = x + (size_t)b * S * D;
    const float* cb = ctx + (size_t)b * CL * D;
    float* outb = out + (size_t)b * S * D;
    const float* mod0 = mod + (0 * 9 + b) * 3072;
    const float* mod0c = mod + (0 * 9 + 8) * 3072;
    const float* mod1 = mod + (1 * 9 + b) * 3072;
    modulate_k<<<S, 256, 0, stream>>>(xb, norm_gain, mod0, XN);
    modulate_k<<<CL, 256, 0, stream>>>(cb, norm_gain, mod0c, CN);
    sgemm_k<<<dim3(EIN / 64, S / 64), dim3(16, 16), 0, stream>>>(XN, even_w_in, P, S, EIN, D);
    sgemm_k<<<dim3(EIN / 64, CL / 64), dim3(16, 16), 0, stream>>>(CN, even_w_in, PC, CL, EIN, D);
    qknorm_rope_k<<<S, 1024, 0, stream>>>(P, qk_gain, 1);
    qknorm_rope_k<<<CL, 1024, 0, stream>>>(PC, qk_gain, 0);
    attn_k<<<dim3(S, 4), 256, 0, stream>>>(P, PC, lam_p, subln_g, y);
    hgrn_k<<<dim3(8, 4, 2), 256, 0, stream>>>(P, PC, lb_logits, of, ob);
    hgrn_out_k<<<dim3(S, 4), 128, 0, stream>>>(P, of, ob, hgrn_g, y);
    sgemm_k<<<dim3(D / 64, S / 64), dim3(16, 16), 0, stream>>>(y, even_w_out, T, S, D, D);
    resid_k<<<S, 256, 0, stream>>>(xb, T, mod0 + 2048, x1);
    modulate_k<<<S, 256, 0, stream>>>(x1, norm_gain + 1024, mod1, XN);
    sgemm_k<<<dim3(OIN / 64, S / 64), dim3(16, 16), 0, stream>>>(XN, odd_w_in, P1, S, OIN, D);
    gmlp_prep_k<<<S, 512, 0, stream>>>(P1, v_g, GV);
    gmlp_k<<<S, 512, 0, stream>>>(P1, GV, w_s, b_s, y);
    conv_k<<<S, 512, 0, stream>>>(P1, conv_w, y);
    sgemm_k<<<dim3(D / 64, S / 64), dim3(16, 16), 0, stream>>>(y, odd_w_out, T, S, D, D);
    resid_k<<<S, 256, 0, stream>>>(x1, T, mod1 + 2048, outb);
  }
}
```

```cpp
#define DIAG 0
#define DSEL -1
#include <hip/hip_runtime.h>
#include <math.h>
#include <stdint.h>
#include <cstdio>

#define LAS __attribute__((address_space(3)))
#define GAS __attribute__((address_space(1)))
typedef unsigned short bf16_t;
typedef short bf16x8 __attribute__((ext_vector_type(8)));
typedef short s16x4 __attribute__((ext_vector_type(4)));
typedef float f32x2 __attribute__((ext_vector_type(2)));
typedef float f32x4 __attribute__((ext_vector_type(4)));
typedef float f32x16 __attribute__((ext_vector_type(16)));
typedef unsigned u32x2 __attribute__((ext_vector_type(2)));
typedef unsigned u32x4 __attribute__((ext_vector_type(4)));
typedef _Float16 f16x2_t __attribute__((ext_vector_type(2)));
typedef __bf16 bf16x2_t __attribute__((ext_vector_type(2)));

constexpr int DM = 1024, NB = 8, SEQ = 2048, CTX = 256, KV = SEQ + CTX  , M_TOK = NB * SEQ  , M_CTX = NB * CTX  ;
constexpr int EIN = 4608, OIN = 3584;
constexpr float EPS = 1e-6f;
constexpr float LOG2E = 1.4426950408889634f;
constexpr float LAM_INIT = 0.2f;

constexpr size_t MiB = 1u << 20;
constexpr size_t WS_CTL = 0, CTL_ZERO_BYTES = 1 * MiB;
constexpr size_t WS_MISC = 1 * MiB;
constexpr size_t WS_WT0 = 2 * MiB;
constexpr size_t WS_WO0 = 11 * MiB;
constexpr size_t WS_WT1 = 13 * MiB;
constexpr size_t WS_WO1 = 20 * MiB;
constexpr size_t WS_WS = 22 * MiB;
constexpr size_t WS_SSQ1 = 23 * MiB;
constexpr size_t WS_RA = 24 * MiB;
constexpr size_t WS_XN = WS_RA, WS_CN = WS_RA + 32 * MiB, WS_ST = WS_RA, WS_A1 = WS_RA;
constexpr size_t WS_Y = 88 * MiB;
constexpr size_t WS_KC = 120 * MiB;
constexpr size_t WS_VT = 138 * MiB;
constexpr size_t WS_GA = 156 * MiB;
constexpr size_t WS_HVT = 172 * MiB;
constexpr size_t WS_LF = 190 * MiB;
constexpr size_t WS_GB = 226 * MiB;
constexpr size_t WS_END = 242 * MiB;
constexpr size_t WS_UG = 120 * MiB;
constexpr size_t WS_BG = 136 * MiB;
constexpr size_t WS_CH = 152 * MiB;
constexpr size_t WS_GVT = 168 * MiB;
constexpr size_t WS_GVSSQ = 184 * MiB;
constexpr int MI_MOD = 0;
constexpr int MI_CS = 55296, MI_SN = MI_CS + 1024, MI_LBV = MI_SN + 1024, MI_SCAL = MI_LBV + 1024, MI_BIAS1 = MI_SCAL + 64;
constexpr int CW_BAR = 4096;
constexpr int CW_QUEUE = 16384;

__device__ __forceinline__ unsigned cvt_pk_bf16(float lo, float hi) { f32x2 v = {lo, hi}; bf16x2_t b = __builtin_convertvector(v, bf16x2_t); return __builtin_bit_cast(unsigned, b); }
__device__ __forceinline__ unsigned cvt_pk_f16(float lo, float hi) { f32x2 v = {lo, hi}; f16x2_t b = __builtin_convertvector(v, f16x2_t); return __builtin_bit_cast(unsigned, b); }
__device__ __forceinline__ float bf2f(unsigned short h) { return __uint_as_float(((unsigned)h) << 16); }
__device__ __forceinline__ float bflo(unsigned w) { return __uint_as_float(w << 16); }
__device__ __forceinline__ float bfhi(unsigned w) { return __uint_as_float(w & 0xffff0000u); }
__device__ __forceinline__ float silu_fast(float v) { return v * __builtin_amdgcn_rcpf(1.f + __expf(-v)); }
__device__ __forceinline__ float gelu_erf(float v) { return 0.5f * v * (1.f + erff(v * 0.70710678118654752f)); }
__device__ __forceinline__ float wave_sum(float v) {
#pragma unroll
  for (int o = 1; o < 64; o <<= 1) v += __shfl_xor(v, o);
  return v;
}
__device__ __forceinline__ int lane_id() { int l = (int)__builtin_amdgcn_mbcnt_hi(~0u, __builtin_amdgcn_mbcnt_lo(~0u, 0u)); asm volatile("" : "+v"(l)); return l; }
#define LDS_WAIT() asm volatile("s_waitcnt lgkmcnt(0)" ::: "memory")
#define VM_WAIT() asm volatile("s_waitcnt vmcnt(0)" ::: "memory")

namespace pg8 {
constexpr int BM = 256, BK = 64, HALF = 128, HTB = HALF * BK * 2, STAGE_BYTES = 8 * HTB;
__host__ __device__ __forceinline__ int lds_byte(int r, int c) { const int st = (r >> 4) * 2 + (c >> 5), rr = r & 15, cc = c & 31, ob = rr * 64 + cc * 2; return st * 1024 + (ob ^ (((ob >> 9) & 1) << 5)); }
__host__ __device__ __forceinline__ void stage_rc(int b, int& R, int& C) { const int st = b / 1024, sb = b % 1024, swz = sb ^ (((sb >> 9) & 1) << 5); R = (st >> 1) * 16 + swz / 64; C = (st & 1) * 32 + (swz % 64) / 2; }
__host__ __device__ __forceinline__ int perm32(int rho) { const int n = rho >> 4, i = rho & 15; return 8 * (i >> 2) + 4 * n + (i & 3); }

struct Unit { const char* a; const char* b; int ty, pm, pn, aux; };

template <class Epi, class Sched>
__device__ __forceinline__ void gemm_phase(LAS unsigned char* lds, const int K, const Sched& S, const Epi& E, const int wv) {
    const int lane = lane_id(), tid = wv * 64 + lane, wid = wv, wr = wid >> 2, wc = wid & 3, fr = lane & 15, fq = lane >> 4;
    const int nt = K / BK;
    unsigned voffA[2], voffB[2];
#pragma unroll
    for (int i = 0; i < 2; ++i) { int R, C; stage_rc(tid * 16 + i * 8192, R, C); const int Rb = (R & ~31) + perm32(R & 31);
        voffA[i] = (unsigned)(R * K + C) * 2u; voffB[i] = (unsigned)(Rb * K + C) * 2u; }
    const size_t kstep = (size_t)(BK * 2);
    const size_t hstep = (size_t)HALF * K * 2;
    const unsigned ldsw = (unsigned)wid * 1024u;
    const int aoff = lds_byte(wr * 64 + fr, fq * 8), boff = lds_byte(wc * 32 + fr, fq * 8);
#define PG8_SA(b, h) (((b) * 2 + (h)) * HTB)
#define PG8_SB(b, h) ((4 + (b) * 2 + (h)) * HTB)
#define PG8_STAGE(bufoff, gbase, voff) do { _Pragma("unroll") for (int _i = 0; _i < 2; ++_i) \
        __builtin_amdgcn_global_load_lds((const unsigned*)((const char*)(gbase) + (voff)[_i]), (LAS unsigned*)(lds + (bufoff) + ldsw + _i * 8192), 16, 0, 0); } while (0)
#define PG8_LDA(dst, b, h) do { _Pragma("unroll") for (int m = 0; m < 4; ++m) _Pragma("unroll") for (int k = 0; k < 2; ++k) dst[m][k] = *(const LAS bf16x8*)(lds + PG8_SA(b, h) + aoff + m * 2048 + k * 1024); } while (0)
#define PG8_LDB(dst, b, h) do { _Pragma("unroll") for (int n = 0; n < 2; ++n) _Pragma("unroll") for (int k = 0; k < 2; ++k) dst[n][k] = *(const LAS bf16x8*)(lds + PG8_SB(b, h) + boff + n * 2048 + k * 1024); } while (0)
#define PG8_MMA(ai, bj, At, Bt) do { __builtin_amdgcn_s_setprio(1); _Pragma("unroll") for (int m = 0; m < 4; ++m) _Pragma("unroll") for (int n = 0; n < 2; ++n) _Pragma("unroll") for (int k = 0; k < 2; ++k) \
        acc[ai][bj][m][n] = __builtin_amdgcn_mfma_f32_16x16x32_bf16(Bt[n][k], At[m][k], acc[ai][bj][m][n], 0, 0, 0); __builtin_amdgcn_s_setprio(0); } while (0)
#define PG8_WAIT_V(n) asm volatile("s_waitcnt vmcnt(" #n ")" ::: "memory")
#define PG8_WAIT_L(n) asm volatile("s_waitcnt lgkmcnt(" #n ")" ::: "memory")
#define PG8_BAR __builtin_amdgcn_s_barrier()
#define PG8_SCHED __builtin_amdgcn_sched_barrier(0)
    Unit cur, nxt; int ui = 0;
    if (!S.next(0, cur)) return;
    f32x4 acc[2][2][4][2];
#pragma unroll
    for (int a = 0; a < 2; ++a)
#pragma unroll
        for (int b = 0; b < 2; ++b)
#pragma unroll
            for (int m = 0; m < 4; ++m)
#pragma unroll
                for (int n = 0; n < 2; ++n) acc[a][b][m][n] = (f32x4){0.f, 0.f, 0.f, 0.f};
    bf16x8 At[4][2], B0[2][2], B1[2][2];
    const char* cA = cur.a; const char* cB = cur.b;
    PG8_STAGE(PG8_SB(0, 0), cB, voffB); PG8_STAGE(PG8_SB(0, 1), cB + hstep, voffB); PG8_STAGE(PG8_SA(0, 0), cA, voffA); PG8_STAGE(PG8_SA(0, 1), cA + hstep, voffA);
    if (wr == 1) PG8_BAR;
    PG8_WAIT_V(2); PG8_BAR;
    PG8_STAGE(PG8_SB(1, 0), cB + kstep, voffB); PG8_STAGE(PG8_SA(1, 0), cA + kstep, voffA); PG8_STAGE(PG8_SB(1, 1), cB + hstep + kstep, voffB);
    PG8_WAIT_V(6); PG8_BAR;
    for (;;) {
        const bool has_next = S.next(ui + 1, nxt);
        const char* nA = has_next ? nxt.a : cA; const char* nB = has_next ? nxt.b : cB;
        for (int t = 0; t < nt; t += 2) {
            const bool last = (t == nt - 2);
            const char* a1 = cA + (size_t)(t + 1) * kstep;
            const char* a2 = last ? nA : cA + (size_t)(t + 2) * kstep; const char* b2 = last ? nB : cB + (size_t)(t + 2) * kstep;
            const char* a3 = a2 + kstep; const char* b3 = b2 + kstep;
            PG8_LDB(B0, 0, 0); PG8_LDB(B1, 0, 1); PG8_SCHED; PG8_LDA(At, 0, 0); PG8_STAGE(PG8_SA(1, 1), a1 + hstep, voffA);
            PG8_WAIT_V(8); PG8_WAIT_L(0); PG8_BAR; PG8_MMA(0, 0, At, B0); PG8_MMA(0, 1, At, B1); PG8_BAR; PG8_SCHED;
            PG8_LDA(At, 0, 1); PG8_STAGE(PG8_SB(0, 0), b2, voffB); PG8_STAGE(PG8_SB(0, 1), b2 + hstep, voffB); PG8_STAGE(PG8_SA(0, 0), a2, voffA);
            PG8_WAIT_V(8); PG8_WAIT_L(0); PG8_BAR; PG8_MMA(1, 0, At, B0); PG8_MMA(1, 1, At, B1); PG8_BAR; PG8_SCHED;
            PG8_LDB(B0, 1, 0); PG8_LDB(B1, 1, 1); PG8_SCHED; PG8_LDA(At, 1, 0); PG8_STAGE(PG8_SA(0, 1), a2 + hstep, voffA);
            PG8_WAIT_V(8); PG8_WAIT_L(0); PG8_BAR; PG8_MMA(0, 0, At, B0); PG8_MMA(0, 1, At, B1); PG8_BAR; PG8_SCHED;
            PG8_LDA(At, 1, 1); PG8_STAGE(PG8_SB(1, 0), b3, voffB); PG8_STAGE(PG8_SB(1, 1), b3 + hstep, voffB); PG8_STAGE(PG8_SA(1, 0), a3, voffA);
            PG8_WAIT_V(8); PG8_WAIT_L(0); PG8_BAR; PG8_MMA(1, 0, At, B0); PG8_MMA(1, 1, At, B1); PG8_BAR; PG8_SCHED;
        }
        if (wr == 0) PG8_BAR;
        { int ln_ = (int)__builtin_amdgcn_mbcnt_hi(~0u, __builtin_amdgcn_mbcnt_lo(~0u, 0u)); asm volatile("" : "+v"(ln_));
          E(acc, cur, wr, wc, ln_ & 15, ln_ >> 4, ln_); }
        if (!has_next) break;
#pragma unroll
        for (int a = 0; a < 2; ++a)
#pragma unroll
            for (int b = 0; b < 2; ++b)
#pragma unroll
                for (int m = 0; m < 4; ++m)
#pragma unroll
                    for (int n = 0; n < 2; ++n) acc[a][b][m][n] = (f32x4){0.f, 0.f, 0.f, 0.f};
        cur = nxt; cA = nA; cB = nB; ++ui;
        if (wr == 1) PG8_BAR;
    }
    PG8_WAIT_V(0);
    PG8_BAR;
#undef PG8_SA
#undef PG8_SB
#undef PG8_STAGE
#undef PG8_LDA
#undef PG8_LDB
#undef PG8_MMA
#undef PG8_WAIT_V
#undef PG8_WAIT_L
#undef PG8_BAR
#undef PG8_SCHED
}
}

#define XB_TMO      128
#define XB_XCNT(j)  (256  + 64 * (j))
#define XB_XSUB(j)  (1280 + 64 * (j))
#define XB_XGEN(j)  (2304 + 64 * (j))
#define XB_TOP      3328
#define XB_TOPGEN   3392
#define XCD_BAR_WORDS 3456
#define XB_SPIN_CAP (1u << 18)
__device__ __forceinline__ unsigned xb_ld(unsigned* p)              { return __hip_atomic_load(p, __ATOMIC_RELAXED, __HIP_MEMORY_SCOPE_AGENT); }
__device__ __forceinline__ unsigned xb_add(unsigned* p, unsigned v) { return __hip_atomic_fetch_add(p, v, __ATOMIC_RELAXED, __HIP_MEMORY_SCOPE_AGENT); }
__device__ __forceinline__ unsigned xb_xcc_id() { return (unsigned)__builtin_amdgcn_s_getreg((3 << 11) | 20) & 0xFu; }
#define XB_SPIN(cond, bar) do { unsigned _sp = 0; while (cond) { __builtin_amdgcn_s_sleep(1); \
    if ((++_sp & 255u) == 0u) { if (xb_ld(&(bar)[XB_TMO])) break; if (_sp > XB_SPIN_CAP) { atomicAdd(&(bar)[XB_TMO], 1u); break; } } } } while (0)
struct XcdBarrier { unsigned* bar; unsigned x; volatile LAS unsigned* st; };
__device__ __forceinline__ XcdBarrier xcd_barrier_post(unsigned* bar, volatile LAS unsigned* st, int tid) {
    XcdBarrier b; b.bar = bar; b.x = xb_xcc_id(); b.st = st;
    if (tid == 0) (void)xb_add(&bar[XB_XCNT(b.x)], 1u);
    return b;
}
__device__ __forceinline__ void xcd_barrier_complete(unsigned* bar, unsigned x, unsigned& nloc, unsigned& nx) {
    const unsigned G = gridDim.x * gridDim.y * gridDim.z;
    unsigned sum, cnt, mine, sp = 0u;
    for (;;) {
        sum = 0u; cnt = 0u; mine = 0u;
#pragma unroll
        for (unsigned j = 0; j < 16; ++j) { const unsigned c = xb_ld(&bar[XB_XCNT(j)]); sum += c; cnt += (c > 0u) ? 1u : 0u; mine = (j == x) ? c : mine; }
        if (sum == G) break;
        __builtin_amdgcn_s_sleep(1);
        if ((++sp & 255u) == 0u) { if (xb_ld(&bar[XB_TMO])) break; if (sp > XB_SPIN_CAP) { atomicAdd(&bar[XB_TMO], 1u); break; } }
    }
    nloc = mine > 0u ? mine : 1u; nx = cnt > 0u ? cnt : 1u;
}
__device__ __forceinline__ void xcd_barrier(const XcdBarrier& b, int tid) {
    asm volatile("s_waitcnt vmcnt(0)" ::: "memory");
    __syncthreads();
    if (tid == 0) {
        unsigned* bar = b.bar;
        __builtin_amdgcn_s_waitcnt(0);
        unsigned nloc = b.st[0], nx = b.st[1];
        if (nloc == 0u) { xcd_barrier_complete(bar, b.x, nloc, nx); b.st[0] = nloc; b.st[1] = nx; }
        const unsigned old = xb_add(&bar[XB_XSUB(b.x)], 1u);
        const unsigned gen = old / nloc;
        if (old + 1u == (gen + 1u) * nloc) {
            __builtin_amdgcn_fence(__ATOMIC_RELEASE, "agent");
            asm volatile("s_waitcnt vmcnt(0)" ::: "memory");
            const unsigned og = xb_add(&bar[XB_TOP], 1u);
            const unsigned tg = og / nx;
            if (og + 1u == (tg + 1u) * nx) xb_add(&bar[XB_TOPGEN], 1u);
            else XB_SPIN(xb_ld(&bar[XB_TOPGEN]) == tg, bar);
            __builtin_amdgcn_fence(__ATOMIC_ACQUIRE, "agent");
            xb_add(&bar[XB_XGEN(b.x)], 1u);
            asm volatile("s_waitcnt vmcnt(0)" ::: "memory");
        } else {
            XB_SPIN(xb_ld(&bar[XB_XGEN(b.x)]) == gen, bar);
            __builtin_amdgcn_fence(__ATOMIC_ACQUIRE, "agent");
            asm volatile("s_waitcnt vmcnt(0)" ::: "memory");
        }
    }
    __syncthreads();
}
constexpr int NWAVES = 8, NTHR = 512;
constexpr int RING_BYTES = 131072;
constexpr int LDSX_OFF = RING_BYTES;
constexpr int LDSCTL_OFF = 162816;
constexpr int LDS_BYTES = 163840;

struct Args {
    const float* in[20]; float* out; unsigned char* ws; int ph_lo, ph_hi;
};
typedef const __attribute__((address_space(4))) Args* KArgsPtr;
__device__ __forceinline__ KArgsPtr kargs() { KArgsPtr p = (KArgsPtr)__builtin_amdgcn_kernarg_segment_ptr(); asm volatile("" : "+s"(p)); return p; }
struct Frame {
    LAS unsigned char* lds;
    volatile LAS unsigned* MISC;
    unsigned* ctl;
    int tid, lane, wave, vcu, G;
    const float *x, *c, *ctx, *c_ctx, *norm_gain, *ada_w, *ada_b, *even_w_in, *even_w_out, *qk_gain, *lam_p, *subln_g, *lb_logits, *hgrn_g,
                *odd_w_in, *odd_w_out, *v_g, *w_s, *b_s, *conv_w;
    float* out; unsigned char* ws; float* misc;
};

__host__ __device__ __forceinline__ int srcmap0(int d) {
    if (d < 1024) { const int base = d < 512 ? 0 : 512; const int e = d & 511; const int pn = e >> 8, rho = e & 255, bj = rho >> 7, wc = (rho >> 5) & 3; return base + (4 * pn + wc) * 64 + 32 * bj + (rho & 31); }
    if (d < 1536) return 1536 + (d - 1024);
    if (d < 2048) return 2048 + (d - 1536);
    if (d < 2560) return 3072 + (d - 2048);
    if (d < 3072) return 3584 + (d - 2560);
    if (d < 3584) return 4096 + (d - 3072);
    if (d < 4096) return 1024 + (d - 3584);
    return 2560 + (d - 4096);
}
__host__ __device__ __forceinline__ int srcmap1(int d) {
    if (d < 1024) { const int t = d >> 8, rho = d & 255, bj = rho >> 7, o = rho & 127; return (bj ? 1024 : 0) + 128 * t + o; }
    if (d < 2048) { const int e = d - 1024; const int t = e >> 8, rho = e & 255, bj = rho >> 7, o = rho & 127; return (bj ? 3072 : 1536) + 128 * t + o; }
    if (d < 3072) { const int e = d - 2048; const int t = e >> 8, rho = e & 255, bj = rho >> 7, o = rho & 127; return (bj ? 2560 : 2048) + 128 * t + o; }
    return 512 + (d - 3072);
}

__device__ __forceinline__ void p0_transpose_item(const float* W, int K, int N, bf16_t* WT, int drow0, int n_src, int k0, LAS float* scr, int lane) {
#pragma unroll 8
    for (int i = 0; i < 32; ++i) { const int kk = 2 * i + (lane >> 5); scr[kk * 33 + (lane & 31)] = W[(size_t)(k0 + kk) * N + n_src + (lane & 31)]; }
    LDS_WAIT(); asm volatile("" ::: "memory");
    const int c = lane & 7;
#pragma unroll
    for (int j = 0; j < 4; ++j) { const int n = (lane >> 3) + 8 * j; const LAS float* s = scr + (8 * c) * 33 + n;
        u32x4 o; o.x = cvt_pk_bf16(s[0 * 33], s[1 * 33]); o.y = cvt_pk_bf16(s[2 * 33], s[3 * 33]); o.z = cvt_pk_bf16(s[4 * 33], s[5 * 33]); o.w = cvt_pk_bf16(s[6 * 33], s[7 * 33]);
        *(u32x4*)(WT + (size_t)(drow0 + n) * K + k0 + 8 * c) = o; }
    LDS_WAIT(); asm volatile("" ::: "memory");
}

__device__ __forceinline__ void p0_prologue(Frame& F) {
    float* misc = F.misc;
    {
        LAS float* sl = (LAS float*)F.lds;
        LAS float* red = (LAS float*)(F.lds + 36864);
        for (int i = F.tid; i < 9 * 1024; i += NTHR) { const int r = i >> 10, k = i & 1023; const float v = (r < 8) ? F.c[r * 1024 + k] : F.c_ctx[k]; sl[i] = v / (1.f + __expf(-v)); }
        __syncthreads();
        const int cc = F.tid & 31, kp = F.tid >> 5;
        const int gcol = F.vcu * 24 + cc;
        float acc[9];
#pragma unroll
        for (int r = 0; r < 9; ++r) acc[r] = 0.f;
        if (cc < 24) {
            const int l = gcol / 3072, col = gcol % 3072;
            const float* w = F.ada_w + (size_t)l * 1024 * 3072 + col;
#pragma unroll 4
            for (int k = kp * 64; k < kp * 64 + 64; ++k) { const float wv = w[(size_t)k * 3072];
#pragma unroll
                for (int r = 0; r < 9; ++r) acc[r] += sl[r * 1024 + k] * wv; }
        }
#pragma unroll
        for (int r = 0; r < 9; ++r) red[(kp * 9 + r) * 32 + cc] = acc[r];
        __syncthreads();
        if (F.tid < 9 * 24) { const int r = F.tid / 24, c2 = F.tid % 24; const int gc = F.vcu * 24 + c2; const int l = gc / 3072, col = gc % 3072;
            float s = F.ada_b[l * 3072 + col];
#pragma unroll
            for (int q = 0; q < 16; ++q) s += red[(q * 9 + r) * 32 + c2];
            misc[MI_MOD + (l * 9 + r) * 3072 + col] = s; }
        __syncthreads();
    }
    if (F.vcu == 0) {
        for (int i = F.tid; i < 1024; i += NTHR) { const int pos = i >> 4, f = i & 15; const float inv = powf(10000.f, -(float)f / 16.f); const float ang = (float)pos * inv;
            misc[MI_CS + i] = cosf(ang); misc[MI_SN + i] = sinf(ang); }
    }
    if (F.vcu == 1) {
        for (int i = F.tid; i < 1024; i += NTHR) { const int dir = i >> 9, ch = i & 511; const float l0 = F.lb_logits[(dir * 2 + 0) * 512 + ch], l1 = F.lb_logits[(dir * 2 + 1) * 512 + ch];
            const float mx = fmaxf(l0, l1); const float e0 = expf(l0 - mx), e1 = expf(l1 - mx); misc[MI_LBV + i] = e0 / (e0 + e1); }
        if (F.tid == 0) {
            float a = 0.f, b = 0.f, gq = 0.f, gk = 0.f;
            for (int i = 0; i < 64; ++i) { a += F.lam_p[i] * F.lam_p[64 + i]; b += F.lam_p[128 + i] * F.lam_p[192 + i]; gq = fmaxf(gq, fabsf(F.qk_gain[i])); gk = fmaxf(gk, fabsf(F.qk_gain[64 + i])); }
            misc[MI_SCAL + 0] = expf(a) - expf(b) + LAM_INIT;
            misc[MI_SCAL + 1] = 8.0f * gq * gk * LOG2E * 1.0001f + 0.01f;
        }
    }
    {
        LAS float* scr = (LAS float*)(F.lds + F.wave * 16384);
        const int gw = F.vcu * NWAVES + F.wave, NGW = F.G * NWAVES;
        constexpr int I0 = 16 * (EIN / 32), I1 = 16 * 32, I2 = 16 * (OIN / 32), I3 = 16 * 32, I4 = 128;
        bf16_t* Wt0 = (bf16_t*)(F.ws + WS_WT0); bf16_t* Wo0 = (bf16_t*)(F.ws + WS_WO0); bf16_t* Wt1 = (bf16_t*)(F.ws + WS_WT1); bf16_t* Wo1 = (bf16_t*)(F.ws + WS_WO1); bf16_t* Wsb = (bf16_t*)(F.ws + WS_WS);
        for (int it = gw; it < I0 + I1 + I2 + I3 + I4; it += NGW) {
            int r = it;
            if (r < I0) { const int kb = r / (EIN / 32), dg = r % (EIN / 32); p0_transpose_item(F.even_w_in, DM, EIN, Wt0, dg * 32, srcmap0(dg * 32), kb * 64, scr, F.lane); continue; } r -= I0;
            if (r < I1) { const int kb = r / 32, dg = r % 32; p0_transpose_item(F.even_w_out, DM, DM, Wo0, dg * 32, dg * 32, kb * 64, scr, F.lane); continue; } r -= I1;
            if (r < I2) { const int kb = r / (OIN / 32), dg = r % (OIN / 32); p0_transpose_item(F.odd_w_in, DM, OIN, Wt1, dg * 32, srcmap1(dg * 32), kb * 64, scr, F.lane); continue; } r -= I2;
            if (r < I3) { const int kb = r / 32, dg = r % 32; p0_transpose_item(F.odd_w_out, DM, DM, Wo1, dg * 32, dg * 32, kb * 64, scr, F.lane); continue; } r -= I3;
            { const int e0 = r * 512 + F.lane * 8; const f32x4 a = *(const f32x4*)(F.w_s + e0), b = *(const f32x4*)(F.w_s + e0 + 4);
              u32x4 o; o.x = cvt_pk_bf16(a.x, a.y); o.y = cvt_pk_bf16(a.z, a.w); o.z = cvt_pk_bf16(b.x, b.y); o.w = cvt_pk_bf16(b.z, b.w); *(u32x4*)(Wsb + e0) = o; }
        }
    }
}

__device__ __forceinline__ void mod_row_to_bf16(const float* xrow, bf16_t* orow, const float* gain, const float* modrow, int lane) {
    const f32x4* xr = (const f32x4*)xrow + lane;
    f32x4 v[4]; float s = 0.f;
#pragma unroll
    for (int j = 0; j < 4; ++j) { v[j] = xr[64 * j]; s += (v[j].x * v[j].x + v[j].y * v[j].y) + (v[j].z * v[j].z + v[j].w * v[j].w); }
    const float rstd = rsqrtf(wave_sum(s) * (1.f / DM) + EPS);
    u32x2* o8 = (u32x2*)orow + lane;
#pragma unroll
    for (int j = 0; j < 4; ++j) {
        const int col = 4 * lane + 256 * j;
        const f32x4 g = *(const f32x4*)(gain + col), sh = *(const f32x4*)(modrow + col), sc = *(const f32x4*)(modrow + 1024 + col);
        const f32x4 o = v[j] * rstd * g * (sc + 1.f) + sh;
        u32x2 w; w.x = cvt_pk_bf16(o.x, o.y); w.y = cvt_pk_bf16(o.z, o.w); o8[64 * j] = w;
    }
}
__device__ __forceinline__ void p0b_phase(Frame& F) {
    const float* misc = F.misc;
    bf16_t* XN = (bf16_t*)(F.ws + WS_XN); bf16_t* CN = (bf16_t*)(F.ws + WS_CN);
    const int gw = F.vcu * NWAVES + F.wave, NGW = F.G * NWAVES;
    for (int m = gw; m < M_TOK + M_CTX; m += NGW) {
        if (m < M_TOK) mod_row_to_bf16(F.x + (size_t)m * DM, XN + (size_t)m * DM, F.norm_gain, misc + MI_MOD + (0 * 9 + (m >> 11)) * 3072, F.lane);
        else { const int mc = m - M_TOK; mod_row_to_bf16(F.ctx + (size_t)mc * DM, CN + (size_t)mc * DM, F.norm_gain, misc + MI_MOD + (0 * 9 + 8) * 3072, F.lane); }
    }
    {
        LAS float* red = (LAS float*)F.lds;
        const int cc = F.tid & 15, kp = F.tid >> 4;
        float acc[8];
#pragma unroll
        for (int b = 0; b < 8; ++b) acc[b] = 0.f;
        if (cc < 14) {
            const int d = F.vcu * 14 + cc; const int src = srcmap1(d & ~31) + (d & 31);
            for (int k = kp * 32; k < kp * 32 + 32; ++k) { const float wv = F.odd_w_in[(size_t)k * OIN + src];
#pragma unroll
                for (int b = 0; b < 8; ++b) acc[b] += misc[MI_MOD + (9 + b) * 3072 + k] * wv; }
        }
        __syncthreads();
#pragma unroll
        for (int b = 0; b < 8; ++b) red[(kp * 8 + b) * 16 + cc] = acc[b];
        __syncthreads();
        if (F.tid < 8 * 14) { const int b = F.tid / 14, c2 = F.tid % 14; float s = 0.f;
            for (int q = 0; q < 32; ++q) s += red[(q * 8 + b) * 16 + c2];
            F.misc[MI_BIAS1 + b * OIN + F.vcu * 14 + c2] = s; }
        __syncthreads();
    }
}

enum { T_Q = 0, T_K = 1, T_SILU = 2, T_PLAIN = 3, T_LF = 4, T_VT = 5 };
struct P1Order {
    int G, c;
    __device__ __forceinline__ bool next(int i, pg8::Unit& u) const {
        const int L = i * G + c;
        const char* wsb = (const char*)kargs()->ws; const char* XN = wsb + WS_XN; const char* CN = wsb + WS_CN; const char* Wt0 = wsb + WS_WT0;
        constexpr size_t TSTEP = (size_t)256 * DM * 2;
        if (L < 896) {
            constexpr int nwg = 896, nN = 14, q = nwg / 8;
            const int xcd = L % 8, offp = L / 8; const int wgid = xcd * q + offp;
            constexpr int nig = 8 * nN; const int gid = wgid / nig, fm = gid * 8;
            u.pm = fm + ((wgid % nig) % 8); u.pn = (wgid % nig) / 8;
            u.a = XN + (size_t)u.pm * TSTEP; u.b = Wt0 + (size_t)u.pn * TSTEP; u.aux = 0;
            u.ty = (u.pn < 2) ? T_Q : (u.pn < 4) ? T_K : (u.pn < 6) ? T_SILU : (u.pn < 8) ? T_PLAIN : (u.pn < 12) ? T_LF : T_SILU;
            return true;
        }
        int r = L - 896;
        if (r < 256) { const int xcd = r % 8, j = r / 8; u.pn = xcd * 8 + j / 4; u.pm = j % 4; u.a = Wt0 + (size_t)(14 + u.pm) * TSTEP; u.b = XN + (size_t)u.pn * TSTEP; u.ty = T_VT; u.aux = 0; return true; }
        r -= 256;
        if (r < 48) { const int pmc = r % 8, j = r / 8; const int pn = (j < 2) ? 2 + j : 6 + j;
            u.pm = pmc; u.pn = pn; u.a = CN + (size_t)pmc * TSTEP; u.b = Wt0 + (size_t)pn * TSTEP; u.aux = 1; u.ty = (pn < 4) ? T_K : T_LF; return true; }
        r -= 48;
        if (r < 32) { u.pn = r % 8; u.pm = r / 8; u.a = Wt0 + (size_t)(14 + u.pm) * TSTEP; u.b = CN + (size_t)u.pn * TSTEP; u.ty = T_VT; u.aux = 1; return true; }
        return false;
    }
};
struct EpiP1 {
    __device__ __forceinline__ void operator()(const f32x4 (&acc)[2][2][4][2], const pg8::Unit& u, int wr, int wc, int fr, int fq, int lane) const {
        KArgsPtr ka = kargs(); unsigned char* wsb = ka->ws; const float* qk_gain = ka->in[9];
        bf16_t* Y = (bf16_t*)(wsb + WS_Y); bf16_t* Kc = (bf16_t*)(wsb + WS_KC); bf16_t* VT = (bf16_t*)(wsb + WS_VT); bf16_t* GA = (bf16_t*)(wsb + WS_GA); bf16_t* HVT = (bf16_t*)(wsb + WS_HVT); bf16_t* GB = (bf16_t*)(wsb + WS_GB);
        unsigned short* LF = (unsigned short*)(wsb + WS_LF); const float* miscp = (const float*)(wsb + WS_MISC); const float* CS = miscp + MI_CS; const float* SN = miscp + MI_SN; const float* LBV = miscp + MI_LBV;
        const int ty = u.ty, ctx = u.aux;
        if (ty == T_Q || ty == T_K) {
            const int seg = 4 * (u.pn & 1) + wc;
            const float* gp = qk_gain + (ty == T_K ? 64 : 0) + 8 * fq;
            const f32x4 g00 = *(const f32x4*)(gp), g01 = *(const f32x4*)(gp + 4), g10 = *(const f32x4*)(gp + 32), g11 = *(const f32x4*)(gp + 36);
            const float osc = (ty == T_Q) ? 0.125f * LOG2E : 1.f;
#pragma unroll
            for (int ai = 0; ai < 2; ++ai)
#pragma unroll
                for (int m = 0; m < 4; ++m) {
                    const int rt = 128 * ai + 64 * wr + 16 * m + fr;
                    const int t = ((u.pm & 7) * 256 + rt);
                    float ss = 0.f;
#pragma unroll
                    for (int bj = 0; bj < 2; ++bj)
#pragma unroll
                        for (int n = 0; n < 2; ++n) { const f32x4 v = acc[ai][bj][m][n]; ss += (v.x * v.x + v.y * v.y) + (v.z * v.z + v.w * v.w); }
                    ss += __shfl_xor(ss, 16); ss += __shfl_xor(ss, 32);
                    const float rstd = rsqrtf(ss * (1.f / 64.f) + EPS);
                    f32x4 a0 = acc[ai][0][m][0] * rstd * g00, a1 = acc[ai][0][m][1] * rstd * g01, b0 = acc[ai][1][m][0] * rstd * g10, b1 = acc[ai][1][m][1] * rstd * g11;
                    if (!ctx) {
                        const int pos = (fq < 2) ? (t >> 6) : (t & 63);
                        const float* cp = CS + pos * 16 + 8 * (fq & 1); const float* sp = SN + pos * 16 + 8 * (fq & 1);
                        const f32x4 c0 = *(const f32x4*)cp, c1 = *(const f32x4*)(cp + 4), s0 = *(const f32x4*)sp, s1 = *(const f32x4*)(sp + 4);
                        const f32x4 o0 = a0 * c0 - b0 * s0, o1 = a1 * c1 - b1 * s1, p0 = a0 * s0 + b0 * c0, p1 = a1 * s1 + b1 * c1;
                        a0 = o0; a1 = o1; b0 = p0; b1 = p1;
                    }
                    a0 = a0 * osc; a1 = a1 * osc; b0 = b0 * osc; b1 = b1 * osc;
                    u32x4 w0, w1;
                    w0.x = cvt_pk_bf16(a0.x, a0.y); w0.y = cvt_pk_bf16(a0.z, a0.w); w0.z = cvt_pk_bf16(a1.x, a1.y); w0.w = cvt_pk_bf16(a1.z, a1.w);
                    w1.x = cvt_pk_bf16(b0.x, b0.y); w1.y = cvt_pk_bf16(b0.z, b0.w); w1.z = cvt_pk_bf16(b1.x, b1.y); w1.w = cvt_pk_bf16(b1.z, b1.w);
                    bf16_t* dst;
                    if (ty == T_Q) dst = Y + (size_t)(u.pm * 256 + rt) * 1024 + seg * 64 + 8 * fq;
                    else if (!ctx) dst = Kc + ((size_t)(u.pm >> 3) * KV + CTX + t) * 512 + seg * 64 + 8 * fq;
                    else dst = Kc + ((size_t)u.pm * KV + rt) * 512 + seg * 64 + 8 * fq;
                    *(u32x4*)dst = w0; *(u32x4*)(dst + 32) = w1;
                }
        } else if (ty == T_SILU || ty == T_PLAIN) {
            bf16_t* base; int pitch;
            if (ty == T_PLAIN) { base = Y + 512 + (u.pn - 6) * 256; pitch = 1024; }
            else if (u.pn < 6) { base = GA + (u.pn - 4) * 256; pitch = 512; }
            else { base = GB + (u.pn - 12) * 256; pitch = 512; }
#pragma unroll
            for (int ai = 0; ai < 2; ++ai)
#pragma unroll
                for (int m = 0; m < 4; ++m) {
                    const int rt = 128 * ai + 64 * wr + 16 * m + fr;
                    bf16_t* rowp = base + (size_t)(u.pm * 256 + rt) * pitch + 32 * wc + 8 * fq;
#pragma unroll
                    for (int bj = 0; bj < 2; ++bj) {
                        f32x4 v0 = acc[ai][bj][m][0], v1 = acc[ai][bj][m][1];
                        if (ty == T_SILU) { v0.x = silu_fast(v0.x); v0.y = silu_fast(v0.y); v0.z = silu_fast(v0.z); v0.w = silu_fast(v0.w); v1.x = silu_fast(v1.x); v1.y = silu_fast(v1.y); v1.z = silu_fast(v1.z); v1.w = silu_fast(v1.w); }
                        u32x4 w; w.x = cvt_pk_bf16(v0.x, v0.y); w.y = cvt_pk_bf16(v0.z, v0.w); w.z = cvt_pk_bf16(v1.x, v1.y); w.w = cvt_pk_bf16(v1.z, v1.w);
                        *(u32x4*)(rowp + 128 * bj) = w;
                    }
                }
        } else if (ty == T_LF) {
            const int dir = (u.pn >= 10) ? 1 : 0; const int pnr = (u.pn - 8) & 1;
            const int col0 = 256 * pnr + 32 * wc + 8 * fq;
            f32x4 lb[2][2];
#pragma unroll
            for (int bj = 0; bj < 2; ++bj)
#pragma unroll
                for (int n = 0; n < 2; ++n) lb[bj][n] = *(const f32x4*)(LBV + dir * 512 + col0 + 128 * bj + 4 * n);
#pragma unroll
            for (int ai = 0; ai < 2; ++ai)
#pragma unroll
                for (int m = 0; m < 4; ++m) {
                    const int rt = 128 * ai + 64 * wr + 16 * m + fr;
                    size_t krow;
                    if (!ctx) krow = ((size_t)(dir * 8 + (u.pm >> 3)) * KV + CTX + (u.pm & 7) * 256 + rt);
                    else krow = ((size_t)(dir * 8 + u.pm) * KV + rt);
                    unsigned short* rowp = LF + krow * 512 + col0;
#pragma unroll
                    for (int bj = 0; bj < 2; ++bj) {
                        float o[8];
#pragma unroll
                        for (int n = 0; n < 2; ++n)
#pragma unroll
                            for (int j = 0; j < 4; ++j) { const float z = acc[ai][bj][m][n][j]; const float l = lb[bj][n][j]; const float f = l + (1.f - l) * __builtin_amdgcn_rcpf(1.f + __expf(-z)); o[4 * n + j] = __logf(f); }
                        u32x4 w; w.x = cvt_pk_f16(o[0], o[1]); w.y = cvt_pk_f16(o[2], o[3]); w.z = cvt_pk_f16(o[4], o[5]); w.w = cvt_pk_f16(o[6], o[7]);
                        *(u32x4*)(rowp + 128 * bj) = w;
                    }
                }
        } else {
#pragma unroll
            for (int ai = 0; ai < 2; ++ai)
#pragma unroll
                for (int m = 0; m < 4; ++m) {
                    const int f = u.pm * 256 + 128 * ai + 64 * wr + 16 * m + fr;
                    bf16_t* base = (f < 512) ? VT : HVT; const int hh = (f & 511) >> 7, dv = f & 127;
                    const int b = ctx ? u.pn : (u.pn >> 3);
                    const int key0 = ctx ? 0 : CTX + (u.pn & 7) * 256;
                    bf16_t* rowp = base + ((size_t)(b * 4 + hh) * 128 + dv) * KV + key0 + 32 * wc + 8 * fq;
#pragma unroll
                    for (int bj = 0; bj < 2; ++bj) {
                        const f32x4 v0 = acc[ai][bj][m][0], v1 = acc[ai][bj][m][1];
                        u32x4 w; w.x = cvt_pk_bf16(v0.x, v0.y); w.y = cvt_pk_bf16(v0.z, v0.w); w.z = cvt_pk_bf16(v1.x, v1.y); w.w = cvt_pk_bf16(v1.z, v1.w);
                        *(u32x4*)(rowp + 128 * bj) = w;
                    }
                }
        }
    }
};
namespace att {
constexpr int NSLOT = 3, SLOTB = 32768, VOFF = 16384, NT = KV / 64;
__device__ __forceinline__ void glds16(const void* gsrc, unsigned lds_dst) {
    unsigned keep;
    asm volatile("s_mov_b32 %0, m0\n\ts_mov_b32 m0, %2\n\ts_nop 0\n\tglobal_load_lds_dwordx4 %1, off\n\ts_mov_b32 m0, %0" : "=&s"(keep) : "v"(gsrc), "s"(lds_dst) : "memory");
}
#define ATT_WAIT_BAR(N) asm volatile("s_waitcnt vmcnt(" #N ") lgkmcnt(0)\n\ts_barrier" ::: "memory")
__device__ __forceinline__ int crow(int r, int hi) { return (r & 3) + 8 * (r >> 2) + 4 * hi; }
#define MFMA32(a, b, c) __builtin_amdgcn_mfma_f32_32x32x16_bf16((a), (b), (c), 0, 0, 0)

__device__ __forceinline__ void attn_unit(int b, int h, int qb, bf16_t* Y, const bf16_t* Kc, const bf16_t* VT, const bf16_t* GA, const float* subln_g,
                                          float lam, float M2, LAS unsigned char* lds, const int wv) {
    const int lane = lane_id(), r32 = lane & 31, hi = lane >> 5;
    const int wid = wv;
    const int m = wid >> 2, qs = wid & 3;
    const unsigned lds0 = (unsigned)(uintptr_t)lds;
    const int tok0 = b * SEQ + qb * 128 + qs * 32;
    const bf16_t* Kb = Kc + (size_t)b * KV * 512 + h * 128;
    const bf16_t* Vb = VT + (size_t)(b * 4 + h) * 128 * KV;
    const bf16_t* ksrc0 = Kb + (size_t)lane * 512 + (2 * wid) * 8;
    const int vrow0 = 16 * wid + (lane >> 3), vrow1 = vrow0 + 8;
    const bf16_t* vsrc0 = Vb + (size_t)vrow0 * KV + 8 * ((lane & 7) ^ ((vrow0 >> 1) & 7));
    const bf16_t* vsrc1 = Vb + (size_t)vrow1 * KV + 8 * ((lane & 7) ^ ((vrow1 >> 1) & 7));
    const unsigned kdst = lds0 + (2 * wid) * 1024, vdst = lds0 + VOFF + (2 * wid) * 1024;
#define ATT_DMA(t, slot) do { const unsigned so_ = (unsigned)(slot) * SLOTB; \
        glds16(ksrc0 + (size_t)(t) * 64 * 512, (unsigned)__builtin_amdgcn_readfirstlane(kdst + so_)); \
        glds16(ksrc0 + (size_t)(t) * 64 * 512 + 8, (unsigned)__builtin_amdgcn_readfirstlane(kdst + so_ + 1024)); \
        glds16(vsrc0 + (size_t)(t) * 64, (unsigned)__builtin_amdgcn_readfirstlane(vdst + so_)); \
        glds16(vsrc1 + (size_t)(t) * 64, (unsigned)__builtin_amdgcn_readfirstlane(vdst + so_ + 1024)); } while (0)
    ATT_DMA(0, 0); ATT_DMA(1, 1);
    bf16x8 qr[4];
    {
        const bf16_t* qp = Y + (size_t)(tok0 + r32) * 1024 + h * 128 + m * 64 + hi * 8;
#pragma unroll
        for (int d0 = 0; d0 < 4; ++d0) qr[d0] = *(const bf16x8*)(qp + d0 * 16);
    }
    const int pi = (r32 & ~12) | ((r32 & 4) << 1) | ((r32 & 8) >> 1);
    const int koff = (8 * m + hi) * 1024 + pi * 16;
    const int swz = (r32 >> 1) & 7;
    int voff[4];
#pragma unroll
    for (int s = 0; s < 4; ++s) voff[s] = VOFF + r32 * 128 + (((2 * s + hi) ^ swz) << 4);
    f32x16 o[4];
#pragma unroll
    for (int i = 0; i < 4; ++i)
#pragma unroll
        for (int r = 0; r < 16; ++r) o[i][r] = 0.f;
    float lsum = 0.f;
    f32x16 negm;
#pragma unroll
    for (int r = 0; r < 16; ++r) negm[r] = -M2;
    int slot = 0, slot2 = 2;
    for (int t = 0; t < NT; ++t) {
        if (t + 1 < NT) ATT_WAIT_BAR(4); else ATT_WAIT_BAR(0);
        if (t + 2 < NT) ATT_DMA(t + 2, slot2);
        const LAS unsigned char* sb = lds + slot * SLOTB;
        f32x16 p0 = negm, p1 = negm;
#pragma unroll
        for (int d0 = 0; d0 < 4; ++d0) {
            const bf16x8 k0 = *(const LAS bf16x8*)(sb + koff + d0 * 2048);
            const bf16x8 k1 = *(const LAS bf16x8*)(sb + koff + d0 * 2048 + 512);
            p0 = MFMA32(k0, qr[d0], p0); p1 = MFMA32(k1, qr[d0], p1);
        }
        float sa = 0.f, sb2 = 0.f;
#pragma unroll
        for (int r = 0; r < 16; ++r) { p0[r] = __builtin_amdgcn_exp2f(p0[r]); p1[r] = __builtin_amdgcn_exp2f(p1[r]); sa += p0[r]; sb2 += p1[r]; }
        lsum += sa + sb2;
        u32x4 pw[4];
#pragma unroll
        for (int s = 0; s < 2; ++s) {
            pw[s] = (u32x4){cvt_pk_bf16(p0[8 * s], p0[8 * s + 1]), cvt_pk_bf16(p0[8 * s + 2], p0[8 * s + 3]), cvt_pk_bf16(p0[8 * s + 4], p0[8 * s + 5]), cvt_pk_bf16(p0[8 * s + 6], p0[8 * s + 7])};
            pw[2 + s] = (u32x4){cvt_pk_bf16(p1[8 * s], p1[8 * s + 1]), cvt_pk_bf16(p1[8 * s + 2], p1[8 * s + 3]), cvt_pk_bf16(p1[8 * s + 4], p1[8 * s + 5]), cvt_pk_bf16(p1[8 * s + 6], p1[8 * s + 7])};
        }
#pragma unroll
        for (int blk = 0; blk < 4; ++blk)
#pragma unroll
            for (int s = 0; s < 4; ++s) {
                const bf16x8 vb = *(const LAS bf16x8*)(sb + voff[s] + blk * 4096);
                o[blk] = MFMA32(__builtin_bit_cast(bf16x8, pw[s]), vb, o[blk]);
            }
        slot = (slot == NSLOT - 1) ? 0 : slot + 1; slot2 = (slot2 == NSLOT - 1) ? 0 : slot2 + 1;
    }
    lsum += __shfl_xor(lsum, 32);
    ATT_WAIT_BAR(0);
    LAS float* wl = (LAS float*)(lds + 98304) + wid * 32;
    LAS float* ex = (LAS float*)lds + qs * 4096;
    if (hi == 0) wl[r32] = lsum;
    LDS_WAIT();
    float rl[16];
#pragma unroll
    for (int r = 0; r < 16; ++r) rl[r] = __builtin_amdgcn_rcpf(wl[crow(r, hi)]) * (m ? lam : 1.f);
    if (m == 1) {
#pragma unroll
        for (int blk = 0; blk < 4; ++blk)
#pragma unroll
            for (int r = 0; r < 16; ++r) ex[crow(r, hi) * 128 + blk * 32 + r32] = o[blk][r] * rl[r];
    }
    ATT_WAIT_BAR(0);
    if (m == 0) {
        float ss[16];
#pragma unroll
        for (int r = 0; r < 16; ++r) ss[r] = 0.f;
#pragma unroll
        for (int blk = 0; blk < 4; ++blk)
#pragma unroll
            for (int r = 0; r < 16; ++r) { const float v = o[blk][r] * rl[r] - ex[crow(r, hi) * 128 + blk * 32 + r32]; o[blk][r] = v; ss[r] += v * v; }
#pragma unroll
        for (int r = 0; r < 16; ++r) {
            float s = ss[r];
            s += __shfl_xor(s, 1); s += __shfl_xor(s, 2); s += __shfl_xor(s, 4); s += __shfl_xor(s, 8); s += __shfl_xor(s, 16);
            ss[r] = rsqrtf(s * (1.f / 128.f) + EPS) * (1.f - LAM_INIT);
        }
#pragma unroll
        for (int blk = 0; blk < 4; ++blk) {
            const float g = subln_g[blk * 32 + r32];
#pragma unroll
            for (int r = 0; r < 16; ++r) {
                const size_t tok = (size_t)(tok0 + crow(r, hi));
                const float ga = bf2f(GA[tok * 512 + h * 128 + blk * 32 + r32]);
                const float v = o[blk][r] * ss[r] * g * ga;
                Y[tok * 1024 + h * 128 + blk * 32 + r32] = (bf16_t)(cvt_pk_bf16(v, 0.f) & 0xffffu);
            }
        }
    }
    ATT_WAIT_BAR(0);
#undef ATT_DMA
}
}
namespace hg {
#define HG_BAR() asm volatile("s_waitcnt vmcnt(0) lgkmcnt(0)\n\ts_barrier" ::: "memory")
#define HG_LBAR() asm volatile("s_waitcnt lgkmcnt(0)\n\ts_barrier" ::: "memory")
__device__ __forceinline__ float h2f(unsigned short h) { return (float)__builtin_bit_cast(_Float16, h); }
__device__ __forceinline__ int crow(int r, int hi) { return (r & 3) + 8 * (r >> 2) + 4 * hi; }
__device__ __forceinline__ int pi32(int x) { return (x & ~12) | ((x & 4) << 1) | ((x & 8) >> 1); }
__device__ __forceinline__ int sw64(int r, int c) { return r * 128 + ((c ^ ((r >> 1) & 7)) << 4); }
__device__ __forceinline__ int sw128(int r, int c) { return r * 256 + ((c ^ (r & 15)) << 4); }

__device__ __forceinline__ void state_chain(int b, int h, int dir, const unsigned short* LF, const bf16_t* HVT, bf16_t* ST, LAS unsigned char* lds, const int wv) {
    const int lane = lane_id(), tid = wv * 64 + lane, r32 = lane & 31, hi = lane >> 5;
    const int wid = wv;
    const int k = tid & 127, part = tid >> 7;
    const int vt = wid & 3, kh = wid >> 2;
    LAS unsigned char* KsT = lds;
    LAS float* dec = (LAS float*)(lds + 32768);
    LAS float* ptot = (LAS float*)(lds + 32768 + 1024);
    const unsigned short* lfb = LF + ((size_t)(dir * 8 + b) * KV) * 512 + h * 128 + k;
    const bf16_t* vb = HVT + ((size_t)(b * 4 + h) * 128 + 32 * vt + r32) * KV + 8 * hi;
    bf16_t* stb = ST + ((size_t)((b * 4 + h) * 2 + dir) * 32) * 16384 + (size_t)(32 * vt + r32) * 128 + 64 * kh + 4 * hi;
    f32x16 S[2];
#pragma unroll
    for (int i = 0; i < 2; ++i)
#pragma unroll
        for (int r = 0; r < 16; ++r) S[i][r] = 0.f;
    unsigned short lfr[16]; bf16x8 bv[4];
    auto ckof = [&](int n) { return dir ? (n < 4 ? 3 - n : 39 - n) : n; };
    {
        const int key0 = 64 * ckof(0);
#pragma unroll
        for (int j = 0; j < 16; ++j) lfr[j] = lfb[(size_t)(key0 + 16 * part + j) * 512];
#pragma unroll
        for (int s = 0; s < 4; ++s) bv[s] = *(const bf16x8*)(vb + key0 + 16 * s);
    }
    for (int n = 0; n < 36; ++n) {
        const int p = n & 1, ck = ckof(n);
        float lfv[16], c[16];
#pragma unroll
        for (int j = 0; j < 16; ++j) lfv[j] = h2f(lfr[j]);
        bf16x8 bcur[4];
#pragma unroll
        for (int s = 0; s < 4; ++s) bcur[s] = bv[s];
        if (n + 1 < 36) {
            const int key1 = 64 * ckof(n + 1);
#pragma unroll
            for (int j = 0; j < 16; ++j) lfr[j] = lfb[(size_t)(key1 + 16 * part + j) * 512];
#pragma unroll
            for (int s = 0; s < 4; ++s) bv[s] = *(const bf16x8*)(vb + key1 + 16 * s);
        }
        if (dir == 0) { float a = 0.f;
#pragma unroll
            for (int j = 0; j < 16; ++j) { a += lfv[j]; c[j] = a; } }
        else { float a = 0.f;
#pragma unroll
            for (int j = 15; j >= 0; --j) { a += lfv[j]; c[j] = a; } }
        const float T = dir ? c[0] : c[15];
        ptot[(p * 4 + part) * 128 + k] = T;
        HG_LBAR();
        float off = 0.f, gtot = 0.f;
#pragma unroll
        for (int q = 0; q < 4; ++q) { const float v = ptot[(p * 4 + q) * 128 + k]; gtot += v; if (dir ? (q > part) : (q < part)) off += v; }
        unsigned w[8];
#pragma unroll
        for (int j = 0; j < 16; j += 2) {
            const float k0 = (1.f - __expf(lfv[j])) * __expf(gtot - (c[j] + off));
            const float k1 = (1.f - __expf(lfv[j + 1])) * __expf(gtot - (c[j + 1] + off));
            w[j >> 1] = cvt_pk_bf16(k0, k1);
        }
        LAS unsigned char* kp = KsT + p * 16384;
        *(LAS u32x4*)(kp + sw64(k, 2 * part)) = (u32x4){w[0], w[1], w[2], w[3]};
        *(LAS u32x4*)(kp + sw64(k, 2 * part + 1)) = (u32x4){w[4], w[5], w[6], w[7]};
        if (part == 0) dec[p * 128 + k] = __expf(gtot);
        HG_LBAR();
        if (ck >= 4) {
            bf16_t* sp = stb + (size_t)(ck - 4) * 16384;
#pragma unroll
            for (int kt = 0; kt < 2; ++kt)
#pragma unroll
                for (int g = 0; g < 4; ++g) {
                    u32x2 o; o.x = cvt_pk_bf16(S[kt][4 * g], S[kt][4 * g + 1]); o.y = cvt_pk_bf16(S[kt][4 * g + 2], S[kt][4 * g + 3]);
                    *(u32x2*)(sp + 32 * kt + 8 * g) = o;
                }
        }
#pragma unroll
        for (int kt = 0; kt < 2; ++kt) {
            const int krow = 32 * (2 * kh + kt);
#pragma unroll
            for (int r = 0; r < 16; ++r) S[kt][r] *= dec[p * 128 + krow + crow(r, hi)];
#pragma unroll
            for (int s = 0; s < 4; ++s) {
                const bf16x8 a = *(const LAS bf16x8*)(kp + sw64(krow + r32, 2 * s + hi));
                S[kt] = __builtin_amdgcn_mfma_f32_32x32x16_bf16(a, bcur[s], S[kt], 0, 0, 0);
            }
        }
    }
    HG_BAR();
}

__device__ __forceinline__ void out_unit(int b, int h, int lc, bf16_t* Y, const unsigned short* LF, const bf16_t* HVT, const bf16_t* ST, const bf16_t* GB, const float* hgrn_g, LAS unsigned char* lds, const int wv) {
    const int lane = lane_id(), tid = wv * 64 + lane, r32 = lane & 31, hi = lane >> 5;
    const int wid = wv;
    const int k = tid & 127, part = tid >> 7;
    const int tb = wid & 1, vt = wid >> 1;
    LAS float* ptot = (LAS float*)(lds + 98304);
    LAS float* ssx = (LAS float*)(lds + 98304 + 4096);
    const int key0 = CTX + 64 * lc;
    const size_t tok0 = (size_t)b * SEQ + 64 * lc;
    float lff[16], lfbw[16], qv[16];
    {
        const unsigned short* pf = LF + ((size_t)(0 * 8 + b) * KV + key0 + 16 * part) * 512 + h * 128 + k;
        const unsigned short* pb = LF + ((size_t)(1 * 8 + b) * KV + key0 + 16 * part) * 512 + h * 128 + k;
        const bf16_t* pq = Y + (tok0 + 16 * part) * 1024 + 512 + h * 128 + k;
#pragma unroll
        for (int j = 0; j < 16; ++j) { lff[j] = h2f(pf[(size_t)j * 512]); lfbw[j] = h2f(pb[(size_t)j * 512]); qv[j] = bf2f(pq[(size_t)j * 1024]); }
    }
    float cf[16], cb[16];
    { float a = 0.f;
#pragma unroll
      for (int j = 0; j < 16; ++j) { a += lff[j]; cf[j] = a; }
      a = 0.f;
#pragma unroll
      for (int j = 15; j >= 0; --j) { a += lfbw[j]; cb[j] = a; } }
    ptot[(0 * 4 + part) * 128 + k] = cf[15];
    ptot[(1 * 4 + part) * 128 + k] = cb[0];
    HG_LBAR();
    float offf = 0.f, offb = 0.f;
    const float pf0 = ptot[0 * 128 + k], pf1 = ptot[1 * 128 + k], pf2 = ptot[2 * 128 + k];
    const float pb1 = ptot[(4 + 1) * 128 + k], pb2 = ptot[(4 + 2) * 128 + k], pb3 = ptot[(4 + 3) * 128 + k];
    offf = (part > 0 ? pf0 : 0.f) + (part > 1 ? pf1 : 0.f) + (part > 2 ? pf2 : 0.f);
    offb = (part < 3 ? pb3 : 0.f) + (part < 2 ? pb2 : 0.f) + (part < 1 ? pb1 : 0.f);
    const float Rf = pf0 + pf1, Rb = pb2 + pb3;
#pragma unroll
    for (int j = 0; j < 16; ++j) {
        const int i = 16 * part + j;
        const float gf = cf[j] + offf, gb = cb[j] + offb;
        const float kf = 1.f - __expf(lff[j]), kb = 1.f - __expf(lfbw[j]);
        const float df = fminf(fmaxf(gf - Rf, -80.f), 80.f), db = fminf(fmaxf(gb - Rb, -80.f), 80.f);
        const float q = qv[j];
        const float v0 = q * __expf(df), v1 = kf * __expf(-df), v2 = q * __expf(gf);
        const float v3 = q * __expf(db), v4 = kb * __expf(-db), v5 = q * __expf(gb);
        const int o = sw128(i, k >> 3) + (k & 7) * 2;
        *(LAS bf16_t*)(lds + 0 * 16384 + o) = (bf16_t)(cvt_pk_bf16(v0, 0.f) & 0xffffu);
        *(LAS bf16_t*)(lds + 1 * 16384 + o) = (bf16_t)(cvt_pk_bf16(v1, 0.f) & 0xffffu);
        *(LAS bf16_t*)(lds + 2 * 16384 + o) = (bf16_t)(cvt_pk_bf16(v2, 0.f) & 0xffffu);
        *(LAS bf16_t*)(lds + 3 * 16384 + o) = (bf16_t)(cvt_pk_bf16(v3, 0.f) & 0xffffu);
        *(LAS bf16_t*)(lds + 4 * 16384 + o) = (bf16_t)(cvt_pk_bf16(v4, 0.f) & 0xffffu);
        *(LAS bf16_t*)(lds + 5 * 16384 + o) = (bf16_t)(cvt_pk_bf16(v5, 0.f) & 0xffffu);
    }
    HG_LBAR();
    f32x16 o;
#pragma unroll
    for (int r = 0; r < 16; ++r) o[r] = 0.f;
    const bf16_t* vtp = HVT + ((size_t)(b * 4 + h) * 128 + 32 * vt + r32) * KV + key0 + 8 * hi;
    const int trow = 32 * tb + r32;
#pragma unroll
    for (int dir = 0; dir < 2; ++dir) {
        const LAS unsigned char* Qx = lds + (3 * dir + 0) * 16384; const LAS unsigned char* Kx = lds + (3 * dir + 1) * 16384; const LAS unsigned char* Qs = lds + (3 * dir + 2) * 16384;
        for (int sb = 0; sb < 2; ++sb) {
            const bool use = dir ? (sb >= tb) : (sb <= tb);
            if (!use) continue;
            f32x16 at;
#pragma unroll
            for (int r = 0; r < 16; ++r) at[r] = 0.f;
            const int srow = 32 * sb + pi32(r32);
#pragma unroll
            for (int ks = 0; ks < 8; ++ks) {
                const bf16x8 a = *(const LAS bf16x8*)(Kx + sw128(srow, 2 * ks + hi));
                const bf16x8 bq = *(const LAS bf16x8*)(Qx + sw128(trow, 2 * ks + hi));
                at = __builtin_amdgcn_mfma_f32_32x32x16_bf16(a, bq, at, 0, 0, 0);
            }
            if (sb == tb) {
#pragma unroll
                for (int r = 0; r < 16; ++r) { const int sl = 16 * (r >> 3) + 8 * hi + (r & 7); const bool keep = dir ? (sl >= r32) : (sl <= r32); at[r] = keep ? at[r] : 0.f; }
            }
#pragma unroll
            for (int s2 = 0; s2 < 2; ++s2) {
                const u32x4 pw = (u32x4){cvt_pk_bf16(at[8 * s2], at[8 * s2 + 1]), cvt_pk_bf16(at[8 * s2 + 2], at[8 * s2 + 3]), cvt_pk_bf16(at[8 * s2 + 4], at[8 * s2 + 5]), cvt_pk_bf16(at[8 * s2 + 6], at[8 * s2 + 7])};
                const bf16x8 va = *(const bf16x8*)(vtp + 32 * sb + 16 * s2);
                o = __builtin_amdgcn_mfma_f32_32x32x16_bf16(va, __builtin_bit_cast(bf16x8, pw), o, 0, 0, 0);
            }
        }
        const bf16_t* stp = ST + ((size_t)((b * 4 + h) * 2 + dir) * 32 + lc) * 16384 + (size_t)(32 * vt + r32) * 128 + 8 * hi;
#pragma unroll
        for (int ks = 0; ks < 8; ++ks) {
            const bf16x8 a = *(const bf16x8*)(stp + 16 * ks);
            const bf16x8 bq = *(const LAS bf16x8*)(Qs + sw128(trow, 2 * ks + hi));
            o = __builtin_amdgcn_mfma_f32_32x32x16_bf16(a, bq, o, 0, 0, 0);
        }
    }
    float ss = 0.f;
#pragma unroll
    for (int r = 0; r < 16; ++r) ss += o[r] * o[r];
    ss += __shfl_xor(ss, 32);
    if (hi == 0) ssx[vt * 64 + trow] = ss;
    HG_LBAR();
    const float tot = ssx[trow] + ssx[64 + trow] + ssx[128 + trow] + ssx[192 + trow];
    const float rstd = rsqrtf(tot * (1.f / 128.f) + EPS);
    const size_t tok = tok0 + trow;
#pragma unroll
    for (int g = 0; g < 4; ++g) {
        const int v = 32 * vt + 8 * g + 4 * hi;
        const f32x4 gn = *(const f32x4*)(hgrn_g + v);
        const u32x2 gb2 = *(const u32x2*)(GB + tok * 512 + h * 128 + v);
        u32x2 w;
        w.x = cvt_pk_bf16(o[4 * g] * rstd * gn.x * bflo(gb2.x), o[4 * g + 1] * rstd * gn.y * bfhi(gb2.x));
        w.y = cvt_pk_bf16(o[4 * g + 2] * rstd * gn.z * bflo(gb2.y), o[4 * g + 3] * rstd * gn.w * bfhi(gb2.y));
        *(u32x2*)(Y + tok * 1024 + 512 + h * 128 + v) = w;
    }
    HG_BAR();
}
}
template <size_t OFFA, size_t OFFB> struct OutOrder {
    int G, c;
    __device__ __forceinline__ bool next(int i, pg8::Unit& u) const {
        const int L = i * G + c; if (L >= 256) return false;
        const char* wsb = (const char*)kargs()->ws; const char* A = wsb + OFFA; const char* Bt = wsb + OFFB;
        constexpr size_t TSTEP = (size_t)256 * DM * 2;
        const int xcd = L % 8, offp = L / 8; const int wgid = xcd * 32 + offp;
        u.pm = xcd * 8 + (wgid % 32) % 8; u.pn = (wgid % 32) / 8; u.a = A + (size_t)u.pm * TSTEP; u.b = Bt + (size_t)u.pn * TSTEP; u.ty = 0; u.aux = 0; return true;
    }
};
struct EpiP4 {
    __device__ __forceinline__ void operator()(const f32x4 (&acc)[2][2][4][2], const pg8::Unit& u, int wr, int wc, int fr, int fq, int lane) const {
        KArgsPtr ka = kargs(); unsigned char* wsb = ka->ws; const float* x = ka->in[0]; float* x1 = ka->out; const float* gain1 = ka->in[4] + 1024;
        bf16_t* A1 = (bf16_t*)(wsb + WS_A1); float* SSQ1 = (float*)(wsb + WS_SSQ1); const float* mod = (const float*)(wsb + WS_MISC) + MI_MOD;
        const int b = u.pm >> 3;
        const int col0 = 256 * u.pn + 32 * wc + 8 * fq;
        f32x4 gt[2][2], gm[2][2];
#pragma unroll
        for (int bj = 0; bj < 2; ++bj)
#pragma unroll
            for (int n = 0; n < 2; ++n) { const int c = col0 + 128 * bj + 4 * n;
                gt[bj][n] = *(const f32x4*)(mod + (0 * 9 + b) * 3072 + 2048 + c);
                gm[bj][n] = *(const f32x4*)(gain1 + c) * (*(const f32x4*)(mod + (9 + b) * 3072 + 1024 + c) + 1.f); }
#pragma unroll
        for (int ai = 0; ai < 2; ++ai)
#pragma unroll
            for (int m = 0; m < 4; ++m) {
                const size_t row = (size_t)u.pm * 256 + 128 * ai + 64 * wr + 16 * m + fr;
                float ss = 0.f;
#pragma unroll
                for (int bj = 0; bj < 2; ++bj) {
                    const size_t o = row * 1024 + col0 + 128 * bj;
                    const f32x4 xa = *(const f32x4*)(x + o), xb = *(const f32x4*)(x + o + 4);
                    const f32x4 v0 = xa + gt[bj][0] * acc[ai][bj][m][0], v1 = xb + gt[bj][1] * acc[ai][bj][m][1];
                    *(f32x4*)(x1 + o) = v0; *(f32x4*)(x1 + o + 4) = v1;
                    ss += (v0.x * v0.x + v0.y * v0.y) + (v0.z * v0.z + v0.w * v0.w) + (v1.x * v1.x + v1.y * v1.y) + (v1.z * v1.z + v1.w * v1.w);
                    const f32x4 a0 = v0 * gm[bj][0], a1 = v1 * gm[bj][1];
                    u32x4 w; w.x = cvt_pk_bf16(a0.x, a0.y); w.y = cvt_pk_bf16(a0.z, a0.w); w.z = cvt_pk_bf16(a1.x, a1.y); w.w = cvt_pk_bf16(a1.z, a1.w);
                    *(u32x4*)(A1 + o) = w;
                }
                ss += __shfl_xor(ss, 16); ss += __shfl_xor(ss, 32);
                if (fq == 0) SSQ1[row * 16 + u.pn * 4 + wc] = ss;
            }
    }
};
struct EpiP7 {
    __device__ __forceinline__ void operator()(const f32x4 (&acc)[2][2][4][2], const pg8::Unit& u, int wr, int wc, int fr, int fq, int lane) const {
        KArgsPtr ka = kargs(); float* x1 = ka->out; const float* mod = (const float*)(ka->ws + WS_MISC) + MI_MOD;
        const int b = u.pm >> 3;
        const int col0 = 256 * u.pn + 32 * wc + 8 * fq;
        f32x4 gt[2][2];
#pragma unroll
        for (int bj = 0; bj < 2; ++bj)
#pragma unroll
            for (int n = 0; n < 2; ++n) gt[bj][n] = *(const f32x4*)(mod + (9 + b) * 3072 + 2048 + col0 + 128 * bj + 4 * n);
#pragma unroll
        for (int ai = 0; ai < 2; ++ai)
#pragma unroll
            for (int m = 0; m < 4; ++m) {
                const size_t row = (size_t)u.pm * 256 + 128 * ai + 64 * wr + 16 * m + fr;
#pragma unroll
                for (int bj = 0; bj < 2; ++bj) {
                    const size_t o = row * 1024 + col0 + 128 * bj;
                    const f32x4 xa = *(const f32x4*)(x1 + o), xb = *(const f32x4*)(x1 + o + 4);
                    *(f32x4*)(x1 + o) = xa + gt[bj][0] * acc[ai][bj][m][0]; *(f32x4*)(x1 + o + 4) = xb + gt[bj][1] * acc[ai][bj][m][1];
                }
            }
    }
};

struct P5Order {
    int G, c;
    __device__ __forceinline__ bool next(int i, pg8::Unit& u) const {
        const int L = i * G + c;
        const char* wsb = (const char*)kargs()->ws; const char* A1 = wsb + WS_A1; const char* Wt1 = wsb + WS_WT1;
        constexpr size_t TSTEP = (size_t)256 * DM * 2;
        if (L < 768) {
            const int xcd = L % 8, offp = L / 8; const int wgid = xcd * 96 + offp;
            u.pm = xcd * 8 + (wgid % 96) % 8; u.pn = (wgid % 96) / 8; u.a = A1 + (size_t)u.pm * TSTEP; u.b = Wt1 + (size_t)u.pn * TSTEP; u.ty = 0; u.aux = 0; return true;
        }
        const int r = L - 768;
        if (r < 128) { const int xcd = r % 8, j = r / 8; u.pn = xcd * 8 + j / 2; u.pm = j % 2; u.a = Wt1 + (size_t)(12 + u.pm) * TSTEP; u.b = A1 + (size_t)u.pn * TSTEP; u.ty = 1; u.aux = 0; return true; }
        return false;
    }
};
__device__ __forceinline__ float gelu_as(float v) {
    const float av = fabsf(v), t = __builtin_amdgcn_rcpf(av * 0.2316418882f + 1.0f);
    float q = t * 0.5307027145f + (-0.7265760135f); q = q * t + 0.7107068705f; q = q * t + (-0.142248368f); q = q * t + 0.127414796f; q = q * t;
    const float e = __builtin_amdgcn_exp2f((v * v) * (-0.72134752044f));
    const float mm = v * (q * e);
    return v < 0.f ? mm : v - mm;
}
__device__ __forceinline__ float rstd16(const float* SSQ1, size_t row) {
    const f32x4* p = (const f32x4*)(SSQ1 + row * 16);
    const f32x4 a = p[0], b = p[1], c = p[2], d = p[3];
    const float s = ((a.x + a.y) + (a.z + a.w)) + ((b.x + b.y) + (b.z + b.w)) + ((c.x + c.y) + (c.z + c.w)) + ((d.x + d.y) + (d.z + d.w));
    return rsqrtf(s * (1.f / 1024.f) + EPS);
}
struct EpiP5 {
    __device__ __forceinline__ void operator()(const f32x4 (&acc)[2][2][4][2], const pg8::Unit& u, int wr, int wc, int fr, int fq, int lane) const {
        unsigned char* wsb = kargs()->ws; bf16_t* UG = (bf16_t*)(wsb + WS_UG); bf16_t* GVT = (bf16_t*)(wsb + WS_GVT); float* GVSSQ = (float*)(wsb + WS_GVSSQ);
        const float* ssq1 = (const float*)(wsb + WS_SSQ1); const float* bias1 = (const float*)(wsb + WS_MISC) + MI_BIAS1;
        if (u.ty == 0) {
            const int b = u.pm >> 3;
            const int kind = u.pn >> 2, pq = u.pn & 3;
            const float* bp = bias1 + b * OIN + 256 * u.pn + 32 * wc + 8 * fq;
            bf16_t* base = UG + (size_t)kind * (8u << 20) + 128 * pq + 32 * wc + 8 * fq;
#pragma unroll
            for (int ai = 0; ai < 2; ++ai)
#pragma unroll
                for (int m = 0; m < 4; ++m) {
                    const size_t row = (size_t)u.pm * 256 + 128 * ai + 64 * wr + 16 * m + fr;
                    float rs = rstd16(ssq1, row); asm volatile("" : "+v"(rs));
                    const f32x4 b00 = *(const f32x4*)(bp), b01 = *(const f32x4*)(bp + 4), b10 = *(const f32x4*)(bp + 128), b11 = *(const f32x4*)(bp + 132);
                    const f32x4 p0 = acc[ai][0][m][0] * rs + b00, p1 = acc[ai][0][m][1] * rs + b01, q0 = acc[ai][1][m][0] * rs + b10, q1 = acc[ai][1][m][1] * rs + b11;
                    float o[8];
#pragma unroll
                    for (int j = 0; j < 4; ++j) {
                        if (kind == 0) { o[j] = gelu_as(p0[j]) * silu_fast(q0[j]); o[4 + j] = gelu_as(p1[j]) * silu_fast(q1[j]); }
                        else if (kind == 1) { o[j] = p0[j] * silu_fast(q0[j]); o[4 + j] = p1[j] * silu_fast(q1[j]); }
                        else { o[j] = p0[j] * q0[j]; o[4 + j] = p1[j] * q1[j]; }
                    }
                    u32x4 w; w.x = cvt_pk_bf16(o[0], o[1]); w.y = cvt_pk_bf16(o[2], o[3]); w.z = cvt_pk_bf16(o[4], o[5]); w.w = cvt_pk_bf16(o[6], o[7]);
                    *(u32x4*)(base + row * 512) = w;
                    __builtin_amdgcn_sched_barrier(0);
                }
        } else {
            const int b = u.pn >> 3;
#pragma unroll
            for (int bj = 0; bj < 2; ++bj) {
                int opq = 0; asm volatile("" : "+s"(opq));
                const size_t tokc = (size_t)u.pn * 256 + 128 * bj + 32 * wc + 8 * fq + opq;
                float rs[8], gs[8];
#pragma unroll
                for (int e = 0; e < 8; ++e) { rs[e] = rstd16(ssq1, tokc + e); gs[e] = 0.f; asm volatile("" : "+v"(rs[e])); __builtin_amdgcn_sched_barrier(0); }
#pragma unroll
                for (int ai = 0; ai < 2; ++ai)
#pragma unroll
                    for (int m = 0; m < 4; ++m) {
                        const int f = u.pm * 256 + 128 * ai + 64 * wr + 16 * m + fr + opq;
                        const float bias = bias1[b * OIN + 3072 + f];
                        bf16_t* rowp = GVT + ((size_t)(b * 4 + (f >> 7)) * 128 + (f & 127)) * SEQ + (u.pn & 7) * 256 + 128 * bj + 32 * wc + 8 * fq;
                        float o[8];
#pragma unroll
                        for (int n = 0; n < 2; ++n)
#pragma unroll
                            for (int j = 0; j < 4; ++j) { const float gv = gelu_as(acc[ai][bj][m][n][j] * rs[4 * n + j] + bias); o[4 * n + j] = gv; gs[4 * n + j] += gv * gv; }
                        u32x4 w; w.x = cvt_pk_bf16(o[0], o[1]); w.y = cvt_pk_bf16(o[2], o[3]); w.z = cvt_pk_bf16(o[4], o[5]); w.w = cvt_pk_bf16(o[6], o[7]);
                        *(u32x4*)(rowp) = w;
                        __builtin_amdgcn_sched_barrier(0);
                    }
#pragma unroll
                for (int e = 0; e < 8; ++e) {
                    float s = gs[e];
                    s += __shfl_xor(s, 1); s += __shfl_xor(s, 2); s += __shfl_xor(s, 4); s += __shfl_xor(s, 8);
                    if (fr == 0) GVSSQ[(tokc + e) * 4 + u.pm * 2 + wr] = s;
                    __builtin_amdgcn_sched_barrier(0);
                }
            }
        }
    }
};

__device__ __forceinline__ void gmlp_unit(int b, int ch, int g, const bf16_t* GVT, const float* GVSSQ, const bf16_t* Wsb, const bf16_t* UG, const float* v_g, const float* b_s, bf16_t* Y1, LAS unsigned char* lds, const int wv) {
    const int lane = lane_id(), tid = wv * 64 + lane, r32 = lane & 31, hi = lane >> 5;
    const int wid = wv;
    const int dt = wid & 3, th = wid >> 2;
    LAS float* rsd = (LAS float*)lds;
    const size_t tokc = (size_t)b * SEQ + ch * 128;
    if (tid < 128) { const f32x4 p = *(const f32x4*)(GVSSQ + (tokc + tid) * 4); rsd[tid] = rsqrtf(((p.x + p.y) + (p.z + p.w)) * (1.f / 512.f) + EPS); }
    asm volatile("s_waitcnt lgkmcnt(0)\n\ts_barrier" ::: "memory");
    f32x16 acc[2];
#pragma unroll
    for (int i = 0; i < 2; ++i)
#pragma unroll
        for (int r = 0; r < 16; ++r) acc[i][r] = 0.f;
    const bf16_t* ap = GVT + ((size_t)(b * 4 + g) * 128 + 32 * dt + r32) * SEQ + ch * 128 + 8 * hi;
#pragma unroll
    for (int ks = 0; ks < 8; ++ks) {
        const bf16x8 a = *(const bf16x8*)(ap + 16 * ks);
        const f32x4 r0 = *(const LAS f32x4*)(rsd + 16 * ks + 8 * hi), r1 = *(const LAS f32x4*)(rsd + 16 * ks + 8 * hi + 4);
#pragma unroll
        for (int tt = 0; tt < 2; ++tt) {
            const int t = 32 * (2 * th + tt) + r32;
            const u32x4 wv = *(const u32x4*)(Wsb + ((size_t)g * 128 + t) * 128 + 16 * ks + 8 * hi);
            u32x4 ws2;
            ws2.x = cvt_pk_bf16(bflo(wv.x) * r0.x, bfhi(wv.x) * r0.y); ws2.y = cvt_pk_bf16(bflo(wv.y) * r0.z, bfhi(wv.y) * r0.w);
            ws2.z = cvt_pk_bf16(bflo(wv.z) * r1.x, bfhi(wv.z) * r1.y); ws2.w = cvt_pk_bf16(bflo(wv.w) * r1.z, bfhi(wv.w) * r1.w);
            acc[tt] = __builtin_amdgcn_mfma_f32_32x32x16_bf16(a, __builtin_bit_cast(bf16x8, ws2), acc[tt], 0, 0, 0);
        }
    }
#pragma unroll
    for (int tt = 0; tt < 2; ++tt) {
        const int t = 32 * (2 * th + tt) + r32;
        const size_t tok = tokc + t;
        const float bs = b_s[g * 128 + t];
#pragma unroll
        for (int q = 0; q < 4; ++q) {
            const int d = 32 * dt + 8 * q + 4 * hi;
            const f32x4 vg = *(const f32x4*)(v_g + g * 128 + d);
            const u32x2 ug = *(const u32x2*)(UG + tok * 512 + g * 128 + d);
            u32x2 w;
            w.x = cvt_pk_bf16(bflo(ug.x) * (vg.x * acc[tt][4 * q] + bs), bfhi(ug.x) * (vg.y * acc[tt][4 * q + 1] + bs));
            w.y = cvt_pk_bf16(bflo(ug.y) * (vg.z * acc[tt][4 * q + 2] + bs), bfhi(ug.y) * (vg.w * acc[tt][4 * q + 3] + bs));
            *(u32x2*)(Y1 + tok * 1024 + g * 128 + d) = w;
        }
    }
    asm volatile("s_waitcnt lgkmcnt(0)\n\ts_barrier" ::: "memory");
}
__device__ __forceinline__ void conv_rows(int row0, const bf16_t* BG, const bf16_t* CH, const float* conv_w, bf16_t* Y1, int lane) {
    float w[3][8];
#pragma unroll
    for (int j = 0; j < 3; ++j) { const f32x4 a = *(const f32x4*)(conv_w + j * 512 + 8 * lane), bq = *(const f32x4*)(conv_w + j * 512 + 8 * lane + 4);
        w[j][0] = a.x; w[j][1] = a.y; w[j][2] = a.z; w[j][3] = a.w; w[j][4] = bq.x; w[j][5] = bq.y; w[j][6] = bq.z; w[j][7] = bq.w; }
    const u32x4 zero = (u32x4){0u, 0u, 0u, 0u};
    u32x4 prev = ((row0 & 2047) == 0) ? zero : *(const u32x4*)(CH + (size_t)(row0 - 1) * 512 + 8 * lane);
    u32x4 cur = *(const u32x4*)(CH + (size_t)row0 * 512 + 8 * lane);
#pragma unroll
    for (int i = 0; i < 8; ++i) {
        const int row = row0 + i;
        const u32x4 nxt = ((row & 2047) == 2047) ? zero : *(const u32x4*)(CH + (size_t)(row + 1) * 512 + 8 * lane);
        const u32x4 bg = *(const u32x4*)(BG + (size_t)row * 512 + 8 * lane);
        float o[8];
#pragma unroll
        for (int e = 0; e < 4; ++e) {
            const unsigned pw = prev[e], cw = cur[e], nw = nxt[e], bw = bg[e];
            o[2 * e] = bflo(bw) * (w[0][2 * e] * bflo(pw) + w[1][2 * e] * bflo(cw) + w[2][2 * e] * bflo(nw));
            o[2 * e + 1] = bfhi(bw) * (w[0][2 * e + 1] * bfhi(pw) + w[1][2 * e + 1] * bfhi(cw) + w[2][2 * e + 1] * bfhi(nw));
        }
        u32x4 wv; wv.x = cvt_pk_bf16(o[0], o[1]); wv.y = cvt_pk_bf16(o[2], o[3]); wv.z = cvt_pk_bf16(o[4], o[5]); wv.w = cvt_pk_bf16(o[6], o[7]);
        *(u32x4*)(Y1 + (size_t)row * 1024 + 512 + 8 * lane) = wv;
        prev = cur; cur = nxt;
    }
}
#ifndef DIAG
#define DIAG 0
#endif
constexpr int N_PHASES = 9;

__global__ void __launch_bounds__(NTHR, 2) mk_fwd(Args args) {
    extern __shared__ __attribute__((aligned(16))) unsigned char lds_raw[];
    Frame F;
#define FRAME_LOAD() do { KArgsPtr ka_ = kargs(); \
    F.lds = (LAS unsigned char*)lds_raw; F.MISC = (volatile LAS unsigned*)(F.lds + LDSCTL_OFF); \
    F.wave = wave0; F.lane = lane_id(); F.tid = wave0 * 64 + F.lane; \
    F.G = gridDim.x; { const int bx = blockIdx.x; F.vcu = (F.G % 8 == 0) ? (bx % 8) * (F.G / 8) + bx / 8 : bx; } \
    F.ws = ka_->ws; F.ctl = (unsigned*)(F.ws + WS_CTL); F.misc = (float*)(F.ws + WS_MISC); F.out = ka_->out; \
    F.x = ka_->in[0]; F.c = ka_->in[1]; F.ctx = ka_->in[2]; F.c_ctx = ka_->in[3]; F.norm_gain = ka_->in[4]; F.ada_w = ka_->in[5]; F.ada_b = ka_->in[6]; \
    F.even_w_in = ka_->in[7]; F.even_w_out = ka_->in[8]; F.qk_gain = ka_->in[9]; F.lam_p = ka_->in[10]; F.subln_g = ka_->in[11]; F.lb_logits = ka_->in[12]; F.hgrn_g = ka_->in[13]; \
    F.odd_w_in = ka_->in[14]; F.odd_w_out = ka_->in[15]; F.v_g = ka_->in[16]; F.w_s = ka_->in[17]; F.b_s = ka_->in[18]; F.conv_w = ka_->in[19]; } while (0)
    const int wave0 = __builtin_amdgcn_readfirstlane(threadIdx.x >> 6);
    FRAME_LOAD();
    for (int u = F.tid; u < (LDS_BYTES - LDSCTL_OFF) / 4; u += NTHR) ((LAS unsigned*)(F.lds + LDSCTL_OFF))[u] = 0u;
    __syncthreads();
    XcdBarrier bar = xcd_barrier_post(F.ctl + CW_BAR, F.MISC + 8, F.tid);
    const int lo = args.ph_lo, hi = args.ph_hi;
#define IN(k) (lo <= (k) && (k) < hi)
#define BOTH(k) (IN(k) && IN((k) + 1))
#define GRID_BAR() xcd_barrier(bar, wave0 * 64 + lane_id())
    unsigned char* ws;

    if (IN(0)) { FRAME_LOAD(); p0_prologue(F); if (BOTH(0)) GRID_BAR(); }
    if (IN(1)) { FRAME_LOAD(); p0b_phase(F); if (BOTH(1)) GRID_BAR(); }
    if (IN(2)) {
        FRAME_LOAD(); ws = F.ws;
        P1Order S{F.G, (int)blockIdx.x}; EpiP1 E;
        pg8::gemm_phase<EpiP1, P1Order>(F.lds, DM, S, E, wave0);
        if (BOTH(2)) GRID_BAR();
    }
    if (IN(3)) {
        FRAME_LOAD(); ws = F.ws;
        const int g = blockIdx.x & 7;
        const float lam = __uint_as_float(__hip_atomic_load((unsigned*)(F.misc + MI_SCAL), __ATOMIC_RELAXED, __HIP_MEMORY_SCOPE_AGENT));
        const float M2 = __uint_as_float(__hip_atomic_load((unsigned*)(F.misc + MI_SCAL + 1), __ATOMIC_RELAXED, __HIP_MEMORY_SCOPE_AGENT));
        for (;;) {
            if (F.tid == 0) F.MISC[16] = __hip_atomic_fetch_add(F.ctl + CW_QUEUE + 64 * g, 1u, __ATOMIC_RELAXED, __HIP_MEMORY_SCOPE_AGENT);
            __syncthreads();
            const int idx = (int)F.MISC[16];
            __syncthreads();
            if (idx >= 72) break;
            if (idx < 8) {
                const int cch = g * 8 + idx;
                hg::state_chain(cch >> 3, (cch >> 1) & 3, cch & 1, (const unsigned short*)(ws + WS_LF), (const bf16_t*)(ws + WS_HVT), (bf16_t*)(ws + WS_ST), F.lds, wave0);
            } else {
                const int j = idx - 8; const int pair = g + 8 * (j >> 4), qb = j & 15;
                att::attn_unit(pair >> 2, pair & 3, qb, (bf16_t*)(ws + WS_Y), (const bf16_t*)(ws + WS_KC), (const bf16_t*)(ws + WS_VT), (const bf16_t*)(ws + WS_GA), F.subln_g, lam, M2, F.lds, wave0);
            }
        }
        if (BOTH(3)) GRID_BAR();
    }
    if (IN(4)) {
        FRAME_LOAD(); ws = F.ws;
        for (int u = F.vcu; u < 1024; u += F.G) {
            const int lc = u & 31, bh = u >> 5;
            hg::out_unit(bh >> 2, bh & 3, lc, (bf16_t*)(ws + WS_Y), (const unsigned short*)(ws + WS_LF), (const bf16_t*)(ws + WS_HVT), (const bf16_t*)(ws + WS_ST), (const bf16_t*)(ws + WS_GB), F.hgrn_g, F.lds, wave0);
        }
        if (BOTH(4)) GRID_BAR();
    }
    if (IN(5)) {
        FRAME_LOAD(); ws = F.ws;
        OutOrder<WS_Y, WS_WO0> S{F.G, (int)blockIdx.x}; EpiP4 E;
        pg8::gemm_phase<EpiP4, OutOrder<WS_Y, WS_WO0>>(F.lds, DM, S, E, wave0);
        if (BOTH(5)) GRID_BAR();
    }
    if (IN(6)) {
        FRAME_LOAD(); ws = F.ws;
        P5Order S{F.G, (int)blockIdx.x}; EpiP5 E;
        pg8::gemm_phase<EpiP5, P5Order>(F.lds, DM, S, E, wave0);
        if (BOTH(6)) GRID_BAR();
    }
    if (IN(7)) {
        FRAME_LOAD(); ws = F.ws;
        for (int u = F.vcu; u < 512; u += F.G) {
            const int g = u & 3, ch = (u >> 2) & 15, b = u >> 6;
            gmlp_unit(b, ch, g, (const bf16_t*)(ws + WS_GVT), (const float*)(ws + WS_GVSSQ), (const bf16_t*)(ws + WS_WS), (const bf16_t*)(ws + WS_UG), F.v_g, F.b_s, (bf16_t*)(ws + WS_Y), F.lds, wave0);
        }
        conv_rows((F.vcu * NWAVES + F.wave) * 8, (const bf16_t*)(ws + WS_BG), (const bf16_t*)(ws + WS_CH), F.conv_w, (bf16_t*)(ws + WS_Y), F.lane);
        if (BOTH(7)) GRID_BAR();
    }
    if (IN(8)) {
        FRAME_LOAD(); ws = F.ws;
        OutOrder<WS_Y, WS_WO1> S{F.G, (int)blockIdx.x}; EpiP7 E;
        pg8::gemm_phase<EpiP7, OutOrder<WS_Y, WS_WO1>>(F.lds, DM, S, E, wave0);
    }
#undef IN
#undef BOTH
}

#if DIAG

#endif

extern "C" void kernel_launch(void* const* d_in, const int* in_sizes, int n_in, void* d_out, int out_size, void* d_ws, size_t ws_size, hipStream_t stream) {
    static int grid = 0;
    if (grid == 0) {
        int dev = 0, cus = 0;
        if (hipGetDevice(&dev) != hipSuccess || hipDeviceGetAttribute(&cus, hipDeviceAttributeMultiprocessorCount, dev) != hipSuccess) { fprintf(stderr, "kernel_launch: device query failed\n"); grid = -1; return; }
        if (hipFuncSetAttribute((const void*)mk_fwd, hipFuncAttributeMaxDynamicSharedMemorySize, LDS_BYTES) != hipSuccess) { fprintf(stderr, "kernel_launch: hipFuncSetAttribute failed\n"); grid = -1; return; }
        int per_cu = 0;
        if (hipOccupancyMaxActiveBlocksPerMultiprocessor(&per_cu, (const void*)mk_fwd, NTHR, LDS_BYTES) != hipSuccess || per_cu < 1) { fprintf(stderr, "kernel_launch: occupancy query says %d blocks/CU\n", per_cu); }
        (void)hipGetLastError();
        grid = cus;
        if (ws_size < WS_END) { fprintf(stderr, "kernel_launch: workspace too small\n"); grid = -1; return; }
    }
    if (grid < 0) return;
    (void)hipMemsetAsync((char*)d_ws + WS_CTL, 0, CTL_ZERO_BYTES, stream);
    Args a{};
    for (int i = 0; i < 20; ++i) a.in[i] = (const float*)d_in[i];
    a.out = (float*)d_out; a.ws = (unsigned char*)d_ws;
#if DIAG
    diag_launch(a, grid, d_in, d_out, d_ws, stream);
#else
    a.ph_lo = 0; a.ph_hi = N_PHASES;
    hipLaunchKernelGGL(mk_fwd, dim3(grid), dim3(NTHR), LDS_BYTES, stream, a);
#endif
}
```

```cpp
#define DIAG 0
#define DSEL -1
#include <hip/hip_runtime.h>
#include <math.h>
#include <stdint.h>
#include <cstdio>

#define LAS __attribute__((address_space(3)))
#define GAS __attribute__((address_space(1)))
typedef unsigned short bf16_t;
typedef short bf16x8 __attribute__((ext_vector_type(8)));
typedef short s16x4 __attribute__((ext_vector_type(4)));
typedef float f32x2 __attribute__((ext_vector_type(2)));
typedef float f32x4 __attribute__((ext_vector_type(4)));
typedef float f32x16 __attribute__((ext_vector_type(16)));
typedef unsigned u32x2 __attribute__((ext_vector_type(2)));
typedef unsigned u32x4 __attribute__((ext_vector_type(4)));
typedef _Float16 f16x2_t __attribute__((ext_vector_type(2)));
typedef __bf16 bf16x2_t __attribute__((ext_vector_type(2)));

constexpr int DM = 1024, NB = 8, SEQ = 2048, CTX = 256, KV = SEQ + CTX  , M_TOK = NB * SEQ  , M_CTX = NB * CTX  ;
constexpr int EIN = 4608, OIN = 3584;
constexpr float EPS = 1e-6f;
constexpr float LOG2E = 1.4426950408889634f;
constexpr float LAM_INIT = 0.2f;

constexpr size_t MiB = 1u << 20;
constexpr size_t WS_CTL = 0, CTL_ZERO_BYTES = 1 * MiB;
constexpr size_t WS_MISC = 1 * MiB;
constexpr size_t WS_WT0 = 2 * MiB;
constexpr size_t WS_WO0 = 11 * MiB;
constexpr size_t WS_WT1 = 13 * MiB;
constexpr size_t WS_WO1 = 20 * MiB;
constexpr size_t WS_WS = 22 * MiB;
constexpr size_t WS_SSQ1 = 23 * MiB;
constexpr size_t WS_RA = 24 * MiB;
constexpr size_t WS_XN = WS_RA, WS_CN = WS_RA + 32 * MiB, WS_ST = WS_RA, WS_A1 = WS_RA, WS_X1B = WS_RA + 32 * MiB;
constexpr size_t WS_Y = 88 * MiB;
constexpr size_t WS_KC = 120 * MiB;
constexpr size_t WS_VT = 138 * MiB;
constexpr size_t WS_GA = 156 * MiB;
constexpr size_t WS_HVT = 172 * MiB;
constexpr size_t WS_LF = 190 * MiB;
constexpr size_t WS_GB = 226 * MiB;
constexpr size_t WS_END = 242 * MiB;
constexpr size_t WS_UG = 120 * MiB;
constexpr size_t WS_BG = 136 * MiB;
constexpr size_t WS_CH = 152 * MiB;
constexpr size_t WS_GVT = 168 * MiB;
constexpr size_t WS_GVSSQ = 186 * MiB;
constexpr int GVP = SEQ + 64;
constexpr int MI_MOD = 0;
constexpr int MI_CS = 55296, MI_SN = MI_CS + 1024, MI_LBV = MI_SN + 1024, MI_SCAL = MI_LBV + 1024, MI_BIAS1 = MI_SCAL + 64;
constexpr int CW_BAR = 4096;
constexpr int CW_QUEUE = 16384;
constexpr int CW_FLAG = 32768;
constexpr int CW_ADA = 40960;

__device__ __forceinline__ unsigned cvt_pk_bf16(float lo, float hi) { f32x2 v = {lo, hi}; bf16x2_t b = __builtin_convertvector(v, bf16x2_t); return __builtin_bit_cast(unsigned, b); }
__device__ __forceinline__ unsigned cvt_pk_f16(float lo, float hi) { f32x2 v = {lo, hi}; f16x2_t b = __builtin_convertvector(v, f16x2_t); return __builtin_bit_cast(unsigned, b); }
__device__ __forceinline__ float bf2f(unsigned short h) { return __uint_as_float(((unsigned)h) << 16); }
__device__ __forceinline__ float bflo(unsigned w) { return __uint_as_float(w << 16); }
__device__ __forceinline__ float bfhi(unsigned w) { return __uint_as_float(w & 0xffff0000u); }
__device__ __forceinline__ float silu_fast(float v) { return v * __builtin_amdgcn_rcpf(1.f + __expf(-v)); }
__device__ __forceinline__ float gelu_erf(float v) { return 0.5f * v * (1.f + erff(v * 0.70710678118654752f)); }
__device__ __forceinline__ float wave_sum(float v) {
#pragma unroll
  for (int o = 1; o < 64; o <<= 1) v += __shfl_xor(v, o);
  return v;
}
__device__ __forceinline__ int lane_id() { int l = (int)__builtin_amdgcn_mbcnt_hi(~0u, __builtin_amdgcn_mbcnt_lo(~0u, 0u)); asm volatile("" : "+v"(l)); return l; }
__device__ __forceinline__ float shfl_xor_l(float v, int mask, int lane) { return __int_as_float(__builtin_amdgcn_ds_bpermute((lane ^ mask) << 2, __float_as_int(v))); }
#define LDS_WAIT() asm volatile("s_waitcnt lgkmcnt(0)" ::: "memory")
#define VM_WAIT() asm volatile("s_waitcnt vmcnt(0)" ::: "memory")

namespace pg8 {
constexpr int BM = 256, BK = 64, HALF = 128, HTB = HALF * BK * 2, STAGE_BYTES = 8 * HTB;
__host__ __device__ __forceinline__ int lds_byte(int r, int c) { const int st = (r >> 4) * 2 + (c >> 5), rr = r & 15, cc = c & 31, ob = rr * 64 + cc * 2; return st * 1024 + (ob ^ (((ob >> 9) & 1) << 5)); }
__host__ __device__ __forceinline__ void stage_rc(int b, int& R, int& C) { const int st = b / 1024, sb = b % 1024, swz = sb ^ (((sb >> 9) & 1) << 5); R = (st >> 1) * 16 + swz / 64; C = (st & 1) * 32 + (swz % 64) / 2; }
__host__ __device__ __forceinline__ int perm32(int rho) { const int n = rho >> 4, i = rho & 15; return 8 * (i >> 2) + 4 * n + (i & 3); }

struct Unit { const char* a; const char* b; int ty, pm, pn, aux; };

template <class Epi, class Sched, bool HALFN = false>
__device__ __forceinline__ void gemm_phase(LAS unsigned char* lds, const int K, const Sched& S, const Epi& E, const int wv) {
    const int lane = lane_id(), tid = wv * 64 + lane, wid = wv, wr = wid >> 2, wc = wid & 3, fr = lane & 15, fq = lane >> 4;
    const int nt = K / BK;
    unsigned voffA[2], voffB[2];
#pragma unroll
    for (int i = 0; i < 2; ++i) { int R, C; stage_rc(tid * 16 + i * 8192, R, C); const int Rb = (R & ~31) + perm32(R & 31);
        voffA[i] = (unsigned)(R * K + C) * 2u; voffB[i] = (unsigned)(Rb * K + C) * 2u; }
    const size_t kstep = (size_t)(BK * 2);
    const size_t hstep = (size_t)HALF * K * 2;
    const unsigned ldsw = (unsigned)wid * 1024u;
    const int aoff = lds_byte(wr * 64 + fr, fq * 8), boff = lds_byte(wc * 32 + fr, fq * 8);
#define PG8_SA(b, h) (((b) * 2 + (h)) * HTB)
#define PG8_SB(b, h) ((4 + (b) * 2 + (h)) * HTB)
#define PG8_STAGE(bufoff, gbase, voff) do { _Pragma("unroll") for (int _i = 0; _i < 2; ++_i) \
        __builtin_amdgcn_global_load_lds((const unsigned*)((const char*)(gbase) + (voff)[_i]), (LAS unsigned*)(lds + (bufoff) + ldsw + _i * 8192), 16, 0, 0); } while (0)
#define PG8_LDA(dst, b, h) do { _Pragma("unroll") for (int m = 0; m < 4; ++m) _Pragma("unroll") for (int k = 0; k < 2; ++k) dst[m][k] = *(const LAS bf16x8*)(lds + PG8_SA(b, h) + aoff + m * 2048 + k * 1024); } while (0)
#define PG8_LDB(dst, b, h) do { _Pragma("unroll") for (int n = 0; n < 2; ++n) _Pragma("unroll") for (int k = 0; k < 2; ++k) dst[n][k] = *(const LAS bf16x8*)(lds + PG8_SB(b, h) + boff + n * 2048 + k * 1024); } while (0)
#define PG8_MMA(ai, bj, At, Bt) do { __builtin_amdgcn_s_setprio(1); _Pragma("unroll") for (int m = 0; m < 4; ++m) _Pragma("unroll") for (int n = 0; n < 2; ++n) _Pragma("unroll") for (int k = 0; k < 2; ++k) \
        acc[ai][bj][m][n] = __builtin_amdgcn_mfma_f32_16x16x32_bf16(Bt[n][k], At[m][k], acc[ai][bj][m][n], 0, 0, 0); __builtin_amdgcn_s_setprio(0); } while (0)
#define PG8_WAIT_V(n) asm volatile("s_waitcnt vmcnt(" #n ")" ::: "memory")
#define PG8_WAIT_L(n) asm volatile("s_waitcnt lgkmcnt(" #n ")" ::: "memory")
#define PG8_BAR __builtin_amdgcn_s_barrier()
#define PG8_SCHED __builtin_amdgcn_sched_barrier(0)
    Unit cur, nxt; int ui = 0;
    if (!S.next(0, cur)) return;
    f32x4 acc[2][2][4][2];
#pragma unroll
    for (int a = 0; a < 2; ++a)
#pragma unroll
        for (int b = 0; b < 2; ++b)
#pragma unroll
            for (int m = 0; m < 4; ++m)
#pragma unroll
                for (int n = 0; n < 2; ++n) acc[a][b][m][n] = (f32x4){0.f, 0.f, 0.f, 0.f};
    bf16x8 At[4][2], B0[2][2], B1[2][2];
    const char* cA = cur.a; const char* cB = cur.b;
    PG8_STAGE(PG8_SB(0, 0), cB, voffB); if (!HALFN) PG8_STAGE(PG8_SB(0, 1), cB + hstep, voffB); PG8_STAGE(PG8_SA(0, 0), cA, voffA); PG8_STAGE(PG8_SA(0, 1), cA + hstep, voffA);
    if (wr == 1) PG8_BAR;
    PG8_WAIT_V(2); PG8_BAR;
    PG8_STAGE(PG8_SB(1, 0), cB + kstep, voffB); PG8_STAGE(PG8_SA(1, 0), cA + kstep, voffA); if (!HALFN) PG8_STAGE(PG8_SB(1, 1), cB + hstep + kstep, voffB);
    if (HALFN) PG8_WAIT_V(4); else PG8_WAIT_V(6); PG8_BAR;
    for (;;) {
        const bool has_next = S.next(ui + 1, nxt);
        const char* nA = has_next ? nxt.a : cA; const char* nB = has_next ? nxt.b : cB;
        for (int t = 0; t < nt; t += 2) {
            const bool last = (t == nt - 2);
            const char* a1 = cA + (size_t)(t + 1) * kstep;
            const char* a2 = last ? nA : cA + (size_t)(t + 2) * kstep; const char* b2 = last ? nB : cB + (size_t)(t + 2) * kstep;
            const char* a3 = a2 + kstep; const char* b3 = b2 + kstep;
#define PG8_WAIT_VK() do { if (HALFN) PG8_WAIT_V(6); else PG8_WAIT_V(8); } while (0)
            PG8_LDB(B0, 0, 0); if (!HALFN) PG8_LDB(B1, 0, 1); PG8_SCHED; PG8_LDA(At, 0, 0); PG8_STAGE(PG8_SA(1, 1), a1 + hstep, voffA);
            PG8_WAIT_VK(); PG8_WAIT_L(0); PG8_BAR; PG8_MMA(0, 0, At, B0); if (!HALFN) PG8_MMA(0, 1, At, B1); PG8_BAR; PG8_SCHED;
            PG8_LDA(At, 0, 1); PG8_STAGE(PG8_SB(0, 0), b2, voffB); if (!HALFN) PG8_STAGE(PG8_SB(0, 1), b2 + hstep, voffB); PG8_STAGE(PG8_SA(0, 0), a2, voffA);
            PG8_WAIT_VK(); PG8_WAIT_L(0); PG8_BAR; PG8_MMA(1, 0, At, B0); if (!HALFN) PG8_MMA(1, 1, At, B1); PG8_BAR; PG8_SCHED;
            PG8_LDB(B0, 1, 0); if (!HALFN) PG8_LDB(B1, 1, 1); PG8_SCHED; PG8_LDA(At, 1, 0); PG8_STAGE(PG8_SA(0, 1), a2 + hstep, voffA);
            PG8_WAIT_VK(); PG8_WAIT_L(0); PG8_BAR; PG8_MMA(0, 0, At, B0); if (!HALFN) PG8_MMA(0, 1, At, B1); PG8_BAR; PG8_SCHED;
            PG8_LDA(At, 1, 1); PG8_STAGE(PG8_SB(1, 0), b3, voffB); if (!HALFN) PG8_STAGE(PG8_SB(1, 1), b3 + hstep, voffB); PG8_STAGE(PG8_SA(1, 0), a3, voffA);
            PG8_WAIT_VK(); PG8_WAIT_L(0); PG8_BAR; PG8_MMA(1, 0, At, B0); if (!HALFN) PG8_MMA(1, 1, At, B1); PG8_BAR; PG8_SCHED;
#undef PG8_WAIT_VK
        }
        if (wr == 0) PG8_BAR;
        { int ln_ = (int)__builtin_amdgcn_mbcnt_hi(~0u, __builtin_amdgcn_mbcnt_lo(~0u, 0u)); asm volatile("" : "+v"(ln_));
          E(acc, cur, wr, wc, ln_ & 15, ln_ >> 4, ln_); }
        if (!has_next) break;
#pragma unroll
        for (int a = 0; a < 2; ++a)
#pragma unroll
            for (int b = 0; b < 2; ++b)
#pragma unroll
                for (int m = 0; m < 4; ++m)
#pragma unroll
                    for (int n = 0; n < 2; ++n) acc[a][b][m][n] = (f32x4){0.f, 0.f, 0.f, 0.f};
        cur = nxt; cA = nA; cB = nB; ++ui;
        if (wr == 1) PG8_BAR;
    }
    PG8_WAIT_V(0);
    PG8_BAR;
#undef PG8_SA
#undef PG8_SB
#undef PG8_STAGE
#undef PG8_LDA
#undef PG8_LDB
#undef PG8_MMA
#undef PG8_WAIT_V
#undef PG8_WAIT_L
#undef PG8_BAR
#undef PG8_SCHED
}
}

__device__ __forceinline__ void ticket_draw(unsigned* qctr, unsigned& tk) {
    const unsigned one = 1u;
    asm volatile("global_atomic_add %0, %1, %2, off sc0" : "=v"(tk) : "v"(qctr), "v"(one) : "memory");
}
__device__ __forceinline__ void ticket_wait(unsigned& tk) { asm volatile("s_waitcnt vmcnt(0)" : "+v"(tk) :: "memory"); }
#define XB_TMO      128
#define XB_XCNT(j)  (256  + 64 * (j))
#define XB_XSUB(j)  (1280 + 64 * (j))
#define XB_XGEN(j)  (2304 + 64 * (j))
#define XB_TOP      3328
#define XB_TOPGEN   3392
#define XCD_BAR_WORDS 3456
#define XB_SPIN_CAP (1u << 18)
__device__ __forceinline__ unsigned xb_ld(unsigned* p)              { return __hip_atomic_load(p, __ATOMIC_RELAXED, __HIP_MEMORY_SCOPE_AGENT); }
__device__ __forceinline__ unsigned xb_add(unsigned* p, unsigned v) { return __hip_atomic_fetch_add(p, v, __ATOMIC_RELAXED, __HIP_MEMORY_SCOPE_AGENT); }
__device__ __forceinline__ unsigned xb_xcc_id() { return (unsigned)__builtin_amdgcn_s_getreg((3 << 11) | 20) & 0xFu; }
#define XB_SPIN(cond, bar) do { unsigned _sp = 0; while (cond) { __builtin_amdgcn_s_sleep(1); \
    if ((++_sp & 255u) == 0u) { if (xb_ld(&(bar)[XB_TMO])) break; if (_sp > XB_SPIN_CAP) { atomicAdd(&(bar)[XB_TMO], 1u); break; } } } } while (0)
struct XcdBarrier { unsigned* bar; unsigned x; volatile LAS unsigned* st; };
__device__ __forceinline__ XcdBarrier xcd_barrier_post(unsigned* bar, volatile LAS unsigned* st, int tid) {
    XcdBarrier b; b.bar = bar; b.x = xb_xcc_id(); b.st = st;
    if (tid == 0) (void)xb_add(&bar[XB_XCNT(b.x)], 1u);
    return b;
}
__device__ __forceinline__ void xcd_barrier_complete(unsigned* bar, unsigned x, unsigned& nloc, unsigned& nx) {
    const unsigned G = gridDim.x * gridDim.y * gridDim.z;
    unsigned sum, cnt, mine, sp = 0u;
    for (;;) {
        sum = 0u; cnt = 0u; mine = 0u;
#pragma unroll
        for (unsigned j = 0; j < 16; ++j) { const unsigned c = xb_ld(&bar[XB_XCNT(j)]); sum += c; cnt += (c > 0u) ? 1u : 0u; mine = (j == x) ? c : mine; }
        if (sum == G) break;
        __builtin_amdgcn_s_sleep(1);
        if ((++sp & 255u) == 0u) { if (xb_ld(&bar[XB_TMO])) break; if (sp > XB_SPIN_CAP) { atomicAdd(&bar[XB_TMO], 1u); break; } }
    }
    nloc = mine > 0u ? mine : 1u; nx = cnt > 0u ? cnt : 1u;
}
__device__ __forceinline__ void xcd_barrier(const XcdBarrier& b, int tid) {
    asm volatile("s_waitcnt vmcnt(0)" ::: "memory");
    __syncthreads();
    if (tid == 0) {
        unsigned* bar = b.bar;
        __builtin_amdgcn_s_waitcnt(0);
        unsigned nloc = b.st[0], nx = b.st[1];
        if (nloc == 0u) { xcd_barrier_complete(bar, b.x, nloc, nx); b.st[0] = nloc; b.st[1] = nx; }
        const unsigned old = xb_add(&bar[XB_XSUB(b.x)], 1u);
        const unsigned gen = old / nloc;
        if (old + 1u == (gen + 1u) * nloc) {
            __builtin_amdgcn_fence(__ATOMIC_RELEASE, "agent");
            asm volatile("s_waitcnt vmcnt(0)" ::: "memory");
            const unsigned og = xb_add(&bar[XB_TOP], 1u);
            const unsigned tg = og / nx;
            if (og + 1u == (tg + 1u) * nx) xb_add(&bar[XB_TOPGEN], 1u);
            else XB_SPIN(xb_ld(&bar[XB_TOPGEN]) == tg, bar);
            __builtin_amdgcn_fence(__ATOMIC_ACQUIRE, "agent");
            xb_add(&bar[XB_XGEN(b.x)], 1u);
            asm volatile("s_waitcnt vmcnt(0)" ::: "memory");
        } else {
            XB_SPIN(xb_ld(&bar[XB_XGEN(b.x)]) == gen, bar);
            __builtin_amdgcn_fence(__ATOMIC_ACQUIRE, "agent");
            asm volatile("s_waitcnt vmcnt(0)" ::: "memory");
        }
    }
    __syncthreads();
}
constexpr int NWAVES = 8, NTHR = 512;
constexpr int RING_BYTES = 131072;
constexpr int LDSX_OFF = RING_BYTES;
constexpr int LDSCTL_OFF = 162816;
constexpr int LDS_BYTES = 163840;

struct Args {
    const float* in[20]; float* out; unsigned char* ws; int ph_lo, ph_hi, dbg, pad;
};
typedef const __attribute__((address_space(4))) Args* KArgsPtr;
__device__ __forceinline__ KArgsPtr kargs() { KArgsPtr p = (KArgsPtr)__builtin_amdgcn_kernarg_segment_ptr(); asm volatile("" : "+s"(p)); return p; }
struct Frame {
    LAS unsigned char* lds;
    volatile LAS unsigned* MISC;
    unsigned* ctl;
    int tid, lane, wave, vcu, G;
    const float *x, *c, *ctx, *c_ctx, *norm_gain, *ada_w, *ada_b, *even_w_in, *even_w_out, *qk_gain, *lam_p, *subln_g, *lb_logits, *hgrn_g,
                *odd_w_in, *odd_w_out, *v_g, *w_s, *b_s, *conv_w;
    float* out; unsigned char* ws; float* misc;
};

__host__ __device__ __forceinline__ int srcmap0(int d) {
    if (d < 1024) { const int base = d < 512 ? 0 : 512; const int e = d & 511; const int pn = e >> 8, rho = e & 255, bj = rho >> 7, wc = (rho >> 5) & 3; return base + (4 * pn + wc) * 64 + 32 * bj + (rho & 31); }
    if (d < 1536) return 1536 + (d - 1024);
    if (d < 2048) return 2048 + (d - 1536);
    if (d < 2560) return 3072 + (d - 2048);
    if (d < 3072) return 3584 + (d - 2560);
    if (d < 3584) return 4096 + (d - 3072);
    if (d < 4096) return 1024 + (d - 3584);
    return 2560 + (d - 4096);
}
__host__ __device__ __forceinline__ int srcmap1(int d) {
    if (d < 1024) { const int t = d >> 8, rho = d & 255, bj = rho >> 7, o = rho & 127; return (bj ? 1024 : 0) + 128 * t + o; }
    if (d < 2048) { const int e = d - 1024; const int t = e >> 8, rho = e & 255, bj = rho >> 7, o = rho & 127; return (bj ? 3072 : 1536) + 128 * t + o; }
    if (d < 3072) { const int e = d - 2048; const int t = e >> 8, rho = e & 255, bj = rho >> 7, o = rho & 127; return (bj ? 2560 : 2048) + 128 * t + o; }
    return 512 + (d - 3072);
}

__device__ __forceinline__ void p0_transpose_item(const float* W, int K, int N, bf16_t* WT, int drow0, int n_src, int k0, LAS float* scr, int lane) {
    float tv[32];
#pragma unroll
    for (int i = 0; i < 32; ++i) { const int kk = 2 * i + (lane >> 5); tv[i] = W[(size_t)(k0 + kk) * N + n_src + (lane & 31)]; }
#pragma unroll
    for (int i = 0; i < 32; ++i) { const int kk = 2 * i + (lane >> 5); scr[kk * 33 + (lane & 31)] = tv[i]; }
    LDS_WAIT(); asm volatile("" ::: "memory");
    const int c = lane & 7;
#pragma unroll
    for (int j = 0; j < 4; ++j) { const int n = (lane >> 3) + 8 * j; const LAS float* s = scr + (8 * c) * 33 + n;
        u32x4 o; o.x = cvt_pk_bf16(s[0 * 33], s[1 * 33]); o.y = cvt_pk_bf16(s[2 * 33], s[3 * 33]); o.z = cvt_pk_bf16(s[4 * 33], s[5 * 33]); o.w = cvt_pk_bf16(s[6 * 33], s[7 * 33]);
        *(u32x4*)(WT + (size_t)(drow0 + n) * K + k0 + 8 * c) = o; }
    LDS_WAIT(); asm volatile("" ::: "memory");
}

__device__ __forceinline__ void weight_copies(Frame& F, int which, int gw, int NGW, int sub_lo = 0, int sub_hi = 1 << 30) {
    LAS float* scr = (LAS float*)(F.lds + F.wave * 16384);
    constexpr int I0 = 16 * (EIN / 32), I1 = 16 * 32, I2 = 16 * (OIN / 32), I3 = 16 * 32, I4 = 128;
    bf16_t* Wt0 = (bf16_t*)(F.ws + WS_WT0); bf16_t* Wo0 = (bf16_t*)(F.ws + WS_WO0); bf16_t* Wt1 = (bf16_t*)(F.ws + WS_WT1); bf16_t* Wo1 = (bf16_t*)(F.ws + WS_WO1); bf16_t* Wsb = (bf16_t*)(F.ws + WS_WS);
    const int lo = (which ? I0 + I1 : 0) + sub_lo, hi0 = which ? I0 + I1 + I2 + I3 + I4 : I0 + I1; const int hi = (lo - sub_lo + sub_hi < hi0) ? lo - sub_lo + sub_hi : hi0;
    for (int it = lo + gw; it < hi; it += NGW) {
        int r = it;
        if (r < I0) { const int kb = r / (EIN / 32), dg = r % (EIN / 32); p0_transpose_item(F.even_w_in, DM, EIN, Wt0, dg * 32, srcmap0(dg * 32), kb * 64, scr, F.lane); continue; } r -= I0;
        if (r < I1) { const int kb = r / 32, dg = r % 32; p0_transpose_item(F.even_w_out, DM, DM, Wo0, dg * 32, dg * 32, kb * 64, scr, F.lane); continue; } r -= I1;
        if (r < I2) { const int kb = r / (OIN / 32), dg = r % (OIN / 32); p0_transpose_item(F.odd_w_in, DM, OIN, Wt1, dg * 32, srcmap1(dg * 32), kb * 64, scr, F.lane); continue; } r -= I2;
        if (r < I3) { const int kb = r / 32, dg = r % 32; p0_transpose_item(F.odd_w_out, DM, DM, Wo1, dg * 32, dg * 32, kb * 64, scr, F.lane); continue; } r -= I3;
        { const int e0 = r * 512 + F.lane * 8; const f32x4 a = *(const f32x4*)(F.w_s + e0), b = *(const f32x4*)(F.w_s + e0 + 4);
          u32x4 o; o.x = cvt_pk_bf16(a.x, a.y); o.y = cvt_pk_bf16(a.z, a.w); o.z = cvt_pk_bf16(b.x, b.y); o.w = cvt_pk_bf16(b.z, b.w); *(u32x4*)(Wsb + e0) = o; }
    }
}
__device__ __forceinline__ void p0_prologue(Frame& F) {
    float* misc = F.misc;
    if (F.vcu < 192) {
        LAS float* sl = (LAS float*)F.lds;
        LAS float* red = (LAS float*)(F.lds + 36864);
        const int cc = F.tid & 31, kp = F.tid >> 5;
        const int gcol = F.vcu * 32 + cc;
        const int l = gcol / 3072, col = gcol % 3072;
        const float* w = F.ada_w + (size_t)l * 1024 * 3072 + col;
        float wv[64];
#pragma unroll
        for (int i = 0; i < 64; ++i) wv[i] = w[(size_t)(kp * 64 + i) * 3072];
        for (int i = F.tid; i < 9 * 1024; i += NTHR) { const int r = i >> 10, k = i & 1023; const float v = (r < 8) ? F.c[r * 1024 + k] : F.c_ctx[k]; sl[i] = v / (1.f + __expf(-v)); }
        __syncthreads();
#pragma unroll
        for (int r = 0; r < 9; ++r) {
            float a = 0.f;
#pragma unroll
            for (int i4 = 0; i4 < 16; ++i4) { const f32x4 sv = *(const LAS f32x4*)(sl + r * 1024 + kp * 64 + 4 * i4);
                a += sv.x * wv[4 * i4] + sv.y * wv[4 * i4 + 1] + sv.z * wv[4 * i4 + 2] + sv.w * wv[4 * i4 + 3]; }
            red[(kp * 9 + r) * 32 + cc] = a;
        }
        __syncthreads();
        if (F.tid < 9 * 32) { const int r = F.tid >> 5, c2 = F.tid & 31; const int gc = F.vcu * 32 + c2; const int l2 = gc / 3072, col2 = gc % 3072;
            float sacc = F.ada_b[l2 * 3072 + col2];
#pragma unroll
            for (int q = 0; q < 16; ++q) sacc += red[(q * 9 + r) * 32 + c2];
            misc[MI_MOD + (l2 * 9 + r) * 3072 + col2] = sacc; }
        asm volatile("s_waitcnt vmcnt(0)" ::: "memory");
        __syncthreads();
        if (F.tid == 0) { __builtin_amdgcn_fence(__ATOMIC_RELEASE, "agent"); __hip_atomic_fetch_add(F.ctl + CW_ADA, 1u, __ATOMIC_RELAXED, __HIP_MEMORY_SCOPE_AGENT); }
    }
    if (F.vcu == 192) {
        for (int i = F.tid; i < 1024; i += NTHR) { const int pos = i >> 4, f = i & 15; const float inv = powf(10000.f, -(float)f / 16.f); const float ang = (float)pos * inv;
            misc[MI_CS + i] = cosf(ang); misc[MI_SN + i] = sinf(ang); }
    }
    if (F.vcu == 193) {
        for (int i = F.tid; i < 1024; i += NTHR) { const int dir = i >> 9, ch = i & 511; const float l0 = F.lb_logits[(dir * 2 + 0) * 512 + ch], l1 = F.lb_logits[(dir * 2 + 1) * 512 + ch];
            const float mx = fmaxf(l0, l1); const float e0 = expf(l0 - mx), e1 = expf(l1 - mx); misc[MI_LBV + i] = e0 / (e0 + e1); }
        if (F.wave == 0) {
            const int i = F.lane;
            float a = F.lam_p[i] * F.lam_p[64 + i], b = F.lam_p[128 + i] * F.lam_p[192 + i], gq = fabsf(F.qk_gain[i]), gk = fabsf(F.qk_gain[64 + i]);
#pragma unroll
            for (int o = 1; o < 64; o <<= 1) { a += __shfl_xor(a, o); b += __shfl_xor(b, o); gq = fmaxf(gq, __shfl_xor(gq, o)); gk = fmaxf(gk, __shfl_xor(gk, o)); }
            if (i == 0) {
                misc[MI_SCAL + 0] = expf(a) - expf(b) + LAM_INIT;
                misc[MI_SCAL + 1] = 8.0f * gq * gk * LOG2E * 1.0001f + 0.01f;
            }
        }
    }
    if (F.vcu >= 194) weight_copies(F, 0, (F.vcu - 194) * NWAVES + F.wave, 62 * NWAVES, 0, 992);
}

__device__ __forceinline__ void mod_rows3(Frame& F, int ma, int mb, int mc, bf16_t* XN, bf16_t* CN) {
    const float* misc = F.misc; const int lane = F.lane;
    f32x4 v[3][4];
#pragma unroll
    for (int r = 0; r < 3; ++r) { const int m = (r == 0) ? ma : (r == 1) ? mb : mc; const float* xrow = (m < M_TOK) ? F.x + (size_t)m * DM : F.ctx + (size_t)(m - M_TOK) * DM; const f32x4* xr = (const f32x4*)xrow + lane;
#pragma unroll
        for (int j = 0; j < 4; ++j) v[r][j] = xr[64 * j]; }
#pragma unroll
    for (int r = 0; r < 3; ++r) {
        const int m = (r == 0) ? ma : (r == 1) ? mb : mc;
        float s = 0.f;
#pragma unroll
        for (int j = 0; j < 4; ++j) s += (v[r][j].x * v[r][j].x + v[r][j].y * v[r][j].y) + (v[r][j].z * v[r][j].z + v[r][j].w * v[r][j].w);
        const float rstd = rsqrtf(wave_sum(s) * (1.f / DM) + EPS);
        const float* modrow = misc + MI_MOD + (0 * 9 + ((m < M_TOK) ? (m >> 11) : 8)) * 3072;
        bf16_t* orow = (m < M_TOK) ? XN + (size_t)m * DM : CN + (size_t)(m - M_TOK) * DM;
        u32x2* o8 = (u32x2*)orow + lane;
#pragma unroll
        for (int j = 0; j < 4; ++j) {
            const int col = 4 * lane + 256 * j;
            const f32x4 g = *(const f32x4*)(F.norm_gain + col), sh = *(const f32x4*)(modrow + col), sc = *(const f32x4*)(modrow + 1024 + col);
            const f32x4 o = v[r][j] * rstd * g * (sc + 1.f) + sh;
            u32x2 w; w.x = cvt_pk_bf16(o.x, o.y); w.y = cvt_pk_bf16(o.z, o.w); o8[64 * j] = w;
        }
    }
}
__device__ __forceinline__ void rows_load(Frame& F, int m, f32x4 (&v)[4]) {
    const float* xrow = (m < M_TOK) ? F.x + (size_t)m * DM : F.ctx + (size_t)(m - M_TOK) * DM; const f32x4* xr = (const f32x4*)xrow + F.lane;
#pragma unroll
    for (int j = 0; j < 4; ++j) v[j] = xr[64 * j];
}
__device__ __forceinline__ void mod_vecs(Frame& F, int modr, f32x4 (&Gm)[4], f32x4 (&Sh)[4]) {
    const float* modrow = F.misc + MI_MOD + (0 * 9 + modr) * 3072;
#pragma unroll
    for (int j = 0; j < 4; ++j) { const int col = 4 * F.lane + 256 * j;
        Gm[j] = *(const f32x4*)(F.norm_gain + col) * (*(const f32x4*)(modrow + 1024 + col) + 1.f); Sh[j] = *(const f32x4*)(modrow + col); }
}
__device__ __forceinline__ void row_proc(Frame& F, int m, const f32x4 (&v)[4], const f32x4 (&Gm)[4], const f32x4 (&Sh)[4], bf16_t* XN, bf16_t* CN) {
    float s = 0.f;
#pragma unroll
    for (int j = 0; j < 4; ++j) s += (v[j].x * v[j].x + v[j].y * v[j].y) + (v[j].z * v[j].z + v[j].w * v[j].w);
    const float rstd = rsqrtf(wave_sum(s) * (1.f / DM) + EPS);
    bf16_t* orow = (m < M_TOK) ? XN + (size_t)m * DM : CN + (size_t)(m - M_TOK) * DM;
    u32x2* o8 = (u32x2*)orow + F.lane;
#pragma unroll
    for (int j = 0; j < 4; ++j) { const f32x4 o = v[j] * rstd * Gm[j] + Sh[j]; u32x2 w; w.x = cvt_pk_bf16(o.x, o.y); w.y = cvt_pk_bf16(o.z, o.w); o8[64 * j] = w; }
}
__device__ __forceinline__ void p0b_phase(Frame& F) {
    const float* misc = F.misc;
    bf16_t* XN = (bf16_t*)(F.ws + WS_XN); bf16_t* CN = (bf16_t*)(F.ws + WS_CN);
    const int gw0 = F.vcu * NWAVES + F.wave;
    f32x4 ra[3][4], rb[3][4];
#pragma unroll
    for (int r = 0; r < 3; ++r) { rows_load(F, 8 * gw0 + r, ra[r]); rows_load(F, 8 * gw0 + 3 + r, rb[r]); }
    weight_copies(F, 0, gw0, F.G * NWAVES, 992);
    __syncthreads();
    if (F.wave == 0) { unsigned sp = 0u;
        while (__hip_atomic_load(F.ctl + CW_ADA, __ATOMIC_RELAXED, __HIP_MEMORY_SCOPE_AGENT) < 192u && ++sp < (1u << 22)) __builtin_amdgcn_s_sleep(2);
        __builtin_amdgcn_fence(__ATOMIC_ACQUIRE, "agent"); }
    __syncthreads();
    {
        LAS float* red = (LAS float*)F.lds;
        LAS float* shs = (LAS float*)(F.lds + 16384);
        const int cc = F.tid & 15, kp = F.tid >> 4;
        float acc[8];
#pragma unroll
        for (int b = 0; b < 8; ++b) acc[b] = 0.f;
        float wv[32];
        if (cc < 14) {
            const int d = F.vcu * 14 + cc; const int src = srcmap1(d & ~31) + (d & 31);
#pragma unroll
            for (int i = 0; i < 32; ++i) wv[i] = F.odd_w_in[(size_t)(kp * 32 + i) * OIN + src];
        } else {
#pragma unroll
            for (int i = 0; i < 32; ++i) wv[i] = 0.f;
        }
        { f32x4 sh4[4];
#pragma unroll
          for (int q = 0; q < 4; ++q) { const int i = F.tid + NTHR * q; const int b = i >> 8, c4 = i & 255; sh4[q] = *(const f32x4*)(misc + MI_MOD + (9 + b) * 3072 + 4 * c4); }
#pragma unroll
          for (int q = 0; q < 4; ++q) { const int i = F.tid + NTHR * q; const int b = i >> 8, c4 = i & 255; *(LAS f32x4*)(shs + b * 1024 + 4 * c4) = sh4[q]; } }
        __syncthreads();
#pragma unroll
        for (int b = 0; b < 8; ++b) {
#pragma unroll
            for (int i4 = 0; i4 < 8; ++i4) { const f32x4 sv = *(const LAS f32x4*)(shs + b * 1024 + kp * 32 + 4 * i4);
                acc[b] += sv.x * wv[4 * i4] + sv.y * wv[4 * i4 + 1] + sv.z * wv[4 * i4 + 2] + sv.w * wv[4 * i4 + 3]; }
        }
        __syncthreads();
#pragma unroll
        for (int b = 0; b < 8; ++b) red[(kp * 8 + b) * 16 + cc] = acc[b];
        __syncthreads();
        if (F.tid < 8 * 14) { const int b = F.tid / 14, c2 = F.tid % 14; float s = 0.f;
            for (int q = 0; q < 32; ++q) s += red[(q * 8 + b) * 16 + c2];
            F.misc[MI_BIAS1 + b * OIN + F.vcu * 14 + c2] = s; }
        __syncthreads();
    }
    {
        const int gw = gw0;
        f32x4 Gm[4], Sh[4];
        mod_vecs(F, (8 * gw) >> 11, Gm, Sh);
#pragma unroll
        for (int r = 0; r < 3; ++r) row_proc(F, 8 * gw + r, ra[r], Gm, Sh, XN, CN);
        rows_load(F, 8 * gw + 6, ra[0]); rows_load(F, 8 * gw + 7, ra[1]); rows_load(F, M_TOK + gw, ra[2]);
        __builtin_amdgcn_sched_barrier(0);
#pragma unroll
        for (int r = 0; r < 3; ++r) row_proc(F, 8 * gw + 3 + r, rb[r], Gm, Sh, XN, CN);
        row_proc(F, 8 * gw + 6, ra[0], Gm, Sh, XN, CN); row_proc(F, 8 * gw + 7, ra[1], Gm, Sh, XN, CN);
        mod_vecs(F, 8, Gm, Sh);
        row_proc(F, M_TOK + gw, ra[2], Gm, Sh, XN, CN);
    }
}

enum { T_Q = 0, T_K = 1, T_SILU = 2, T_PLAIN = 3, T_LF = 4, T_VT = 5 };
struct P1Order {
    int G, c;
    __device__ __forceinline__ bool next(int i, pg8::Unit& u) const {
        const int L = i * G + c;
        const char* wsb = (const char*)kargs()->ws; const char* XN = wsb + WS_XN; const char* CN = wsb + WS_CN; const char* Wt0 = wsb + WS_WT0;
        constexpr size_t TSTEP = (size_t)256 * DM * 2;
        if (L < 896) {
            constexpr int nwg = 896, nN = 14, q = nwg / 8;
            const int xcd = L % 8, offp = L / 8; const int wgid = xcd * q + offp;
            constexpr int nig = 8 * nN; const int gid = wgid / nig, fm = gid * 8;
            u.pm = fm + ((wgid % nig) % 8); u.pn = (wgid % nig) / 8;
            u.a = XN + (size_t)u.pm * TSTEP; u.b = Wt0 + (size_t)u.pn * TSTEP; u.aux = 0;
            u.ty = (u.pn < 2) ? T_Q : (u.pn < 4) ? T_K : (u.pn < 6) ? T_SILU : (u.pn < 8) ? T_PLAIN : (u.pn < 12) ? T_LF : T_SILU;
            return true;
        }
        int r = L - 896;
        if (r < 256) { const int xcd = r % 8, j = r / 8; u.pn = xcd * 8 + j / 4; u.pm = j % 4; u.a = Wt0 + (size_t)(14 + u.pm) * TSTEP; u.b = XN + (size_t)u.pn * TSTEP; u.ty = T_VT; u.aux = 0; return true; }
        r -= 256;
        if (r < 48) { const int pmc = r % 8, j = r / 8; const int pn = (j < 2) ? 2 + j : 6 + j;
            u.pm = pmc; u.pn = pn; u.a = CN + (size_t)pmc * TSTEP; u.b = Wt0 + (size_t)pn * TSTEP; u.aux = 1; u.ty = (pn < 4) ? T_K : T_LF; return true; }
        r -= 48;
        if (r < 32) { u.pn = r % 8; u.pm = r / 8; u.a = Wt0 + (size_t)(14 + u.pm) * TSTEP; u.b = CN + (size_t)u.pn * TSTEP; u.ty = T_VT; u.aux = 1; return true; }
        return false;
    }
};
struct EpiP1 {
    const LAS float* tab;
    __device__ __forceinline__ void operator()(const f32x4 (&acc)[2][2][4][2], const pg8::Unit& u, int wr, int wc, int fr, int fq, int lane) const {
        KArgsPtr ka = kargs(); unsigned char* wsb = ka->ws; const float* qk_gain = ka->in[9];
        bf16_t* Y = (bf16_t*)(wsb + WS_Y); bf16_t* Kc = (bf16_t*)(wsb + WS_KC); bf16_t* VT = (bf16_t*)(wsb + WS_VT); bf16_t* GA = (bf16_t*)(wsb + WS_GA); bf16_t* HVT = (bf16_t*)(wsb + WS_HVT); bf16_t* GB = (bf16_t*)(wsb + WS_GB);
        unsigned short* LF = (unsigned short*)(wsb + WS_LF); const float* miscp = (const float*)(wsb + WS_MISC); const float* CS = miscp + MI_CS; const float* SN = miscp + MI_SN; const float* LBV = miscp + MI_LBV;
        const int ty = u.ty, ctx = u.aux;
        if (ty == T_Q || ty == T_K) {
            const int seg = 4 * (u.pn & 1) + wc;
            const LAS float* gp = tab + 2048 + (ty == T_K ? 64 : 0) + 8 * fq;
            const f32x4 g00 = *(const LAS f32x4*)(gp), g01 = *(const LAS f32x4*)(gp + 4), g10 = *(const LAS f32x4*)(gp + 32), g11 = *(const LAS f32x4*)(gp + 36);
            const float osc = (ty == T_Q) ? 0.125f * LOG2E : 1.f;
#pragma unroll
            for (int ai = 0; ai < 2; ++ai)
#pragma unroll
                for (int m = 0; m < 4; ++m) {
                    const int rt = 128 * ai + 64 * wr + 16 * m + fr;
                    const int t = ((u.pm & 7) * 256 + rt);
                    float ss = 0.f;
#pragma unroll
                    for (int bj = 0; bj < 2; ++bj)
#pragma unroll
                        for (int n = 0; n < 2; ++n) { const f32x4 v = acc[ai][bj][m][n]; ss += (v.x * v.x + v.y * v.y) + (v.z * v.z + v.w * v.w); }
                    ss += __shfl_xor(ss, 16); ss += __shfl_xor(ss, 32);
                    const float rstd = rsqrtf(ss * (1.f / 64.f) + EPS);
                    f32x4 a0 = acc[ai][0][m][0] * rstd * g00, a1 = acc[ai][0][m][1] * rstd * g01, b0 = acc[ai][1][m][0] * rstd * g10, b1 = acc[ai][1][m][1] * rstd * g11;
                    if (!ctx) {
                        const int pos = (fq < 2) ? (t >> 6) : (t & 63);
                        const LAS float* cp = tab + pos * 16 + 8 * (fq & 1); const LAS float* sp = cp + 1024;
                        const f32x4 c0 = *(const LAS f32x4*)cp, c1 = *(const LAS f32x4*)(cp + 4), s0 = *(const LAS f32x4*)sp, s1 = *(const LAS f32x4*)(sp + 4);
                        const f32x4 o0 = a0 * c0 - b0 * s0, o1 = a1 * c1 - b1 * s1, p0 = a0 * s0 + b0 * c0, p1 = a1 * s1 + b1 * c1;
                        a0 = o0; a1 = o1; b0 = p0; b1 = p1;
                    }
                    a0 = a0 * osc; a1 = a1 * osc; b0 = b0 * osc; b1 = b1 * osc;
                    u32x4 w0, w1;
                    w0.x = cvt_pk_bf16(a0.x, a0.y); w0.y = cvt_pk_bf16(a0.z, a0.w); w0.z = cvt_pk_bf16(a1.x, a1.y); w0.w = cvt_pk_bf16(a1.z, a1.w);
                    w1.x = cvt_pk_bf16(b0.x, b0.y); w1.y = cvt_pk_bf16(b0.z, b0.w); w1.z = cvt_pk_bf16(b1.x, b1.y); w1.w = cvt_pk_bf16(b1.z, b1.w);
                    bf16_t* dst;
                    if (ty == T_Q) dst = Y + (size_t)(u.pm * 256 + rt) * 1024 + seg * 64 + 8 * fq;
                    else if (!ctx) dst = Kc + ((size_t)(u.pm >> 3) * KV + CTX + t) * 512 + seg * 64 + 8 * fq;
                    else dst = Kc + ((size_t)u.pm * KV + rt) * 512 + seg * 64 + 8 * fq;
                    *(u32x4*)dst = w0; *(u32x4*)(dst + 32) = w1;
                }
        } else if (ty == T_SILU || ty == T_PLAIN) {
            bf16_t* base; int pitch;
            if (ty == T_PLAIN) { base = Y + 512 + (u.pn - 6) * 256; pitch = 1024; }
            else if (u.pn < 6) { base = GA + (u.pn - 4) * 256; pitch = 512; }
            else { base = GB + (u.pn - 12) * 256; pitch = 512; }
#pragma unroll
            for (int ai = 0; ai < 2; ++ai)
#pragma unroll
                for (int m = 0; m < 4; ++m) {
                    const int rt = 128 * ai + 64 * wr + 16 * m + fr;
                    bf16_t* rowp = base + (size_t)(u.pm * 256 + rt) * pitch + 32 * wc + 8 * fq;
#pragma unroll
                    for (int bj = 0; bj < 2; ++bj) {
                        f32x4 v0 = acc[ai][bj][m][0], v1 = acc[ai][bj][m][1];
                        if (ty == T_SILU) { v0.x = silu_fast(v0.x); v0.y = silu_fast(v0.y); v0.z = silu_fast(v0.z); v0.w = silu_fast(v0.w); v1.x = silu_fast(v1.x); v1.y = silu_fast(v1.y); v1.z = silu_fast(v1.z); v1.w = silu_fast(v1.w); }
                        u32x4 w; w.x = cvt_pk_bf16(v0.x, v0.y); w.y = cvt_pk_bf16(v0.z, v0.w); w.z = cvt_pk_bf16(v1.x, v1.y); w.w = cvt_pk_bf16(v1.z, v1.w);
                        *(u32x4*)(rowp + 128 * bj) = w;
                    }
                }
        } else if (ty == T_LF) {
            const int dir = (u.pn >= 10) ? 1 : 0; const int pnr = (u.pn - 8) & 1;
            const int col0 = 256 * pnr + 32 * wc + 8 * fq;
            f32x4 lb[2][2];
#pragma unroll
            for (int bj = 0; bj < 2; ++bj)
#pragma unroll
                for (int n = 0; n < 2; ++n) lb[bj][n] = *(const LAS f32x4*)(tab + 2176 + dir * 512 + col0 + 128 * bj + 4 * n);
#pragma unroll
            for (int ai = 0; ai < 2; ++ai)
#pragma unroll
                for (int m = 0; m < 4; ++m) {
                    const int rt = 128 * ai + 64 * wr + 16 * m + fr;
                    size_t krow;
                    if (!ctx) krow = ((size_t)(dir * 8 + (u.pm >> 3)) * KV + CTX + (u.pm & 7) * 256 + rt);
                    else krow = ((size_t)(dir * 8 + u.pm) * KV + rt);
                    unsigned short* rowp = LF + krow * 512 + col0;
#pragma unroll
                    for (int bj = 0; bj < 2; ++bj) {
                        float o[8];
#pragma unroll
                        for (int n = 0; n < 2; ++n)
#pragma unroll
                            for (int j = 0; j < 4; ++j) { const float z = acc[ai][bj][m][n][j]; const float l = lb[bj][n][j]; const float f = l + (1.f - l) * __builtin_amdgcn_rcpf(1.f + __expf(-z)); o[4 * n + j] = __builtin_amdgcn_logf(f); }
                        u32x4 w; w.x = cvt_pk_f16(o[0], o[1]); w.y = cvt_pk_f16(o[2], o[3]); w.z = cvt_pk_f16(o[4], o[5]); w.w = cvt_pk_f16(o[6], o[7]);
                        *(u32x4*)(rowp + 128 * bj) = w;
                    }
                }
        } else {
#pragma unroll
            for (int ai = 0; ai < 2; ++ai)
#pragma unroll
                for (int m = 0; m < 4; ++m) {
                    const int f = u.pm * 256 + 128 * ai + 64 * wr + 16 * m + fr;
                    bf16_t* base = (f < 512) ? VT : HVT; const int hh = (f & 511) >> 7, dv = f & 127;
                    const int b = ctx ? u.pn : (u.pn >> 3);
                    const int key0 = ctx ? 0 : CTX + (u.pn & 7) * 256;
                    bf16_t* rowp = base + ((size_t)(b * 4 + hh) * 128 + dv) * KV + key0 + 32 * wc + 8 * fq;
#pragma unroll
                    for (int bj = 0; bj < 2; ++bj) {
                        const f32x4 v0 = acc[ai][bj][m][0], v1 = acc[ai][bj][m][1];
                        u32x4 w; w.x = cvt_pk_bf16(v0.x, v0.y); w.y = cvt_pk_bf16(v0.z, v0.w); w.z = cvt_pk_bf16(v1.x, v1.y); w.w = cvt_pk_bf16(v1.z, v1.w);
                        *(u32x4*)(rowp + 128 * bj) = w;
                    }
                }
        }
    }
};
namespace att {
constexpr int NSLOT = 4, SLOTB = 32768, VOFF = 16384, NT = KV / 64;
__device__ __forceinline__ void glds16s(const void* sbase, unsigned voff, unsigned lds_dst) {
    unsigned keep;
    asm volatile("s_mov_b32 %0, m0\n\ts_mov_b32 m0, %3\n\ts_nop 0\n\tglobal_load_lds_dwordx4 %1, %2\n\ts_mov_b32 m0, %0" : "=&s"(keep) : "v"(voff), "s"(sbase), "s"(lds_dst) : "memory");
}
__device__ __forceinline__ void glds16(const void* gsrc, unsigned lds_dst) {
    unsigned keep;
    asm volatile("s_mov_b32 %0, m0\n\ts_mov_b32 m0, %2\n\ts_nop 0\n\tglobal_load_lds_dwordx4 %1, off\n\ts_mov_b32 m0, %0" : "=&s"(keep) : "v"(gsrc), "s"(lds_dst) : "memory");
}
#define ATT_WAIT_BAR(N) asm volatile("s_waitcnt vmcnt(" #N ") lgkmcnt(0)\n\ts_barrier" ::: "memory")
__device__ __forceinline__ int crow(int r, int hi) { return (r & 3) + 8 * (r >> 2) + 4 * hi; }
#define MFMA32(a, b, c) __builtin_amdgcn_mfma_f32_32x32x16_bf16((a), (b), (c), 0, 0, 0)

__device__ __forceinline__ void attn_unit(int b, int h, int qb, bf16_t* Y, const bf16_t* Kc, const bf16_t* VT, const bf16_t* GA, const float* subln_g,
                                          float lam, float M2, LAS unsigned char* lds, const int wv, const bool dry = false, unsigned* qctr = nullptr) {
    const int lane = lane_id(), r32 = lane & 31, hi = lane >> 5;
    const int wid = wv;
    const int m = wid >> 2, qs = wid & 3;
    const unsigned lds0 = (unsigned)(uintptr_t)lds;
    const int tok0 = b * SEQ + qb * 128 + qs * 32;
    const bf16_t* Kb = Kc + (size_t)b * KV * 512 + h * 128;
    const bf16_t* Vb = VT + (size_t)(b * 4 + h) * 128 * KV;
    const int krow0 = 16 * (wid & 3) + (lane >> 3), krow1 = krow0 + 8;
    const bf16_t* ksrc0 = Kb + (size_t)krow0 * 512 + (wid >> 2) * 64 + 8 * ((lane & 7) ^ ((krow0 >> 1) & 7));
    const bf16_t* ksrc1 = Kb + (size_t)krow1 * 512 + (wid >> 2) * 64 + 8 * ((lane & 7) ^ ((krow1 >> 1) & 7));
    const int vrow0 = 16 * wid + (lane >> 3), vrow1 = vrow0 + 8;
    const bf16_t* vsrc0 = Vb + (size_t)vrow0 * KV + 8 * ((lane & 7) ^ ((vrow0 >> 1) & 7));
    const bf16_t* vsrc1 = Vb + (size_t)vrow1 * KV + 8 * ((lane & 7) ^ ((vrow1 >> 1) & 7));
    const unsigned kdst = lds0 + (2 * wid) * 1024, vdst = lds0 + VOFF + (2 * wid) * 1024;
#define ATT_DMA(t, slot) do { const unsigned so_ = (unsigned)(slot) * SLOTB; \
        glds16(ksrc0 + (size_t)(t) * 64 * 512, (unsigned)__builtin_amdgcn_readfirstlane(kdst + so_)); \
        glds16(ksrc1 + (size_t)(t) * 64 * 512, (unsigned)__builtin_amdgcn_readfirstlane(kdst + so_ + 1024)); \
        glds16(vsrc0 + (size_t)(t) * 64, (unsigned)__builtin_amdgcn_readfirstlane(vdst + so_)); \
        glds16(vsrc1 + (size_t)(t) * 64, (unsigned)__builtin_amdgcn_readfirstlane(vdst + so_ + 1024)); } while (0)
    const unsigned kvo0 = (unsigned)((const char*)ksrc0 - (const char*)Kb), kvo1 = (unsigned)((const char*)ksrc1 - (const char*)Kb);
    const unsigned vvo0 = (unsigned)((const char*)vsrc0 - (const char*)Vb), vvo1 = (unsigned)((const char*)vsrc1 - (const char*)Vb);
#define ATT_DMA1(t, slot, i) do { const unsigned so_ = (unsigned)(slot) * SLOTB; \
        if ((i) == 0) glds16s(Kb + (size_t)(t) * 64 * 512, kvo0, (unsigned)__builtin_amdgcn_readfirstlane(kdst + so_)); \
        if ((i) == 1) glds16s(Kb + (size_t)(t) * 64 * 512, kvo1, (unsigned)__builtin_amdgcn_readfirstlane(kdst + so_ + 1024)); \
        if ((i) == 2) glds16s(Vb + (size_t)(t) * 64, vvo0, (unsigned)__builtin_amdgcn_readfirstlane(vdst + so_)); \
        if ((i) == 3) glds16s(Vb + (size_t)(t) * 64, vvo1, (unsigned)__builtin_amdgcn_readfirstlane(vdst + so_ + 1024)); } while (0)
    bf16x8 qr[4];
    {
        const bf16_t* qp = Y + (size_t)(tok0 + r32) * 1024 + h * 128 + m * 64 + hi * 8;
#pragma unroll
        for (int d0 = 0; d0 < 4; ++d0) qr[d0] = *(const bf16x8*)(qp + d0 * 16);
    }
    __builtin_amdgcn_sched_barrier(0);
    ATT_DMA(0, 0);
    const int pi = (r32 & ~12) | ((r32 & 4) << 1) | ((r32 & 8) >> 1);
    int koff[4], voff[4];
#pragma unroll
    for (int d0 = 0; d0 < 4; ++d0) koff[d0] = m * 8192 + pi * 128 + (((2 * d0 + hi) ^ ((pi >> 1) & 7)) << 4);
    const int swz = (r32 >> 1) & 7;
#pragma unroll
    for (int s = 0; s < 4; ++s) voff[s] = VOFF + r32 * 128 + (((2 * s + hi) ^ swz) << 4);
    f32x16 o[4];
#pragma unroll
    for (int i = 0; i < 4; ++i)
#pragma unroll
        for (int r = 0; r < 16; ++r) o[i][r] = 0.f;
    float lsum = 0.f;
    f32x16 negm;
#pragma unroll
    for (int r = 0; r < 16; ++r) negm[r] = -M2;
    f32x16 pA0, pA1, pB0, pB1;
#define ATT_QK(N0, N1, sbk) do { N0 = negm; N1 = negm; \
        _Pragma("unroll") for (int d0 = 0; d0 < 4; ++d0) { \
            const bf16x8 k0_ = *(const LAS bf16x8*)((sbk) + koff[d0]); const bf16x8 k1_ = *(const LAS bf16x8*)((sbk) + koff[d0] + 4096); \
            N0 = MFMA32(k0_, qr[d0], N0); N1 = MFMA32(k1_, qr[d0], N1); } } while (0)
#define ATT_EXP(N0, N1) do { _Pragma("unroll") for (int r = 0; r < 16; ++r) { N0[r] = __builtin_amdgcn_exp2f(N0[r]); N1[r] = __builtin_amdgcn_exp2f(N1[r]); } } while (0)
#define ATT_PACK8(X, B) (u32x4){cvt_pk_bf16(X[B], X[B + 1]), cvt_pk_bf16(X[B + 2], X[B + 3]), cvt_pk_bf16(X[B + 4], X[B + 5]), cvt_pk_bf16(X[B + 6], X[B + 7])}
#define ATT_KRD(d0, half) (*(const LAS bf16x8*)(sbk_ + koff[d0] + (half) * 4096))
#define ATT_VRD(blk, s) (*(const LAS bf16x8*)(sbv_ + voff[s] + (blk) * 4096))
#define ATT_GAP() __builtin_amdgcn_sched_barrier(0)
#define ATT_E4(X, B) do { X[B] = __builtin_amdgcn_exp2f(X[B]); X[B + 1] = __builtin_amdgcn_exp2f(X[B + 1]); X[B + 2] = __builtin_amdgcn_exp2f(X[B + 2]); X[B + 3] = __builtin_amdgcn_exp2f(X[B + 3]); } while (0)
#define ATT_PVROW(blk, V0, V1, V2, V3, W0, W1, W2, W3, nb, F0, F1, F2, F3) do { \
        o[blk] = MFMA32(__builtin_bit_cast(bf16x8, pw0_), V0, o[blk]); if ((nb) < 4) W0 = ATT_VRD((nb) & 3, 0); F0; ATT_GAP(); \
        o[blk] = MFMA32(__builtin_bit_cast(bf16x8, pw1_), V1, o[blk]); if ((nb) < 4) W1 = ATT_VRD((nb) & 3, 1); F1; ATT_GAP(); \
        o[blk] = MFMA32(__builtin_bit_cast(bf16x8, pw2_), V2, o[blk]); if ((nb) < 4) W2 = ATT_VRD((nb) & 3, 2); F2; ATT_GAP(); \
        o[blk] = MFMA32(__builtin_bit_cast(bf16x8, pw3_), V3, o[blk]); if ((nb) < 4) W3 = ATT_VRD((nb) & 3, 3); F3; ATT_GAP(); } while (0)
#define ATT_S2(X, B) do { sacc_ += X[B]; sacc_ += X[B + 1]; } while (0)
#define ATT_STEP(N0, N1, P0, P1, t) do { \
        ATT_WAIT_BAR(4); const int tn_ = ((t) + 2 < NT) ? (t) + 2 : NT - 1;     \
        const LAS unsigned char* sbk_ = lds + ((t) & 3) * SLOTB; const LAS unsigned char* sbv_ = lds + (((t) - 1) & 3) * SLOTB; \
        bf16x8 ka_ = ATT_KRD(0, 0), kb_ = ATT_KRD(1, 0), kc_ = ATT_KRD(2, 0), kd_ = ATT_KRD(3, 0); \
        u32x4 pw0_, pw1_, pw2_, pw3_; bf16x8 ke_, kf_, kg_, kh_, va_, vb_, vc_, vd_, ve_, vf_, vg_, vh_; float sacc_ = 0.f; \
        ATT_GAP(); \
        N0 = MFMA32(ka_, qr[0], negm); pw0_ = ATT_PACK8(P0, 0); ke_ = ATT_KRD(0, 1); kf_ = ATT_KRD(1, 1); ATT_GAP(); \
        N0 = MFMA32(kb_, qr[1], N0);   pw1_ = ATT_PACK8(P0, 8); kg_ = ATT_KRD(2, 1); kh_ = ATT_KRD(3, 1); ATT_GAP(); \
        N0 = MFMA32(kc_, qr[2], N0);   pw2_ = ATT_PACK8(P1, 0); va_ = ATT_VRD(0, 0); vb_ = ATT_VRD(0, 1); ATT_GAP(); \
        N0 = MFMA32(kd_, qr[3], N0);   pw3_ = ATT_PACK8(P1, 8); vc_ = ATT_VRD(0, 2); vd_ = ATT_VRD(0, 3); ATT_GAP(); \
        N1 = MFMA32(ke_, qr[0], negm); ATT_S2(P0, 0); ATT_S2(P0, 2); ATT_S2(P0, 4); ATT_S2(P0, 6); ATT_GAP(); \
        N1 = MFMA32(kf_, qr[1], N1);   ATT_E4(N0, 0);  ATT_GAP(); \
        N1 = MFMA32(kg_, qr[2], N1);   ATT_E4(N0, 4);  ATT_GAP(); \
        N1 = MFMA32(kh_, qr[3], N1);   ATT_E4(N0, 8);  ATT_GAP(); \
        ATT_PVROW(0, va_, vb_, vc_, vd_, ve_, vf_, vg_, vh_, 1, ATT_E4(N0, 12), do { ATT_S2(P0, 8); ATT_S2(P0, 10); ATT_S2(P0, 12); ATT_S2(P0, 14); } while (0), ATT_E4(N1, 0), do { ATT_S2(P1, 0); ATT_S2(P1, 2); ATT_S2(P1, 4); } while (0)); \
        ATT_PVROW(1, ve_, vf_, vg_, vh_, va_, vb_, vc_, vd_, 2, ATT_E4(N1, 4), do { ATT_S2(P1, 6); ATT_S2(P1, 8); ATT_S2(P1, 10); } while (0), ATT_E4(N1, 8), do { ATT_S2(P1, 12); ATT_S2(P1, 14); } while (0)); \
        ATT_PVROW(2, va_, vb_, vc_, vd_, ve_, vf_, vg_, vh_, 3, ATT_E4(N1, 12), (void)0, (void)0, (void)0); \
        ATT_PVROW(3, ve_, vf_, vg_, vh_, va_, vb_, vc_, vd_, 4, ATT_DMA1(tn_, ((t) + 2) & 3, 0), ATT_DMA1(tn_, ((t) + 2) & 3, 1), ATT_DMA1(tn_, ((t) + 2) & 3, 2), ATT_DMA1(tn_, ((t) + 2) & 3, 3)); \
        lsum += sacc_; } while (0)
#define ATT_PV(O0, O1, sbv) do { float sa_ = 0.f, sb_ = 0.f; \
        _Pragma("unroll") for (int r = 0; r < 16; ++r) { sa_ += O0[r]; sb_ += O1[r]; } lsum += sa_ + sb_; \
        u32x4 pw_[4]; pw_[0] = ATT_PACK8(O0, 0); pw_[1] = ATT_PACK8(O0, 8); pw_[2] = ATT_PACK8(O1, 0); pw_[3] = ATT_PACK8(O1, 8); \
        _Pragma("unroll") for (int blk = 0; blk < 4; ++blk) _Pragma("unroll") for (int s = 0; s < 4; ++s) { \
            const bf16x8 vb_ = *(const LAS bf16x8*)((sbv) + voff[s] + blk * 4096); \
            o[blk] = MFMA32(__builtin_bit_cast(bf16x8, pw_[s]), vb_, o[blk]); } } while (0)
    ATT_WAIT_BAR(0);
#pragma unroll
    for (int d0 = 0; d0 < 4; ++d0) asm volatile("" : "+v"(qr[d0]));
    ATT_DMA(1, 1); ATT_DMA(2, 2);
    ATT_QK(pA0, pA1, lds); ATT_EXP(pA0, pA1);
    for (int t = 1; t + 1 < NT; t += 2) {
        ATT_STEP(pB0, pB1, pA0, pA1, t);
        ATT_STEP(pA0, pA1, pB0, pB1, t + 1);
    }
    unsigned tk;
    if (qctr != nullptr && wv == 0 && lane == 0) ticket_draw(qctr, tk);
    ATT_STEP(pB0, pB1, pA0, pA1, NT - 1);
    const int rowq = 16 * m + (lane >> 4), ch16 = lane & 15;
    u32x4 gav[4];
#pragma unroll
    for (int ps = 0; ps < 4; ++ps) gav[ps] = *(const u32x4*)(GA + (size_t)(tok0 + rowq + 4 * ps) * 512 + h * 128 + 8 * ch16);
    { const LAS unsigned char* sbv_ = lds + ((NT - 1) & 3) * SLOTB; ATT_PV(pB0, pB1, sbv_); }
#undef ATT_STEP
#undef ATT_PV
#undef ATT_EXP
#undef ATT_QK
#undef ATT_PVROW
#undef ATT_S2
#undef ATT_E4
#undef ATT_GAP
#undef ATT_KRD
#undef ATT_VRD
#undef ATT_PACK8
    lsum += shfl_xor_l(lsum, 32, lane);
    ATT_WAIT_BAR(0);
    LAS float* wl = (LAS float*)(lds + 131072) + wid * 32;
    LAS float* ex = (LAS float*)lds + qs * 4096;
    if (hi == 0) wl[r32] = lsum;
    LDS_WAIT();
    float rl[16];
#pragma unroll
    for (int r = 0; r < 16; ++r) rl[r] = __builtin_amdgcn_rcpf(wl[crow(r, hi)]) * (m ? lam : 1.f);
    if (m == 1) {
#pragma unroll
        for (int blk = 0; blk < 4; ++blk)
#pragma unroll
            for (int r = 0; r < 16; ++r) ex[crow(r, hi) * 128 + blk * 32 + r32] = o[blk][r] * rl[r];
    }
    ATT_WAIT_BAR(0);
    if (m == 0) {
        float ss[16];
#pragma unroll
        for (int r = 0; r < 16; ++r) ss[r] = 0.f;
#pragma unroll
        for (int blk = 0; blk < 4; ++blk)
#pragma unroll
            for (int r = 0; r < 16; ++r) { const float v = o[blk][r] * rl[r] - ex[crow(r, hi) * 128 + blk * 32 + r32]; o[blk][r] = v; ss[r] += v * v; }
#pragma unroll
        for (int r = 0; r < 16; ++r) {
            float s = ss[r];
            s += shfl_xor_l(s, 1, lane); s += shfl_xor_l(s, 2, lane); s += shfl_xor_l(s, 4, lane); s += shfl_xor_l(s, 8, lane); s += shfl_xor_l(s, 16, lane);
            ss[r] = rsqrtf(s * (1.f / 128.f) + EPS) * (1.f - LAM_INIT);
        }
#pragma unroll
        for (int blk = 0; blk < 4; ++blk) {
            const float g = subln_g[blk * 32 + r32];
#pragma unroll
            for (int r = 0; r < 16; ++r) ex[crow(r, hi) * 128 + blk * 32 + r32] = o[blk][r] * ss[r] * g;
        }
    }
    ATT_WAIT_BAR(0);
    {
#pragma unroll
        for (int ps = 0; ps < 4; ++ps) {
            const int row = rowq + 4 * ps;
            const f32x4 a = *(const LAS f32x4*)(ex + row * 128 + 8 * ch16), c = *(const LAS f32x4*)(ex + row * 128 + 8 * ch16 + 4);
            const u32x4 g4 = gav[ps];
            u32x4 w; w.x = cvt_pk_bf16(a.x * bflo(g4.x), a.y * bfhi(g4.x)); w.y = cvt_pk_bf16(a.z * bflo(g4.y), a.w * bfhi(g4.y));
            w.z = cvt_pk_bf16(c.x * bflo(g4.z), c.y * bfhi(g4.z)); w.w = cvt_pk_bf16(c.z * bflo(g4.w), c.w * bfhi(g4.w));
            if (!dry) *(u32x4*)(Y + (size_t)(tok0 + row) * 1024 + h * 128 + 8 * ch16) = w;
        }
    }
    if (qctr != nullptr && wv == 0 && lane == 0) { ticket_wait(tk); ((volatile LAS unsigned*)(lds + LDSCTL_OFF))[16] = tk; }
    ATT_WAIT_BAR(0);
#undef ATT_DMA
#undef ATT_DMA1
}
}
namespace hg {
#define HG_BAR() asm volatile("s_waitcnt vmcnt(0) lgkmcnt(0)\n\ts_barrier" ::: "memory")
#define HG_LBAR() asm volatile("s_waitcnt lgkmcnt(0)\n\ts_barrier" ::: "memory")
__device__ __forceinline__ float h2f(unsigned short h) { return (float)__builtin_bit_cast(_Float16, h); }
__device__ __forceinline__ int crow(int r, int hi) { return (r & 3) + 8 * (r >> 2) + 4 * hi; }
__device__ __forceinline__ int pi32(int x) { return (x & ~12) | ((x & 4) << 1) | ((x & 8) >> 1); }
__device__ __forceinline__ int sw64(int r, int c) { return r * 128 + ((c ^ ((r >> 1) & 7)) << 4); }
__device__ __forceinline__ int sw128(int r, int c) { return r * 256 + ((c ^ (r & 15)) << 4); }

__device__ __forceinline__ void state_chain(int b, int h, int dir, const unsigned short* LF, const bf16_t* HVT, bf16_t* ST, LAS unsigned char* lds, const int wv, unsigned* qctr = nullptr) {
    const int lane = lane_id(), tid = wv * 64 + lane, r32 = lane & 31, hi = lane >> 5;
    const int wid = wv;
    const int k = tid & 127, part = tid >> 7;
    const int vt = wid & 3, kh = wid >> 2;
    LAS unsigned char* KsT = lds;
    LAS float* dec = (LAS float*)(lds + 32768);
    LAS float* ptot = (LAS float*)(lds + 32768 + 1024);
    LAS unsigned char* stage = lds + 40960;
    const unsigned short* lfb = LF + ((size_t)(dir * 8 + b) * KV) * 512 + h * 128 + k;
    const bf16_t* vb = HVT + ((size_t)(b * 4 + h) * 128 + 32 * vt + r32) * KV + 8 * hi;
    f32x16 S[2];
#pragma unroll
    for (int i = 0; i < 2; ++i)
#pragma unroll
        for (int r = 0; r < 16; ++r) S[i][r] = 0.f;
    unsigned short lfr[16]; bf16x8 bv[4];
    auto ckof = [&](int n) { return dir ? (n < 4 ? 3 - n : 39 - n) : n; };
    {
        const int key0 = 64 * ckof(0);
#pragma unroll
        for (int j = 0; j < 16; ++j) lfr[j] = lfb[(size_t)(key0 + 16 * part + j) * 512];
#pragma unroll
        for (int s = 0; s < 4; ++s) bv[s] = *(const bf16x8*)(vb + key0 + 16 * s);
    }
    unsigned tk = 0u;
    for (int n = 0; n < 36; ++n) {
        const int p = n & 1, ck = ckof(n);
        if (n == 34 && qctr != nullptr && wv == 0 && lane == 0) tk = __hip_atomic_fetch_add(qctr, 1u, __ATOMIC_RELAXED, __HIP_MEMORY_SCOPE_AGENT);
        float lfv[16], c[16];
#pragma unroll
        for (int j = 0; j < 16; ++j) lfv[j] = h2f(lfr[j]);
        bf16x8 bcur[4];
#pragma unroll
        for (int s = 0; s < 4; ++s) bcur[s] = bv[s];
        if (n + 1 < 36) {
            const int key1 = 64 * ckof(n + 1);
#pragma unroll
            for (int j = 0; j < 16; ++j) lfr[j] = lfb[(size_t)(key1 + 16 * part + j) * 512];
#pragma unroll
            for (int s = 0; s < 4; ++s) bv[s] = *(const bf16x8*)(vb + key1 + 16 * s);
        }
        if (dir == 0) { float a = 0.f;
#pragma unroll
            for (int j = 0; j < 16; ++j) { a += lfv[j]; c[j] = a; } }
        else { float a = 0.f;
#pragma unroll
            for (int j = 15; j >= 0; --j) { a += lfv[j]; c[j] = a; } }
        const float T = dir ? c[0] : c[15];
        ptot[(p * 4 + part) * 128 + k] = T;
        HG_LBAR();
        float off = 0.f, gtot = 0.f;
        float pv4[4];
#pragma unroll
        for (int q = 0; q < 4; ++q) pv4[q] = ptot[(p * 4 + q) * 128 + k];
#pragma unroll
        for (int q = 0; q < 4; ++q) { gtot += pv4[q]; const bool take = dir ? (q > part) : (q < part); off += take ? pv4[q] : 0.f; }
        unsigned w[8];
#pragma unroll
        for (int j = 0; j < 16; j += 2) {
            const float k0 = (1.f - __builtin_amdgcn_exp2f(lfv[j])) * __builtin_amdgcn_exp2f(gtot - (c[j] + off));
            const float k1 = (1.f - __builtin_amdgcn_exp2f(lfv[j + 1])) * __builtin_amdgcn_exp2f(gtot - (c[j + 1] + off));
            w[j >> 1] = cvt_pk_bf16(k0, k1);
        }
        LAS unsigned char* kp = KsT + p * 16384;
        *(LAS u32x4*)(kp + sw64(k, 2 * part)) = (u32x4){w[0], w[1], w[2], w[3]};
        *(LAS u32x4*)(kp + sw64(k, 2 * part + 1)) = (u32x4){w[4], w[5], w[6], w[7]};
        if (part == 0) dec[p * 128 + k] = __builtin_amdgcn_exp2f(gtot);
        if (ck >= 4) {
#pragma unroll
            for (int kt = 0; kt < 2; ++kt)
#pragma unroll
                for (int g = 0; g < 4; ++g) {
                    u32x2 o; o.x = cvt_pk_bf16(S[kt][4 * g], S[kt][4 * g + 1]); o.y = cvt_pk_bf16(S[kt][4 * g + 2], S[kt][4 * g + 3]);
                    *(LAS u32x2*)(stage + sw128(32 * vt + r32, 8 * kh + 4 * kt + g) + 8 * hi) = o;
                }
        }
        HG_LBAR();
        if (ck >= 4) {
            bf16_t* sp = ST + ((size_t)((b * 4 + h) * 2 + dir) * 32 + (ck - 4)) * 16384;
            const int row = tid >> 2, q4 = tid & 3;
            u32x4 cv[4];
#pragma unroll
            for (int c = 0; c < 4; ++c) cv[c] = *(const LAS u32x4*)(stage + sw128(row, 4 * q4 + c));
#pragma unroll
            for (int c = 0; c < 4; ++c) *(u32x4*)(sp + row * 128 + (4 * q4 + c) * 8) = cv[c];
        }
        {
            bf16x8 af[2][4]; f32x4 dc[2][4];
#pragma unroll
            for (int kt = 0; kt < 2; ++kt) {
                const int krow = 32 * (2 * kh + kt);
#pragma unroll
                for (int g = 0; g < 4; ++g) dc[kt][g] = *(const LAS f32x4*)(dec + p * 128 + krow + 8 * g + 4 * hi);
#pragma unroll
                for (int s2 = 0; s2 < 4; ++s2) af[kt][s2] = *(const LAS bf16x8*)(kp + sw64(krow + r32, 2 * s2 + hi));
            }
#pragma unroll
            for (int kt = 0; kt < 2; ++kt) {
#pragma unroll
                for (int g = 0; g < 4; ++g) { S[kt][4 * g] *= dc[kt][g].x; S[kt][4 * g + 1] *= dc[kt][g].y; S[kt][4 * g + 2] *= dc[kt][g].z; S[kt][4 * g + 3] *= dc[kt][g].w; }
#pragma unroll
                for (int s2 = 0; s2 < 4; ++s2) S[kt] = __builtin_amdgcn_mfma_f32_32x32x16_bf16(af[kt][s2], bcur[s2], S[kt], 0, 0, 0);
            }
        }
    }
    if (qctr != nullptr && wv == 0 && lane == 0) ((volatile LAS unsigned*)(lds + LDSCTL_OFF))[16] = tk;
    HG_BAR();
}

struct OutPre { u32x4 sraw[2][4], vraw[2]; unsigned fa[8], fb[8], fq[8]; };
__device__ __forceinline__ void out_load(OutPre& P, int b, int h, int lc, const int wv) {
    unsigned char* wsb_ = kargs()->ws; const bf16_t* Y = (const bf16_t*)(wsb_ + WS_Y); const unsigned short* LF = (const unsigned short*)(wsb_ + WS_LF);
    const int tid = wv * 64 + lane_id();
    const int key0 = CTX + 64 * lc;
    const size_t tok0 = (size_t)b * SEQ + 64 * lc;
    { const bf16_t* ST = (const bf16_t*)(wsb_ + WS_ST); const bf16_t* HVT = (const bf16_t*)(wsb_ + WS_HVT);
      const int schunk = tid & 15, srow = tid >> 4;
#pragma unroll
      for (int dir = 0; dir < 2; ++dir) {
          const bf16_t* stp = ST + ((size_t)((b * 4 + h) * 2 + dir) * 32 + lc) * 16384;
#pragma unroll
          for (int i = 0; i < 4; ++i) P.sraw[dir][i] = *(const u32x4*)(stp + (size_t)(srow + 32 * i) * 128 + 8 * schunk);
      }
      const bf16_t* vtp = HVT + ((size_t)(b * 4 + h) * 128) * KV + key0;
#pragma unroll
      for (int i = 0; i < 2; ++i) P.vraw[i] = *(const u32x4*)(vtp + (size_t)((tid >> 3) + 64 * i) * KV + 8 * (tid & 7)); }
    const int kp2 = tid & 63, part8 = tid >> 6;
    const unsigned short* pf = LF + ((size_t)(0 * 8 + b) * KV + key0 + 8 * part8) * 512 + h * 128 + 2 * kp2;
    const unsigned short* pb = LF + ((size_t)(1 * 8 + b) * KV + key0 + 8 * part8) * 512 + h * 128 + 2 * kp2;
    const bf16_t* pq = Y + (tok0 + 8 * part8) * 1024 + 512 + h * 128 + 2 * kp2;
#pragma unroll
    for (int j = 0; j < 8; ++j) { P.fa[j] = *(const unsigned*)(pf + (size_t)j * 512); P.fb[j] = *(const unsigned*)(pb + (size_t)j * 512); P.fq[j] = *(const unsigned*)(pq + (size_t)j * 1024); }
}
__device__ __forceinline__ void out_settle(OutPre& P) {
#pragma unroll
    for (int d = 0; d < 2; ++d)
#pragma unroll
        for (int i = 0; i < 4; ++i) asm volatile("" : "+v"(P.sraw[d][i]));
    asm volatile("" : "+v"(P.vraw[0]), "+v"(P.vraw[1]));
#pragma unroll
    for (int j = 0; j < 8; ++j) asm volatile("" : "+v"(P.fa[j]), "+v"(P.fb[j]), "+v"(P.fq[j]));
}
__device__ __forceinline__ void out_unit(int b, int h, int lc, LAS unsigned char* lds, const int wv,
                                         OutPre& P, const bool pre_valid, const unsigned acq_mask, const int qoff, int& nidx, bool& npre, const bool dry = false, unsigned* qctr = nullptr) {
    const int lane = lane_id(), tid = wv * 64 + lane, r32 = lane & 31, hi = lane >> 5;
    const int wid = wv;
    const int tb = wid & 1, vt = wid >> 1;
    LAS unsigned char* STx = lds + 65536;
    LAS unsigned char* VTt = lds + 131072;
    LAS float* ptot = (LAS float*)(lds + 147456);
    LAS float* ssx = (LAS float*)(lds + 147456 + 8192);
    const size_t tok0 = (size_t)b * SEQ + 64 * lc;
    const int trow = 32 * tb + r32;
    const int schunk = tid & 15, srow = tid >> 4;
    if (!pre_valid) { out_load(P, b, h, lc, wv); asm volatile("s_waitcnt vmcnt(0)" ::: "memory"); out_settle(P); }
    unsigned tk;
    if (qctr != nullptr && wv == 0 && lane == 0) ticket_draw(qctr, tk);
    const int kp2 = tid & 63, part8 = tid >> 6;
    float lff[8][2], lfbw[8][2], qv[8][2];
#pragma unroll
    for (int j = 0; j < 8; ++j) {
        const unsigned a = P.fa[j], c2 = P.fb[j], d = P.fq[j];
        lff[j][0] = h2f((unsigned short)(a & 0xffffu)); lff[j][1] = h2f((unsigned short)(a >> 16));
        lfbw[j][0] = h2f((unsigned short)(c2 & 0xffffu)); lfbw[j][1] = h2f((unsigned short)(c2 >> 16));
        qv[j][0] = bflo(d); qv[j][1] = bfhi(d);
    }
    float cf[8][2], cb[8][2];
#pragma unroll
    for (int e = 0; e < 2; ++e) {
        float a = 0.f;
#pragma unroll
        for (int j = 0; j < 8; ++j) { a += lff[j][e]; cf[j][e] = a; }
        a = 0.f;
#pragma unroll
        for (int j = 7; j >= 0; --j) { a += lfbw[j][e]; cb[j][e] = a; }
    }
    *(LAS f32x2*)(ptot + (0 * 8 + part8) * 128 + 2 * kp2) = (f32x2){cf[7][0], cf[7][1]};
    *(LAS f32x2*)(ptot + (1 * 8 + part8) * 128 + 2 * kp2) = (f32x2){cb[0][0], cb[0][1]};
    HG_LBAR();
    f32x2 offf = {0.f, 0.f}, offb = {0.f, 0.f}, Rf = {0.f, 0.f}, Rb = {0.f, 0.f};
#pragma unroll
    for (int q = 0; q < 8; ++q) {
        const f32x2 pfq = *(const LAS f32x2*)(ptot + (0 * 8 + q) * 128 + 2 * kp2), pbq = *(const LAS f32x2*)(ptot + (1 * 8 + q) * 128 + 2 * kp2);
        if (q < 4) Rf += pfq; else Rb += pbq;
        offf += (q < part8) ? pfq : (f32x2){0.f, 0.f};
        offb += (q > part8) ? pbq : (f32x2){0.f, 0.f};
    }
#pragma unroll
    for (int j = 0; j < 8; ++j) {
        const int i = 8 * part8 + j;
        float v[4][2];
#pragma unroll
        for (int e = 0; e < 2; ++e) {
            const float gf = cf[j][e] + (e ? offf.y : offf.x), gb = cb[j][e] + (e ? offb.y : offb.x);
            const float kf = 1.f - __builtin_amdgcn_exp2f(lff[j][e]), kb = 1.f - __builtin_amdgcn_exp2f(lfbw[j][e]);
            const float df = fminf(fmaxf(gf - (e ? Rf.y : Rf.x), -100.f), 100.f), db = fminf(fmaxf(gb - (e ? Rb.y : Rb.x), -100.f), 100.f);
            const float q = qv[j][e];
            const float e1 = __builtin_amdgcn_exp2f(df), e2 = __builtin_amdgcn_exp2f(db);
            v[0][e] = q * e1; v[1][e] = kf * __builtin_amdgcn_rcpf(e1);
            v[2][e] = q * e2; v[3][e] = kb * __builtin_amdgcn_rcpf(e2);
        }
        const int o = sw128(i, kp2 >> 2) + (kp2 & 3) * 4;
#pragma unroll
        for (int mtx = 0; mtx < 4; ++mtx) *(LAS unsigned*)(lds + mtx * 16384 + o) = cvt_pk_bf16(v[mtx][0], v[mtx][1]);
    }
#pragma unroll
    for (int dir = 0; dir < 2; ++dir) {
        f32x4 ra = {0.f, 0.f, 0.f, 0.f}, rb2 = {0.f, 0.f, 0.f, 0.f};
#pragma unroll
        for (int q = 0; q < 4; ++q) { const LAS float* pp = ptot + (dir * 8 + 4 * dir + q) * 128 + 8 * schunk; ra += *(const LAS f32x4*)pp; rb2 += *(const LAS f32x4*)(pp + 4); }
        float er[8];
        er[0] = __builtin_amdgcn_exp2f(ra.x); er[1] = __builtin_amdgcn_exp2f(ra.y); er[2] = __builtin_amdgcn_exp2f(ra.z); er[3] = __builtin_amdgcn_exp2f(ra.w);
        er[4] = __builtin_amdgcn_exp2f(rb2.x); er[5] = __builtin_amdgcn_exp2f(rb2.y); er[6] = __builtin_amdgcn_exp2f(rb2.z); er[7] = __builtin_amdgcn_exp2f(rb2.w);
#pragma unroll
        for (int i = 0; i < 4; ++i) {
            const u32x4 r = P.sraw[dir][i]; u32x4 w;
            w.x = cvt_pk_bf16(bflo(r.x) * er[0], bfhi(r.x) * er[1]); w.y = cvt_pk_bf16(bflo(r.y) * er[2], bfhi(r.y) * er[3]);
            w.z = cvt_pk_bf16(bflo(r.z) * er[4], bfhi(r.z) * er[5]); w.w = cvt_pk_bf16(bflo(r.w) * er[6], bfhi(r.w) * er[7]);
            *(LAS u32x4*)(STx + dir * 32768 + sw128(srow + 32 * i, schunk)) = w;
        }
    }
#pragma unroll
    for (int i = 0; i < 2; ++i) *(LAS u32x4*)(VTt + sw64((tid >> 3) + 64 * i, tid & 7)) = P.vraw[i];
    if (qctr != nullptr && wv == 0 && lane == 0) { ticket_wait(tk); ((volatile LAS unsigned*)(lds + LDSCTL_OFF))[16] = tk; }
    HG_LBAR();
    u32x4 gbv[2];
#pragma unroll
    for (int i = 0; i < 2; ++i) gbv[i] = *(const u32x4*)((const bf16_t*)(kargs()->ws + WS_GB) + (tok0 + (tid >> 4) + 32 * i) * 512 + h * 128 + 8 * (tid & 15));
    nidx = -1; npre = false;
    if (qctr != nullptr) {
        nidx = (int)((volatile LAS unsigned*)(lds + LDSCTL_OFF))[16] + qoff;
        if (nidx >= 72 && nidx < 200) { const int nh = (nidx - 72) >> 5, nlc = (nidx - 72) & 31;
            if ((acq_mask >> nh) & 1u) { out_load(P, b, nh, nlc, wv); npre = true; } }
    }
    f32x16 o;
#pragma unroll
    for (int r = 0; r < 16; ++r) o[r] = 0.f;
    const int prow = pi32(r32), vrow = 32 * vt + r32;
    bf16x8 vd[2], vo[2];
#pragma unroll
    for (int s2 = 0; s2 < 2; ++s2) { vd[s2] = *(const LAS bf16x8*)(VTt + sw64(vrow, 4 * tb + 2 * s2 + hi)); vo[s2] = *(const LAS bf16x8*)(VTt + sw64(vrow, 4 * (1 - tb) + 2 * s2 + hi)); }
#pragma unroll
    for (int dir = 0; dir < 2; ++dir) {
        const LAS unsigned char* Qx = lds + (2 * dir + 0) * 16384; const LAS unsigned char* Kx = lds + (2 * dir + 1) * 16384; const LAS unsigned char* Sx = STx + dir * 32768;
        bf16x8 qf[8], kd[8], sf[8];
#pragma unroll
        for (int ks = 0; ks < 8; ++ks) { qf[ks] = *(const LAS bf16x8*)(Qx + sw128(trow, 2 * ks + hi)); kd[ks] = *(const LAS bf16x8*)(Kx + sw128(32 * tb + prow, 2 * ks + hi)); }
#pragma unroll
        for (int ks = 0; ks < 8; ++ks) sf[ks] = *(const LAS bf16x8*)(Sx + sw128(vrow, 2 * ks + hi));
        f32x16 at;
#pragma unroll
        for (int r = 0; r < 16; ++r) at[r] = 0.f;
#pragma unroll
        for (int ks = 0; ks < 8; ++ks) at = __builtin_amdgcn_mfma_f32_32x32x16_bf16(kd[ks], qf[ks], at, 0, 0, 0);
#pragma unroll
        for (int r = 0; r < 16; ++r) { const int sl = 16 * (r >> 3) + 8 * hi + (r & 7); const bool keep = dir ? (sl >= r32) : (sl <= r32); at[r] = keep ? at[r] : 0.f; }
#pragma unroll
        for (int s2 = 0; s2 < 2; ++s2) {
            const u32x4 pw = (u32x4){cvt_pk_bf16(at[8 * s2], at[8 * s2 + 1]), cvt_pk_bf16(at[8 * s2 + 2], at[8 * s2 + 3]), cvt_pk_bf16(at[8 * s2 + 4], at[8 * s2 + 5]), cvt_pk_bf16(at[8 * s2 + 6], at[8 * s2 + 7])};
            o = __builtin_amdgcn_mfma_f32_32x32x16_bf16(vd[s2], __builtin_bit_cast(bf16x8, pw), o, 0, 0, 0);
        }
        if (dir != tb) {
#pragma unroll
            for (int ks = 0; ks < 8; ++ks) kd[ks] = *(const LAS bf16x8*)(Kx + sw128(32 * (1 - tb) + prow, 2 * ks + hi));
#pragma unroll
            for (int r = 0; r < 16; ++r) at[r] = 0.f;
#pragma unroll
            for (int ks = 0; ks < 8; ++ks) at = __builtin_amdgcn_mfma_f32_32x32x16_bf16(kd[ks], qf[ks], at, 0, 0, 0);
#pragma unroll
            for (int s2 = 0; s2 < 2; ++s2) {
                const u32x4 pw = (u32x4){cvt_pk_bf16(at[8 * s2], at[8 * s2 + 1]), cvt_pk_bf16(at[8 * s2 + 2], at[8 * s2 + 3]), cvt_pk_bf16(at[8 * s2 + 4], at[8 * s2 + 5]), cvt_pk_bf16(at[8 * s2 + 6], at[8 * s2 + 7])};
                o = __builtin_amdgcn_mfma_f32_32x32x16_bf16(vo[s2], __builtin_bit_cast(bf16x8, pw), o, 0, 0, 0);
            }
        }
#pragma unroll
        for (int ks = 0; ks < 8; ++ks) o = __builtin_amdgcn_mfma_f32_32x32x16_bf16(sf[ks], qf[ks], o, 0, 0, 0);
    }
    float ss = 0.f;
#pragma unroll
    for (int r = 0; r < 16; ++r) ss += o[r] * o[r];
    ss += shfl_xor_l(ss, 32, lane);
    if (hi == 0) ssx[vt * 64 + trow] = ss;
    HG_LBAR();
    const float tot = ssx[trow] + ssx[64 + trow] + ssx[128 + trow] + ssx[192 + trow];
    const float rstd = rsqrtf(tot * (1.f / 128.f) + EPS);
    LAS float* og = (LAS float*)lds;
#pragma unroll
    for (int g = 0; g < 4; ++g) {
        const int v = 32 * vt + 8 * g + 4 * hi;
        const f32x4 gn = *(const LAS f32x4*)((const LAS float*)(lds + 156672) + v);
        *(LAS f32x4*)(og + trow * 132 + v) = (f32x4){o[4 * g] * rstd * gn.x, o[4 * g + 1] * rstd * gn.y, o[4 * g + 2] * rstd * gn.z, o[4 * g + 3] * rstd * gn.w};
    }
    HG_LBAR();
#pragma unroll
    for (int i = 0; i < 2; ++i) {
        const int row = (tid >> 4) + 32 * i, ch = tid & 15;
        const f32x4 a = *(const LAS f32x4*)(og + row * 132 + 8 * ch), c = *(const LAS f32x4*)(og + row * 132 + 8 * ch + 4);
        const u32x4 g4 = gbv[i];
        u32x4 w; w.x = cvt_pk_bf16(a.x * bflo(g4.x), a.y * bfhi(g4.x)); w.y = cvt_pk_bf16(a.z * bflo(g4.y), a.w * bfhi(g4.y));
        w.z = cvt_pk_bf16(c.x * bflo(g4.z), c.y * bfhi(g4.z)); w.w = cvt_pk_bf16(c.z * bflo(g4.w), c.w * bfhi(g4.w));
        if (!dry) *(u32x4*)((bf16_t*)(kargs()->ws + WS_Y) + (tok0 + row) * 1024 + 512 + h * 128 + 8 * ch) = w;
    }
    HG_BAR();
    if (npre) out_settle(P);
}
}
template <size_t OFFA, size_t OFFB> struct OutOrder {
    int G, c;
    __device__ __forceinline__ bool next(int i, pg8::Unit& u) const {
        const int L = i * G + c; if (L >= 256) return false;
        const char* wsb = (const char*)kargs()->ws; const char* A = wsb + OFFA; const char* Bt = wsb + OFFB;
        constexpr size_t TSTEP = (size_t)256 * DM * 2;
        const int xcd = L % 8, offp = L / 8; const int wgid = xcd * 32 + offp;
        u.pm = xcd * 8 + (wgid % 32) % 8; u.pn = (wgid % 32) / 8; u.a = A + (size_t)u.pm * TSTEP; u.b = Bt + (size_t)u.pn * TSTEP; u.ty = 0; u.aux = 0; return true;
    }
};
struct EpiP4 {
    __device__ __forceinline__ void operator()(const f32x4 (&acc)[2][2][4][2], const pg8::Unit& u, int wr, int wc, int fr, int fq, int lane) const {
        KArgsPtr ka = kargs(); unsigned char* wsb = ka->ws; const float* x = ka->in[0]; bf16_t* x1b = (bf16_t*)(wsb + WS_X1B); const float* gain1 = ka->in[4] + 1024;
        bf16_t* A1 = (bf16_t*)(wsb + WS_A1); float* SSQ1 = (float*)(wsb + WS_SSQ1); const float* mod = (const float*)(wsb + WS_MISC) + MI_MOD;
        const int b = u.pm >> 3;
        const int col0 = 256 * u.pn + 32 * wc + 8 * fq;
        f32x4 gt[2][2], gm[2][2];
#pragma unroll
        for (int bj = 0; bj < 2; ++bj)
#pragma unroll
            for (int n = 0; n < 2; ++n) { const int c = col0 + 128 * bj + 4 * n;
                gt[bj][n] = *(const f32x4*)(mod + (0 * 9 + b) * 3072 + 2048 + c);
                gm[bj][n] = *(const f32x4*)(gain1 + c) * (*(const f32x4*)(mod + (9 + b) * 3072 + 1024 + c) + 1.f); }
        const float* xbase = x + ((size_t)u.pm * 256 + 64 * wr + fr) * 1024 + col0;
        f32x4 xr[3][4];
#define P4_LDX(it) do { const float* xp_ = xbase + (size_t)(128 * ((it) >> 2) + 16 * ((it) & 3)) * 1024; \
            xr[(it) % 3][0] = *(const f32x4*)(xp_); xr[(it) % 3][1] = *(const f32x4*)(xp_ + 4); xr[(it) % 3][2] = *(const f32x4*)(xp_ + 128); xr[(it) % 3][3] = *(const f32x4*)(xp_ + 132); } while (0)
        P4_LDX(0); P4_LDX(1);
#pragma unroll
        for (int it = 0; it < 8; ++it) {
            if (it + 2 < 8) P4_LDX(it + 2);
            __builtin_amdgcn_sched_barrier(0);
            const int ai = it >> 2, m = it & 3;
            {
                const size_t row = (size_t)u.pm * 256 + 128 * ai + 64 * wr + 16 * m + fr;
                float ss = 0.f;
#pragma unroll
                for (int bj = 0; bj < 2; ++bj) {
                    const size_t o = row * 1024 + col0 + 128 * bj;
                    const f32x4 xa = xr[it % 3][2 * bj], xb = xr[it % 3][2 * bj + 1];
                    const f32x4 v0 = xa + gt[bj][0] * acc[ai][bj][m][0], v1 = xb + gt[bj][1] * acc[ai][bj][m][1];
                    { u32x4 xw; xw.x = cvt_pk_bf16(v0.x, v0.y); xw.y = cvt_pk_bf16(v0.z, v0.w); xw.z = cvt_pk_bf16(v1.x, v1.y); xw.w = cvt_pk_bf16(v1.z, v1.w); *(u32x4*)(x1b + o) = xw; }
                    ss += (v0.x * v0.x + v0.y * v0.y) + (v0.z * v0.z + v0.w * v0.w) + (v1.x * v1.x + v1.y * v1.y) + (v1.z * v1.z + v1.w * v1.w);
                    const f32x4 a0 = v0 * gm[bj][0], a1 = v1 * gm[bj][1];
                    u32x4 w; w.x = cvt_pk_bf16(a0.x, a0.y); w.y = cvt_pk_bf16(a0.z, a0.w); w.z = cvt_pk_bf16(a1.x, a1.y); w.w = cvt_pk_bf16(a1.z, a1.w);
                    *(u32x4*)(A1 + o) = w;
                }
                ss += __shfl_xor(ss, 16); ss += __shfl_xor(ss, 32);
                if (fq == 0) SSQ1[row * 16 + u.pn * 4 + wc] = ss;
            }
            __builtin_amdgcn_sched_barrier(0);
        }
#undef P4_LDX
    }
};
struct EpiP7 {
    __device__ __forceinline__ void operator()(const f32x4 (&acc)[2][2][4][2], const pg8::Unit& u, int wr, int wc, int fr, int fq, int lane) const {
        KArgsPtr ka = kargs(); float* outp = ka->out; const bf16_t* x1b = (const bf16_t*)(ka->ws + WS_X1B); const float* mod = (const float*)(ka->ws + WS_MISC) + MI_MOD;
        const int b = u.pm >> 3;
        const int col0 = 256 * u.pn + 32 * wc + 8 * fq;
        f32x4 gt[2][2];
#pragma unroll
        for (int bj = 0; bj < 2; ++bj)
#pragma unroll
            for (int n = 0; n < 2; ++n) gt[bj][n] = *(const f32x4*)(mod + (9 + b) * 3072 + 2048 + col0 + 128 * bj + 4 * n);
        u32x4 xq[8][2];
#pragma unroll
        for (int it = 0; it < 8; ++it)
#pragma unroll
            for (int bj = 0; bj < 2; ++bj) xq[it][bj] = *(const u32x4*)(x1b + ((size_t)u.pm * 256 + 128 * (it >> 2) + 64 * wr + 16 * (it & 3) + fr) * 1024 + col0 + 128 * bj);
        __builtin_amdgcn_sched_barrier(0);
#pragma unroll
        for (int ai = 0; ai < 2; ++ai)
#pragma unroll
            for (int m = 0; m < 4; ++m) {
                const size_t row = (size_t)u.pm * 256 + 128 * ai + 64 * wr + 16 * m + fr;
#pragma unroll
                for (int bj = 0; bj < 2; ++bj) {
                    const size_t o = row * 1024 + col0 + 128 * bj;
                    const u32x4 xw = xq[ai * 4 + m][bj];
                    const f32x4 xa = (f32x4){bflo(xw.x), bfhi(xw.x), bflo(xw.y), bfhi(xw.y)}, xb = (f32x4){bflo(xw.z), bfhi(xw.z), bflo(xw.w), bfhi(xw.w)};
                    *(f32x4*)(outp + o) = xa + gt[bj][0] * acc[ai][bj][m][0]; *(f32x4*)(outp + o + 4) = xb + gt[bj][1] * acc[ai][bj][m][1];
                }
            }
    }
};

struct P5Order {
    int G, c;
    __device__ __forceinline__ bool next(int i, pg8::Unit& u) const {
        const int L = i * G + c; if (L >= 768) return false;
        const char* wsb = (const char*)kargs()->ws; const char* A1 = wsb + WS_A1; const char* Wt1 = wsb + WS_WT1;
        constexpr size_t TSTEP = (size_t)256 * DM * 2;
        const int xcd = L % 8, offp = L / 8; const int wgid = xcd * 96 + offp;
        u.pm = xcd * 8 + (wgid % 96) % 8; u.pn = (wgid % 96) / 8; u.a = A1 + (size_t)u.pm * TSTEP; u.b = Wt1 + (size_t)u.pn * TSTEP; u.ty = 0; u.aux = 0; return true;
    }
};
struct P5HalfOrder {
    int G, c;
    __device__ __forceinline__ bool next(int i, pg8::Unit& u) const {
        const int L = i * G + c; if (L >= 256) return false;
        const char* wsb = (const char*)kargs()->ws; const char* A1 = wsb + WS_A1; const char* Wt1 = wsb + WS_WT1;
        constexpr size_t TSTEP = (size_t)256 * DM * 2;
        const int xcd = L % 8, j = L / 8; u.pn = xcd * 16 + j / 2; u.pm = j % 2;
        u.a = Wt1 + (size_t)(12 + u.pm) * TSTEP; u.b = A1 + (size_t)u.pn * (TSTEP / 2); u.ty = 1; u.aux = 0; return true;
    }
};
__device__ __forceinline__ float gelu_as(float v) {
    const float av = fabsf(v), t = __builtin_amdgcn_rcpf(av * 0.2316418882f + 1.0f);
    float q = t * 0.5307027145f + (-0.7265760135f); q = q * t + 0.7107068705f; q = q * t + (-0.142248368f); q = q * t + 0.127414796f; q = q * t;
    const float e = __builtin_amdgcn_exp2f((v * v) * (-0.72134752044f));
    const float mm = v * (q * e);
    return v < 0.f ? mm : v - mm;
}
__device__ __forceinline__ float rstd16(const float* SSQ1, size_t row) {
    const f32x4* p = (const f32x4*)(SSQ1 + row * 16);
    const f32x4 a = p[0], b = p[1], c = p[2], d = p[3];
    const float s = ((a.x + a.y) + (a.z + a.w)) + ((b.x + b.y) + (b.z + b.w)) + ((c.x + c.y) + (c.z + c.w)) + ((d.x + d.y) + (d.z + d.w));
    return rsqrtf(s * (1.f / 1024.f) + EPS);
}
struct EpiP5 {
    const LAS float* rst; int tpm;
    __device__ __forceinline__ void operator()(const f32x4 (&acc)[2][2][4][2], const pg8::Unit& u, int wr, int wc, int fr, int fq, int lane) const {
        unsigned char* wsb = kargs()->ws; bf16_t* UG = (bf16_t*)(wsb + WS_UG); bf16_t* GVT = (bf16_t*)(wsb + WS_GVT); float* GVSSQ = (float*)(wsb + WS_GVSSQ);
        const float* ssq1 = (const float*)(wsb + WS_SSQ1); const float* bias1 = (const float*)(wsb + WS_MISC) + MI_BIAS1;
        if (u.ty == 0) {
            const int b = u.pm >> 3;
            const int kind = u.pn >> 2, pq = u.pn & 3;
            const float* bp = bias1 + b * OIN + 256 * u.pn + 32 * wc + 8 * fq;
            bf16_t* base = UG + (size_t)kind * (8u << 20) + 128 * pq + 32 * wc + 8 * fq;
#pragma unroll
            for (int ai = 0; ai < 2; ++ai)
#pragma unroll
                for (int m = 0; m < 4; ++m) {
                    const size_t row = (size_t)u.pm * 256 + 128 * ai + 64 * wr + 16 * m + fr;
                    float rs = (u.pm == tpm) ? rst[128 * ai + 64 * wr + 16 * m + fr] : rstd16(ssq1, row); asm volatile("" : "+v"(rs));
                    f32x4 b00, b01, b10, b11;
                    if (u.pm == tpm) { const LAS float* bl = rst + 384 + 256 * u.pn + 32 * wc + 8 * fq; b00 = *(const LAS f32x4*)(bl); b01 = *(const LAS f32x4*)(bl + 4); b10 = *(const LAS f32x4*)(bl + 128); b11 = *(const LAS f32x4*)(bl + 132); }
                    else { b00 = *(const f32x4*)(bp); b01 = *(const f32x4*)(bp + 4); b10 = *(const f32x4*)(bp + 128); b11 = *(const f32x4*)(bp + 132); }
                    const f32x4 p0 = acc[ai][0][m][0] * rs + b00, p1 = acc[ai][0][m][1] * rs + b01, q0 = acc[ai][1][m][0] * rs + b10, q1 = acc[ai][1][m][1] * rs + b11;
                    float o[8];
#pragma unroll
                    for (int j = 0; j < 4; ++j) {
                        if (kind == 0) { o[j] = gelu_as(p0[j]) * silu_fast(q0[j]); o[4 + j] = gelu_as(p1[j]) * silu_fast(q1[j]); }
                        else if (kind == 1) { o[j] = p0[j] * silu_fast(q0[j]); o[4 + j] = p1[j] * silu_fast(q1[j]); }
                        else { o[j] = p0[j] * q0[j]; o[4 + j] = p1[j] * q1[j]; }
                    }
                    u32x4 w; w.x = cvt_pk_bf16(o[0], o[1]); w.y = cvt_pk_bf16(o[2], o[3]); w.z = cvt_pk_bf16(o[4], o[5]); w.w = cvt_pk_bf16(o[6], o[7]);
                    *(u32x4*)(base + row * 512) = w;
                    __builtin_amdgcn_sched_barrier(0);
                }
        }
    }
};
struct EpiP5H {
    const LAS float* rsth; int tpn, tpmh;
    __device__ __forceinline__ void operator()(const f32x4 (&acc)[2][2][4][2], const pg8::Unit& u, int wr, int wc, int fr, int fq, int lane) const {
        unsigned char* wsb = kargs()->ws; bf16_t* GVT = (bf16_t*)(wsb + WS_GVT); float* GVSSQ = (float*)(wsb + WS_GVSSQ);
        const float* ssq1 = (const float*)(wsb + WS_SSQ1); const float* bias1 = (const float*)(wsb + WS_MISC) + MI_BIAS1;
        {
            const int b = u.pn >> 4;
            { constexpr int bj = 0;
                int opq = 0; asm volatile("" : "+s"(opq));
                const size_t tokc = (size_t)u.pn * 128 + 32 * wc + 8 * fq + opq;
                float rs[8], gs[8];
                if (u.pn == tpn) {
#pragma unroll
                    for (int e = 0; e < 8; ++e) { rs[e] = rsth[32 * wc + 8 * fq + e]; gs[e] = 0.f; }
                } else {
#pragma unroll
                for (int e = 0; e < 8; ++e) { rs[e] = rstd16(ssq1, tokc + e); gs[e] = 0.f; asm volatile("" : "+v"(rs[e])); __builtin_amdgcn_sched_barrier(0); }
                }
#pragma unroll
                for (int ai = 0; ai < 2; ++ai)
#pragma unroll
                    for (int m = 0; m < 4; ++m) {
                        const int f = u.pm * 256 + 128 * ai + 64 * wr + 16 * m + fr + opq;
                        const float bias = (u.pn == tpn && u.pm == tpmh) ? rsth[128 + 3072 + 128 * ai + 64 * wr + 16 * m + fr] : bias1[b * OIN + 3072 + f];
                        bf16_t* rowp = GVT + ((size_t)(b * 4 + (f >> 7)) * 128 + (f & 127)) * GVP + (u.pn & 15) * 128 + 32 * wc + 8 * fq;
                        float o[8];
#pragma unroll
                        for (int n = 0; n < 2; ++n)
#pragma unroll
                            for (int j = 0; j < 4; ++j) { const float gv = gelu_as(acc[ai][bj][m][n][j] * rs[4 * n + j] + bias); o[4 * n + j] = gv; gs[4 * n + j] += gv * gv; }
                        u32x4 w; w.x = cvt_pk_bf16(o[0], o[1]); w.y = cvt_pk_bf16(o[2], o[3]); w.z = cvt_pk_bf16(o[4], o[5]); w.w = cvt_pk_bf16(o[6], o[7]);
                        *(u32x4*)(rowp) = w;
                        __builtin_amdgcn_sched_barrier(0);
                    }
#pragma unroll
                for (int e = 0; e < 8; ++e) {
                    float s = gs[e];
                    s += __shfl_xor(s, 1); s += __shfl_xor(s, 2); s += __shfl_xor(s, 4); s += __shfl_xor(s, 8);
                    if (fr == 0) GVSSQ[(tokc + e) * 4 + u.pm * 2 + wr] = s;
                    __builtin_amdgcn_sched_barrier(0);
                }
            }
        }
    }
};

__device__ __forceinline__ int gsw(int r, int c) { return r * 256 + ((c ^ (r & 15)) << 4); }
struct GmlpRegs { u32x4 ta[4], tw[4], tu[4]; f32x4 ssq; };
__device__ __forceinline__ void gmlp_load(GmlpRegs& R, int b, int ch, int g, const bf16_t* GVT, const float* GVSSQ, const bf16_t* Wsb, const bf16_t* UG, const int wv) {
    const int lane = lane_id(), tid = wv * 64 + lane;
    const size_t tokc = (size_t)b * SEQ + ch * 128;
    const int chunk = tid & 15, rb = tid >> 4;
#pragma unroll
    for (int i = 0; i < 4; ++i) { const int row = rb + 32 * i;
        R.ta[i] = *(const u32x4*)(GVT + ((size_t)(b * 4 + g) * 128 + row) * GVP + ch * 128 + 8 * chunk);
        R.tw[i] = *(const u32x4*)(Wsb + ((size_t)g * 128 + row) * 128 + 8 * chunk);
        R.tu[i] = *(const u32x4*)(UG + (tokc + row) * 512 + g * 128 + 8 * chunk); }
    R.ssq = *(const f32x4*)(GVSSQ + (tokc + (tid & 127)) * 4);
}
__device__ __forceinline__ void gmlp_unit(const GmlpRegs& R, int b, int ch, int g, const float* v_g, const float* b_s, bf16_t* Y1, LAS unsigned char* lds, const int wv) {
    const int lane = lane_id(), tid = wv * 64 + lane, r32 = lane & 31, hi = lane >> 5;
    const int wid = wv;
    const int dt = wid & 3, th = wid >> 2;
    LAS unsigned char* At = lds; LAS unsigned char* Wt = lds + 32768; LAS unsigned char* Ut = lds + 65536;
    LAS float* rsd = (LAS float*)(lds + 98304);
    const size_t tokc = (size_t)b * SEQ + ch * 128;
    {
        const int chunk = tid & 15, rb = tid >> 4;
        if (tid < 128) { const f32x4 p = R.ssq; rsd[tid] = rsqrtf(((p.x + p.y) + (p.z + p.w)) * (1.f / 512.f) + EPS); }
#pragma unroll
        for (int i = 0; i < 4; ++i) { const int row = rb + 32 * i; *(LAS u32x4*)(At + gsw(row, chunk)) = R.ta[i]; *(LAS u32x4*)(Wt + gsw(row, chunk)) = R.tw[i]; *(LAS u32x4*)(Ut + gsw(row, chunk)) = R.tu[i]; }
    }
    float bsf[2]; f32x4 vgf[4];
#pragma unroll
    for (int tt = 0; tt < 2; ++tt) bsf[tt] = b_s[g * 128 + 32 * (2 * th + tt) + r32];
#pragma unroll
    for (int q = 0; q < 4; ++q) vgf[q] = *(const f32x4*)(v_g + g * 128 + 32 * dt + 8 * q + 4 * hi);
    asm volatile("s_waitcnt lgkmcnt(0)\n\ts_barrier" ::: "memory");
    f32x16 acc[2];
#pragma unroll
    for (int i = 0; i < 2; ++i)
#pragma unroll
        for (int r = 0; r < 16; ++r) acc[i][r] = 0.f;
    bf16x8 af[8]; u32x4 wf[2][8];
#pragma unroll
    for (int ks = 0; ks < 8; ++ks) { af[ks] = *(const LAS bf16x8*)(At + gsw(32 * dt + r32, 2 * ks + hi));
#pragma unroll
        for (int tt = 0; tt < 2; ++tt) wf[tt][ks] = *(const LAS u32x4*)(Wt + gsw(32 * (2 * th + tt) + r32, 2 * ks + hi)); }
#pragma unroll
    for (int ks = 0; ks < 8; ++ks) {
        const f32x4 r0 = *(const LAS f32x4*)(rsd + 16 * ks + 8 * hi), r1 = *(const LAS f32x4*)(rsd + 16 * ks + 8 * hi + 4);
#pragma unroll
        for (int tt = 0; tt < 2; ++tt) {
            const u32x4 wv4 = wf[tt][ks];
            u32x4 ws2;
            ws2.x = cvt_pk_bf16(bflo(wv4.x) * r0.x, bfhi(wv4.x) * r0.y); ws2.y = cvt_pk_bf16(bflo(wv4.y) * r0.z, bfhi(wv4.y) * r0.w);
            ws2.z = cvt_pk_bf16(bflo(wv4.z) * r1.x, bfhi(wv4.z) * r1.y); ws2.w = cvt_pk_bf16(bflo(wv4.w) * r1.z, bfhi(wv4.w) * r1.w);
            acc[tt] = __builtin_amdgcn_mfma_f32_32x32x16_bf16(af[ks], __builtin_bit_cast(bf16x8, ws2), acc[tt], 0, 0, 0);
        }
    }
#pragma unroll
    for (int tt = 0; tt < 2; ++tt) {
        const int t = 32 * (2 * th + tt) + r32;
        const float bs = bsf[tt];
#pragma unroll
        for (int q = 0; q < 4; ++q) {
            LAS u32x2* up = (LAS u32x2*)(Ut + gsw(t, 4 * dt + q) + 8 * hi);
            const f32x4 vg = vgf[q];
            const u32x2 ug = *up;
            u32x2 w;
            w.x = cvt_pk_bf16(bflo(ug.x) * (vg.x * acc[tt][4 * q] + bs), bfhi(ug.x) * (vg.y * acc[tt][4 * q + 1] + bs));
            w.y = cvt_pk_bf16(bflo(ug.y) * (vg.z * acc[tt][4 * q + 2] + bs), bfhi(ug.y) * (vg.w * acc[tt][4 * q + 3] + bs));
            *up = w;
        }
    }
    asm volatile("s_waitcnt lgkmcnt(0)\n\ts_barrier" ::: "memory");
    {
        const int chunk = tid & 15, rb = tid >> 4;
#pragma unroll
        for (int i = 0; i < 4; ++i) { const int row = rb + 32 * i; *(u32x4*)(Y1 + (tokc + row) * 1024 + g * 128 + 8 * chunk) = *(const LAS u32x4*)(Ut + gsw(row, chunk)); }
    }
    asm volatile("s_waitcnt lgkmcnt(0)\n\ts_barrier" ::: "memory");
}
struct ConvRegs { u32x4 chv[10], bgv[8]; };
__device__ __forceinline__ void conv_load(ConvRegs& R, int row0, const bf16_t* BG, const bf16_t* CH, int lane) {
    const bool top = (row0 & 2047) == 0, bot = ((row0 + 7) & 2047) == 2047;
    R.chv[0] = *(const u32x4*)(CH + (size_t)(top ? row0 : row0 - 1) * 512 + 8 * lane);
#pragma unroll
    for (int i = 0; i < 8; ++i) { R.chv[i + 1] = *(const u32x4*)(CH + (size_t)(row0 + i) * 512 + 8 * lane); R.bgv[i] = *(const u32x4*)(BG + (size_t)(row0 + i) * 512 + 8 * lane); }
    R.chv[9] = *(const u32x4*)(CH + (size_t)(bot ? row0 + 7 : row0 + 8) * 512 + 8 * lane);
}
__device__ __forceinline__ void conv_finish(const ConvRegs& R, int row0, const float* conv_w, bf16_t* Y1, int lane) {
    const bool top = (row0 & 2047) == 0, bot = ((row0 + 7) & 2047) == 2047;
    float w[3][8];
#pragma unroll
    for (int j = 0; j < 3; ++j) { const f32x4 a = *(const f32x4*)(conv_w + j * 512 + 8 * lane), bq = *(const f32x4*)(conv_w + j * 512 + 8 * lane + 4);
        w[j][0] = a.x; w[j][1] = a.y; w[j][2] = a.z; w[j][3] = a.w; w[j][4] = bq.x; w[j][5] = bq.y; w[j][6] = bq.z; w[j][7] = bq.w; }
#pragma unroll
    for (int i = 0; i < 8; ++i) {
        float o[8];
#pragma unroll
        for (int e = 0; e < 4; ++e) {
            const unsigned pw = (i == 0 && top) ? 0u : R.chv[i][e], cw = R.chv[i + 1][e], nw = (i == 7 && bot) ? 0u : R.chv[i + 2][e], bw = R.bgv[i][e];
            o[2 * e] = bflo(bw) * (w[0][2 * e] * bflo(pw) + w[1][2 * e] * bflo(cw) + w[2][2 * e] * bflo(nw));
            o[2 * e + 1] = bfhi(bw) * (w[0][2 * e + 1] * bfhi(pw) + w[1][2 * e + 1] * bfhi(cw) + w[2][2 * e + 1] * bfhi(nw));
        }
        u32x4 wv; wv.x = cvt_pk_bf16(o[0], o[1]); wv.y = cvt_pk_bf16(o[2], o[3]); wv.z = cvt_pk_bf16(o[4], o[5]); wv.w = cvt_pk_bf16(o[6], o[7]);
        *(u32x4*)(Y1 + (size_t)(row0 + i) * 1024 + 512 + 8 * lane) = wv;
    }
}
#ifndef DIAG
#define DIAG 0
#endif
constexpr int N_PHASES = 9;
#ifndef REP
#define REP -1
#endif
#ifndef NDRY
#define NDRY 1
#endif

__global__ void __launch_bounds__(NTHR, 2) mk_fwd(Args args) {
    extern __shared__ __attribute__((aligned(16))) unsigned char lds_raw[];
    Frame F;
#define FRAME_LOAD() do { KArgsPtr ka_ = kargs(); \
    F.lds = (LAS unsigned char*)lds_raw; F.MISC = (volatile LAS unsigned*)(F.lds + LDSCTL_OFF); \
    F.wave = wave0; F.lane = lane_id(); F.tid = wave0 * 64 + F.lane; \
    F.G = gridDim.x; { const int bx = blockIdx.x; F.vcu = (F.G % 8 == 0) ? (bx % 8) * (F.G / 8) + bx / 8 : bx; } \
    F.ws = ka_->ws; F.ctl = (unsigned*)(F.ws + WS_CTL); F.misc = (float*)(F.ws + WS_MISC); F.out = ka_->out; \
    F.x = ka_->in[0]; F.c = ka_->in[1]; F.ctx = ka_->in[2]; F.c_ctx = ka_->in[3]; F.norm_gain = ka_->in[4]; F.ada_w = ka_->in[5]; F.ada_b = ka_->in[6]; \
    F.even_w_in = ka_->in[7]; F.even_w_out = ka_->in[8]; F.qk_gain = ka_->in[9]; F.lam_p = ka_->in[10]; F.subln_g = ka_->in[11]; F.lb_logits = ka_->in[12]; F.hgrn_g = ka_->in[13]; \
    F.odd_w_in = ka_->in[14]; F.odd_w_out = ka_->in[15]; F.v_g = ka_->in[16]; F.w_s = ka_->in[17]; F.b_s = ka_->in[18]; F.conv_w = ka_->in[19]; } while (0)
    const int wave0 = __builtin_amdgcn_readfirstlane(threadIdx.x >> 6);
    FRAME_LOAD();
    for (int u = F.tid; u < (LDS_BYTES - LDSCTL_OFF) / 4; u += NTHR) ((LAS unsigned*)(F.lds + LDSCTL_OFF))[u] = 0u;
    __syncthreads();
    XcdBarrier bar = xcd_barrier_post(F.ctl + CW_BAR, F.MISC + 8, F.tid);
    const int lo = args.ph_lo, hi = args.ph_hi;
#ifdef ONLYPH
#define IN(k) ((k) == ONLYPH && lo <= (k) && (k) < hi)
#else
#define IN(k) (lo <= (k) && (k) < hi)
#endif
#define BOTH(k) (IN(k) && IN((k) + 1))
#if DIAG == 10
#define STAMP(k) do { if (blockIdx.x == 0 && wave0 == 0 && lane_id() == 0) ((unsigned long long*)(kargs()->ws + WS_CTL + 900000))[k] = __builtin_amdgcn_s_memrealtime(); } while (0)
#else
#define STAMP(k) do {} while (0)
#endif
#define GRID_BAR() xcd_barrier(bar, wave0 * 64 + lane_id())
    unsigned char* ws;

    STAMP(0);
    if (IN(0)) { for (int rep = 0; rep < (REP == 0 ? 2 : 1); ++rep) { FRAME_LOAD(); p0_prologue(F); if (REP == 0 && rep == 0) GRID_BAR(); } STAMP(1); }
    if (IN(1)) { for (int rep = 0; rep < (REP == 1 ? 2 : 1); ++rep) { FRAME_LOAD(); p0b_phase(F); if (REP == 1 && rep == 0) GRID_BAR(); } if (BOTH(1)) GRID_BAR(); STAMP(2); }
    if (IN(2)) {
        FRAME_LOAD(); ws = F.ws;
        LAS float* tab = (LAS float*)(F.lds + 131072);
        { const float* miscp = (const float*)(ws + WS_MISC); const float* qkg = kargs()->in[9];
          float tv[6]; const float qg = qkg[F.tid & 127];
#pragma unroll
          for (int k = 0; k < 6; ++k) tv[k] = miscp[MI_CS + F.tid + 512 * k];
#pragma unroll
          for (int k = 0; k < 4; ++k) tab[F.tid + 512 * k] = tv[k];
          if (F.tid < 128) tab[2048 + F.tid] = qg;
          tab[2176 + F.tid] = tv[4]; tab[2176 + 512 + F.tid] = tv[5];
          __syncthreads(); }
        P1Order S{F.G, (int)blockIdx.x}; EpiP1 E{tab};
        for (int rep = 0; rep < (REP == 2 ? 2 : 1); ++rep) { pg8::gemm_phase<EpiP1, P1Order>(F.lds, DM, S, E, wave0); if (REP == 2 && rep == 0) GRID_BAR(); }
        if ((int)blockIdx.x >= 208) { FRAME_LOAD(); weight_copies(F, 1, ((int)blockIdx.x - 208) * NWAVES + F.wave, 48 * NWAVES); }
        if (BOTH(2)) GRID_BAR();
        STAMP(3);
    }
    if (IN(3)) {
        FRAME_LOAD(); ws = F.ws;
        const int g = blockIdx.x & 7;
        const float lam = __uint_as_float(__hip_atomic_load((unsigned*)(F.misc + MI_SCAL), __ATOMIC_RELAXED, __HIP_MEMORY_SCOPE_AGENT));
        const float M2 = __uint_as_float(__hip_atomic_load((unsigned*)(F.misc + MI_SCAL + 1), __ATOMIC_RELAXED, __HIP_MEMORY_SCOPE_AGENT));
        for (int rep = 0; rep < ((REP == 3 || REP == 30 || REP == 31) ? 2 : (REP == 32 ? 1 + NDRY : 1)); ++rep) {
        const bool dry = (REP == 3 || REP == 30 || REP == 31) ? (rep == 0) : (REP == 32 ? rep < NDRY : false);
        unsigned acq_mask = 0u;
        bool have = false;
        constexpr bool EARLY = (REP < 0 || REP == 32);
        int first_out = 200;
        const int QOFF = EARLY ? ((int)gridDim.x + 7 - g) / 8 : 0;
        bool first = EARLY;
        for (;;) {
            if (!have && !first) {
                if (wave0 == 0 && lane_id() == 0) ((volatile LAS unsigned*)((LAS unsigned char*)lds_raw + LDSCTL_OFF))[16] = __hip_atomic_fetch_add((unsigned*)(kargs()->ws + WS_CTL) + CW_QUEUE + 64 * (g + 8 * rep), 1u, __ATOMIC_RELAXED, __HIP_MEMORY_SCOPE_AGENT);
                __syncthreads();
            }
            const int idx = first ? ((int)blockIdx.x >> 3) : (int)((volatile LAS unsigned*)((LAS unsigned char*)lds_raw + LDSCTL_OFF))[16] + QOFF;
            if (!have && !first) __syncthreads();
            first = false;
            have = EARLY;
            unsigned* qc = EARLY ? (unsigned*)(kargs()->ws + WS_CTL) + CW_QUEUE + 64 * (g + 8 * rep) : nullptr;
            if (idx >= 72) { first_out = idx; break; }
            if (REP == 30 && rep == 0 && idx < 8) { have = false; continue; }
            if (REP == 32 && dry && idx < 72) { have = false; continue; }
            if (REP == 31 && rep == 0 && idx >= 8) break;
            if (idx < 8) {
                const int cch = g * 8 + idx;
                { unsigned char* w2 = kargs()->ws;
                  hg::state_chain(cch >> 3, (cch >> 1) & 3, cch & 1, (const unsigned short*)(w2 + WS_LF), (const bf16_t*)(w2 + WS_HVT), (bf16_t*)(w2 + WS_ST), (LAS unsigned char*)lds_raw, wave0, qc); }
                if (wave0 == 0 && lane_id() == 0) { __builtin_amdgcn_fence(__ATOMIC_RELEASE, "agent"); asm volatile("s_waitcnt vmcnt(0)" ::: "memory");
                    __hip_atomic_store((unsigned*)(kargs()->ws + WS_CTL) + CW_FLAG + 64 * cch + 16 * rep, 1u, __ATOMIC_RELAXED, __HIP_MEMORY_SCOPE_AGENT); }
            } else {
                const int j = idx - 8; const int pair = g * 4 + (j >> 4), qb = j & 15;
                KArgsPtr ka2 = kargs(); unsigned char* w2 = ka2->ws;
                att::attn_unit(pair >> 2, pair & 3, qb, (bf16_t*)(w2 + WS_Y), (const bf16_t*)(w2 + WS_KC), (const bf16_t*)(w2 + WS_VT), (const bf16_t*)(w2 + WS_GA), ka2->in[11], lam, M2, (LAS unsigned char*)lds_raw, wave0, dry, qc);
            }
        }
        if (first_out < 200 && !((REP == 30 || REP == 31) && rep == 0)) {
            unsigned* qc = EARLY ? (unsigned*)(kargs()->ws + WS_CTL) + CW_QUEUE + 64 * (g + 8 * rep) : nullptr;
            hg::OutPre P; bool pre = false; int cur = first_out;
            { unsigned z0 = 0u; asm volatile("" : "+v"(z0));
#pragma unroll
              for (int j0 = 0; j0 < 8; ++j0) { P.fa[j0] = z0; P.fb[j0] = z0; P.fq[j0] = z0; P.sraw[j0 >> 2][j0 & 3] = (u32x4){z0, z0, z0, z0}; if (j0 < 2) P.vraw[j0] = (u32x4){z0, z0, z0, z0}; } }
            { const float* hg_g = kargs()->in[13]; if (wave0 < 2) ((LAS float*)((LAS unsigned char*)lds_raw + 156672))[wave0 * 64 + lane_id()] = hg_g[wave0 * 64 + lane_id()]; __syncthreads(); }
            for (;;) {
                const int j = cur - 72; const int hh = j >> 5, lc = j & 31;
                if (!((acq_mask >> hh) & 1u) && !(REP == 32 && dry)) {
                acq_mask |= 1u << hh;
                if (wave0 == 0) {
                    unsigned* f0 = (unsigned*)(kargs()->ws + WS_CTL) + CW_FLAG + 64 * (g * 8 + 2 * hh) + 16 * rep; unsigned sp = 0;
                    while ((__hip_atomic_load(f0, __ATOMIC_RELAXED, __HIP_MEMORY_SCOPE_AGENT) == 0u || __hip_atomic_load(f0 + 64, __ATOMIC_RELAXED, __HIP_MEMORY_SCOPE_AGENT) == 0u) && ++sp < (1u << 22)) __builtin_amdgcn_s_sleep(8);
                    __builtin_amdgcn_fence(__ATOMIC_ACQUIRE, "agent");
                    asm volatile("s_waitcnt vmcnt(0)" ::: "memory");
                }
                __syncthreads();
                }
                int nidx = -1; bool npre = false;
                hg::out_unit(g, hh, lc, (LAS unsigned char*)lds_raw, wave0, P, pre, acq_mask, QOFF, nidx, npre, dry, qc);
                if (!EARLY) {
                    if (wave0 == 0 && lane_id() == 0) ((volatile LAS unsigned*)((LAS unsigned char*)lds_raw + LDSCTL_OFF))[16] = __hip_atomic_fetch_add((unsigned*)(kargs()->ws + WS_CTL) + CW_QUEUE + 64 * (g + 8 * rep), 1u, __ATOMIC_RELAXED, __HIP_MEMORY_SCOPE_AGENT);
                    __syncthreads();
                    nidx = (int)((volatile LAS unsigned*)((LAS unsigned char*)lds_raw + LDSCTL_OFF))[16]; npre = false;
                    __syncthreads();
                }
                cur = nidx; pre = npre;
                if (cur >= 200) break;
            }
        }
        if (dry) GRID_BAR();
        }
        if (BOTH(3)) GRID_BAR();
        STAMP(4);
    }
    if (IN(5)) {
        FRAME_LOAD(); ws = F.ws;
        OutOrder<WS_Y, WS_WO0> S{F.G, (int)blockIdx.x}; EpiP4 E;
        for (int rep = 0; rep < (REP == 5 ? 2 : 1); ++rep) { pg8::gemm_phase<EpiP4, OutOrder<WS_Y, WS_WO0>>(F.lds, DM, S, E, wave0); if (REP == 5 && rep == 0) GRID_BAR(); }
        if (BOTH(5)) GRID_BAR();
        STAMP(6);
    }
    if (IN(6)) {
        FRAME_LOAD(); ws = F.ws;
        P5Order S{F.G, (int)blockIdx.x}; P5HalfOrder SH{F.G, (int)blockIdx.x};
        LAS float* rst = (LAS float*)(F.lds + 131072);
        int tpm = -1, tpn = -1, tpmh = -1;
        { pg8::Unit u0; if (S.next(0, u0)) tpm = u0.pm; if (SH.next(0, u0)) { tpn = u0.pn; tpmh = u0.pm; }
          const float* ssq1 = (const float*)(ws + WS_SSQ1); const float* bias1 = (const float*)(ws + WS_MISC) + MI_BIAS1;
          const int r = F.tid; const bool full = r < 256; const int blk = full ? tpm : tpn; const int blkc = blk < 0 ? 0 : blk;
          const size_t row = full ? (size_t)blkc * 256 + r : (size_t)blkc * 128 + ((r - 256) & 127);
          const f32x4* pp = (const f32x4*)(ssq1 + row * 16); const f32x4 qa = pp[0], qb = pp[1], qc4 = pp[2], qd = pp[3];
          const int bb = (tpm < 0 ? 0 : tpm) >> 3, bh = (tpn < 0 ? 0 : tpn) >> 4, pmh = tpmh < 0 ? 0 : tpmh;
          float bv[6];
#pragma unroll
          for (int k = 0; k < 6; ++k) bv[k] = bias1[bb * OIN + F.tid + 512 * k];
          const float bhv = bias1[bh * OIN + 3072 + pmh * 256 + (F.tid & 255)];
          if (F.tid < 384 && blk >= 0) rst[r] = rsqrtf((((qa.x + qa.y) + (qa.z + qa.w)) + ((qb.x + qb.y) + (qb.z + qb.w)) + ((qc4.x + qc4.y) + (qc4.z + qc4.w)) + ((qd.x + qd.y) + (qd.z + qd.w))) * (1.f / 1024.f) + EPS);
#pragma unroll
          for (int k = 0; k < 6; ++k) rst[384 + F.tid + 512 * k] = bv[k];
          if (F.tid < 256) rst[384 + 3072 + F.tid] = bhv;
          __syncthreads(); }
        EpiP5 E{rst, tpm};
        for (int rep = 0; rep < (REP == 6 ? 2 : 1); ++rep) {
            pg8::gemm_phase<EpiP5, P5Order>(F.lds, DM, S, E, wave0);
            { EpiP5H EH{rst + 256, tpn, tpmh}; pg8::gemm_phase<EpiP5H, P5HalfOrder, true>(F.lds, DM, SH, EH, wave0); }
            if (REP == 6 && rep == 0) GRID_BAR(); }
        if (BOTH(6)) GRID_BAR();
        STAMP(7);
    }
    if (IN(7)) {
        FRAME_LOAD(); ws = F.ws;
        for (int rep = 0; rep < (REP == 7 ? 2 : 1); ++rep) {
        const int uA = (F.vcu >> 5) * 64 + (F.vcu & 31), uB = uA + 32;
        const int row0 = (F.vcu * NWAVES + F.wave) * 8;
        GmlpRegs GR; ConvRegs CR;
        gmlp_load(GR, uA >> 6, (uA >> 2) & 15, uA & 3, (const bf16_t*)(ws + WS_GVT), (const float*)(ws + WS_GVSSQ), (const bf16_t*)(ws + WS_WS), (const bf16_t*)(ws + WS_UG), wave0);
        conv_load(CR, row0, (const bf16_t*)(ws + WS_BG), (const bf16_t*)(ws + WS_CH), F.lane);
        gmlp_unit(GR, uA >> 6, (uA >> 2) & 15, uA & 3, F.v_g, F.b_s, (bf16_t*)(ws + WS_Y), F.lds, wave0);
        gmlp_load(GR, uB >> 6, (uB >> 2) & 15, uB & 3, (const bf16_t*)(ws + WS_GVT), (const float*)(ws + WS_GVSSQ), (const bf16_t*)(ws + WS_WS), (const bf16_t*)(ws + WS_UG), wave0);
        conv_finish(CR, row0, F.conv_w, (bf16_t*)(ws + WS_Y), F.lane);
        gmlp_unit(GR, uB >> 6, (uB >> 2) & 15, uB & 3, F.v_g, F.b_s, (bf16_t*)(ws + WS_Y), F.lds, wave0);
        if (REP == 7 && rep == 0) GRID_BAR();
        }
        if (BOTH(7)) GRID_BAR();
        STAMP(8);
    }
    if (IN(8)) {
        FRAME_LOAD(); ws = F.ws;
        OutOrder<WS_Y, WS_WO1> S{F.G, (int)blockIdx.x}; EpiP7 E;
        pg8::gemm_phase<EpiP7, OutOrder<WS_Y, WS_WO1>>(F.lds, DM, S, E, wave0);
        STAMP(9);
    }
#undef IN
#undef BOTH
}

#if DIAG

#endif

extern "C" void kernel_launch(void* const* d_in, const int* in_sizes, int n_in, void* d_out, int out_size, void* d_ws, size_t ws_size, hipStream_t stream) {
    static int grid = 0;
    if (grid == 0) {
        int dev = 0, cus = 0;
        if (hipGetDevice(&dev) != hipSuccess || hipDeviceGetAttribute(&cus, hipDeviceAttributeMultiprocessorCount, dev) != hipSuccess) { fprintf(stderr, "kernel_launch: device query failed\n"); grid = -1; return; }
        if (hipFuncSetAttribute((const void*)mk_fwd, hipFuncAttributeMaxDynamicSharedMemorySize, LDS_BYTES) != hipSuccess) { fprintf(stderr, "kernel_launch: hipFuncSetAttribute failed\n"); grid = -1; return; }
        int per_cu = 0;
        if (hipOccupancyMaxActiveBlocksPerMultiprocessor(&per_cu, (const void*)mk_fwd, NTHR, LDS_BYTES) != hipSuccess || per_cu < 1) { fprintf(stderr, "kernel_launch: occupancy query says %d blocks/CU\n", per_cu); }
        (void)hipGetLastError();
        grid = cus;
        if (ws_size < WS_END) { fprintf(stderr, "kernel_launch: workspace too small\n"); grid = -1; return; }
    }
    if (grid < 0) return;
    (void)hipMemsetAsync((char*)d_ws + WS_CTL, 0, CTL_ZERO_BYTES, stream);
    Args a{};
    for (int i = 0; i < 20; ++i) a.in[i] = (const float*)d_in[i];
    a.out = (float*)d_out; a.ws = (unsigned char*)d_ws;
#ifdef OUT_SKIP
    a.dbg = OUT_SKIP;
#endif
#if DIAG
    diag_launch(a, grid, d_in, d_out, d_ws, stream);
#else
#if REP >= 91 && REP <= 98
    a.ph_lo = 0; a.ph_hi = REP - 90;
    hipLaunchKernelGGL(mk_fwd, dim3(grid), dim3(NTHR), LDS_BYTES, stream, a);
    (void)hipMemsetAsync((char*)d_ws + WS_CTL, 0, CTL_ZERO_BYTES, stream);
#endif
    a.ph_lo = 0; a.ph_hi = N_PHASES;
    hipLaunchKernelGGL(mk_fwd, dim3(grid), dim3(NTHR), LDS_BYTES, stream, a);
#endif
}
```

```cpp
#define DIAG 0
#define DSEL -1
#include <hip/hip_runtime.h>
#include <math.h>
#include <stdint.h>
#include <cstdio>

#define LAS __attribute__((address_space(3)))
#define GAS __attribute__((address_space(1)))
typedef unsigned short bf16_t;
typedef short bf16x8 __attribute__((ext_vector_type(8)));
typedef short s16x4 __attribute__((ext_vector_type(4)));
typedef float f32x2 __attribute__((ext_vector_type(2)));
typedef float f32x4 __attribute__((ext_vector_type(4)));
typedef float f32x16 __attribute__((ext_vector_type(16)));
typedef unsigned u32x2 __attribute__((ext_vector_type(2)));
typedef unsigned u32x4 __attribute__((ext_vector_type(4)));
typedef _Float16 f16x2_t __attribute__((ext_vector_type(2)));
typedef __bf16 bf16x2_t __attribute__((ext_vector_type(2)));

constexpr int DM = 1024, NB = 8, SEQ = 2048, CTX = 256, KV = SEQ + CTX  , M_TOK = NB * SEQ  , M_CTX = NB * CTX  ;
constexpr int EIN = 4608, OIN = 3584;
constexpr float EPS = 1e-6f;
constexpr float LOG2E = 1.4426950408889634f;
constexpr float LAM_INIT = 0.2f;

constexpr size_t MiB = 1u << 20;
constexpr size_t WS_CTL = 0, CTL_ZERO_BYTES = 1 * MiB;
constexpr size_t WS_MISC = 1 * MiB;
constexpr size_t WS_WT0 = 2 * MiB;
constexpr size_t WS_WO0 = 11 * MiB;
constexpr size_t WS_WT1 = 13 * MiB;
constexpr size_t WS_WO1 = 20 * MiB;
constexpr size_t WS_WS = 22 * MiB;
constexpr size_t WS_SSQ1 = 23 * MiB;
constexpr size_t WS_RA = 24 * MiB;
constexpr size_t WS_XN = WS_RA, WS_CN = WS_RA + 32 * MiB, WS_ST = WS_RA, WS_A1 = WS_RA, WS_X1B = WS_RA + 32 * MiB;
constexpr size_t WS_Y = 88 * MiB;
constexpr size_t WS_KC = 120 * MiB;
constexpr size_t WS_VT = 138 * MiB;
constexpr size_t WS_GA = 156 * MiB;
constexpr size_t WS_HVT = 172 * MiB;
constexpr size_t WS_LF = 190 * MiB;
constexpr size_t WS_GB = 226 * MiB;
constexpr size_t WS_END = 242 * MiB;
constexpr size_t WS_UG = 120 * MiB;
constexpr size_t WS_BG = 136 * MiB;
constexpr size_t WS_CH = 152 * MiB;
constexpr size_t WS_GVT = 168 * MiB;
constexpr size_t WS_GVSSQ = 186 * MiB;
constexpr int GVP = SEQ + 64;
constexpr int MI_MOD = 0;
constexpr int MI_CS = 55296, MI_SN = MI_CS + 1024, MI_LBV = MI_SN + 1024, MI_SCAL = MI_LBV + 1024, MI_BIAS1 = MI_SCAL + 64;
constexpr int CW_BAR = 4096;
constexpr int CW_QUEUE = 16384;
constexpr int CW_FLAG = 32768;
constexpr int CW_XCC = 45056;
constexpr int CW_UNCLEAN = 45056 + 1024;
constexpr int CW_GRP = 49152;
constexpr int CW_ADA = 40960;

__device__ __forceinline__ unsigned cvt_pk_bf16(float lo, float hi) { f32x2 v = {lo, hi}; bf16x2_t b = __builtin_convertvector(v, bf16x2_t); return __builtin_bit_cast(unsigned, b); }
__device__ __forceinline__ unsigned cvt_pk_f16(float lo, float hi) { f32x2 v = {lo, hi}; f16x2_t b = __builtin_convertvector(v, f16x2_t); return __builtin_bit_cast(unsigned, b); }
__device__ __forceinline__ float bf2f(unsigned short h) { return __uint_as_float(((unsigned)h) << 16); }
__device__ __forceinline__ float bflo(unsigned w) { return __uint_as_float(w << 16); }
__device__ __forceinline__ float bfhi(unsigned w) { return __uint_as_float(w & 0xffff0000u); }
__device__ __forceinline__ float silu_fast(float v) { return v * __builtin_amdgcn_rcpf(1.f + __expf(-v)); }
__device__ __forceinline__ float gelu_erf(float v) { return 0.5f * v * (1.f + erff(v * 0.70710678118654752f)); }
__device__ __forceinline__ float wave_sum(float v) {
#pragma unroll
  for (int o = 1; o < 64; o <<= 1) v += __shfl_xor(v, o);
  return v;
}
__device__ __forceinline__ int lane_id() { int l = (int)__builtin_amdgcn_mbcnt_hi(~0u, __builtin_amdgcn_mbcnt_lo(~0u, 0u)); asm volatile("" : "+v"(l)); return l; }
__device__ __forceinline__ float shfl_xor_l(float v, int mask, int lane) { return __int_as_float(__builtin_amdgcn_ds_bpermute((lane ^ mask) << 2, __float_as_int(v))); }
#define LDS_WAIT() asm volatile("s_waitcnt lgkmcnt(0)" ::: "memory")
#define VM_WAIT() asm volatile("s_waitcnt vmcnt(0)" ::: "memory")

namespace pg8 {
constexpr int BM = 256, BK = 64, HALF = 128, HTB = HALF * BK * 2, STAGE_BYTES = 8 * HTB;
__host__ __device__ __forceinline__ int lds_byte(int r, int c) { const int st = (r >> 4) * 2 + (c >> 5), rr = r & 15, cc = c & 31, ob = rr * 64 + cc * 2; return st * 1024 + (ob ^ (((ob >> 9) & 1) << 5)); }
__host__ __device__ __forceinline__ void stage_rc(int b, int& R, int& C) { const int st = b / 1024, sb = b % 1024, swz = sb ^ (((sb >> 9) & 1) << 5); R = (st >> 1) * 16 + swz / 64; C = (st & 1) * 32 + (swz % 64) / 2; }
__host__ __device__ __forceinline__ int perm32(int rho) { const int n = rho >> 4, i = rho & 15; return 8 * (i >> 2) + 4 * n + (i & 3); }

struct Unit { const char* a; const char* b; int ty, pm, pn, aux; };

template <class Epi, class Sched, bool HALFN = false>
__device__ __forceinline__ void gemm_phase(LAS unsigned char* lds, const int K, const Sched& S, const Epi& E, const int wv) {
    const int lane = lane_id(), tid = wv * 64 + lane, wid = wv, wr = wid >> 2, wc = wid & 3, fr = lane & 15, fq = lane >> 4;
    const int nt = K / BK;
    unsigned voffA[2], voffB[2];
#pragma unroll
    for (int i = 0; i < 2; ++i) { int R, C; stage_rc(tid * 16 + i * 8192, R, C); const int Rb = (R & ~31) + perm32(R & 31);
        voffA[i] = (unsigned)(R * K + C) * 2u; voffB[i] = (unsigned)(Rb * K + C) * 2u; }
    const size_t kstep = (size_t)(BK * 2);
    const size_t hstep = (size_t)HALF * K * 2;
    const unsigned ldsw = (unsigned)wid * 1024u;
    const int aoff = lds_byte(wr * 64 + fr, fq * 8), boff = lds_byte(wc * 32 + fr, fq * 8);
#define PG8_SA(b, h) (((b) * 2 + (h)) * HTB)
#define PG8_SB(b, h) ((4 + (b) * 2 + (h)) * HTB)
#define PG8_STAGE(bufoff, gbase, voff) do { _Pragma("unroll") for (int _i = 0; _i < 2; ++_i) \
        __builtin_amdgcn_global_load_lds((const unsigned*)((const char*)(gbase) + (voff)[_i]), (LAS unsigned*)(lds + (bufoff) + ldsw + _i * 8192), 16, 0, 0); } while (0)
#define PG8_LDA(dst, b, h) do { _Pragma("unroll") for (int m = 0; m < 4; ++m) _Pragma("unroll") for (int k = 0; k < 2; ++k) dst[m][k] = *(const LAS bf16x8*)(lds + PG8_SA(b, h) + aoff + m * 2048 + k * 1024); } while (0)
#define PG8_LDB(dst, b, h) do { _Pragma("unroll") for (int n = 0; n < 2; ++n) _Pragma("unroll") for (int k = 0; k < 2; ++k) dst[n][k] = *(const LAS bf16x8*)(lds + PG8_SB(b, h) + boff + n * 2048 + k * 1024); } while (0)
#define PG8_MMA(ai, bj, At, Bt) do { __builtin_amdgcn_s_setprio(1); _Pragma("unroll") for (int m = 0; m < 4; ++m) _Pragma("unroll") for (int n = 0; n < 2; ++n) _Pragma("unroll") for (int k = 0; k < 2; ++k) \
        acc[ai][bj][m][n] = __builtin_amdgcn_mfma_f32_16x16x32_bf16(Bt[n][k], At[m][k], acc[ai][bj][m][n], 0, 0, 0); __builtin_amdgcn_s_setprio(0); } while (0)
#define PG8_WAIT_V(n) asm volatile("s_waitcnt vmcnt(" #n ")" ::: "memory")
#define PG8_WAIT_L(n) asm volatile("s_waitcnt lgkmcnt(" #n ")" ::: "memory")
#define PG8_BAR __builtin_amdgcn_s_barrier()
#define PG8_SCHED __builtin_amdgcn_sched_barrier(0)
    Unit cur, nxt; int ui = 0;
    if (!S.next(0, cur)) return;
    f32x4 acc[2][2][4][2];
#pragma unroll
    for (int a = 0; a < 2; ++a)
#pragma unroll
        for (int b = 0; b < 2; ++b)
#pragma unroll
            for (int m = 0; m < 4; ++m)
#pragma unroll
                for (int n = 0; n < 2; ++n) acc[a][b][m][n] = (f32x4){0.f, 0.f, 0.f, 0.f};
    bf16x8 At[4][2], B0[2][2], B1[2][2];
    const char* cA = cur.a; const char* cB = cur.b;
    PG8_STAGE(PG8_SB(0, 0), cB, voffB); if (!HALFN) PG8_STAGE(PG8_SB(0, 1), cB + hstep, voffB); PG8_STAGE(PG8_SA(0, 0), cA, voffA); PG8_STAGE(PG8_SA(0, 1), cA + hstep, voffA);
    if (wr == 1) PG8_BAR;
    PG8_WAIT_V(2); PG8_BAR;
    PG8_STAGE(PG8_SB(1, 0), cB + kstep, voffB); PG8_STAGE(PG8_SA(1, 0), cA + kstep, voffA); if (!HALFN) PG8_STAGE(PG8_SB(1, 1), cB + hstep + kstep, voffB);
    if (HALFN) PG8_WAIT_V(4); else PG8_WAIT_V(6); PG8_BAR;
    for (;;) {
        const bool has_next = S.next(ui + 1, nxt);
        const char* nA = has_next ? nxt.a : cA; const char* nB = has_next ? nxt.b : cB;
        for (int t = 0; t < nt; t += 2) {
            const bool last = (t == nt - 2);
            const char* a1 = cA + (size_t)(t + 1) * kstep;
            const char* a2 = last ? nA : cA + (size_t)(t + 2) * kstep; const char* b2 = last ? nB : cB + (size_t)(t + 2) * kstep;
            const char* a3 = a2 + kstep; const char* b3 = b2 + kstep;
#define PG8_WAIT_VK() do { if (HALFN) PG8_WAIT_V(6); else PG8_WAIT_V(8); } while (0)
            PG8_LDB(B0, 0, 0); if (!HALFN) PG8_LDB(B1, 0, 1); PG8_SCHED; PG8_LDA(At, 0, 0); PG8_STAGE(PG8_SA(1, 1), a1 + hstep, voffA);
            PG8_WAIT_VK(); PG8_WAIT_L(0); PG8_BAR; PG8_MMA(0, 0, At, B0); if (!HALFN) PG8_MMA(0, 1, At, B1); PG8_BAR; PG8_SCHED;
            PG8_LDA(At, 0, 1); PG8_STAGE(PG8_SB(0, 0), b2, voffB); if (!HALFN) PG8_STAGE(PG8_SB(0, 1), b2 + hstep, voffB); PG8_STAGE(PG8_SA(0, 0), a2, voffA);
            PG8_WAIT_VK(); PG8_WAIT_L(0); PG8_BAR; PG8_MMA(1, 0, At, B0); if (!HALFN) PG8_MMA(1, 1, At, B1); PG8_BAR; PG8_SCHED;
            PG8_LDB(B0, 1, 0); if (!HALFN) PG8_LDB(B1, 1, 1); PG8_SCHED; PG8_LDA(At, 1, 0); PG8_STAGE(PG8_SA(0, 1), a2 + hstep, voffA);
            PG8_WAIT_VK(); PG8_WAIT_L(0); PG8_BAR; PG8_MMA(0, 0, At, B0); if (!HALFN) PG8_MMA(0, 1, At, B1); PG8_BAR; PG8_SCHED;
            PG8_LDA(At, 1, 1); PG8_STAGE(PG8_SB(1, 0), b3, voffB); if (!HALFN) PG8_STAGE(PG8_SB(1, 1), b3 + hstep, voffB); PG8_STAGE(PG8_SA(1, 0), a3, voffA);
            PG8_WAIT_VK(); PG8_WAIT_L(0); PG8_BAR; PG8_MMA(1, 0, At, B0); if (!HALFN) PG8_MMA(1, 1, At, B1); PG8_BAR; PG8_SCHED;
#undef PG8_WAIT_VK
        }
        if (wr == 0) PG8_BAR;
        { int ln_ = (int)__builtin_amdgcn_mbcnt_hi(~0u, __builtin_amdgcn_mbcnt_lo(~0u, 0u)); asm volatile("" : "+v"(ln_));
          E(acc, cur, wr, wc, ln_ & 15, ln_ >> 4, ln_); }
        if (!has_next) break;
#pragma unroll
        for (int a = 0; a < 2; ++a)
#pragma unroll
            for (int b = 0; b < 2; ++b)
#pragma unroll
                for (int m = 0; m < 4; ++m)
#pragma unroll
                    for (int n = 0; n < 2; ++n) acc[a][b][m][n] = (f32x4){0.f, 0.f, 0.f, 0.f};
        cur = nxt; cA = nA; cB = nB; ++ui;
        if (wr == 1) PG8_BAR;
    }
    PG8_WAIT_V(0);
    PG8_BAR;
#undef PG8_SA
#undef PG8_SB
#undef PG8_STAGE
#undef PG8_LDA
#undef PG8_LDB
#undef PG8_MMA
#undef PG8_WAIT_V
#undef PG8_WAIT_L
#undef PG8_BAR
#undef PG8_SCHED
}
}

__device__ __forceinline__ void ticket_draw(unsigned* qctr, unsigned& tk) {
    const unsigned one = 1u;
    asm volatile("global_atomic_add %0, %1, %2, off sc0" : "=v"(tk) : "v"(qctr), "v"(one) : "memory");
}
__device__ __forceinline__ void ticket_wait(unsigned& tk) { asm volatile("s_waitcnt vmcnt(0)" : "+v"(tk) :: "memory"); }
__device__ __forceinline__ void group_barrier_light(unsigned* cnt, unsigned target, int tid) {
    asm volatile("s_waitcnt vmcnt(0)" ::: "memory");
    __syncthreads();
    if (tid == 0) {
        const unsigned old = __hip_atomic_fetch_add(cnt, 1u, __ATOMIC_RELAXED, __HIP_MEMORY_SCOPE_AGENT);
        if (old + 1u == target) __hip_atomic_store(cnt + 64, 1u, __ATOMIC_RELAXED, __HIP_MEMORY_SCOPE_AGENT);
        else { unsigned sp = 0u; while (__hip_atomic_load(cnt + 64, __ATOMIC_RELAXED, __HIP_MEMORY_SCOPE_AGENT) == 0u && ++sp < (1u << 22)) __builtin_amdgcn_s_sleep(1); }
        __builtin_amdgcn_fence(__ATOMIC_ACQUIRE, "agent");
        asm volatile("s_waitcnt vmcnt(0)" ::: "memory");
    }
    __syncthreads();
}
#define XB_TMO      128
#define XB_XCNT(j)  (256  + 64 * (j))
#define XB_XSUB(j)  (1280 + 64 * (j))
#define XB_XGEN(j)  (2304 + 64 * (j))
#define XB_TOP      3328
#define XB_TOPGEN   3392
#define XCD_BAR_WORDS 3456
#define XB_SPIN_CAP (1u << 18)
__device__ __forceinline__ unsigned xb_ld(unsigned* p)              { return __hip_atomic_load(p, __ATOMIC_RELAXED, __HIP_MEMORY_SCOPE_AGENT); }
__device__ __forceinline__ unsigned xb_add(unsigned* p, unsigned v) { return __hip_atomic_fetch_add(p, v, __ATOMIC_RELAXED, __HIP_MEMORY_SCOPE_AGENT); }
__device__ __forceinline__ unsigned xb_xcc_id() { return (unsigned)__builtin_amdgcn_s_getreg((3 << 11) | 20) & 0xFu; }
#define XB_SPIN(cond, bar) do { unsigned _sp = 0; while (cond) { __builtin_amdgcn_s_sleep(1); \
    if ((++_sp & 255u) == 0u) { if (xb_ld(&(bar)[XB_TMO])) break; if (_sp > XB_SPIN_CAP) { atomicAdd(&(bar)[XB_TMO], 1u); break; } } } } while (0)
struct XcdBarrier { unsigned* bar; unsigned x; volatile LAS unsigned* st; };
__device__ __forceinline__ XcdBarrier xcd_barrier_post(unsigned* bar, volatile LAS unsigned* st, int tid) {
    XcdBarrier b; b.bar = bar; b.x = xb_xcc_id(); b.st = st;
    if (tid == 0) (void)xb_add(&bar[XB_XCNT(b.x)], 1u);
    return b;
}
__device__ __forceinline__ void xcd_barrier_complete(unsigned* bar, unsigned x, unsigned& nloc, unsigned& nx) {
    const unsigned G = gridDim.x * gridDim.y * gridDim.z;
    unsigned sum, cnt, mine, sp = 0u;
    for (;;) {
        sum = 0u; cnt = 0u; mine = 0u;
#pragma unroll
        for (unsigned j = 0; j < 16; ++j) { const unsigned c = xb_ld(&bar[XB_XCNT(j)]); sum += c; cnt += (c > 0u) ? 1u : 0u; mine = (j == x) ? c : mine; }
        if (sum == G) break;
        __builtin_amdgcn_s_sleep(1);
        if ((++sp & 255u) == 0u) { if (xb_ld(&bar[XB_TMO])) break; if (sp > XB_SPIN_CAP) { atomicAdd(&bar[XB_TMO], 1u); break; } }
    }
    nloc = mine > 0u ? mine : 1u; nx = cnt > 0u ? cnt : 1u;
}
__device__ __forceinline__ void xcd_barrier(const XcdBarrier& b, int tid, const bool light = false) {
    asm volatile("s_waitcnt vmcnt(0)" ::: "memory");
    __syncthreads();
    if (tid == 0) {
        unsigned* bar = b.bar;
        __builtin_amdgcn_s_waitcnt(0);
        unsigned nloc = b.st[0], nx = b.st[1];
        if (nloc == 0u) { xcd_barrier_complete(bar, b.x, nloc, nx); b.st[0] = nloc; b.st[1] = nx; }
        const unsigned old = xb_add(&bar[XB_XSUB(b.x)], 1u);
        const unsigned gen = old / nloc;
        if (old + 1u == (gen + 1u) * nloc) {
            if (!light) __builtin_amdgcn_fence(__ATOMIC_RELEASE, "agent");
            asm volatile("s_waitcnt vmcnt(0)" ::: "memory");
            const unsigned og = xb_add(&bar[XB_TOP], 1u);
            const unsigned tg = og / nx;
            if (og + 1u == (tg + 1u) * nx) xb_add(&bar[XB_TOPGEN], 1u);
            else XB_SPIN(xb_ld(&bar[XB_TOPGEN]) == tg, bar);
            __builtin_amdgcn_fence(__ATOMIC_ACQUIRE, "agent");
            xb_add(&bar[XB_XGEN(b.x)], 1u);
            asm volatile("s_waitcnt vmcnt(0)" ::: "memory");
        } else {
            XB_SPIN(xb_ld(&bar[XB_XGEN(b.x)]) == gen, bar);
            __builtin_amdgcn_fence(__ATOMIC_ACQUIRE, "agent");
            asm volatile("s_waitcnt vmcnt(0)" ::: "memory");
        }
    }
    __syncthreads();
}
constexpr int NWAVES = 8, NTHR = 512;
constexpr int RING_BYTES = 131072;
constexpr int LDSX_OFF = RING_BYTES;
constexpr int LDSCTL_OFF = 162816;
constexpr int LDS_BYTES = 163840;

struct Args {
    const float* in[20]; float* out; unsigned char* ws; int ph_lo, ph_hi, dbg, pad;
};
typedef const __attribute__((address_space(4))) Args* KArgsPtr;
__device__ __forceinline__ KArgsPtr kargs() { KArgsPtr p = (KArgsPtr)__builtin_amdgcn_kernarg_segment_ptr(); asm volatile("" : "+s"(p)); return p; }
struct Frame {
    LAS unsigned char* lds;
    volatile LAS unsigned* MISC;
    unsigned* ctl;
    int tid, lane, wave, vcu, G;
    const float *x, *c, *ctx, *c_ctx, *norm_gain, *ada_w, *ada_b, *even_w_in, *even_w_out, *qk_gain, *lam_p, *subln_g, *lb_logits, *hgrn_g,
                *odd_w_in, *odd_w_out, *v_g, *w_s, *b_s, *conv_w;
    float* out; unsigned char* ws; float* misc;
};

__host__ __device__ __forceinline__ int srcmap0(int d) {
    if (d < 1024) { const int base = d < 512 ? 0 : 512; const int e = d & 511; const int pn = e >> 8, rho = e & 255, bj = rho >> 7, wc = (rho >> 5) & 3; return base + (4 * pn + wc) * 64 + 32 * bj + (rho & 31); }
    if (d < 1536) return 1536 + (d - 1024);
    if (d < 2048) return 2048 + (d - 1536);
    if (d < 2560) return 3072 + (d - 2048);
    if (d < 3072) return 3584 + (d - 2560);
    if (d < 3584) return 4096 + (d - 3072);
    if (d < 4096) return 1024 + (d - 3584);
    return 2560 + (d - 4096);
}
__host__ __device__ __forceinline__ int srcmap1(int d) {
    if (d < 1024) { const int t = d >> 8, rho = d & 255, bj = rho >> 7, o = rho & 127; return (bj ? 1024 : 0) + 128 * t + o; }
    if (d < 2048) { const int e = d - 1024; const int t = e >> 8, rho = e & 255, bj = rho >> 7, o = rho & 127; return (bj ? 3072 : 1536) + 128 * t + o; }
    if (d < 3072) { const int e = d - 2048; const int t = e >> 8, rho = e & 255, bj = rho >> 7, o = rho & 127; return (bj ? 2560 : 2048) + 128 * t + o; }
    return 512 + (d - 3072);
}

__device__ __forceinline__ void p0_transpose_item(const float* W, int K, int N, bf16_t* WT, int drow0, int n_src, int k0, LAS float* scr, int lane) {
    float tv[32];
#pragma unroll
    for (int i = 0; i < 32; ++i) { const int kk = 2 * i + (lane >> 5); tv[i] = W[(size_t)(k0 + kk) * N + n_src + (lane & 31)]; }
#pragma unroll
    for (int i = 0; i < 32; ++i) { const int kk = 2 * i + (lane >> 5); scr[kk * 33 + (lane & 31)] = tv[i]; }
    LDS_WAIT(); asm volatile("" ::: "memory");
    const int c = lane & 7;
#pragma unroll
    for (int j = 0; j < 4; ++j) { const int n = (lane >> 3) + 8 * j; const LAS float* s = scr + (8 * c) * 33 + n;
        u32x4 o; o.x = cvt_pk_bf16(s[0 * 33], s[1 * 33]); o.y = cvt_pk_bf16(s[2 * 33], s[3 * 33]); o.z = cvt_pk_bf16(s[4 * 33], s[5 * 33]); o.w = cvt_pk_bf16(s[6 * 33], s[7 * 33]);
        *(u32x4*)(WT + (size_t)(drow0 + n) * K + k0 + 8 * c) = o; }
    LDS_WAIT(); asm volatile("" ::: "memory");
}

__device__ __forceinline__ void weight_copies(Frame& F, int which, int gw, int NGW, int sub_lo = 0, int sub_hi = 1 << 30) {
    LAS float* scr = (LAS float*)(F.lds + F.wave * 16384);
    constexpr int I0 = 16 * (EIN / 32), I1 = 16 * 32, I2 = 16 * (OIN / 32), I3 = 16 * 32, I4 = 128;
    bf16_t* Wt0 = (bf16_t*)(F.ws + WS_WT0); bf16_t* Wo0 = (bf16_t*)(F.ws + WS_WO0); bf16_t* Wt1 = (bf16_t*)(F.ws + WS_WT1); bf16_t* Wo1 = (bf16_t*)(F.ws + WS_WO1); bf16_t* Wsb = (bf16_t*)(F.ws + WS_WS);
    const int lo = (which ? I0 + I1 : 0) + sub_lo, hi0 = which ? I0 + I1 + I2 + I3 + I4 : I0 + I1; const int hi = (lo - sub_lo + sub_hi < hi0) ? lo - sub_lo + sub_hi : hi0;
    for (int it = lo + gw; it < hi; it += NGW) {
        int r = it;
        if (r < I0) { const int kb = r / (EIN / 32), dg = r % (EIN / 32); p0_transpose_item(F.even_w_in, DM, EIN, Wt0, dg * 32, srcmap0(dg * 32), kb * 64, scr, F.lane); continue; } r -= I0;
        if (r < I1) { const int kb = r / 32, dg = r % 32; p0_transpose_item(F.even_w_out, DM, DM, Wo0, dg * 32, dg * 32, kb * 64, scr, F.lane); continue; } r -= I1;
        if (r < I2) { const int kb = r / (OIN / 32), dg = r % (OIN / 32); p0_transpose_item(F.odd_w_in, DM, OIN, Wt1, dg * 32, srcmap1(dg * 32), kb * 64, scr, F.lane); continue; } r -= I2;
        if (r < I3) { const int kb = r / 32, dg = r % 32; p0_transpose_item(F.odd_w_out, DM, DM, Wo1, dg * 32, dg * 32, kb * 64, scr, F.lane); continue; } r -= I3;
        { const int e0 = r * 512 + F.lane * 8; const f32x4 a = *(const f32x4*)(F.w_s + e0), b = *(const f32x4*)(F.w_s + e0 + 4);
          u32x4 o; o.x = cvt_pk_bf16(a.x, a.y); o.y = cvt_pk_bf16(a.z, a.w); o.z = cvt_pk_bf16(b.x, b.y); o.w = cvt_pk_bf16(b.z, b.w); *(u32x4*)(Wsb + e0) = o; }
    }
}
__device__ __forceinline__ void p0_prologue(Frame& F) {
    float* misc = F.misc;
    if (F.vcu < 192) {
        LAS float* sl = (LAS float*)F.lds;
        LAS float* red = (LAS float*)(F.lds + 36864);
        const int cc = F.tid & 31, kp = F.tid >> 5;
        const int gcol = F.vcu * 32 + cc;
        const int l = gcol / 3072, col = gcol % 3072;
        const float* w = F.ada_w + (size_t)l * 1024 * 3072 + col;
        float wv[64];
#pragma unroll
        for (int i = 0; i < 64; ++i) wv[i] = w[(size_t)(kp * 64 + i) * 3072];
        for (int i = F.tid; i < 9 * 1024; i += NTHR) { const int r = i >> 10, k = i & 1023; const float v = (r < 8) ? F.c[r * 1024 + k] : F.c_ctx[k]; sl[i] = v / (1.f + __expf(-v)); }
        __syncthreads();
#pragma unroll
        for (int r = 0; r < 9; ++r) {
            float a = 0.f;
#pragma unroll
            for (int i4 = 0; i4 < 16; ++i4) { const f32x4 sv = *(const LAS f32x4*)(sl + r * 1024 + kp * 64 + 4 * i4);
                a += sv.x * wv[4 * i4] + sv.y * wv[4 * i4 + 1] + sv.z * wv[4 * i4 + 2] + sv.w * wv[4 * i4 + 3]; }
            red[(kp * 9 + r) * 32 + cc] = a;
        }
        __syncthreads();
        if (F.tid < 9 * 32) { const int r = F.tid >> 5, c2 = F.tid & 31; const int gc = F.vcu * 32 + c2; const int l2 = gc / 3072, col2 = gc % 3072;
            float sacc = F.ada_b[l2 * 3072 + col2];
#pragma unroll
            for (int q = 0; q < 16; ++q) sacc += red[(q * 9 + r) * 32 + c2];
            misc[MI_MOD + (l2 * 9 + r) * 3072 + col2] = sacc; }
        asm volatile("s_waitcnt vmcnt(0)" ::: "memory");
        __syncthreads();
        if (F.tid == 0) { __builtin_amdgcn_fence(__ATOMIC_RELEASE, "agent"); __hip_atomic_fetch_add(F.ctl + CW_ADA, 1u, __ATOMIC_RELAXED, __HIP_MEMORY_SCOPE_AGENT); }
    }
    if (F.vcu == 192) {
        for (int i = F.tid; i < 1024; i += NTHR) { const int pos = i >> 4, f = i & 15; const float inv = powf(10000.f, -(float)f / 16.f); const float ang = (float)pos * inv;
            misc[MI_CS + i] = cosf(ang); misc[MI_SN + i] = sinf(ang); }
    }
    if (F.vcu == 193) {
        for (int i = F.tid; i < 1024; i += NTHR) { const int dir = i >> 9, ch = i & 511; const float l0 = F.lb_logits[(dir * 2 + 0) * 512 + ch], l1 = F.lb_logits[(dir * 2 + 1) * 512 + ch];
            const float mx = fmaxf(l0, l1); const float e0 = expf(l0 - mx), e1 = expf(l1 - mx); misc[MI_LBV + i] = e0 / (e0 + e1); }
        if (F.wave == 0) {
            const int i = F.lane;
            float a = F.lam_p[i] * F.lam_p[64 + i], b = F.lam_p[128 + i] * F.lam_p[192 + i], gq = fabsf(F.qk_gain[i]), gk = fabsf(F.qk_gain[64 + i]);
#pragma unroll
            for (int o = 1; o < 64; o <<= 1) { a += __shfl_xor(a, o); b += __shfl_xor(b, o); gq = fmaxf(gq, __shfl_xor(gq, o)); gk = fmaxf(gk, __shfl_xor(gk, o)); }
            if (i == 0) {
                misc[MI_SCAL + 0] = expf(a) - expf(b) + LAM_INIT;
                misc[MI_SCAL + 1] = 8.0f * gq * gk * LOG2E * 1.0001f + 0.01f;
            }
        }
    }
    if (F.vcu >= 194) weight_copies(F, 0, (F.vcu - 194) * NWAVES + F.wave, 62 * NWAVES, 0, 992);
}

__device__ __forceinline__ void mod_rows3(Frame& F, int ma, int mb, int mc, bf16_t* XN, bf16_t* CN) {
    const float* misc = F.misc; const int lane = F.lane;
    f32x4 v[3][4];
#pragma unroll
    for (int r = 0; r < 3; ++r) { const int m = (r == 0) ? ma : (r == 1) ? mb : mc; const float* xrow = (m < M_TOK) ? F.x + (size_t)m * DM : F.ctx + (size_t)(m - M_TOK) * DM; const f32x4* xr = (const f32x4*)xrow + lane;
#pragma unroll
        for (int j = 0; j < 4; ++j) v[r][j] = xr[64 * j]; }
#pragma unroll
    for (int r = 0; r < 3; ++r) {
        const int m = (r == 0) ? ma : (r == 1) ? mb : mc;
        float s = 0.f;
#pragma unroll
        for (int j = 0; j < 4; ++j) s += (v[r][j].x * v[r][j].x + v[r][j].y * v[r][j].y) + (v[r][j].z * v[r][j].z + v[r][j].w * v[r][j].w);
        const float rstd = rsqrtf(wave_sum(s) * (1.f / DM) + EPS);
        const float* modrow = misc + MI_MOD + (0 * 9 + ((m < M_TOK) ? (m >> 11) : 8)) * 3072;
        bf16_t* orow = (m < M_TOK) ? XN + (size_t)m * DM : CN + (size_t)(m - M_TOK) * DM;
        u32x2* o8 = (u32x2*)orow + lane;
#pragma unroll
        for (int j = 0; j < 4; ++j) {
            const int col = 4 * lane + 256 * j;
            const f32x4 g = *(const f32x4*)(F.norm_gain + col), sh = *(const f32x4*)(modrow + col), sc = *(const f32x4*)(modrow + 1024 + col);
            const f32x4 o = v[r][j] * rstd * g * (sc + 1.f) + sh;
            u32x2 w; w.x = cvt_pk_bf16(o.x, o.y); w.y = cvt_pk_bf16(o.z, o.w); o8[64 * j] = w;
        }
    }
}
__device__ __forceinline__ void rows_load(Frame& F, int m, f32x4 (&v)[4]) {
    const float* xrow = (m < M_TOK) ? F.x + (size_t)m * DM : F.ctx + (size_t)(m - M_TOK) * DM; const f32x4* xr = (const f32x4*)xrow + F.lane;
#pragma unroll
    for (int j = 0; j < 4; ++j) v[j] = xr[64 * j];
}
__device__ __forceinline__ void mod_vecs(Frame& F, int modr, f32x4 (&Gm)[4], f32x4 (&Sh)[4]) {
    const float* modrow = F.misc + MI_MOD + (0 * 9 + modr) * 3072;
#pragma unroll
    for (int j = 0; j < 4; ++j) { const int col = 4 * F.lane + 256 * j;
        Gm[j] = *(const f32x4*)(F.norm_gain + col) * (*(const f32x4*)(modrow + 1024 + col) + 1.f); Sh[j] = *(const f32x4*)(modrow + col); }
}
__device__ __forceinline__ void row_proc(Frame& F, int m, const f32x4 (&v)[4], const f32x4 (&Gm)[4], const f32x4 (&Sh)[4], bf16_t* XN, bf16_t* CN) {
    float s = 0.f;
#pragma unroll
    for (int j = 0; j < 4; ++j) s += (v[j].x * v[j].x + v[j].y * v[j].y) + (v[j].z * v[j].z + v[j].w * v[j].w);
    const float rstd = rsqrtf(wave_sum(s) * (1.f / DM) + EPS);
    bf16_t* orow = (m < M_TOK) ? XN + (size_t)m * DM : CN + (size_t)(m - M_TOK) * DM;
    u32x2* o8 = (u32x2*)orow + F.lane;
#pragma unroll
    for (int j = 0; j < 4; ++j) { const f32x4 o = v[j] * rstd * Gm[j] + Sh[j]; u32x2 w; w.x = cvt_pk_bf16(o.x, o.y); w.y = cvt_pk_bf16(o.z, o.w); o8[64 * j] = w; }
}
__device__ __forceinline__ void p0b_phase(Frame& F) {
    const float* misc = F.misc;
    bf16_t* XN = (bf16_t*)(F.ws + WS_XN); bf16_t* CN = (bf16_t*)(F.ws + WS_CN);
    const int gw0 = F.vcu * NWAVES + F.wave;
    f32x4 ra[3][4], rb[3][4];
#pragma unroll
    for (int r = 0; r < 3; ++r) { rows_load(F, 8 * gw0 + r, ra[r]); rows_load(F, 8 * gw0 + 3 + r, rb[r]); }
    weight_copies(F, 0, gw0, F.G * NWAVES, 992);
    __syncthreads();
    if (F.wave == 0) { unsigned sp = 0u;
        while (__hip_atomic_load(F.ctl + CW_ADA, __ATOMIC_RELAXED, __HIP_MEMORY_SCOPE_AGENT) < 192u && ++sp < (1u << 22)) __builtin_amdgcn_s_sleep(2);
        __builtin_amdgcn_fence(__ATOMIC_ACQUIRE, "agent"); }
    __syncthreads();
    {
        LAS float* red = (LAS float*)F.lds;
        LAS float* shs = (LAS float*)(F.lds + 16384);
        const int cc = F.tid & 15, kp = F.tid >> 4;
        float acc[8];
#pragma unroll
        for (int b = 0; b < 8; ++b) acc[b] = 0.f;
        float wv[32];
        if (cc < 14) {
            const int d = F.vcu * 14 + cc; const int src = srcmap1(d & ~31) + (d & 31);
#pragma unroll
            for (int i = 0; i < 32; ++i) wv[i] = F.odd_w_in[(size_t)(kp * 32 + i) * OIN + src];
        } else {
#pragma unroll
            for (int i = 0; i < 32; ++i) wv[i] = 0.f;
        }
        { f32x4 sh4[4];
#pragma unroll
          for (int q = 0; q < 4; ++q) { const int i = F.tid + NTHR * q; const int b = i >> 8, c4 = i & 255; sh4[q] = *(const f32x4*)(misc + MI_MOD + (9 + b) * 3072 + 4 * c4); }
#pragma unroll
          for (int q = 0; q < 4; ++q) { const int i = F.tid + NTHR * q; const int b = i >> 8, c4 = i & 255; *(LAS f32x4*)(shs + b * 1024 + 4 * c4) = sh4[q]; } }
        __syncthreads();
#pragma unroll
        for (int b = 0; b < 8; ++b) {
#pragma unroll
            for (int i4 = 0; i4 < 8; ++i4) { const f32x4 sv = *(const LAS f32x4*)(shs + b * 1024 + kp * 32 + 4 * i4);
                acc[b] += sv.x * wv[4 * i4] + sv.y * wv[4 * i4 + 1] + sv.z * wv[4 * i4 + 2] + sv.w * wv[4 * i4 + 3]; }
        }
        __syncthreads();
#pragma unroll
        for (int b = 0; b < 8; ++b) red[(kp * 8 + b) * 16 + cc] = acc[b];
        __syncthreads();
        if (F.tid < 8 * 14) { const int b = F.tid / 14, c2 = F.tid % 14; float s = 0.f;
            for (int q = 0; q < 32; ++q) s += red[(q * 8 + b) * 16 + c2];
            F.misc[MI_BIAS1 + b * OIN + F.vcu * 14 + c2] = s; }
        __syncthreads();
    }
    {
        const int gw = gw0;
        f32x4 Gm[4], Sh[4];
        mod_vecs(F, (8 * gw) >> 11, Gm, Sh);
#pragma unroll
        for (int r = 0; r < 3; ++r) row_proc(F, 8 * gw + r, ra[r], Gm, Sh, XN, CN);
        rows_load(F, 8 * gw + 6, ra[0]); rows_load(F, 8 * gw + 7, ra[1]); rows_load(F, M_TOK + gw, ra[2]);
        __builtin_amdgcn_sched_barrier(0);
#pragma unroll
        for (int r = 0; r < 3; ++r) row_proc(F, 8 * gw + 3 + r, rb[r], Gm, Sh, XN, CN);
        row_proc(F, 8 * gw + 6, ra[0], Gm, Sh, XN, CN); row_proc(F, 8 * gw + 7, ra[1], Gm, Sh, XN, CN);
        mod_vecs(F, 8, Gm, Sh);
        row_proc(F, M_TOK + gw, ra[2], Gm, Sh, XN, CN);
    }
}

enum { T_Q = 0, T_K = 1, T_SILU = 2, T_PLAIN = 3, T_LF = 4, T_VT = 5 };
struct P1Order {
    int G, c;
    __device__ __forceinline__ bool next(int i, pg8::Unit& u) const {
        const int L = i * G + c;
        const char* wsb = (const char*)kargs()->ws; const char* XN = wsb + WS_XN; const char* CN = wsb + WS_CN; const char* Wt0 = wsb + WS_WT0;
        constexpr size_t TSTEP = (size_t)256 * DM * 2;
        if (L < 896) {
            constexpr int nwg = 896, nN = 14, q = nwg / 8;
            const int xcd = L % 8, offp = L / 8; const int wgid = xcd * q + offp;
            constexpr int nig = 8 * nN; const int gid = wgid / nig, fm = gid * 8;
            u.pm = fm + ((wgid % nig) % 8); u.pn = (wgid % nig) / 8;
            u.a = XN + (size_t)u.pm * TSTEP; u.b = Wt0 + (size_t)u.pn * TSTEP; u.aux = 0;
            u.ty = (u.pn < 2) ? T_Q : (u.pn < 4) ? T_K : (u.pn < 6) ? T_SILU : (u.pn < 8) ? T_PLAIN : (u.pn < 12) ? T_LF : T_SILU;
            return true;
        }
        int r = L - 896;
        if (r < 256) { const int xcd = r % 8, j = r / 8; u.pn = xcd * 8 + j / 4; u.pm = j % 4; u.a = Wt0 + (size_t)(14 + u.pm) * TSTEP; u.b = XN + (size_t)u.pn * TSTEP; u.ty = T_VT; u.aux = 0; return true; }
        r -= 256;
        if (r < 48) { const int pmc = r % 8, j = r / 8; const int pn = (j < 2) ? 2 + j : 6 + j;
            u.pm = pmc; u.pn = pn; u.a = CN + (size_t)pmc * TSTEP; u.b = Wt0 + (size_t)pn * TSTEP; u.aux = 1; u.ty = (pn < 4) ? T_K : T_LF; return true; }
        r -= 48;
        if (r < 32) { u.pn = r % 8; u.pm = r / 8; u.a = Wt0 + (size_t)(14 + u.pm) * TSTEP; u.b = CN + (size_t)u.pn * TSTEP; u.ty = T_VT; u.aux = 1; return true; }
        return false;
    }
};
struct EpiP1 {
    const LAS float* tab;
    __device__ __forceinline__ void operator()(const f32x4 (&acc)[2][2][4][2], const pg8::Unit& u, int wr, int wc, int fr, int fq, int lane) const {
        KArgsPtr ka = kargs(); unsigned char* wsb = ka->ws; const float* qk_gain = ka->in[9];
        bf16_t* Y = (bf16_t*)(wsb + WS_Y); bf16_t* Kc = (bf16_t*)(wsb + WS_KC); bf16_t* VT = (bf16_t*)(wsb + WS_VT); bf16_t* GA = (bf16_t*)(wsb + WS_GA); bf16_t* HVT = (bf16_t*)(wsb + WS_HVT); bf16_t* GB = (bf16_t*)(wsb + WS_GB);
        unsigned short* LF = (unsigned short*)(wsb + WS_LF); const float* miscp = (const float*)(wsb + WS_MISC); const float* CS = miscp + MI_CS; const float* SN = miscp + MI_SN; const float* LBV = miscp + MI_LBV;
        const int ty = u.ty, ctx = u.aux;
        if (ty == T_Q || ty == T_K) {
            const int seg = 4 * (u.pn & 1) + wc;
            const LAS float* gp = tab + 2048 + (ty == T_K ? 64 : 0) + 8 * fq;
            const f32x4 g00 = *(const LAS f32x4*)(gp), g01 = *(const LAS f32x4*)(gp + 4), g10 = *(const LAS f32x4*)(gp + 32), g11 = *(const LAS f32x4*)(gp + 36);
            const float osc = (ty == T_Q) ? 0.125f * LOG2E : 1.f;
#pragma unroll
            for (int ai = 0; ai < 2; ++ai)
#pragma unroll
                for (int m = 0; m < 4; ++m) {
                    const int rt = 128 * ai + 64 * wr + 16 * m + fr;
                    const int t = ((u.pm & 7) * 256 + rt);
                    float ss = 0.f;
#pragma unroll
                    for (int bj = 0; bj < 2; ++bj)
#pragma unroll
                        for (int n = 0; n < 2; ++n) { const f32x4 v = acc[ai][bj][m][n]; ss += (v.x * v.x + v.y * v.y) + (v.z * v.z + v.w * v.w); }
                    ss += __shfl_xor(ss, 16); ss += __shfl_xor(ss, 32);
                    const float rstd = rsqrtf(ss * (1.f / 64.f) + EPS);
                    f32x4 a0 = acc[ai][0][m][0] * rstd * g00, a1 = acc[ai][0][m][1] * rstd * g01, b0 = acc[ai][1][m][0] * rstd * g10, b1 = acc[ai][1][m][1] * rstd * g11;
                    if (!ctx) {
                        const int pos = (fq < 2) ? (t >> 6) : (t & 63);
                        const LAS float* cp = tab + pos * 16 + 8 * (fq & 1); const LAS float* sp = cp + 1024;
                        const f32x4 c0 = *(const LAS f32x4*)cp, c1 = *(const LAS f32x4*)(cp + 4), s0 = *(const LAS f32x4*)sp, s1 = *(const LAS f32x4*)(sp + 4);
                        const f32x4 o0 = a0 * c0 - b0 * s0, o1 = a1 * c1 - b1 * s1, p0 = a0 * s0 + b0 * c0, p1 = a1 * s1 + b1 * c1;
                        a0 = o0; a1 = o1; b0 = p0; b1 = p1;
                    }
                    a0 = a0 * osc; a1 = a1 * osc; b0 = b0 * osc; b1 = b1 * osc;
                    u32x4 w0, w1;
                    w0.x = cvt_pk_bf16(a0.x, a0.y); w0.y = cvt_pk_bf16(a0.z, a0.w); w0.z = cvt_pk_bf16(a1.x, a1.y); w0.w = cvt_pk_bf16(a1.z, a1.w);
                    w1.x = cvt_pk_bf16(b0.x, b0.y); w1.y = cvt_pk_bf16(b0.z, b0.w); w1.z = cvt_pk_bf16(b1.x, b1.y); w1.w = cvt_pk_bf16(b1.z, b1.w);
                    bf16_t* dst;
                    if (ty == T_Q) dst = Y + (size_t)(u.pm * 256 + rt) * 1024 + seg * 64 + 8 * fq;
                    else if (!ctx) dst = Kc + ((size_t)(u.pm >> 3) * KV + CTX + t) * 512 + seg * 64 + 8 * fq;
                    else dst = Kc + ((size_t)u.pm * KV + rt) * 512 + seg * 64 + 8 * fq;
                    *(u32x4*)dst = w0; *(u32x4*)(dst + 32) = w1;
                }
        } else if (ty == T_SILU || ty == T_PLAIN) {
            bf16_t* base; int pitch;
            if (ty == T_PLAIN) { base = Y + 512 + (u.pn - 6) * 256; pitch = 1024; }
            else if (u.pn < 6) { base = GA + (u.pn - 4) * 256; pitch = 512; }
            else { base = GB + (u.pn - 12) * 256; pitch = 512; }
#pragma unroll
            for (int ai = 0; ai < 2; ++ai)
#pragma unroll
                for (int m = 0; m < 4; ++m) {
                    const int rt = 128 * ai + 64 * wr + 16 * m + fr;
                    bf16_t* rowp = base + (size_t)(u.pm * 256 + rt) * pitch + 32 * wc + 8 * fq;
#pragma unroll
                    for (int bj = 0; bj < 2; ++bj) {
                        f32x4 v0 = acc[ai][bj][m][0], v1 = acc[ai][bj][m][1];
                        if (ty == T_SILU) { v0.x = silu_fast(v0.x); v0.y = silu_fast(v0.y); v0.z = silu_fast(v0.z); v0.w = silu_fast(v0.w); v1.x = silu_fast(v1.x); v1.y = silu_fast(v1.y); v1.z = silu_fast(v1.z); v1.w = silu_fast(v1.w); }
                        u32x4 w; w.x = cvt_pk_bf16(v0.x, v0.y); w.y = cvt_pk_bf16(v0.z, v0.w); w.z = cvt_pk_bf16(v1.x, v1.y); w.w = cvt_pk_bf16(v1.z, v1.w);
                        *(u32x4*)(rowp + 128 * bj) = w;
                    }
                }
        } else if (ty == T_LF) {
            const int dir = (u.pn >= 10) ? 1 : 0; const int pnr = (u.pn - 8) & 1;
            const int col0 = 256 * pnr + 32 * wc + 8 * fq;
            f32x4 lb[2][2];
#pragma unroll
            for (int bj = 0; bj < 2; ++bj)
#pragma unroll
                for (int n = 0; n < 2; ++n) lb[bj][n] = *(const LAS f32x4*)(tab + 2176 + dir * 512 + col0 + 128 * bj + 4 * n);
#pragma unroll
            for (int ai = 0; ai < 2; ++ai)
#pragma unroll
                for (int m = 0; m < 4; ++m) {
                    const int rt = 128 * ai + 64 * wr + 16 * m + fr;
                    size_t krow;
                    if (!ctx) krow = ((size_t)(dir * 8 + (u.pm >> 3)) * KV + CTX + (u.pm & 7) * 256 + rt);
                    else krow = ((size_t)(dir * 8 + u.pm) * KV + rt);
                    unsigned short* rowp = LF + krow * 512 + col0;
#pragma unroll
                    for (int bj = 0; bj < 2; ++bj) {
                        float o[8];
#pragma unroll
                        for (int n = 0; n < 2; ++n)
#pragma unroll
                            for (int j = 0; j < 4; ++j) { const float z = acc[ai][bj][m][n][j]; const float l = lb[bj][n][j]; const float f = l + (1.f - l) * __builtin_amdgcn_rcpf(1.f + __expf(-z)); o[4 * n + j] = __builtin_amdgcn_logf(f); }
                        u32x4 w; w.x = cvt_pk_f16(o[0], o[1]); w.y = cvt_pk_f16(o[2], o[3]); w.z = cvt_pk_f16(o[4], o[5]); w.w = cvt_pk_f16(o[6], o[7]);
                        *(u32x4*)(rowp + 128 * bj) = w;
                    }
                }
        } else {
#pragma unroll
            for (int ai = 0; ai < 2; ++ai)
#pragma unroll
                for (int m = 0; m < 4; ++m) {
                    const int f = u.pm * 256 + 128 * ai + 64 * wr + 16 * m + fr;
                    bf16_t* base = (f < 512) ? VT : HVT; const int hh = (f & 511) >> 7, dv = f & 127;
                    const int b = ctx ? u.pn : (u.pn >> 3);
                    const int key0 = ctx ? 0 : CTX + (u.pn & 7) * 256;
                    bf16_t* rowp = base + ((size_t)(b * 4 + hh) * 128 + dv) * KV + key0 + 32 * wc + 8 * fq;
#pragma unroll
                    for (int bj = 0; bj < 2; ++bj) {
                        const f32x4 v0 = acc[ai][bj][m][0], v1 = acc[ai][bj][m][1];
                        u32x4 w; w.x = cvt_pk_bf16(v0.x, v0.y); w.y = cvt_pk_bf16(v0.z, v0.w); w.z = cvt_pk_bf16(v1.x, v1.y); w.w = cvt_pk_bf16(v1.z, v1.w);
                        *(u32x4*)(rowp + 128 * bj) = w;
                    }
                }
        }
    }
};
namespace att {
constexpr int NSLOT = 4, SLOTB = 32768, VOFF = 16384, NT = KV / 64;
__device__ __forceinline__ void glds16s(const void* sbase, unsigned voff, unsigned lds_dst) {
    unsigned keep;
    asm volatile("s_mov_b32 %0, m0\n\ts_mov_b32 m0, %3\n\ts_nop 0\n\tglobal_load_lds_dwordx4 %1, %2\n\ts_mov_b32 m0, %0" : "=&s"(keep) : "v"(voff), "s"(sbase), "s"(lds_dst) : "memory");
}
__device__ __forceinline__ void glds16(const void* gsrc, unsigned lds_dst) {
    unsigned keep;
    asm volatile("s_mov_b32 %0, m0\n\ts_mov_b32 m0, %2\n\ts_nop 0\n\tglobal_load_lds_dwordx4 %1, off\n\ts_mov_b32 m0, %0" : "=&s"(keep) : "v"(gsrc), "s"(lds_dst) : "memory");
}
#define ATT_WAIT_BAR(N) asm volatile("s_waitcnt vmcnt(" #N ") lgkmcnt(0)\n\ts_barrier" ::: "memory")
__device__ __forceinline__ int crow(int r, int hi) { return (r & 3) + 8 * (r >> 2) + 4 * hi; }
#define MFMA32(a, b, c) __builtin_amdgcn_mfma_f32_32x32x16_bf16((a), (b), (c), 0, 0, 0)

__device__ __forceinline__ void attn_unit(int b, int h, int qb, bf16_t* Y, const bf16_t* Kc, const bf16_t* VT, const bf16_t* GA, const float* subln_g,
                                          float lam, float M2, LAS unsigned char* lds, const int wv, const bool dry = false, unsigned* qctr = nullptr) {
    const int lane = lane_id(), r32 = lane & 31, hi = lane >> 5;
    const int wid = wv;
    const int m = wid >> 2, qs = wid & 3;
    const unsigned lds0 = (unsigned)(uintptr_t)lds;
    const int tok0 = b * SEQ + qb * 128 + qs * 32;
    const bf16_t* Kb = Kc + (size_t)b * KV * 512 + h * 128;
    const bf16_t* Vb = VT + (size_t)(b * 4 + h) * 128 * KV;
    const int krow0 = 16 * (wid & 3) + (lane >> 3), krow1 = krow0 + 8;
    const bf16_t* ksrc0 = Kb + (size_t)krow0 * 512 + (wid >> 2) * 64 + 8 * ((lane & 7) ^ ((krow0 >> 1) & 7));
    const bf16_t* ksrc1 = Kb + (size_t)krow1 * 512 + (wid >> 2) * 64 + 8 * ((lane & 7) ^ ((krow1 >> 1) & 7));
    const int vrow0 = 16 * wid + (lane >> 3), vrow1 = vrow0 + 8;
    const bf16_t* vsrc0 = Vb + (size_t)vrow0 * KV + 8 * ((lane & 7) ^ ((vrow0 >> 1) & 7));
    const bf16_t* vsrc1 = Vb + (size_t)vrow1 * KV + 8 * ((lane & 7) ^ ((vrow1 >> 1) & 7));
    const unsigned kdst = lds0 + (2 * wid) * 1024, vdst = lds0 + VOFF + (2 * wid) * 1024;
#define ATT_DMA(t, slot) do { const unsigned so_ = (unsigned)(slot) * SLOTB; \
        glds16(ksrc0 + (size_t)(t) * 64 * 512, (unsigned)__builtin_amdgcn_readfirstlane(kdst + so_)); \
        glds16(ksrc1 + (size_t)(t) * 64 * 512, (unsigned)__builtin_amdgcn_readfirstlane(kdst + so_ + 1024)); \
        glds16(vsrc0 + (size_t)(t) * 64, (unsigned)__builtin_amdgcn_readfirstlane(vdst + so_)); \
        glds16(vsrc1 + (size_t)(t) * 64, (unsigned)__builtin_amdgcn_readfirstlane(vdst + so_ + 1024)); } while (0)
    const unsigned kvo0 = (unsigned)((const char*)ksrc0 - (const char*)Kb), kvo1 = (unsigned)((const char*)ksrc1 - (const char*)Kb);
    const unsigned vvo0 = (unsigned)((const char*)vsrc0 - (const char*)Vb), vvo1 = (unsigned)((const char*)vsrc1 - (const char*)Vb);
#define ATT_DMA1(t, slot, i) do { const unsigned so_ = (unsigned)(slot) * SLOTB; \
        if ((i) == 0) glds16s(Kb + (size_t)(t) * 64 * 512, kvo0, (unsigned)__builtin_amdgcn_readfirstlane(kdst + so_)); \
        if ((i) == 1) glds16s(Kb + (size_t)(t) * 64 * 512, kvo1, (unsigned)__builtin_amdgcn_readfirstlane(kdst + so_ + 1024)); \
        if ((i) == 2) glds16s(Vb + (size_t)(t) * 64, vvo0, (unsigned)__builtin_amdgcn_readfirstlane(vdst + so_)); \
        if ((i) == 3) glds16s(Vb + (size_t)(t) * 64, vvo1, (unsigned)__builtin_amdgcn_readfirstlane(vdst + so_ + 1024)); } while (0)
    bf16x8 qr[4];
    {
        const bf16_t* qp = Y + (size_t)(tok0 + r32) * 1024 + h * 128 + m * 64 + hi * 8;
#pragma unroll
        for (int d0 = 0; d0 < 4; ++d0) qr[d0] = *(const bf16x8*)(qp + d0 * 16);
    }
    __builtin_amdgcn_sched_barrier(0);
    ATT_DMA(0, 0);
    const int pi = (r32 & ~12) | ((r32 & 4) << 1) | ((r32 & 8) >> 1);
    int koff[4], voff[4];
#pragma unroll
    for (int d0 = 0; d0 < 4; ++d0) koff[d0] = m * 8192 + pi * 128 + (((2 * d0 + hi) ^ ((pi >> 1) & 7)) << 4);
    const int swz = (r32 >> 1) & 7;
#pragma unroll
    for (int s = 0; s < 4; ++s) voff[s] = VOFF + r32 * 128 + (((2 * s + hi) ^ swz) << 4);
    f32x16 o[4];
#pragma unroll
    for (int i = 0; i < 4; ++i)
#pragma unroll
        for (int r = 0; r < 16; ++r) o[i][r] = 0.f;
    float lsum = 0.f;
    f32x16 negm;
#pragma unroll
    for (int r = 0; r < 16; ++r) negm[r] = -M2;
    f32x16 pA0, pA1, pB0, pB1;
#define ATT_QK(N0, N1, sbk) do { N0 = negm; N1 = negm; \
        _Pragma("unroll") for (int d0 = 0; d0 < 4; ++d0) { \
            const bf16x8 k0_ = *(const LAS bf16x8*)((sbk) + koff[d0]); const bf16x8 k1_ = *(const LAS bf16x8*)((sbk) + koff[d0] + 4096); \
            N0 = MFMA32(k0_, qr[d0], N0); N1 = MFMA32(k1_, qr[d0], N1); } } while (0)
#define ATT_EXP(N0, N1) do { _Pragma("unroll") for (int r = 0; r < 16; ++r) { N0[r] = __builtin_amdgcn_exp2f(N0[r]); N1[r] = __builtin_amdgcn_exp2f(N1[r]); } } while (0)
#define ATT_PACK8(X, B) (u32x4){cvt_pk_bf16(X[B], X[B + 1]), cvt_pk_bf16(X[B + 2], X[B + 3]), cvt_pk_bf16(X[B + 4], X[B + 5]), cvt_pk_bf16(X[B + 6], X[B + 7])}
#define ATT_KRD(d0, half) (*(const LAS bf16x8*)(sbk_ + koff[d0] + (half) * 4096))
#define ATT_VRD(blk, s) (*(const LAS bf16x8*)(sbv_ + voff[s] + (blk) * 4096))
#define ATT_GAP() __builtin_amdgcn_sched_barrier(0)
#define ATT_E4(X, B) do { X[B] = __builtin_amdgcn_exp2f(X[B]); X[B + 1] = __builtin_amdgcn_exp2f(X[B + 1]); X[B + 2] = __builtin_amdgcn_exp2f(X[B + 2]); X[B + 3] = __builtin_amdgcn_exp2f(X[B + 3]); } while (0)
#define ATT_PVROW(blk, V0, V1, V2, V3, W0, W1, W2, W3, nb, F0, F1, F2, F3) do { \
        o[blk] = MFMA32(__builtin_bit_cast(bf16x8, pw0_), V0, o[blk]); if ((nb) < 4) W0 = ATT_VRD((nb) & 3, 0); F0; ATT_GAP(); \
        o[blk] = MFMA32(__builtin_bit_cast(bf16x8, pw1_), V1, o[blk]); if ((nb) < 4) W1 = ATT_VRD((nb) & 3, 1); F1; ATT_GAP(); \
        o[blk] = MFMA32(__builtin_bit_cast(bf16x8, pw2_), V2, o[blk]); if ((nb) < 4) W2 = ATT_VRD((nb) & 3, 2); F2; ATT_GAP(); \
        o[blk] = MFMA32(__builtin_bit_cast(bf16x8, pw3_), V3, o[blk]); if ((nb) < 4) W3 = ATT_VRD((nb) & 3, 3); F3; ATT_GAP(); } while (0)
#define ATT_S2(X, B) do { sacc_ += X[B]; sacc_ += X[B + 1]; } while (0)
#define ATT_STEP(N0, N1, P0, P1, t) do { \
        ATT_WAIT_BAR(4); const int tn_ = ((t) + 2 < NT) ? (t) + 2 : NT - 1;     \
        const LAS unsigned char* sbk_ = lds + ((t) & 3) * SLOTB; const LAS unsigned char* sbv_ = lds + (((t) - 1) & 3) * SLOTB; \
        bf16x8 ka_ = ATT_KRD(0, 0), kb_ = ATT_KRD(1, 0), kc_ = ATT_KRD(2, 0), kd_ = ATT_KRD(3, 0); \
        u32x4 pw0_, pw1_, pw2_, pw3_; bf16x8 ke_, kf_, kg_, kh_, va_, vb_, vc_, vd_, ve_, vf_, vg_, vh_; float sacc_ = 0.f; \
        ATT_GAP(); \
        N0 = MFMA32(ka_, qr[0], negm); pw0_ = ATT_PACK8(P0, 0); ke_ = ATT_KRD(0, 1); kf_ = ATT_KRD(1, 1); ATT_GAP(); \
        N0 = MFMA32(kb_, qr[1], N0);   pw1_ = ATT_PACK8(P0, 8); kg_ = ATT_KRD(2, 1); kh_ = ATT_KRD(3, 1); ATT_GAP(); \
        N0 = MFMA32(kc_, qr[2], N0);   pw2_ = ATT_PACK8(P1, 0); va_ = ATT_VRD(0, 0); vb_ = ATT_VRD(0, 1); ATT_GAP(); \
        N0 = MFMA32(kd_, qr[3], N0);   pw3_ = ATT_PACK8(P1, 8); vc_ = ATT_VRD(0, 2); vd_ = ATT_VRD(0, 3); ATT_GAP(); \
        N1 = MFMA32(ke_, qr[0], negm); ATT_S2(P0, 0); ATT_S2(P0, 2); ATT_S2(P0, 4); ATT_S2(P0, 6); ATT_GAP(); \
        N1 = MFMA32(kf_, qr[1], N1);   ATT_E4(N0, 0);  ATT_GAP(); \
        N1 = MFMA32(kg_, qr[2], N1);   ATT_E4(N0, 4);  ATT_GAP(); \
        N1 = MFMA32(kh_, qr[3], N1);   ATT_E4(N0, 8);  ATT_GAP(); \
        ATT_PVROW(0, va_, vb_, vc_, vd_, ve_, vf_, vg_, vh_, 1, ATT_E4(N0, 12), do { ATT_S2(P0, 8); ATT_S2(P0, 10); ATT_S2(P0, 12); ATT_S2(P0, 14); } while (0), ATT_E4(N1, 0), do { ATT_S2(P1, 0); ATT_S2(P1, 2); ATT_S2(P1, 4); } while (0)); \
        ATT_PVROW(1, ve_, vf_, vg_, vh_, va_, vb_, vc_, vd_, 2, ATT_E4(N1, 4), do { ATT_S2(P1, 6); ATT_S2(P1, 8); ATT_S2(P1, 10); } while (0), ATT_E4(N1, 8), do { ATT_S2(P1, 12); ATT_S2(P1, 14); } while (0)); \
        ATT_PVROW(2, va_, vb_, vc_, vd_, ve_, vf_, vg_, vh_, 3, ATT_E4(N1, 12), (void)0, (void)0, (void)0); \
        ATT_PVROW(3, ve_, vf_, vg_, vh_, va_, vb_, vc_, vd_, 4, ATT_DMA1(tn_, ((t) + 2) & 3, 0), ATT_DMA1(tn_, ((t) + 2) & 3, 1), ATT_DMA1(tn_, ((t) + 2) & 3, 2), ATT_DMA1(tn_, ((t) + 2) & 3, 3)); \
        lsum += sacc_; } while (0)
#define ATT_PV(O0, O1, sbv) do { float sa_ = 0.f, sb_ = 0.f; \
        _Pragma("unroll") for (int r = 0; r < 16; ++r) { sa_ += O0[r]; sb_ += O1[r]; } lsum += sa_ + sb_; \
        u32x4 pw_[4]; pw_[0] = ATT_PACK8(O0, 0); pw_[1] = ATT_PACK8(O0, 8); pw_[2] = ATT_PACK8(O1, 0); pw_[3] = ATT_PACK8(O1, 8); \
        _Pragma("unroll") for (int blk = 0; blk < 4; ++blk) _Pragma("unroll") for (int s = 0; s < 4; ++s) { \
            const bf16x8 vb_ = *(const LAS bf16x8*)((sbv) + voff[s] + blk * 4096); \
            o[blk] = MFMA32(__builtin_bit_cast(bf16x8, pw_[s]), vb_, o[blk]); } } while (0)
    ATT_WAIT_BAR(0);
#pragma unroll
    for (int d0 = 0; d0 < 4; ++d0) asm volatile("" : "+v"(qr[d0]));
    ATT_DMA(1, 1); ATT_DMA(2, 2);
    ATT_QK(pA0, pA1, lds); ATT_EXP(pA0, pA1);
    for (int t = 1; t + 1 < NT; t += 2) {
        ATT_STEP(pB0, pB1, pA0, pA1, t);
        ATT_STEP(pA0, pA1, pB0, pB1, t + 1);
    }
    unsigned tk;
    if (qctr != nullptr && wv == 0 && lane == 0) ticket_draw(qctr, tk);
    ATT_STEP(pB0, pB1, pA0, pA1, NT - 1);
    const int rowq = 16 * m + (lane >> 4), ch16 = lane & 15;
    u32x4 gav[4];
#pragma unroll
    for (int ps = 0; ps < 4; ++ps) gav[ps] = *(const u32x4*)(GA + (size_t)(tok0 + rowq + 4 * ps) * 512 + h * 128 + 8 * ch16);
    { const LAS unsigned char* sbv_ = lds + ((NT - 1) & 3) * SLOTB; ATT_PV(pB0, pB1, sbv_); }
#undef ATT_STEP
#undef ATT_PV
#undef ATT_EXP
#undef ATT_QK
#undef ATT_PVROW
#undef ATT_S2
#undef ATT_E4
#undef ATT_GAP
#undef ATT_KRD
#undef ATT_VRD
#undef ATT_PACK8
    lsum += shfl_xor_l(lsum, 32, lane);
    ATT_WAIT_BAR(0);
    LAS float* wl = (LAS float*)(lds + 131072) + wid * 32;
    LAS float* ex = (LAS float*)lds + qs * 4096;
    if (hi == 0) wl[r32] = lsum;
    LDS_WAIT();
    float rl[16];
#pragma unroll
    for (int r = 0; r < 16; ++r) rl[r] = __builtin_amdgcn_rcpf(wl[crow(r, hi)]) * (m ? lam : 1.f);
    if (m == 1) {
#pragma unroll
        for (int blk = 0; blk < 4; ++blk)
#pragma unroll
            for (int r = 0; r < 16; ++r) ex[crow(r, hi) * 128 + blk * 32 + r32] = o[blk][r] * rl[r];
    }
    ATT_WAIT_BAR(0);
    if (m == 0) {
        float ss[16];
#pragma unroll
        for (int r = 0; r < 16; ++r) ss[r] = 0.f;
#pragma unroll
        for (int blk = 0; blk < 4; ++blk)
#pragma unroll
            for (int r = 0; r < 16; ++r) { const float v = o[blk][r] * rl[r] - ex[crow(r, hi) * 128 + blk * 32 + r32]; o[blk][r] = v; ss[r] += v * v; }
#pragma unroll
        for (int r = 0; r < 16; ++r) {
            float s = ss[r];
            s += shfl_xor_l(s, 1, lane); s += shfl_xor_l(s, 2, lane); s += shfl_xor_l(s, 4, lane); s += shfl_xor_l(s, 8, lane); s += shfl_xor_l(s, 16, lane);
            ss[r] = rsqrtf(s * (1.f / 128.f) + EPS) * (1.f - LAM_INIT);
        }
#pragma unroll
        for (int blk = 0; blk < 4; ++blk) {
            const float g = subln_g[blk * 32 + r32];
#pragma unroll
            for (int r = 0; r < 16; ++r) ex[crow(r, hi) * 128 + blk * 32 + r32] = o[blk][r] * ss[r] * g;
        }
    }
    ATT_WAIT_BAR(0);
    {
#pragma unroll
        for (int ps = 0; ps < 4; ++ps) {
            const int row = rowq + 4 * ps;
            const f32x4 a = *(const LAS f32x4*)(ex + row * 128 + 8 * ch16), c = *(const LAS f32x4*)(ex + row * 128 + 8 * ch16 + 4);
            const u32x4 g4 = gav[ps];
            u32x4 w; w.x = cvt_pk_bf16(a.x * bflo(g4.x), a.y * bfhi(g4.x)); w.y = cvt_pk_bf16(a.z * bflo(g4.y), a.w * bfhi(g4.y));
            w.z = cvt_pk_bf16(c.x * bflo(g4.z), c.y * bfhi(g4.z)); w.w = cvt_pk_bf16(c.z * bflo(g4.w), c.w * bfhi(g4.w));
            if (!dry) *(u32x4*)(Y + (size_t)(tok0 + row) * 1024 + h * 128 + 8 * ch16) = w;
        }
    }
    if (qctr != nullptr && wv == 0 && lane == 0) { ticket_wait(tk); ((volatile LAS unsigned*)(lds + LDSCTL_OFF))[16] = tk; }
    ATT_WAIT_BAR(0);
#undef ATT_DMA
#undef ATT_DMA1
}
}
namespace hg {
#define HG_BAR() asm volatile("s_waitcnt vmcnt(0) lgkmcnt(0)\n\ts_barrier" ::: "memory")
#define HG_LBAR() asm volatile("s_waitcnt lgkmcnt(0)\n\ts_barrier" ::: "memory")
__device__ __forceinline__ float h2f(unsigned short h) { return (float)__builtin_bit_cast(_Float16, h); }
__device__ __forceinline__ int crow(int r, int hi) { return (r & 3) + 8 * (r >> 2) + 4 * hi; }
__device__ __forceinline__ int pi32(int x) { return (x & ~12) | ((x & 4) << 1) | ((x & 8) >> 1); }
__device__ __forceinline__ int sw64(int r, int c) { return r * 128 + ((c ^ ((r >> 1) & 7)) << 4); }
__device__ __forceinline__ int sw128(int r, int c) { return r * 256 + ((c ^ (r & 15)) << 4); }

__device__ __forceinline__ void state_chain(int b, int h, int dir, const unsigned short* LF, const bf16_t* HVT, bf16_t* ST, LAS unsigned char* lds, const int wv, unsigned* qctr = nullptr) {
    const int lane = lane_id(), tid = wv * 64 + lane, r32 = lane & 31, hi = lane >> 5;
    const int wid = wv;
    const int k = tid & 127, part = tid >> 7;
    const int vt = wid & 3, kh = wid >> 2;
    LAS unsigned char* KsT = lds;
    LAS float* dec = (LAS float*)(lds + 32768);
    LAS float* ptot = (LAS float*)(lds + 32768 + 1024);
    LAS unsigned char* stage = lds + 40960;
    const unsigned short* lfb = LF + ((size_t)(dir * 8 + b) * KV) * 512 + h * 128 + k;
    const bf16_t* vb = HVT + ((size_t)(b * 4 + h) * 128 + 32 * vt + r32) * KV + 8 * hi;
    f32x16 S[2];
#pragma unroll
    for (int i = 0; i < 2; ++i)
#pragma unroll
        for (int r = 0; r < 16; ++r) S[i][r] = 0.f;
    unsigned short lfr[16]; bf16x8 bv[4];
    auto ckof = [&](int n) { return dir ? (n < 4 ? 3 - n : 39 - n) : n; };
    {
        const int key0 = 64 * ckof(0);
#pragma unroll
        for (int j = 0; j < 16; ++j) lfr[j] = lfb[(size_t)(key0 + 16 * part + j) * 512];
#pragma unroll
        for (int s = 0; s < 4; ++s) bv[s] = *(const bf16x8*)(vb + key0 + 16 * s);
    }
    unsigned tk = 0u;
    for (int n = 0; n < 36; ++n) {
        const int p = n & 1, ck = ckof(n);
        if (n == 34 && qctr != nullptr && wv == 0 && lane == 0) tk = __hip_atomic_fetch_add(qctr, 1u, __ATOMIC_RELAXED, __HIP_MEMORY_SCOPE_AGENT);
        float lfv[16], c[16];
#pragma unroll
        for (int j = 0; j < 16; ++j) lfv[j] = h2f(lfr[j]);
        bf16x8 bcur[4];
#pragma unroll
        for (int s = 0; s < 4; ++s) bcur[s] = bv[s];
        if (n + 1 < 36) {
            const int key1 = 64 * ckof(n + 1);
#pragma unroll
            for (int j = 0; j < 16; ++j) lfr[j] = lfb[(size_t)(key1 + 16 * part + j) * 512];
#pragma unroll
            for (int s = 0; s < 4; ++s) bv[s] = *(const bf16x8*)(vb + key1 + 16 * s);
        }
        if (dir == 0) { float a = 0.f;
#pragma unroll
            for (int j = 0; j < 16; ++j) { a += lfv[j]; c[j] = a; } }
        else { float a = 0.f;
#pragma unroll
            for (int j = 15; j >= 0; --j) { a += lfv[j]; c[j] = a; } }
        const float T = dir ? c[0] : c[15];
        ptot[(p * 4 + part) * 128 + k] = T;
        HG_LBAR();
        float off = 0.f, gtot = 0.f;
        float pv4[4];
#pragma unroll
        for (int q = 0; q < 4; ++q) pv4[q] = ptot[(p * 4 + q) * 128 + k];
#pragma unroll
        for (int q = 0; q < 4; ++q) { gtot += pv4[q]; const bool take = dir ? (q > part) : (q < part); off += take ? pv4[q] : 0.f; }
        unsigned w[8];
#pragma unroll
        for (int j = 0; j < 16; j += 2) {
            const float k0 = (1.f - __builtin_amdgcn_exp2f(lfv[j])) * __builtin_amdgcn_exp2f(gtot - (c[j] + off));
            const float k1 = (1.f - __builtin_amdgcn_exp2f(lfv[j + 1])) * __builtin_amdgcn_exp2f(gtot - (c[j + 1] + off));
            w[j >> 1] = cvt_pk_bf16(k0, k1);
        }
        LAS unsigned char* kp = KsT + p * 16384;
        *(LAS u32x4*)(kp + sw64(k, 2 * part)) = (u32x4){w[0], w[1], w[2], w[3]};
        *(LAS u32x4*)(kp + sw64(k, 2 * part + 1)) = (u32x4){w[4], w[5], w[6], w[7]};
        if (part == 0) dec[p * 128 + k] = __builtin_amdgcn_exp2f(gtot);
        if (ck >= 4) {
#pragma unroll
            for (int kt = 0; kt < 2; ++kt)
#pragma unroll
                for (int g = 0; g < 4; ++g) {
                    u32x2 o; o.x = cvt_pk_bf16(S[kt][4 * g], S[kt][4 * g + 1]); o.y = cvt_pk_bf16(S[kt][4 * g + 2], S[kt][4 * g + 3]);
                    *(LAS u32x2*)(stage + sw128(32 * vt + r32, 8 * kh + 4 * kt + g) + 8 * hi) = o;
                }
        }
        HG_LBAR();
        if (ck >= 4) {
            bf16_t* sp = ST + ((size_t)((b * 4 + h) * 2 + dir) * 32 + (ck - 4)) * 16384;
            const int row = tid >> 2, q4 = tid & 3;
            u32x4 cv[4];
#pragma unroll
            for (int c = 0; c < 4; ++c) cv[c] = *(const LAS u32x4*)(stage + sw128(row, 4 * q4 + c));
#pragma unroll
            for (int c = 0; c < 4; ++c) *(u32x4*)(sp + row * 128 + (4 * q4 + c) * 8) = cv[c];
        }
        {
            bf16x8 af[2][4]; f32x4 dc[2][4];
#pragma unroll
            for (int kt = 0; kt < 2; ++kt) {
                const int krow = 32 * (2 * kh + kt);
#pragma unroll
                for (int g = 0; g < 4; ++g) dc[kt][g] = *(const LAS f32x4*)(dec + p * 128 + krow + 8 * g + 4 * hi);
#pragma unroll
                for (int s2 = 0; s2 < 4; ++s2) af[kt][s2] = *(const LAS bf16x8*)(kp + sw64(krow + r32, 2 * s2 + hi));
            }
#pragma unroll
            for (int kt = 0; kt < 2; ++kt) {
#pragma unroll
                for (int g = 0; g < 4; ++g) { S[kt][4 * g] *= dc[kt][g].x; S[kt][4 * g + 1] *= dc[kt][g].y; S[kt][4 * g + 2] *= dc[kt][g].z; S[kt][4 * g + 3] *= dc[kt][g].w; }
#pragma unroll
                for (int s2 = 0; s2 < 4; ++s2) S[kt] = __builtin_amdgcn_mfma_f32_32x32x16_bf16(af[kt][s2], bcur[s2], S[kt], 0, 0, 0);
            }
        }
    }
    if (qctr != nullptr && wv == 0 && lane == 0) ((volatile LAS unsigned*)(lds + LDSCTL_OFF))[16] = tk;
    HG_BAR();
}

struct OutPre { u32x4 sraw[2][4], vraw[2]; unsigned fa[8], fb[8], fq[8]; };
__device__ __forceinline__ void out_load(OutPre& P, int b, int h, int lc, const int wv) {
    unsigned char* wsb_ = kargs()->ws; const bf16_t* Y = (const bf16_t*)(wsb_ + WS_Y); const unsigned short* LF = (const unsigned short*)(wsb_ + WS_LF);
    const int tid = wv * 64 + lane_id();
    const int key0 = CTX + 64 * lc;
    const size_t tok0 = (size_t)b * SEQ + 64 * lc;
    { const bf16_t* ST = (const bf16_t*)(wsb_ + WS_ST); const bf16_t* HVT = (const bf16_t*)(wsb_ + WS_HVT);
      const int schunk = tid & 15, srow = tid >> 4;
#pragma unroll
      for (int dir = 0; dir < 2; ++dir) {
          const bf16_t* stp = ST + ((size_t)((b * 4 + h) * 2 + dir) * 32 + lc) * 16384;
#pragma unroll
          for (int i = 0; i < 4; ++i) P.sraw[dir][i] = *(const u32x4*)(stp + (size_t)(srow + 32 * i) * 128 + 8 * schunk);
      }
      const bf16_t* vtp = HVT + ((size_t)(b * 4 + h) * 128) * KV + key0;
#pragma unroll
      for (int i = 0; i < 2; ++i) P.vraw[i] = *(const u32x4*)(vtp + (size_t)((tid >> 3) + 64 * i) * KV + 8 * (tid & 7)); }
    const int kp2 = tid & 63, part8 = tid >> 6;
    const unsigned short* pf = LF + ((size_t)(0 * 8 + b) * KV + key0 + 8 * part8) * 512 + h * 128 + 2 * kp2;
    const unsigned short* pb = LF + ((size_t)(1 * 8 + b) * KV + key0 + 8 * part8) * 512 + h * 128 + 2 * kp2;
    const bf16_t* pq = Y + (tok0 + 8 * part8) * 1024 + 512 + h * 128 + 2 * kp2;
#pragma unroll
    for (int j = 0; j < 8; ++j) { P.fa[j] = *(const unsigned*)(pf + (size_t)j * 512); P.fb[j] = *(const unsigned*)(pb + (size_t)j * 512); P.fq[j] = *(const unsigned*)(pq + (size_t)j * 1024); }
}
__device__ __forceinline__ void out_settle(OutPre& P) {
#pragma unroll
    for (int d = 0; d < 2; ++d)
#pragma unroll
        for (int i = 0; i < 4; ++i) asm volatile("" : "+v"(P.sraw[d][i]));
    asm volatile("" : "+v"(P.vraw[0]), "+v"(P.vraw[1]));
#pragma unroll
    for (int j = 0; j < 8; ++j) asm volatile("" : "+v"(P.fa[j]), "+v"(P.fb[j]), "+v"(P.fq[j]));
}
__device__ __forceinline__ void out_unit(int b, int h, int lc, LAS unsigned char* lds, const int wv,
                                         OutPre& P, const bool pre_valid, const unsigned acq_mask, const int qoff, int& nidx, bool& npre, const bool dry = false, unsigned* qctr = nullptr) {
    const int lane = lane_id(), tid = wv * 64 + lane, r32 = lane & 31, hi = lane >> 5;
    const int wid = wv;
    const int tb = wid & 1, vt = wid >> 1;
    LAS unsigned char* STx = lds + 65536;
    LAS unsigned char* VTt = lds + 131072;
    LAS float* ptot = (LAS float*)(lds + 147456);
    LAS float* ssx = (LAS float*)(lds + 147456 + 8192);
    const size_t tok0 = (size_t)b * SEQ + 64 * lc;
    const int trow = 32 * tb + r32;
    const int schunk = tid & 15, srow = tid >> 4;
    if (!pre_valid) { out_load(P, b, h, lc, wv); asm volatile("s_waitcnt vmcnt(0)" ::: "memory"); out_settle(P); }
    unsigned tk;
    if (qctr != nullptr && wv == 0 && lane == 0) ticket_draw(qctr, tk);
    const int kp2 = tid & 63, part8 = tid >> 6;
    float lff[8][2], lfbw[8][2], qv[8][2];
#pragma unroll
    for (int j = 0; j < 8; ++j) {
        const unsigned a = P.fa[j], c2 = P.fb[j], d = P.fq[j];
        lff[j][0] = h2f((unsigned short)(a & 0xffffu)); lff[j][1] = h2f((unsigned short)(a >> 16));
        lfbw[j][0] = h2f((unsigned short)(c2 & 0xffffu)); lfbw[j][1] = h2f((unsigned short)(c2 >> 16));
        qv[j][0] = bflo(d); qv[j][1] = bfhi(d);
    }
    float cf[8][2], cb[8][2];
#pragma unroll
    for (int e = 0; e < 2; ++e) {
        float a = 0.f;
#pragma unroll
        for (int j = 0; j < 8; ++j) { a += lff[j][e]; cf[j][e] = a; }
        a = 0.f;
#pragma unroll
        for (int j = 7; j >= 0; --j) { a += lfbw[j][e]; cb[j][e] = a; }
    }
    *(LAS f32x2*)(ptot + (0 * 8 + part8) * 128 + 2 * kp2) = (f32x2){cf[7][0], cf[7][1]};
    *(LAS f32x2*)(ptot + (1 * 8 + part8) * 128 + 2 * kp2) = (f32x2){cb[0][0], cb[0][1]};
    HG_LBAR();
    f32x2 offf = {0.f, 0.f}, offb = {0.f, 0.f}, Rf = {0.f, 0.f}, Rb = {0.f, 0.f};
#pragma unroll
    for (int q = 0; q < 8; ++q) {
        const f32x2 pfq = *(const LAS f32x2*)(ptot + (0 * 8 + q) * 128 + 2 * kp2), pbq = *(const LAS f32x2*)(ptot + (1 * 8 + q) * 128 + 2 * kp2);
        if (q < 4) Rf += pfq; else Rb += pbq;
        offf += (q < part8) ? pfq : (f32x2){0.f, 0.f};
        offb += (q > part8) ? pbq : (f32x2){0.f, 0.f};
    }
#pragma unroll
    for (int j = 0; j < 8; ++j) {
        const int i = 8 * part8 + j;
        float v[4][2];
#pragma unroll
        for (int e = 0; e < 2; ++e) {
            const float gf = cf[j][e] + (e ? offf.y : offf.x), gb = cb[j][e] + (e ? offb.y : offb.x);
            const float kf = 1.f - __builtin_amdgcn_exp2f(lff[j][e]), kb = 1.f - __builtin_amdgcn_exp2f(lfbw[j][e]);
            const float df = fminf(fmaxf(gf - (e ? Rf.y : Rf.x), -100.f), 100.f), db = fminf(fmaxf(gb - (e ? Rb.y : Rb.x), -100.f), 100.f);
            const float q = qv[j][e];
            const float e1 = __builtin_amdgcn_exp2f(df), e2 = __builtin_amdgcn_exp2f(db);
            v[0][e] = q * e1; v[1][e] = kf * __builtin_amdgcn_rcpf(e1);
            v[2][e] = q * e2; v[3][e] = kb * __builtin_amdgcn_rcpf(e2);
        }
        const int o = sw128(i, kp2 >> 2) + (kp2 & 3) * 4;
#pragma unroll
        for (int mtx = 0; mtx < 4; ++mtx) *(LAS unsigned*)(lds + mtx * 16384 + o) = cvt_pk_bf16(v[mtx][0], v[mtx][1]);
    }
#pragma unroll
    for (int dir = 0; dir < 2; ++dir) {
        f32x4 ra = {0.f, 0.f, 0.f, 0.f}, rb2 = {0.f, 0.f, 0.f, 0.f};
#pragma unroll
        for (int q = 0; q < 4; ++q) { const LAS float* pp = ptot + (dir * 8 + 4 * dir + q) * 128 + 8 * schunk; ra += *(const LAS f32x4*)pp; rb2 += *(const LAS f32x4*)(pp + 4); }
        float er[8];
        er[0] = __builtin_amdgcn_exp2f(ra.x); er[1] = __builtin_amdgcn_exp2f(ra.y); er[2] = __builtin_amdgcn_exp2f(ra.z); er[3] = __builtin_amdgcn_exp2f(ra.w);
        er[4] = __builtin_amdgcn_exp2f(rb2.x); er[5] = __builtin_amdgcn_exp2f(rb2.y); er[6] = __builtin_amdgcn_exp2f(rb2.z); er[7] = __builtin_amdgcn_exp2f(rb2.w);
#pragma unroll
        for (int i = 0; i < 4; ++i) {
            const u32x4 r = P.sraw[dir][i]; u32x4 w;
            w.x = cvt_pk_bf16(bflo(r.x) * er[0], bfhi(r.x) * er[1]); w.y = cvt_pk_bf16(bflo(r.y) * er[2], bfhi(r.y) * er[3]);
            w.z = cvt_pk_bf16(bflo(r.z) * er[4], bfhi(r.z) * er[5]); w.w = cvt_pk_bf16(bflo(r.w) * er[6], bfhi(r.w) * er[7]);
            *(LAS u32x4*)(STx + dir * 32768 + sw128(srow + 32 * i, schunk)) = w;
        }
    }
#pragma unroll
    for (int i = 0; i < 2; ++i) *(LAS u32x4*)(VTt + sw64((tid >> 3) + 64 * i, tid & 7)) = P.vraw[i];
    if (qctr != nullptr && wv == 0 && lane == 0) { ticket_wait(tk); ((volatile LAS unsigned*)(lds + LDSCTL_OFF))[16] = tk; }
    HG_LBAR();
    u32x4 gbv[2];
#pragma unroll
    for (int i = 0; i < 2; ++i) gbv[i] = *(const u32x4*)((const bf16_t*)(kargs()->ws + WS_GB) + (tok0 + (tid >> 4) + 32 * i) * 512 + h * 128 + 8 * (tid & 15));
    nidx = -1; npre = false;
    if (qctr != nullptr) {
        nidx = (int)((volatile LAS unsigned*)(lds + LDSCTL_OFF))[16] + qoff;
        if (nidx >= 72 && nidx < 200) { const int nh = (nidx - 72) >> 5, nlc = (nidx - 72) & 31;
            if ((acq_mask >> nh) & 1u) { out_load(P, b, nh, nlc, wv); npre = true; } }
    }
    f32x16 o;
#pragma unroll
    for (int r = 0; r < 16; ++r) o[r] = 0.f;
    const int prow = pi32(r32), vrow = 32 * vt + r32;
    bf16x8 vd[2], vo[2];
#pragma unroll
    for (int s2 = 0; s2 < 2; ++s2) { vd[s2] = *(const LAS bf16x8*)(VTt + sw64(vrow, 4 * tb + 2 * s2 + hi)); vo[s2] = *(const LAS bf16x8*)(VTt + sw64(vrow, 4 * (1 - tb) + 2 * s2 + hi)); }
#pragma unroll
    for (int dir = 0; dir < 2; ++dir) {
        const LAS unsigned char* Qx = lds + (2 * dir + 0) * 16384; const LAS unsigned char* Kx = lds + (2 * dir + 1) * 16384; const LAS unsigned char* Sx = STx + dir * 32768;
        bf16x8 qf[8], kd[8], sf[8];
#pragma unroll
        for (int ks = 0; ks < 8; ++ks) { qf[ks] = *(const LAS bf16x8*)(Qx + sw128(trow, 2 * ks + hi)); kd[ks] = *(const LAS bf16x8*)(Kx + sw128(32 * tb + prow, 2 * ks + hi)); }
#pragma unroll
        for (int ks = 0; ks < 8; ++ks) sf[ks] = *(const LAS bf16x8*)(Sx + sw128(vrow, 2 * ks + hi));
        f32x16 at;
#pragma unroll
        for (int r = 0; r < 16; ++r) at[r] = 0.f;
#pragma unroll
        for (int ks = 0; ks < 8; ++ks) at = __builtin_amdgcn_mfma_f32_32x32x16_bf16(kd[ks], qf[ks], at, 0, 0, 0);
#pragma unroll
        for (int r = 0; r < 16; ++r) { const int sl = 16 * (r >> 3) + 8 * hi + (r & 7); const bool keep = dir ? (sl >= r32) : (sl <= r32); at[r] = keep ? at[r] : 0.f; }
#pragma unroll
        for (int s2 = 0; s2 < 2; ++s2) {
            const u32x4 pw = (u32x4){cvt_pk_bf16(at[8 * s2], at[8 * s2 + 1]), cvt_pk_bf16(at[8 * s2 + 2], at[8 * s2 + 3]), cvt_pk_bf16(at[8 * s2 + 4], at[8 * s2 + 5]), cvt_pk_bf16(at[8 * s2 + 6], at[8 * s2 + 7])};
            o = __builtin_amdgcn_mfma_f32_32x32x16_bf16(vd[s2], __builtin_bit_cast(bf16x8, pw), o, 0, 0, 0);
        }
        if (dir != tb) {
#pragma unroll
            for (int ks = 0; ks < 8; ++ks) kd[ks] = *(const LAS bf16x8*)(Kx + sw128(32 * (1 - tb) + prow, 2 * ks + hi));
#pragma unroll
            for (int r = 0; r < 16; ++r) at[r] = 0.f;
#pragma unroll
            for (int ks = 0; ks < 8; ++ks) at = __builtin_amdgcn_mfma_f32_32x32x16_bf16(kd[ks], qf[ks], at, 0, 0, 0);
#pragma unroll
            for (int s2 = 0; s2 < 2; ++s2) {
                const u32x4 pw = (u32x4){cvt_pk_bf16(at[8 * s2], at[8 * s2 + 1]), cvt_pk_bf16(at[8 * s2 + 2], at[8 * s2 + 3]), cvt_pk_bf16(at[8 * s2 + 4], at[8 * s2 + 5]), cvt_pk_bf16(at[8 * s2 + 6], at[8 * s2 + 7])};
                o = __builtin_amdgcn_mfma_f32_32x32x16_bf16(vo[s2], __builtin_bit_cast(bf16x8, pw), o, 0, 0, 0);
            }
        }
#pragma unroll
        for (int ks = 0; ks < 8; ++ks) o = __builtin_amdgcn_mfma_f32_32x32x16_bf16(sf[ks], qf[ks], o, 0, 0, 0);
    }
    float ss = 0.f;
#pragma unroll
    for (int r = 0; r < 16; ++r) ss += o[r] * o[r];
    ss += shfl_xor_l(ss, 32, lane);
    if (hi == 0) ssx[vt * 64 + trow] = ss;
    HG_LBAR();
    const float tot = ssx[trow] + ssx[64 + trow] + ssx[128 + trow] + ssx[192 + trow];
    const float rstd = rsqrtf(tot * (1.f / 128.f) + EPS);
    LAS float* og = (LAS float*)lds;
#pragma unroll
    for (int g = 0; g < 4; ++g) {
        const int v = 32 * vt + 8 * g + 4 * hi;
        const f32x4 gn = *(const LAS f32x4*)((const LAS float*)(lds + 156672) + v);
        *(LAS f32x4*)(og + trow * 132 + v) = (f32x4){o[4 * g] * rstd * gn.x, o[4 * g + 1] * rstd * gn.y, o[4 * g + 2] * rstd * gn.z, o[4 * g + 3] * rstd * gn.w};
    }
    HG_LBAR();
#pragma unroll
    for (int i = 0; i < 2; ++i) {
        const int row = (tid >> 4) + 32 * i, ch = tid & 15;
        const f32x4 a = *(const LAS f32x4*)(og + row * 132 + 8 * ch), c = *(const LAS f32x4*)(og + row * 132 + 8 * ch + 4);
        const u32x4 g4 = gbv[i];
        u32x4 w; w.x = cvt_pk_bf16(a.x * bflo(g4.x), a.y * bfhi(g4.x)); w.y = cvt_pk_bf16(a.z * bflo(g4.y), a.w * bfhi(g4.y));
        w.z = cvt_pk_bf16(c.x * bflo(g4.z), c.y * bfhi(g4.z)); w.w = cvt_pk_bf16(c.z * bflo(g4.w), c.w * bfhi(g4.w));
        if (!dry) *(u32x4*)((bf16_t*)(kargs()->ws + WS_Y) + (tok0 + row) * 1024 + 512 + h * 128 + 8 * ch) = w;
    }
    HG_BAR();
    if (npre) out_settle(P);
}
}
template <size_t OFFA, size_t OFFB> struct OutOrder {
    int G, c;
    __device__ __forceinline__ bool next(int i, pg8::Unit& u) const {
        const int L = i * G + c; if (L >= 256) return false;
        const char* wsb = (const char*)kargs()->ws; const char* A = wsb + OFFA; const char* Bt = wsb + OFFB;
        constexpr size_t TSTEP = (size_t)256 * DM * 2;
        const int xcd = L % 8, offp = L / 8; const int wgid = xcd * 32 + offp;
        u.pm = xcd * 8 + (wgid % 32) % 8; u.pn = (wgid % 32) / 8; u.a = A + (size_t)u.pm * TSTEP; u.b = Bt + (size_t)u.pn * TSTEP; u.ty = 0; u.aux = 0; return true;
    }
};
struct EpiP4 {
    __device__ __forceinline__ void operator()(const f32x4 (&acc)[2][2][4][2], const pg8::Unit& u, int wr, int wc, int fr, int fq, int lane) const {
        KArgsPtr ka = kargs(); unsigned char* wsb = ka->ws; const float* x = ka->in[0]; bf16_t* x1b = (bf16_t*)(wsb + WS_X1B); const float* gain1 = ka->in[4] + 1024;
        bf16_t* A1 = (bf16_t*)(wsb + WS_A1); float* SSQ1 = (float*)(wsb + WS_SSQ1); const float* mod = (const float*)(wsb + WS_MISC) + MI_MOD;
        const int b = u.pm >> 3;
        const int col0 = 256 * u.pn + 32 * wc + 8 * fq;
        f32x4 gt[2][2], gm[2][2];
#pragma unroll
        for (int bj = 0; bj < 2; ++bj)
#pragma unroll
            for (int n = 0; n < 2; ++n) { const int c = col0 + 128 * bj + 4 * n;
                gt[bj][n] = *(const f32x4*)(mod + (0 * 9 + b) * 3072 + 2048 + c);
                gm[bj][n] = *(const f32x4*)(gain1 + c) * (*(const f32x4*)(mod + (9 + b) * 3072 + 1024 + c) + 1.f); }
        const float* xbase = x + ((size_t)u.pm * 256 + 64 * wr + fr) * 1024 + col0;
        f32x4 xr[3][4];
#define P4_LDX(it) do { const float* xp_ = xbase + (size_t)(128 * ((it) >> 2) + 16 * ((it) & 3)) * 1024; \
            xr[(it) % 3][0] = *(const f32x4*)(xp_); xr[(it) % 3][1] = *(const f32x4*)(xp_ + 4); xr[(it) % 3][2] = *(const f32x4*)(xp_ + 128); xr[(it) % 3][3] = *(const f32x4*)(xp_ + 132); } while (0)
        P4_LDX(0); P4_LDX(1);
#pragma unroll
        for (int it = 0; it < 8; ++it) {
            if (it + 2 < 8) P4_LDX(it + 2);
            __builtin_amdgcn_sched_barrier(0);
            const int ai = it >> 2, m = it & 3;
            {
                const size_t row = (size_t)u.pm * 256 + 128 * ai + 64 * wr + 16 * m + fr;
                float ss = 0.f;
#pragma unroll
                for (int bj = 0; bj < 2; ++bj) {
                    const size_t o = row * 1024 + col0 + 128 * bj;
                    const f32x4 xa = xr[it % 3][2 * bj], xb = xr[it % 3][2 * bj + 1];
                    const f32x4 v0 = xa + gt[bj][0] * acc[ai][bj][m][0], v1 = xb + gt[bj][1] * acc[ai][bj][m][1];
                    { u32x4 xw; xw.x = cvt_pk_bf16(v0.x, v0.y); xw.y = cvt_pk_bf16(v0.z, v0.w); xw.z = cvt_pk_bf16(v1.x, v1.y); xw.w = cvt_pk_bf16(v1.z, v1.w); *(u32x4*)(x1b + o) = xw; }
                    ss += (v0.x * v0.x + v0.y * v0.y) + (v0.z * v0.z + v0.w * v0.w) + (v1.x * v1.x + v1.y * v1.y) + (v1.z * v1.z + v1.w * v1.w);
                    const f32x4 a0 = v0 * gm[bj][0], a1 = v1 * gm[bj][1];
                    u32x4 w; w.x = cvt_pk_bf16(a0.x, a0.y); w.y = cvt_pk_bf16(a0.z, a0.w); w.z = cvt_pk_bf16(a1.x, a1.y); w.w = cvt_pk_bf16(a1.z, a1.w);
                    *(u32x4*)(A1 + o) = w;
                }
                ss += __shfl_xor(ss, 16); ss += __shfl_xor(ss, 32);
                if (fq == 0) SSQ1[row * 16 + u.pn * 4 + wc] = ss;
            }
            __builtin_amdgcn_sched_barrier(0);
        }
#undef P4_LDX
    }
};
struct EpiP7 {
    __device__ __forceinline__ void operator()(const f32x4 (&acc)[2][2][4][2], const pg8::Unit& u, int wr, int wc, int fr, int fq, int lane) const {
        KArgsPtr ka = kargs(); float* outp = ka->out; const bf16_t* x1b = (const bf16_t*)(ka->ws + WS_X1B); const float* mod = (const float*)(ka->ws + WS_MISC) + MI_MOD;
        const int b = u.pm >> 3;
        const int col0 = 256 * u.pn + 32 * wc + 8 * fq;
        f32x4 gt[2][2];
#pragma unroll
        for (int bj = 0; bj < 2; ++bj)
#pragma unroll
            for (int n = 0; n < 2; ++n) gt[bj][n] = *(const f32x4*)(mod + (9 + b) * 3072 + 2048 + col0 + 128 * bj + 4 * n);
        u32x4 xq[8][2];
#pragma unroll
        for (int it = 0; it < 8; ++it)
#pragma unroll
            for (int bj = 0; bj < 2; ++bj) xq[it][bj] = *(const u32x4*)(x1b + ((size_t)u.pm * 256 + 128 * (it >> 2) + 64 * wr + 16 * (it & 3) + fr) * 1024 + col0 + 128 * bj);
        __builtin_amdgcn_sched_barrier(0);
#pragma unroll
        for (int ai = 0; ai < 2; ++ai)
#pragma unroll
            for (int m = 0; m < 4; ++m) {
                const size_t row = (size_t)u.pm * 256 + 128 * ai + 64 * wr + 16 * m + fr;
#pragma unroll
                for (int bj = 0; bj < 2; ++bj) {
                    const size_t o = row * 1024 + col0 + 128 * bj;
                    const u32x4 xw = xq[ai * 4 + m][bj];
                    const f32x4 xa = (f32x4){bflo(xw.x), bfhi(xw.x), bflo(xw.y), bfhi(xw.y)}, xb = (f32x4){bflo(xw.z), bfhi(xw.z), bflo(xw.w), bfhi(xw.w)};
                    *(f32x4*)(outp + o) = xa + gt[bj][0] * acc[ai][bj][m][0]; *(f32x4*)(outp + o + 4) = xb + gt[bj][1] * acc[ai][bj][m][1];
                }
            }
    }
};

struct P5Order {
    int G, c;
    __device__ __forceinline__ bool next(int i, pg8::Unit& u) const {
        const int L = i * G + c; if (L >= 768) return false;
        const char* wsb = (const char*)kargs()->ws; const char* A1 = wsb + WS_A1; const char* Wt1 = wsb + WS_WT1;
        constexpr size_t TSTEP = (size_t)256 * DM * 2;
        const int xcd = L % 8, offp = L / 8; const int wgid = xcd * 96 + offp;
        u.pm = xcd * 8 + (wgid % 96) % 8; u.pn = (wgid % 96) / 8; u.a = A1 + (size_t)u.pm * TSTEP; u.b = Wt1 + (size_t)u.pn * TSTEP; u.ty = 0; u.aux = 0; return true;
    }
};
struct P5HalfOrder {
    int G, c;
    __device__ __forceinline__ bool next(int i, pg8::Unit& u) const {
        const int L = i * G + c; if (L >= 256) return false;
        const char* wsb = (const char*)kargs()->ws; const char* A1 = wsb + WS_A1; const char* Wt1 = wsb + WS_WT1;
        constexpr size_t TSTEP = (size_t)256 * DM * 2;
        const int xcd = L % 8, j = L / 8; u.pn = xcd * 16 + j / 2; u.pm = j % 2;
        u.a = Wt1 + (size_t)(12 + u.pm) * TSTEP; u.b = A1 + (size_t)u.pn * (TSTEP / 2); u.ty = 1; u.aux = 0; return true;
    }
};
__device__ __forceinline__ float gelu_as(float v) {
    const float av = fabsf(v), t = __builtin_amdgcn_rcpf(av * 0.2316418882f + 1.0f);
    float q = t * 0.5307027145f + (-0.7265760135f); q = q * t + 0.7107068705f; q = q * t + (-0.142248368f); q = q * t + 0.127414796f; q = q * t;
    const float e = __builtin_amdgcn_exp2f((v * v) * (-0.72134752044f));
    const float mm = v * (q * e);
    return v < 0.f ? mm : v - mm;
}
__device__ __forceinline__ float rstd16(const float* SSQ1, size_t row) {
    const f32x4* p = (const f32x4*)(SSQ1 + row * 16);
    const f32x4 a = p[0], b = p[1], c = p[2], d = p[3];
    const float s = ((a.x + a.y) + (a.z + a.w)) + ((b.x + b.y) + (b.z + b.w)) + ((c.x + c.y) + (c.z + c.w)) + ((d.x + d.y) + (d.z + d.w));
    return rsqrtf(s * (1.f / 1024.f) + EPS);
}
struct EpiP5 {
    const LAS float* rst; int tpm;
    __device__ __forceinline__ void operator()(const f32x4 (&acc)[2][2][4][2], const pg8::Unit& u, int wr, int wc, int fr, int fq, int lane) const {
        unsigned char* wsb = kargs()->ws; bf16_t* UG = (bf16_t*)(wsb + WS_UG); bf16_t* GVT = (bf16_t*)(wsb + WS_GVT); float* GVSSQ = (float*)(wsb + WS_GVSSQ);
        const float* ssq1 = (const float*)(wsb + WS_SSQ1); const float* bias1 = (const float*)(wsb + WS_MISC) + MI_BIAS1;
        if (u.ty == 0) {
            const int b = u.pm >> 3;
            const int kind = u.pn >> 2, pq = u.pn & 3;
            const float* bp = bias1 + b * OIN + 256 * u.pn + 32 * wc + 8 * fq;
            bf16_t* base = UG + (size_t)kind * (8u << 20) + 128 * pq + 32 * wc + 8 * fq;
#pragma unroll
            for (int ai = 0; ai < 2; ++ai)
#pragma unroll
                for (int m = 0; m < 4; ++m) {
                    const size_t row = (size_t)u.pm * 256 + 128 * ai + 64 * wr + 16 * m + fr;
                    float rs = (u.pm == tpm) ? rst[128 * ai + 64 * wr + 16 * m + fr] : rstd16(ssq1, row); asm volatile("" : "+v"(rs));
                    f32x4 b00, b01, b10, b11;
                    if (u.pm == tpm) { const LAS float* bl = rst + 384 + 256 * u.pn + 32 * wc + 8 * fq; b00 = *(const LAS f32x4*)(bl); b01 = *(const LAS f32x4*)(bl + 4); b10 = *(const LAS f32x4*)(bl + 128); b11 = *(const LAS f32x4*)(bl + 132); }
                    else { b00 = *(const f32x4*)(bp); b01 = *(const f32x4*)(bp + 4); b10 = *(const f32x4*)(bp + 128); b11 = *(const f32x4*)(bp + 132); }
                    const f32x4 p0 = acc[ai][0][m][0] * rs + b00, p1 = acc[ai][0][m][1] * rs + b01, q0 = acc[ai][1][m][0] * rs + b10, q1 = acc[ai][1][m][1] * rs + b11;
                    float o[8];
#pragma unroll
                    for (int j = 0; j < 4; ++j) {
                        if (kind == 0) { o[j] = gelu_as(p0[j]) * silu_fast(q0[j]); o[4 + j] = gelu_as(p1[j]) * silu_fast(q1[j]); }
                        else if (kind == 1) { o[j] = p0[j] * silu_fast(q0[j]); o[4 + j] = p1[j] * silu_fast(q1[j]); }
                        else { o[j] = p0[j] * q0[j]; o[4 + j] = p1[j] * q1[j]; }
                    }
                    u32x4 w; w.x = cvt_pk_bf16(o[0], o[1]); w.y = cvt_pk_bf16(o[2], o[3]); w.z = cvt_pk_bf16(o[4], o[5]); w.w = cvt_pk_bf16(o[6], o[7]);
                    *(u32x4*)(base + row * 512) = w;
                    __builtin_amdgcn_sched_barrier(0);
                }
        }
    }
};
struct EpiP5H {
    const LAS float* rsth; int tpn, tpmh;
    __device__ __forceinline__ void operator()(const f32x4 (&acc)[2][2][4][2], const pg8::Unit& u, int wr, int wc, int fr, int fq, int lane) const {
        unsigned char* wsb = kargs()->ws; bf16_t* GVT = (bf16_t*)(wsb + WS_GVT); float* GVSSQ = (float*)(wsb + WS_GVSSQ);
        const float* ssq1 = (const float*)(wsb + WS_SSQ1); const float* bias1 = (const float*)(wsb + WS_MISC) + MI_BIAS1;
        {
            const int b = u.pn >> 4;
            { constexpr int bj = 0;
                int opq = 0; asm volatile("" : "+s"(opq));
                const size_t tokc = (size_t)u.pn * 128 + 32 * wc + 8 * fq + opq;
                float rs[8], gs[8];
                if (u.pn == tpn) {
#pragma unroll
                    for (int e = 0; e < 8; ++e) { rs[e] = rsth[32 * wc + 8 * fq + e]; gs[e] = 0.f; }
                } else {
#pragma unroll
                for (int e = 0; e < 8; ++e) { rs[e] = rstd16(ssq1, tokc + e); gs[e] = 0.f; asm volatile("" : "+v"(rs[e])); __builtin_amdgcn_sched_barrier(0); }
                }
#pragma unroll
                for (int ai = 0; ai < 2; ++ai)
#pragma unroll
                    for (int m = 0; m < 4; ++m) {
                        const int f = u.pm * 256 + 128 * ai + 64 * wr + 16 * m + fr + opq;
                        const float bias = (u.pn == tpn && u.pm == tpmh) ? rsth[128 + 3072 + 128 * ai + 64 * wr + 16 * m + fr] : bias1[b * OIN + 3072 + f];
                        bf16_t* rowp = GVT + ((size_t)(b * 4 + (f >> 7)) * 128 + (f & 127)) * GVP + (u.pn & 15) * 128 + 32 * wc + 8 * fq;
                        float o[8];
#pragma unroll
                        for (int n = 0; n < 2; ++n)
#pragma unroll
                            for (int j = 0; j < 4; ++j) { const float gv = gelu_as(acc[ai][bj][m][n][j] * rs[4 * n + j] + bias); o[4 * n + j] = gv; gs[4 * n + j] += gv * gv; }
                        u32x4 w; w.x = cvt_pk_bf16(o[0], o[1]); w.y = cvt_pk_bf16(o[2], o[3]); w.z = cvt_pk_bf16(o[4], o[5]); w.w = cvt_pk_bf16(o[6], o[7]);
                        *(u32x4*)(rowp) = w;
                        __builtin_amdgcn_sched_barrier(0);
                    }
#pragma unroll
                for (int e = 0; e < 8; ++e) {
                    float s = gs[e];
                    s += __shfl_xor(s, 1); s += __shfl_xor(s, 2); s += __shfl_xor(s, 4); s += __shfl_xor(s, 8);
                    if (fr == 0) GVSSQ[(tokc + e) * 4 + u.pm * 2 + wr] = s;
                    __builtin_amdgcn_sched_barrier(0);
                }
            }
        }
    }
};

__device__ __forceinline__ int gsw(int r, int c) { return r * 256 + ((c ^ (r & 15)) << 4); }
struct GmlpRegs { u32x4 ta[4], tw[4], tu[4]; f32x4 ssq; };
__device__ __forceinline__ void gmlp_load(GmlpRegs& R, int b, int ch, int g, const bf16_t* GVT, const float* GVSSQ, const bf16_t* Wsb, const bf16_t* UG, const int wv) {
    const int lane = lane_id(), tid = wv * 64 + lane;
    const size_t tokc = (size_t)b * SEQ + ch * 128;
    const int chunk = tid & 15, rb = tid >> 4;
#pragma unroll
    for (int i = 0; i < 4; ++i) { const int row = rb + 32 * i;
        R.ta[i] = *(const u32x4*)(GVT + ((size_t)(b * 4 + g) * 128 + row) * GVP + ch * 128 + 8 * chunk);
        R.tw[i] = *(const u32x4*)(Wsb + ((size_t)g * 128 + row) * 128 + 8 * chunk);
        R.tu[i] = *(const u32x4*)(UG + (tokc + row) * 512 + g * 128 + 8 * chunk); }
    R.ssq = *(const f32x4*)(GVSSQ + (tokc + (tid & 127)) * 4);
}
__device__ __forceinline__ void gmlp_unit(const GmlpRegs& R, int b, int ch, int g, const float* v_g, const float* b_s, bf16_t* Y1, LAS unsigned char* lds, const int wv) {
    const int lane = lane_id(), tid = wv * 64 + lane, r32 = lane & 31, hi = lane >> 5;
    const int wid = wv;
    const int dt = wid & 3, th = wid >> 2;
    LAS unsigned char* At = lds; LAS unsigned char* Wt = lds + 32768; LAS unsigned char* Ut = lds + 65536;
    LAS float* rsd = (LAS float*)(lds + 98304);
    const size_t tokc = (size_t)b * SEQ + ch * 128;
    {
        const int chunk = tid & 15, rb = tid >> 4;
        if (tid < 128) { const f32x4 p = R.ssq; rsd[tid] = rsqrtf(((p.x + p.y) + (p.z + p.w)) * (1.f / 512.f) + EPS); }
#pragma unroll
        for (int i = 0; i < 4; ++i) { const int row = rb + 32 * i; *(LAS u32x4*)(At + gsw(row, chunk)) = R.ta[i]; *(LAS u32x4*)(Wt + gsw(row, chunk)) = R.tw[i]; *(LAS u32x4*)(Ut + gsw(row, chunk)) = R.tu[i]; }
    }
    float bsf[2]; f32x4 vgf[4];
#pragma unroll
    for (int tt = 0; tt < 2; ++tt) bsf[tt] = b_s[g * 128 + 32 * (2 * th + tt) + r32];
#pragma unroll
    for (int q = 0; q < 4; ++q) vgf[q] = *(const f32x4*)(v_g + g * 128 + 32 * dt + 8 * q + 4 * hi);
    asm volatile("s_waitcnt lgkmcnt(0)\n\ts_barrier" ::: "memory");
    f32x16 acc[2];
#pragma unroll
    for (int i = 0; i < 2; ++i)
#pragma unroll
        for (int r = 0; r < 16; ++r) acc[i][r] = 0.f;
    bf16x8 af[8]; u32x4 wf[2][8];
#pragma unroll
    for (int ks = 0; ks < 8; ++ks) { af[ks] = *(const LAS bf16x8*)(At + gsw(32 * dt + r32, 2 * ks + hi));
#pragma unroll
        for (int tt = 0; tt < 2; ++tt) wf[tt][ks] = *(const LAS u32x4*)(Wt + gsw(32 * (2 * th + tt) + r32, 2 * ks + hi)); }
#pragma unroll
    for (int ks = 0; ks < 8; ++ks) {
        const f32x4 r0 = *(const LAS f32x4*)(rsd + 16 * ks + 8 * hi), r1 = *(const LAS f32x4*)(rsd + 16 * ks + 8 * hi + 4);
#pragma unroll
        for (int tt = 0; tt < 2; ++tt) {
            const u32x4 wv4 = wf[tt][ks];
            u32x4 ws2;
            ws2.x = cvt_pk_bf16(bflo(wv4.x) * r0.x, bfhi(wv4.x) * r0.y); ws2.y = cvt_pk_bf16(bflo(wv4.y) * r0.z, bfhi(wv4.y) * r0.w);
            ws2.z = cvt_pk_bf16(bflo(wv4.z) * r1.x, bfhi(wv4.z) * r1.y); ws2.w = cvt_pk_bf16(bflo(wv4.w) * r1.z, bfhi(wv4.w) * r1.w);
            acc[tt] = __builtin_amdgcn_mfma_f32_32x32x16_bf16(af[ks], __builtin_bit_cast(bf16x8, ws2), acc[tt], 0, 0, 0);
        }
    }
#pragma unroll
    for (int tt = 0; tt < 2; ++tt) {
        const int t = 32 * (2 * th + tt) + r32;
        const float bs = bsf[tt];
#pragma unroll
        for (int q = 0; q < 4; ++q) {
            LAS u32x2* up = (LAS u32x2*)(Ut + gsw(t, 4 * dt + q) + 8 * hi);
            const f32x4 vg = vgf[q];
            const u32x2 ug = *up;
            u32x2 w;
            w.x = cvt_pk_bf16(bflo(ug.x) * (vg.x * acc[tt][4 * q] + bs), bfhi(ug.x) * (vg.y * acc[tt][4 * q + 1] + bs));
            w.y = cvt_pk_bf16(bflo(ug.y) * (vg.z * acc[tt][4 * q + 2] + bs), bfhi(ug.y) * (vg.w * acc[tt][4 * q + 3] + bs));
            *up = w;
        }
    }
    asm volatile("s_waitcnt lgkmcnt(0)\n\ts_barrier" ::: "memory");
    {
        const int chunk = tid & 15, rb = tid >> 4;
#pragma unroll
        for (int i = 0; i < 4; ++i) { const int row = rb + 32 * i; *(u32x4*)(Y1 + (tokc + row) * 1024 + g * 128 + 8 * chunk) = *(const LAS u32x4*)(Ut + gsw(row, chunk)); }
    }
    asm volatile("s_waitcnt lgkmcnt(0)\n\ts_barrier" ::: "memory");
}
struct ConvRegs { u32x4 chv[10], bgv[8]; };
__device__ __forceinline__ void conv_load(ConvRegs& R, int row0, const bf16_t* BG, const bf16_t* CH, int lane) {
    const bool top = (row0 & 2047) == 0, bot = ((row0 + 7) & 2047) == 2047;
    R.chv[0] = *(const u32x4*)(CH + (size_t)(top ? row0 : row0 - 1) * 512 + 8 * lane);
#pragma unroll
    for (int i = 0; i < 8; ++i) { R.chv[i + 1] = *(const u32x4*)(CH + (size_t)(row0 + i) * 512 + 8 * lane); R.bgv[i] = *(const u32x4*)(BG + (size_t)(row0 + i) * 512 + 8 * lane); }
    R.chv[9] = *(const u32x4*)(CH + (size_t)(bot ? row0 + 7 : row0 + 8) * 512 + 8 * lane);
}
__device__ __forceinline__ void conv_finish(const ConvRegs& R, int row0, const float* conv_w, bf16_t* Y1, int lane) {
    const bool top = (row0 & 2047) == 0, bot = ((row0 + 7) & 2047) == 2047;
    float w[3][8];
#pragma unroll
    for (int j = 0; j < 3; ++j) { const f32x4 a = *(const f32x4*)(conv_w + j * 512 + 8 * lane), bq = *(const f32x4*)(conv_w + j * 512 + 8 * lane + 4);
        w[j][0] = a.x; w[j][1] = a.y; w[j][2] = a.z; w[j][3] = a.w; w[j][4] = bq.x; w[j][5] = bq.y; w[j][6] = bq.z; w[j][7] = bq.w; }
#pragma unroll
    for (int i = 0; i < 8; ++i) {
        float o[8];
#pragma unroll
        for (int e = 0; e < 4; ++e) {
            const unsigned pw = (i == 0 && top) ? 0u : R.chv[i][e], cw = R.chv[i + 1][e], nw = (i == 7 && bot) ? 0u : R.chv[i + 2][e], bw = R.bgv[i][e];
            o[2 * e] = bflo(bw) * (w[0][2 * e] * bflo(pw) + w[1][2 * e] * bflo(cw) + w[2][2 * e] * bflo(nw));
            o[2 * e + 1] = bfhi(bw) * (w[0][2 * e + 1] * bfhi(pw) + w[1][2 * e + 1] * bfhi(cw) + w[2][2 * e + 1] * bfhi(nw));
        }
        u32x4 wv; wv.x = cvt_pk_bf16(o[0], o[1]); wv.y = cvt_pk_bf16(o[2], o[3]); wv.z = cvt_pk_bf16(o[4], o[5]); wv.w = cvt_pk_bf16(o[6], o[7]);
        *(u32x4*)(Y1 + (size_t)(row0 + i) * 1024 + 512 + 8 * lane) = wv;
    }
}
#ifndef DIAG
#define DIAG 0
#endif
constexpr int N_PHASES = 9;
#ifndef REP
#define REP -1
#endif
#ifndef NDRY
#define NDRY 1
#endif

__global__ void __launch_bounds__(NTHR, 2) mk_fwd(Args args) {
    extern __shared__ __attribute__((aligned(16))) unsigned char lds_raw[];
    Frame F;
#define FRAME_LOAD() do { KArgsPtr ka_ = kargs(); \
    F.lds = (LAS unsigned char*)lds_raw; F.MISC = (volatile LAS unsigned*)(F.lds + LDSCTL_OFF); \
    F.wave = wave0; F.lane = lane_id(); F.tid = wave0 * 64 + F.lane; \
    F.G = gridDim.x; { const int bx = blockIdx.x; F.vcu = (F.G % 8 == 0) ? (bx % 8) * (F.G / 8) + bx / 8 : bx; } \
    F.ws = ka_->ws; F.ctl = (unsigned*)(F.ws + WS_CTL); F.misc = (float*)(F.ws + WS_MISC); F.out = ka_->out; \
    F.x = ka_->in[0]; F.c = ka_->in[1]; F.ctx = ka_->in[2]; F.c_ctx = ka_->in[3]; F.norm_gain = ka_->in[4]; F.ada_w = ka_->in[5]; F.ada_b = ka_->in[6]; \
    F.even_w_in = ka_->in[7]; F.even_w_out = ka_->in[8]; F.qk_gain = ka_->in[9]; F.lam_p = ka_->in[10]; F.subln_g = ka_->in[11]; F.lb_logits = ka_->in[12]; F.hgrn_g = ka_->in[13]; \
    F.odd_w_in = ka_->in[14]; F.odd_w_out = ka_->in[15]; F.v_g = ka_->in[16]; F.w_s = ka_->in[17]; F.b_s = ka_->in[18]; F.conv_w = ka_->in[19]; } while (0)
    const int wave0 = __builtin_amdgcn_readfirstlane(threadIdx.x >> 6);
    FRAME_LOAD();
    for (int u = F.tid; u < (LDS_BYTES - LDSCTL_OFF) / 4; u += NTHR) ((LAS unsigned*)(F.lds + LDSCTL_OFF))[u] = 0u;
    __syncthreads();
    XcdBarrier bar = xcd_barrier_post(F.ctl + CW_BAR, F.MISC + 8, F.tid);
    if (F.tid == 0) __hip_atomic_store(F.ctl + CW_XCC + (int)blockIdx.x, xb_xcc_id() + 1u, __ATOMIC_RELAXED, __HIP_MEMORY_SCOPE_AGENT);
    bool light_ok = false;
    const int lo = args.ph_lo, hi = args.ph_hi;
#ifdef ONLYPH
#define IN(k) ((k) == ONLYPH && lo <= (k) && (k) < hi)
#else
#define IN(k) (lo <= (k) && (k) < hi)
#endif
#define BOTH(k) (IN(k) && IN((k) + 1))
#if DIAG == 10
#define STAMP(k) do { if (blockIdx.x == 0 && wave0 == 0 && lane_id() == 0) ((unsigned long long*)(kargs()->ws + WS_CTL + 900000))[k] = __builtin_amdgcn_s_memrealtime(); } while (0)
#else
#define STAMP(k) do {} while (0)
#endif
#define GRID_BAR() xcd_barrier(bar, wave0 * 64 + lane_id())
#define LIGHT_BAR(site) do { if (light_ok) group_barrier_light((unsigned*)(kargs()->ws + WS_CTL) + CW_GRP + 128 * ((site) * 8 + ((int)blockIdx.x & 7)), 32u, wave0 * 64 + lane_id()); else xcd_barrier(bar, wave0 * 64 + lane_id()); } while (0)
    unsigned char* ws;

    STAMP(0);
    if (IN(0)) { for (int rep = 0; rep < (REP == 0 ? 2 : 1); ++rep) { FRAME_LOAD(); p0_prologue(F); if (REP == 0 && rep == 0) GRID_BAR(); } STAMP(1); }
    if (IN(1)) { for (int rep = 0; rep < (REP == 1 ? 2 : 1); ++rep) { FRAME_LOAD(); p0b_phase(F); if (REP == 1 && rep == 0) GRID_BAR(); } if (BOTH(1)) GRID_BAR(); STAMP(2); }
    if (IN(2)) {
        FRAME_LOAD(); ws = F.ws;
        if (BOTH(1) && wave0 == 0) {
            const int ln = lane_id(); const int peer = ((int)blockIdx.x & 7) + 8 * ln;
            const unsigned mine = xb_xcc_id() + 1u;
            const unsigned theirs = (ln < 32 && peer < (int)gridDim.x) ? __hip_atomic_load(F.ctl + CW_XCC + peer, __ATOMIC_RELAXED, __HIP_MEMORY_SCOPE_AGENT) : mine;
            if (__builtin_amdgcn_ballot_w64(theirs != mine) != 0ull && ln == 0) (void)__hip_atomic_fetch_or(F.ctl + CW_UNCLEAN, 1u, __ATOMIC_RELAXED, __HIP_MEMORY_SCOPE_AGENT);
        }
        LAS float* tab = (LAS float*)(F.lds + 131072);
        { const float* miscp = (const float*)(ws + WS_MISC); const float* qkg = kargs()->in[9];
          float tv[6]; const float qg = qkg[F.tid & 127];
#pragma unroll
          for (int k = 0; k < 6; ++k) tv[k] = miscp[MI_CS + F.tid + 512 * k];
#pragma unroll
          for (int k = 0; k < 4; ++k) tab[F.tid + 512 * k] = tv[k];
          if (F.tid < 128) tab[2048 + F.tid] = qg;
          tab[2176 + F.tid] = tv[4]; tab[2176 + 512 + F.tid] = tv[5];
          __syncthreads(); }
        P1Order S{F.G, (int)blockIdx.x}; EpiP1 E{tab};
        for (int rep = 0; rep < (REP == 2 ? 2 : 1); ++rep) { pg8::gemm_phase<EpiP1, P1Order>(F.lds, DM, S, E, wave0); if (REP == 2 && rep == 0) GRID_BAR(); }
        if ((int)blockIdx.x >= 208) { FRAME_LOAD(); weight_copies(F, 1, ((int)blockIdx.x - 208) * NWAVES + F.wave, 48 * NWAVES); }
        if (BOTH(2)) { GRID_BAR(); light_ok = BOTH(1) && (int)gridDim.x == 256 && __hip_atomic_load((unsigned*)(kargs()->ws + WS_CTL) + CW_UNCLEAN, __ATOMIC_RELAXED, __HIP_MEMORY_SCOPE_AGENT) == 0u; }
        STAMP(3);
    }
    if (IN(3)) {
        FRAME_LOAD(); ws = F.ws;
        const int g = blockIdx.x & 7;
        const float lam = __uint_as_float(__hip_atomic_load((unsigned*)(F.misc + MI_SCAL), __ATOMIC_RELAXED, __HIP_MEMORY_SCOPE_AGENT));
        const float M2 = __uint_as_float(__hip_atomic_load((unsigned*)(F.misc + MI_SCAL + 1), __ATOMIC_RELAXED, __HIP_MEMORY_SCOPE_AGENT));
        for (int rep = 0; rep < ((REP == 3 || REP == 30 || REP == 31) ? 2 : (REP == 32 ? 1 + NDRY : 1)); ++rep) {
        const bool dry = (REP == 3 || REP == 30 || REP == 31) ? (rep == 0) : (REP == 32 ? rep < NDRY : false);
        unsigned acq_mask = 0u;
        bool have = false;
        constexpr bool EARLY = (REP < 0 || REP == 32);
        int first_out = 200;
        const int QOFF = EARLY ? ((int)gridDim.x + 7 - g) / 8 : 0;
        bool first = EARLY;
        for (;;) {
            if (!have && !first) {
                if (wave0 == 0 && lane_id() == 0) ((volatile LAS unsigned*)((LAS unsigned char*)lds_raw + LDSCTL_OFF))[16] = __hip_atomic_fetch_add((unsigned*)(kargs()->ws + WS_CTL) + CW_QUEUE + 64 * (g + 8 * rep), 1u, __ATOMIC_RELAXED, __HIP_MEMORY_SCOPE_AGENT);
                __syncthreads();
            }
            const int idx = first ? ((int)blockIdx.x >> 3) : (int)((volatile LAS unsigned*)((LAS unsigned char*)lds_raw + LDSCTL_OFF))[16] + QOFF;
            if (!have && !first) __syncthreads();
            first = false;
            have = EARLY;
            unsigned* qc = EARLY ? (unsigned*)(kargs()->ws + WS_CTL) + CW_QUEUE + 64 * (g + 8 * rep) : nullptr;
            if (idx >= 72) { first_out = idx; break; }
            if (REP == 30 && rep == 0 && idx < 8) { have = false; continue; }
            if (REP == 32 && dry && idx < 72) { have = false; continue; }
            if (REP == 31 && rep == 0 && idx >= 8) break;
            if (idx < 8) {
                const int cch = g * 8 + idx;
                { unsigned char* w2 = kargs()->ws;
                  hg::state_chain(cch >> 3, (cch >> 1) & 3, cch & 1, (const unsigned short*)(w2 + WS_LF), (const bf16_t*)(w2 + WS_HVT), (bf16_t*)(w2 + WS_ST), (LAS unsigned char*)lds_raw, wave0, qc); }
                if (wave0 == 0 && lane_id() == 0) { __builtin_amdgcn_fence(__ATOMIC_RELEASE, "agent"); asm volatile("s_waitcnt vmcnt(0)" ::: "memory");
                    __hip_atomic_store((unsigned*)(kargs()->ws + WS_CTL) + CW_FLAG + 64 * cch + 16 * rep, 1u, __ATOMIC_RELAXED, __HIP_MEMORY_SCOPE_AGENT); }
            } else {
                const int j = idx - 8; const int pair = g * 4 + (j >> 4), qb = j & 15;
                KArgsPtr ka2 = kargs(); unsigned char* w2 = ka2->ws;
                att::attn_unit(pair >> 2, pair & 3, qb, (bf16_t*)(w2 + WS_Y), (const bf16_t*)(w2 + WS_KC), (const bf16_t*)(w2 + WS_VT), (const bf16_t*)(w2 + WS_GA), ka2->in[11], lam, M2, (LAS unsigned char*)lds_raw, wave0, dry, qc);
            }
        }
        if (first_out < 200 && !((REP == 30 || REP == 31) && rep == 0)) {
            unsigned* qc = EARLY ? (unsigned*)(kargs()->ws + WS_CTL) + CW_QUEUE + 64 * (g + 8 * rep) : nullptr;
            hg::OutPre P; bool pre = false; int cur = first_out;
            { unsigned z0 = 0u; asm volatile("" : "+v"(z0));
#pragma unroll
              for (int j0 = 0; j0 < 8; ++j0) { P.fa[j0] = z0; P.fb[j0] = z0; P.fq[j0] = z0; P.sraw[j0 >> 2][j0 & 3] = (u32x4){z0, z0, z0, z0}; if (j0 < 2) P.vraw[j0] = (u32x4){z0, z0, z0, z0}; } }
            { const float* hg_g = kargs()->in[13]; if (wave0 < 2) ((LAS float*)((LAS unsigned char*)lds_raw + 156672))[wave0 * 64 + lane_id()] = hg_g[wave0 * 64 + lane_id()]; __syncthreads(); }
            for (;;) {
                const int j = cur - 72; const int hh = j >> 5, lc = j & 31;
                if (!((acq_mask >> hh) & 1u) && !(REP == 32 && dry)) {
                acq_mask |= 1u << hh;
                if (wave0 == 0) {
                    unsigned* f0 = (unsigned*)(kargs()->ws + WS_CTL) + CW_FLAG + 64 * (g * 8 + 2 * hh) + 16 * rep; unsigned sp = 0;
                    while ((__hip_atomic_load(f0, __ATOMIC_RELAXED, __HIP_MEMORY_SCOPE_AGENT) == 0u || __hip_atomic_load(f0 + 64, __ATOMIC_RELAXED, __HIP_MEMORY_SCOPE_AGENT) == 0u) && ++sp < (1u << 22)) __builtin_amdgcn_s_sleep(8);
                    __builtin_amdgcn_fence(__ATOMIC_ACQUIRE, "agent");
                    asm volatile("s_waitcnt vmcnt(0)" ::: "memory");
                }
                __syncthreads();
                }
                int nidx = -1; bool npre = false;
                hg::out_unit(g, hh, lc, (LAS unsigned char*)lds_raw, wave0, P, pre, acq_mask, QOFF, nidx, npre, dry, qc);
                if (!EARLY) {
                    if (wave0 == 0 && lane_id() == 0) ((volatile LAS unsigned*)((LAS unsigned char*)lds_raw + LDSCTL_OFF))[16] = __hip_atomic_fetch_add((unsigned*)(kargs()->ws + WS_CTL) + CW_QUEUE + 64 * (g + 8 * rep), 1u, __ATOMIC_RELAXED, __HIP_MEMORY_SCOPE_AGENT);
                    __syncthreads();
                    nidx = (int)((volatile LAS unsigned*)((LAS unsigned char*)lds_raw + LDSCTL_OFF))[16]; npre = false;
                    __syncthreads();
                }
                cur = nidx; pre = npre;
                if (cur >= 200) break;
            }
        }
        if (dry) GRID_BAR();
        }
        if (BOTH(3)) GRID_BAR();
        STAMP(4);
    }
    if (IN(5)) {
        FRAME_LOAD(); ws = F.ws;
        OutOrder<WS_Y, WS_WO0> S{F.G, (int)blockIdx.x}; EpiP4 E;
        for (int rep = 0; rep < (REP == 5 ? 2 : 1); ++rep) { pg8::gemm_phase<EpiP4, OutOrder<WS_Y, WS_WO0>>(F.lds, DM, S, E, wave0); if (REP == 5 && rep == 0) GRID_BAR(); }
        if (BOTH(5)) LIGHT_BAR(0);
        STAMP(6);
    }
    if (IN(6)) {
        FRAME_LOAD(); ws = F.ws;
        P5Order S{F.G, (int)blockIdx.x}; P5HalfOrder SH{F.G, (int)blockIdx.x};
        LAS float* rst = (LAS float*)(F.lds + 131072);
        int tpm = -1, tpn = -1, tpmh = -1;
        { pg8::Unit u0; if (S.next(0, u0)) tpm = u0.pm; if (SH.next(0, u0)) { tpn = u0.pn; tpmh = u0.pm; }
          const float* ssq1 = (const float*)(ws + WS_SSQ1); const float* bias1 = (const float*)(ws + WS_MISC) + MI_BIAS1;
          const int r = F.tid; const bool full = r < 256; const int blk = full ? tpm : tpn; const int blkc = blk < 0 ? 0 : blk;
          const size_t row = full ? (size_t)blkc * 256 + r : (size_t)blkc * 128 + ((r - 256) & 127);
          const f32x4* pp = (const f32x4*)(ssq1 + row * 16); const f32x4 qa = pp[0], qb = pp[1], qc4 = pp[2], qd = pp[3];
          const int bb = (tpm < 0 ? 0 : tpm) >> 3, bh = (tpn < 0 ? 0 : tpn) >> 4, pmh = tpmh < 0 ? 0 : tpmh;
          float bv[6];
#pragma unroll
          for (int k = 0; k < 6; ++k) bv[k] = bias1[bb * OIN + F.tid + 512 * k];
          const float bhv = bias1[bh * OIN + 3072 + pmh * 256 + (F.tid & 255)];
          if (F.tid < 384 && blk >= 0) rst[r] = rsqrtf((((qa.x + qa.y) + (qa.z + qa.w)) + ((qb.x + qb.y) + (qb.z + qb.w)) + ((qc4.x + qc4.y) + (qc4.z + qc4.w)) + ((qd.x + qd.y) + (qd.z + qd.w))) * (1.f / 1024.f) + EPS);
#pragma unroll
          for (int k = 0; k < 6; ++k) rst[384 + F.tid + 512 * k] = bv[k];
          if (F.tid < 256) rst[384 + 3072 + F.tid] = bhv;
          __syncthreads(); }
        EpiP5 E{rst, tpm};
        for (int rep = 0; rep < (REP == 6 ? 2 : 1); ++rep) {
            pg8::gemm_phase<EpiP5, P5Order>(F.lds, DM, S, E, wave0);
            { EpiP5H EH{rst + 256, tpn, tpmh}; pg8::gemm_phase<EpiP5H, P5HalfOrder, true>(F.lds, DM, SH, EH, wave0); }
            if (REP == 6 && rep == 0) GRID_BAR(); }
        if (BOTH(6)) LIGHT_BAR(1);
        STAMP(7);
    }
    if (IN(7)) {
        FRAME_LOAD(); ws = F.ws;
        for (int rep = 0; rep < (REP == 7 ? 2 : 1); ++rep) {
        const int uA = (F.vcu >> 5) * 64 + (F.vcu & 31), uB = uA + 32;
        const int row0 = (F.vcu * NWAVES + F.wave) * 8;
        GmlpRegs GR; ConvRegs CR;
        gmlp_load(GR, uA >> 6, (uA >> 2) & 15, uA & 3, (const bf16_t*)(ws + WS_GVT), (const float*)(ws + WS_GVSSQ), (const bf16_t*)(ws + WS_WS), (const bf16_t*)(ws + WS_UG), wave0);
        conv_load(CR, row0, (const bf16_t*)(ws + WS_BG), (const bf16_t*)(ws + WS_CH), F.lane);
        gmlp_unit(GR, uA >> 6, (uA >> 2) & 15, uA & 3, F.v_g, F.b_s, (bf16_t*)(ws + WS_Y), F.lds, wave0);
        gmlp_load(GR, uB >> 6, (uB >> 2) & 15, uB & 3, (const bf16_t*)(ws + WS_GVT), (const float*)(ws + WS_GVSSQ), (const bf16_t*)(ws + WS_WS), (const bf16_t*)(ws + WS_UG), wave0);
        conv_finish(CR, row0, F.conv_w, (bf16_t*)(ws + WS_Y), F.lane);
        gmlp_unit(GR, uB >> 6, (uB >> 2) & 15, uB & 3, F.v_g, F.b_s, (bf16_t*)(ws + WS_Y), F.lds, wave0);
        if (REP == 7 && rep == 0) GRID_BAR();
        }
        if (BOTH(7)) LIGHT_BAR(2);
        STAMP(8);
    }
    if (IN(8)) {
        FRAME_LOAD(); ws = F.ws;
        OutOrder<WS_Y, WS_WO1> S{F.G, (int)blockIdx.x}; EpiP7 E;
        pg8::gemm_phase<EpiP7, OutOrder<WS_Y, WS_WO1>>(F.lds, DM, S, E, wave0);
        STAMP(9);
    }
#undef IN
#undef BOTH
}

#if DIAG

#endif

extern "C" void kernel_launch(void* const* d_in, const int* in_sizes, int n_in, void* d_out, int out_size, void* d_ws, size_t ws_size, hipStream_t stream) {
    static int grid = 0;
    if (grid == 0) {
        int dev = 0, cus = 0;
        if (hipGetDevice(&dev) != hipSuccess || hipDeviceGetAttribute(&cus, hipDeviceAttributeMultiprocessorCount, dev) != hipSuccess) { fprintf(stderr, "kernel_launch: device query failed\n"); grid = -1; return; }
        if (hipFuncSetAttribute((const void*)mk_fwd, hipFuncAttributeMaxDynamicSharedMemorySize, LDS_BYTES) != hipSuccess) { fprintf(stderr, "kernel_launch: hipFuncSetAttribute failed\n"); grid = -1; return; }
        int per_cu = 0;
        if (hipOccupancyMaxActiveBlocksPerMultiprocessor(&per_cu, (const void*)mk_fwd, NTHR, LDS_BYTES) != hipSuccess || per_cu < 1) { fprintf(stderr, "kernel_launch: occupancy query says %d blocks/CU\n", per_cu); }
        (void)hipGetLastError();
        grid = cus;
        if (ws_size < WS_END) { fprintf(stderr, "kernel_launch: workspace too small\n"); grid = -1; return; }
    }
    if (grid < 0) return;
    (void)hipMemsetAsync((char*)d_ws + WS_CTL, 0, CTL_ZERO_BYTES, stream);
    Args a{};
    for (int i = 0; i < 20; ++i) a.in[i] = (const float*)d_in[i];
    a.out = (float*)d_out; a.ws = (unsigned char*)d_ws;
#ifdef OUT_SKIP
    a.dbg = OUT_SKIP;
#endif
#if DIAG
    diag_launch(a, grid, d_in, d_out, d_ws, stream);
#else
#if REP >= 91 && REP <= 98
    a.ph_lo = 0; a.ph_hi = REP - 90;
    hipLaunchKernelGGL(mk_fwd, dim3(grid), dim3(NTHR), LDS_BYTES, stream, a);
    (void)hipMemsetAsync((char*)d_ws + WS_CTL, 0, CTL_ZERO_BYTES, stream);
#endif
    a.ph_lo = 0; a.ph_hi = N_PHASES;
    hipLaunchKernelGGL(mk_fwd, dim3(grid), dim3(NTHR), LDS_BYTES, stream, a);
#endif
}
```

```cpp
#define DIAG 0
#define DSEL -1
#include <hip/hip_runtime.h>
#include <math.h>
#include <stdint.h>
#include <cstdio>

#define LAS __attribute__((address_space(3)))
#define GAS __attribute__((address_space(1)))
typedef unsigned short bf16_t;
typedef short bf16x8 __attribute__((ext_vector_type(8)));
typedef short s16x4 __attribute__((ext_vector_type(4)));
typedef float f32x2 __attribute__((ext_vector_type(2)));
typedef float f32x4 __attribute__((ext_vector_type(4)));
typedef float f32x16 __attribute__((ext_vector_type(16)));
typedef unsigned u32x2 __attribute__((ext_vector_type(2)));
typedef unsigned u32x4 __attribute__((ext_vector_type(4)));
typedef _Float16 f16x2_t __attribute__((ext_vector_type(2)));
typedef __bf16 bf16x2_t __attribute__((ext_vector_type(2)));

constexpr int DM = 1024, NB = 8, SEQ = 2048, CTX = 256, KV = SEQ + CTX  , M_TOK = NB * SEQ  , M_CTX = NB * CTX  ;
constexpr int EIN = 4608, OIN = 3584;
constexpr float EPS = 1e-6f;
constexpr float LOG2E = 1.4426950408889634f;
constexpr float LAM_INIT = 0.2f;

constexpr size_t MiB = 1u << 20;
constexpr size_t WS_CTL = 0, CTL_ZERO_BYTES = 1 * MiB;
constexpr size_t WS_MISC = 1 * MiB;
constexpr size_t WS_WT0 = 2 * MiB;
constexpr size_t WS_WO0 = 11 * MiB;
constexpr size_t WS_WT1 = 13 * MiB;
constexpr size_t WS_WO1 = 20 * MiB;
constexpr size_t WS_WS = 22 * MiB;
constexpr size_t WS_SSQ1 = 23 * MiB;
constexpr size_t WS_RA = 24 * MiB;
constexpr size_t WS_XN = WS_RA, WS_CN = WS_RA + 32 * MiB, WS_ST = WS_RA, WS_A1 = WS_RA, WS_X1B = WS_RA + 32 * MiB;
constexpr size_t WS_Y = 88 * MiB;
constexpr size_t WS_KC = 120 * MiB;
constexpr size_t WS_VT = 138 * MiB;
constexpr size_t WS_GA = 156 * MiB;
constexpr size_t WS_HVT = 172 * MiB;
constexpr size_t WS_LF = 190 * MiB;
constexpr size_t WS_GB = 226 * MiB;
constexpr size_t WS_END = 242 * MiB;
constexpr size_t WS_UG = 120 * MiB;
constexpr size_t WS_BG = 136 * MiB;
constexpr size_t WS_CH = 152 * MiB;
constexpr size_t WS_GVT = 168 * MiB;
constexpr size_t WS_GVSSQ = 186 * MiB;
constexpr int GVP = SEQ + 64;
constexpr int MI_MOD = 0;
constexpr int MI_CS = 55296, MI_SN = MI_CS + 1024, MI_LBV = MI_SN + 1024, MI_SCAL = MI_LBV + 1024, MI_BIAS1 = MI_SCAL + 64;
constexpr int CW_BAR = 4096;
constexpr int CW_QUEUE = 16384;
constexpr int CW_FLAG = 32768;
constexpr int CW_XCC = 45056;
constexpr int CW_UNCLEAN = 45056 + 1024;
constexpr int CW_GRP = 49152;
constexpr int CW_ADA = 40960;

__device__ __forceinline__ unsigned cvt_pk_bf16(float lo, float hi) { f32x2 v = {lo, hi}; bf16x2_t b = __builtin_convertvector(v, bf16x2_t); return __builtin_bit_cast(unsigned, b); }
__device__ __forceinline__ unsigned cvt_pk_f16(float lo, float hi) { f32x2 v = {lo, hi}; f16x2_t b = __builtin_convertvector(v, f16x2_t); return __builtin_bit_cast(unsigned, b); }
__device__ __forceinline__ float bf2f(unsigned short h) { return __uint_as_float(((unsigned)h) << 16); }
__device__ __forceinline__ float bflo(unsigned w) { return __uint_as_float(w << 16); }
__device__ __forceinline__ float bfhi(unsigned w) { return __uint_as_float(w & 0xffff0000u); }
__device__ __forceinline__ float silu_fast(float v) { return v * __builtin_amdgcn_rcpf(1.f + __expf(-v)); }
__device__ __forceinline__ float gelu_erf(float v) { return 0.5f * v * (1.f + erff(v * 0.70710678118654752f)); }
__device__ __forceinline__ float wave_sum(float v) {
#pragma unroll
  for (int o = 1; o < 64; o <<= 1) v += __shfl_xor(v, o);
  return v;
}
__device__ __forceinline__ int lane_id() { int l = (int)__builtin_amdgcn_mbcnt_hi(~0u, __builtin_amdgcn_mbcnt_lo(~0u, 0u)); asm volatile("" : "+v"(l)); return l; }
__device__ __forceinline__ float shfl_xor_l(float v, int mask, int lane) { return __int_as_float(__builtin_amdgcn_ds_bpermute((lane ^ mask) << 2, __float_as_int(v))); }
#define LDS_WAIT() asm volatile("s_waitcnt lgkmcnt(0)" ::: "memory")
#define VM_WAIT() asm volatile("s_waitcnt vmcnt(0)" ::: "memory")

namespace pg8 {
constexpr int BM = 256, BK = 64, HALF = 128, HTB = HALF * BK * 2, STAGE_BYTES = 8 * HTB;
__host__ __device__ __forceinline__ int lds_byte(int r, int c) { const int st = (r >> 4) * 2 + (c >> 5), rr = r & 15, cc = c & 31, ob = rr * 64 + cc * 2; return st * 1024 + (ob ^ (((ob >> 9) & 1) << 5)); }
__host__ __device__ __forceinline__ void stage_rc(int b, int& R, int& C) { const int st = b / 1024, sb = b % 1024, swz = sb ^ (((sb >> 9) & 1) << 5); R = (st >> 1) * 16 + swz / 64; C = (st & 1) * 32 + (swz % 64) / 2; }
__host__ __device__ __forceinline__ int perm32(int rho) { const int n = rho >> 4, i = rho & 15; return 8 * (i >> 2) + 4 * n + (i & 3); }

struct Unit { const char* a; const char* b; int ty, pm, pn, aux; };

template <class Epi, class Sched, bool HALFN = false>
__device__ __forceinline__ void gemm_phase(LAS unsigned char* lds, const int K, const Sched& S, const Epi& E, const int wv) {
    const int lane = lane_id(), tid = wv * 64 + lane, wid = wv, wr = wid >> 2, wc = wid & 3, fr = lane & 15, fq = lane >> 4;
    const int nt = K / BK;
    unsigned voffA[2], voffB[2];
#pragma unroll
    for (int i = 0; i < 2; ++i) { int R, C; stage_rc(tid * 16 + i * 8192, R, C); const int Rb = (R & ~31) + perm32(R & 31);
        voffA[i] = (unsigned)(R * K + C) * 2u; voffB[i] = (unsigned)(Rb * K + C) * 2u; }
    const size_t kstep = (size_t)(BK * 2);
    const size_t hstep = (size_t)HALF * K * 2;
    const unsigned ldsw = (unsigned)wid * 1024u;
    const int aoff = lds_byte(wr * 64 + fr, fq * 8), boff = lds_byte(wc * 32 + fr, fq * 8);
#define PG8_SA(b, h) (((b) * 2 + (h)) * HTB)
#define PG8_SB(b, h) ((4 + (b) * 2 + (h)) * HTB)
#define PG8_STAGE(bufoff, gbase, voff) do { _Pragma("unroll") for (int _i = 0; _i < 2; ++_i) \
        __builtin_amdgcn_global_load_lds((const unsigned*)((const char*)(gbase) + (voff)[_i]), (LAS unsigned*)(lds + (bufoff) + ldsw + _i * 8192), 16, 0, 0); } while (0)
#define PG8_LDA(dst, b, h) do { _Pragma("unroll") for (int m = 0; m < 4; ++m) _Pragma("unroll") for (int k = 0; k < 2; ++k) dst[m][k] = *(const LAS bf16x8*)(lds + PG8_SA(b, h) + aoff + m * 2048 + k * 1024); } while (0)
#define PG8_LDB(dst, b, h) do { _Pragma("unroll") for (int n = 0; n < 2; ++n) _Pragma("unroll") for (int k = 0; k < 2; ++k) dst[n][k] = *(const LAS bf16x8*)(lds + PG8_SB(b, h) + boff + n * 2048 + k * 1024); } while (0)
#define PG8_MMA(ai, bj, At, Bt) do { __builtin_amdgcn_s_setprio(1); _Pragma("unroll") for (int m = 0; m < 4; ++m) _Pragma("unroll") for (int n = 0; n < 2; ++n) _Pragma("unroll") for (int k = 0; k < 2; ++k) \
        acc[ai][bj][m][n] = __builtin_amdgcn_mfma_f32_16x16x32_bf16(Bt[n][k], At[m][k], acc[ai][bj][m][n], 0, 0, 0); __builtin_amdgcn_s_setprio(0); } while (0)
#define PG8_WAIT_V(n) asm volatile("s_waitcnt vmcnt(" #n ")" ::: "memory")
#define PG8_WAIT_L(n) asm volatile("s_waitcnt lgkmcnt(" #n ")" ::: "memory")
#define PG8_BAR __builtin_amdgcn_s_barrier()
#define PG8_SCHED __builtin_amdgcn_sched_barrier(0)
    Unit cur, nxt; int ui = 0;
    if (!S.next(0, cur)) return;
    f32x4 acc[2][2][4][2];
#pragma unroll
    for (int a = 0; a < 2; ++a)
#pragma unroll
        for (int b = 0; b < 2; ++b)
#pragma unroll
            for (int m = 0; m < 4; ++m)
#pragma unroll
                for (int n = 0; n < 2; ++n) acc[a][b][m][n] = (f32x4){0.f, 0.f, 0.f, 0.f};
    bf16x8 At[4][2], B0[2][2], B1[2][2];
    const char* cA = cur.a; const char* cB = cur.b;
    PG8_STAGE(PG8_SB(0, 0), cB, voffB); if (!HALFN) PG8_STAGE(PG8_SB(0, 1), cB + hstep, voffB); PG8_STAGE(PG8_SA(0, 0), cA, voffA); PG8_STAGE(PG8_SA(0, 1), cA + hstep, voffA);
    if (wr == 1) PG8_BAR;
    PG8_WAIT_V(2); PG8_BAR;
    PG8_STAGE(PG8_SB(1, 0), cB + kstep, voffB); PG8_STAGE(PG8_SA(1, 0), cA + kstep, voffA); if (!HALFN) PG8_STAGE(PG8_SB(1, 1), cB + hstep + kstep, voffB);
    if (HALFN) PG8_WAIT_V(4); else PG8_WAIT_V(6); PG8_BAR;
    for (;;) {
        const bool has_next = S.next(ui + 1, nxt);
        const char* nA = has_next ? nxt.a : cA; const char* nB = has_next ? nxt.b : cB;
        for (int t = 0; t < nt; t += 2) {
            const bool last = (t == nt - 2);
            const char* a1 = cA + (size_t)(t + 1) * kstep;
            const char* a2 = last ? nA : cA + (size_t)(t + 2) * kstep; const char* b2 = last ? nB : cB + (size_t)(t + 2) * kstep;
            const char* a3 = a2 + kstep; const char* b3 = b2 + kstep;
#define PG8_WAIT_VK() do { if (HALFN) PG8_WAIT_V(6); else PG8_WAIT_V(8); } while (0)
            PG8_LDB(B0, 0, 0); if (!HALFN) PG8_LDB(B1, 0, 1); PG8_SCHED; PG8_LDA(At, 0, 0); PG8_STAGE(PG8_SA(1, 1), a1 + hstep, voffA);
            PG8_WAIT_VK(); PG8_WAIT_L(0); PG8_BAR; PG8_MMA(0, 0, At, B0); if (!HALFN) PG8_MMA(0, 1, At, B1); PG8_BAR; PG8_SCHED;
            PG8_LDA(At, 0, 1); PG8_STAGE(PG8_SB(0, 0), b2, voffB); if (!HALFN) PG8_STAGE(PG8_SB(0, 1), b2 + hstep, voffB); PG8_STAGE(PG8_SA(0, 0), a2, voffA);
            PG8_WAIT_VK(); PG8_WAIT_L(0); PG8_BAR; PG8_MMA(1, 0, At, B0); if (!HALFN) PG8_MMA(1, 1, At, B1); PG8_BAR; PG8_SCHED;
            PG8_LDB(B0, 1, 0); if (!HALFN) PG8_LDB(B1, 1, 1); PG8_SCHED; PG8_LDA(At, 1, 0); PG8_STAGE(PG8_SA(0, 1), a2 + hstep, voffA);
            PG8_WAIT_VK(); PG8_WAIT_L(0); PG8_BAR; PG8_MMA(0, 0, At, B0); if (!HALFN) PG8_MMA(0, 1, At, B1); PG8_BAR; PG8_SCHED;
            PG8_LDA(At, 1, 1); PG8_STAGE(PG8_SB(1, 0), b3, voffB); if (!HALFN) PG8_STAGE(PG8_SB(1, 1), b3 + hstep, voffB); PG8_STAGE(PG8_SA(1, 0), a3, voffA);
            PG8_WAIT_VK(); PG8_WAIT_L(0); PG8_BAR; PG8_MMA(1, 0, At, B0); if (!HALFN) PG8_MMA(1, 1, At, B1); PG8_BAR; PG8_SCHED;
#undef PG8_WAIT_VK
        }
        if (wr == 0) PG8_BAR;
        { int ln_ = (int)__builtin_amdgcn_mbcnt_hi(~0u, __builtin_amdgcn_mbcnt_lo(~0u, 0u)); asm volatile("" : "+v"(ln_));
          E(acc, cur, wr, wc, ln_ & 15, ln_ >> 4, ln_); }
        if (!has_next) break;
#pragma unroll
        for (int a = 0; a < 2; ++a)
#pragma unroll
            for (int b = 0; b < 2; ++b)
#pragma unroll
                for (int m = 0; m < 4; ++m)
#pragma unroll
                    for (int n = 0; n < 2; ++n) acc[a][b][m][n] = (f32x4){0.f, 0.f, 0.f, 0.f};
        cur = nxt; cA = nA; cB = nB; ++ui;
        if (wr == 1) PG8_BAR;
    }
    PG8_WAIT_V(0);
    PG8_BAR;
#undef PG8_SA
#undef PG8_SB
#undef PG8_STAGE
#undef PG8_LDA
#undef PG8_LDB
#undef PG8_MMA
#undef PG8_WAIT_V
#undef PG8_WAIT_L
#undef PG8_BAR
#undef PG8_SCHED
}
}

__device__ __forceinline__ void ticket_draw(unsigned* qctr, unsigned& tk) {
    const unsigned one = 1u;
    asm volatile("global_atomic_add %0, %1, %2, off sc0" : "=v"(tk) : "v"(qctr), "v"(one) : "memory");
}
__device__ __forceinline__ void ticket_wait(unsigned& tk) { asm volatile("s_waitcnt vmcnt(0)" : "+v"(tk) :: "memory"); }
__device__ __forceinline__ void group_barrier_light(unsigned* cnt, unsigned target, int tid) {
    asm volatile("s_waitcnt vmcnt(0)" ::: "memory");
    __syncthreads();
    if (tid == 0) {
        const unsigned old = __hip_atomic_fetch_add(cnt, 1u, __ATOMIC_RELAXED, __HIP_MEMORY_SCOPE_AGENT);
        if (old + 1u == target) __hip_atomic_store(cnt + 64, 1u, __ATOMIC_RELAXED, __HIP_MEMORY_SCOPE_AGENT);
        else { unsigned sp = 0u; while (__hip_atomic_load(cnt + 64, __ATOMIC_RELAXED, __HIP_MEMORY_SCOPE_AGENT) == 0u && ++sp < (1u << 22)) __builtin_amdgcn_s_sleep(1); }
        __builtin_amdgcn_fence(__ATOMIC_ACQUIRE, "agent");
        asm volatile("s_waitcnt vmcnt(0)" ::: "memory");
    }
    __syncthreads();
}
#define XB_TMO      128
#define XB_XCNT(j)  (256  + 64 * (j))
#define XB_XSUB(j)  (1280 + 64 * (j))
#define XB_XGEN(j)  (2304 + 64 * (j))
#define XB_TOP      3328
#define XB_TOPGEN   3392
#define XCD_BAR_WORDS 3456
#define XB_SPIN_CAP (1u << 18)
__device__ __forceinline__ unsigned xb_ld(unsigned* p)              { return __hip_atomic_load(p, __ATOMIC_RELAXED, __HIP_MEMORY_SCOPE_AGENT); }
__device__ __forceinline__ unsigned xb_add(unsigned* p, unsigned v) { return __hip_atomic_fetch_add(p, v, __ATOMIC_RELAXED, __HIP_MEMORY_SCOPE_AGENT); }
__device__ __forceinline__ unsigned xb_xcc_id() { return (unsigned)__builtin_amdgcn_s_getreg((3 << 11) | 20) & 0xFu; }
#define XB_SPIN(cond, bar) do { unsigned _sp = 0; while (cond) { __builtin_amdgcn_s_sleep(1); \
    if ((++_sp & 255u) == 0u) { if (xb_ld(&(bar)[XB_TMO])) break; if (_sp > XB_SPIN_CAP) { atomicAdd(&(bar)[XB_TMO], 1u); break; } } } } while (0)
struct XcdBarrier { unsigned* bar; unsigned x; volatile LAS unsigned* st; };
__device__ __forceinline__ XcdBarrier xcd_barrier_post(unsigned* bar, volatile LAS unsigned* st, int tid) {
    XcdBarrier b; b.bar = bar; b.x = xb_xcc_id(); b.st = st;
    if (tid == 0) (void)xb_add(&bar[XB_XCNT(b.x)], 1u);
    return b;
}
__device__ __forceinline__ void xcd_barrier_complete(unsigned* bar, unsigned x, unsigned& nloc, unsigned& nx) {
    const unsigned G = gridDim.x * gridDim.y * gridDim.z;
    unsigned sum, cnt, mine, sp = 0u;
    for (;;) {
        sum = 0u; cnt = 0u; mine = 0u;
#pragma unroll
        for (unsigned j = 0; j < 16; ++j) { const unsigned c = xb_ld(&bar[XB_XCNT(j)]); sum += c; cnt += (c > 0u) ? 1u : 0u; mine = (j == x) ? c : mine; }
        if (sum == G) break;
        __builtin_amdgcn_s_sleep(1);
        if ((++sp & 255u) == 0u) { if (xb_ld(&bar[XB_TMO])) break; if (sp > XB_SPIN_CAP) { atomicAdd(&bar[XB_TMO], 1u); break; } }
    }
    nloc = mine > 0u ? mine : 1u; nx = cnt > 0u ? cnt : 1u;
}
__device__ __forceinline__ void xcd_barrier(const XcdBarrier& b, int tid, const bool light = false) {
    asm volatile("s_waitcnt vmcnt(0)" ::: "memory");
    __syncthreads();
    if (tid == 0) {
        unsigned* bar = b.bar;
        __builtin_amdgcn_s_waitcnt(0);
        unsigned nloc = b.st[0], nx = b.st[1];
        if (nloc == 0u) { xcd_barrier_complete(bar, b.x, nloc, nx); b.st[0] = nloc; b.st[1] = nx; }
        const unsigned old = xb_add(&bar[XB_XSUB(b.x)], 1u);
        const unsigned gen = old / nloc;
        if (old + 1u == (gen + 1u) * nloc) {
            if (!light) __builtin_amdgcn_fence(__ATOMIC_RELEASE, "agent");
            asm volatile("s_waitcnt vmcnt(0)" ::: "memory");
            const unsigned og = xb_add(&bar[XB_TOP], 1u);
            const unsigned tg = og / nx;
            if (og + 1u == (tg + 1u) * nx) xb_add(&bar[XB_TOPGEN], 1u);
            else XB_SPIN(xb_ld(&bar[XB_TOPGEN]) == tg, bar);
            __builtin_amdgcn_fence(__ATOMIC_ACQUIRE, "agent");
            xb_add(&bar[XB_XGEN(b.x)], 1u);
            asm volatile("s_waitcnt vmcnt(0)" ::: "memory");
        } else {
            XB_SPIN(xb_ld(&bar[XB_XGEN(b.x)]) == gen, bar);
            __builtin_amdgcn_fence(__ATOMIC_ACQUIRE, "agent");
            asm volatile("s_waitcnt vmcnt(0)" ::: "memory");
        }
    }
    __syncthreads();
}
constexpr int NWAVES = 8, NTHR = 512;
constexpr int RING_BYTES = 131072;
constexpr int LDSX_OFF = RING_BYTES;
constexpr int LDSCTL_OFF = 162816;
constexpr int LDS_BYTES = 163840;

struct Args {
    const float* in[20]; float* out; unsigned char* ws; int ph_lo, ph_hi, dbg, pad;
};
typedef const __attribute__((address_space(4))) Args* KArgsPtr;
__device__ __forceinline__ KArgsPtr kargs() { KArgsPtr p = (KArgsPtr)__builtin_amdgcn_kernarg_segment_ptr(); asm volatile("" : "+s"(p)); return p; }
struct Frame {
    LAS unsigned char* lds;
    volatile LAS unsigned* MISC;
    unsigned* ctl;
    int tid, lane, wave, vcu, G;
    const float *x, *c, *ctx, *c_ctx, *norm_gain, *ada_w, *ada_b, *even_w_in, *even_w_out, *qk_gain, *lam_p, *subln_g, *lb_logits, *hgrn_g,
                *odd_w_in, *odd_w_out, *v_g, *w_s, *b_s, *conv_w;
    float* out; unsigned char* ws; float* misc;
};

__host__ __device__ __forceinline__ int srcmap0(int d) {
    if (d < 1024) { const int base = d < 512 ? 0 : 512; const int e = d & 511; const int pn = e >> 8, rho = e & 255, bj = rho >> 7, wc = (rho >> 5) & 3; return base + (4 * pn + wc) * 64 + 32 * bj + (rho & 31); }
    if (d < 1536) return 1536 + (d - 1024);
    if (d < 2048) return 2048 + (d - 1536);
    if (d < 2560) return 3072 + (d - 2048);
    if (d < 3072) return 3584 + (d - 2560);
    if (d < 3584) return 4096 + (d - 3072);
    if (d < 4096) return 1024 + (d - 3584);
    return 2560 + (d - 4096);
}
__host__ __device__ __forceinline__ int srcmap1(int d) {
    if (d < 1024) { const int t = d >> 8, rho = d & 255, bj = rho >> 7, o = rho & 127; return (bj ? 1024 : 0) + 128 * t + o; }
    if (d < 2048) { const int e = d - 1024; const int t = e >> 8, rho = e & 255, bj = rho >> 7, o = rho & 127; return (bj ? 3072 : 1536) + 128 * t + o; }
    if (d < 3072) { const int e = d - 2048; const int t = e >> 8, rho = e & 255, bj = rho >> 7, o = rho & 127; return (bj ? 2560 : 2048) + 128 * t + o; }
    return 512 + (d - 3072);
}

__device__ __forceinline__ void p0_transpose_item(const float* W, int K, int N, bf16_t* WT, int drow0, int n_src, int k0, LAS float* scr, int lane) {
    float tv[32];
#pragma unroll
    for (int i = 0; i < 32; ++i) { const int kk = 2 * i + (lane >> 5); tv[i] = W[(size_t)(k0 + kk) * N + n_src + (lane & 31)]; }
#pragma unroll
    for (int i = 0; i < 32; ++i) { const int kk = 2 * i + (lane >> 5); scr[kk * 33 + (lane & 31)] = tv[i]; }
    LDS_WAIT(); asm volatile("" ::: "memory");
    const int c = lane & 7;
#pragma unroll
    for (int j = 0; j < 4; ++j) { const int n = (lane >> 3) + 8 * j; const LAS float* s = scr + (8 * c) * 33 + n;
        u32x4 o; o.x = cvt_pk_bf16(s[0 * 33], s[1 * 33]); o.y = cvt_pk_bf16(s[2 * 33], s[3 * 33]); o.z = cvt_pk_bf16(s[4 * 33], s[5 * 33]); o.w = cvt_pk_bf16(s[6 * 33], s[7 * 33]);
        *(u32x4*)(WT + (size_t)(drow0 + n) * K + k0 + 8 * c) = o; }
    LDS_WAIT(); asm volatile("" ::: "memory");
}

__device__ __forceinline__ void weight_copies(Frame& F, int which, int gw, int NGW, int sub_lo = 0, int sub_hi = 1 << 30) {
    LAS float* scr = (LAS float*)(F.lds + F.wave * 16384);
    constexpr int I0 = 16 * (EIN / 32), I1 = 16 * 32, I2 = 16 * (OIN / 32), I3 = 16 * 32, I4 = 128;
    bf16_t* Wt0 = (bf16_t*)(F.ws + WS_WT0); bf16_t* Wo0 = (bf16_t*)(F.ws + WS_WO0); bf16_t* Wt1 = (bf16_t*)(F.ws + WS_WT1); bf16_t* Wo1 = (bf16_t*)(F.ws + WS_WO1); bf16_t* Wsb = (bf16_t*)(F.ws + WS_WS);
    const int lo = (which ? I0 + I1 : 0) + sub_lo, hi0 = which ? I0 + I1 + I2 + I3 + I4 : I0 + I1; const int hi = (lo - sub_lo + sub_hi < hi0) ? lo - sub_lo + sub_hi : hi0;
    for (int it = lo + gw; it < hi; it += NGW) {
        int r = it;
        if (r < I0) { const int kb = r / (EIN / 32), dg = r % (EIN / 32); p0_transpose_item(F.even_w_in, DM, EIN, Wt0, dg * 32, srcmap0(dg * 32), kb * 64, scr, F.lane); continue; } r -= I0;
        if (r < I1) { const int kb = r / 32, dg = r % 32; p0_transpose_item(F.even_w_out, DM, DM, Wo0, dg * 32, dg * 32, kb * 64, scr, F.lane); continue; } r -= I1;
        if (r < I2) { const int kb = r / (OIN / 32), dg = r % (OIN / 32); p0_transpose_item(F.odd_w_in, DM, OIN, Wt1, dg * 32, srcmap1(dg * 32), kb * 64, scr, F.lane); continue; } r -= I2;
        if (r < I3) { const int kb = r / 32, dg = r % 32; p0_transpose_item(F.odd_w_out, DM, DM, Wo1, dg * 32, dg * 32, kb * 64, scr, F.lane); continue; } r -= I3;
        { const int e0 = r * 512 + F.lane * 8; const f32x4 a = *(const f32x4*)(F.w_s + e0), b = *(const f32x4*)(F.w_s + e0 + 4);
          u32x4 o; o.x = cvt_pk_bf16(a.x, a.y); o.y = cvt_pk_bf16(a.z, a.w); o.z = cvt_pk_bf16(b.x, b.y); o.w = cvt_pk_bf16(b.z, b.w); *(u32x4*)(Wsb + e0) = o; }
    }
}
__device__ __forceinline__ void p0_prologue(Frame& F) {
    float* misc = F.misc;
    if (F.vcu < 192) {
        LAS float* sl = (LAS float*)F.lds;
        LAS float* red = (LAS float*)(F.lds + 36864);
        const int cc = F.tid & 31, kp = F.tid >> 5;
        const int gcol = F.vcu * 32 + cc;
        const int l = gcol / 3072, col = gcol % 3072;
        const float* w = F.ada_w + (size_t)l * 1024 * 3072 + col;
        float wv[64];
#pragma unroll
        for (int i = 0; i < 64; ++i) wv[i] = w[(size_t)(kp * 64 + i) * 3072];
        for (int i = F.tid; i < 9 * 1024; i += NTHR) { const int r = i >> 10, k = i & 1023; const float v = (r < 8) ? F.c[r * 1024 + k] : F.c_ctx[k]; sl[i] = v / (1.f + __expf(-v)); }
        __syncthreads();
#pragma unroll
        for (int r = 0; r < 9; ++r) {
            float a = 0.f;
#pragma unroll
            for (int i4 = 0; i4 < 16; ++i4) { const f32x4 sv = *(const LAS f32x4*)(sl + r * 1024 + kp * 64 + 4 * i4);
                a += sv.x * wv[4 * i4] + sv.y * wv[4 * i4 + 1] + sv.z * wv[4 * i4 + 2] + sv.w * wv[4 * i4 + 3]; }
            red[(kp * 9 + r) * 32 + cc] = a;
        }
        __syncthreads();
        if (F.tid < 9 * 32) { const int r = F.tid >> 5, c2 = F.tid & 31; const int gc = F.vcu * 32 + c2; const int l2 = gc / 3072, col2 = gc % 3072;
            float sacc = F.ada_b[l2 * 3072 + col2];
#pragma unroll
            for (int q = 0; q < 16; ++q) sacc += red[(q * 9 + r) * 32 + c2];
            misc[MI_MOD + (l2 * 9 + r) * 3072 + col2] = sacc; }
        asm volatile("s_waitcnt vmcnt(0)" ::: "memory");
        __syncthreads();
        if (F.tid == 0) { __builtin_amdgcn_fence(__ATOMIC_RELEASE, "agent"); __hip_atomic_fetch_add(F.ctl + CW_ADA, 1u, __ATOMIC_RELAXED, __HIP_MEMORY_SCOPE_AGENT); }
    }
    if (F.vcu == 192) {
        for (int i = F.tid; i < 1024; i += NTHR) { const int pos = i >> 4, f = i & 15; const float inv = powf(10000.f, -(float)f / 16.f); const float ang = (float)pos * inv;
            misc[MI_CS + i] = cosf(ang); misc[MI_SN + i] = sinf(ang); }
    }
    if (F.vcu == 193) {
        for (int i = F.tid; i < 1024; i += NTHR) { const int dir = i >> 9, ch = i & 511; const float l0 = F.lb_logits[(dir * 2 + 0) * 512 + ch], l1 = F.lb_logits[(dir * 2 + 1) * 512 + ch];
            const float mx = fmaxf(l0, l1); const float e0 = expf(l0 - mx), e1 = expf(l1 - mx); misc[MI_LBV + i] = e0 / (e0 + e1); }
        if (F.wave == 0) {
            const int i = F.lane;
            float a = F.lam_p[i] * F.lam_p[64 + i], b = F.lam_p[128 + i] * F.lam_p[192 + i], gq = fabsf(F.qk_gain[i]), gk = fabsf(F.qk_gain[64 + i]);
#pragma unroll
            for (int o = 1; o < 64; o <<= 1) { a += __shfl_xor(a, o); b += __shfl_xor(b, o); gq = fmaxf(gq, __shfl_xor(gq, o)); gk = fmaxf(gk, __shfl_xor(gk, o)); }
            if (i == 0) {
                misc[MI_SCAL + 0] = expf(a) - expf(b) + LAM_INIT;
                misc[MI_SCAL + 1] = 8.0f * gq * gk * LOG2E * 1.0001f + 0.01f;
            }
        }
    }
    if (F.vcu >= 194) weight_copies(F, 0, (F.vcu - 194) * NWAVES + F.wave, 62 * NWAVES, 0, 992);
}

__device__ __forceinline__ void mod_rows3(Frame& F, int ma, int mb, int mc, bf16_t* XN, bf16_t* CN) {
    const float* misc = F.misc; const int lane = F.lane;
    f32x4 v[3][4];
#pragma unroll
    for (int r = 0; r < 3; ++r) { const int m = (r == 0) ? ma : (r == 1) ? mb : mc; const float* xrow = (m < M_TOK) ? F.x + (size_t)m * DM : F.ctx + (size_t)(m - M_TOK) * DM; const f32x4* xr = (const f32x4*)xrow + lane;
#pragma unroll
        for (int j = 0; j < 4; ++j) v[r][j] = xr[64 * j]; }
#pragma unroll
    for (int r = 0; r < 3; ++r) {
        const int m = (r == 0) ? ma : (r == 1) ? mb : mc;
        float s = 0.f;
#pragma unroll
        for (int j = 0; j < 4; ++j) s += (v[r][j].x * v[r][j].x + v[r][j].y * v[r][j].y) + (v[r][j].z * v[r][j].z + v[r][j].w * v[r][j].w);
        const float rstd = rsqrtf(wave_sum(s) * (1.f / DM) + EPS);
        const float* modrow = misc + MI_MOD + (0 * 9 + ((m < M_TOK) ? (m >> 11) : 8)) * 3072;
        bf16_t* orow = (m < M_TOK) ? XN + (size_t)m * DM : CN + (size_t)(m - M_TOK) * DM;
        u32x2* o8 = (u32x2*)orow + lane;
#pragma unroll
        for (int j = 0; j < 4; ++j) {
            const int col = 4 * lane + 256 * j;
            const f32x4 g = *(const f32x4*)(F.norm_gain + col), sh = *(const f32x4*)(modrow + col), sc = *(const f32x4*)(modrow + 1024 + col);
            const f32x4 o = v[r][j] * rstd * g * (sc + 1.f) + sh;
            u32x2 w; w.x = cvt_pk_bf16(o.x, o.y); w.y = cvt_pk_bf16(o.z, o.w); o8[64 * j] = w;
        }
    }
}
__device__ __forceinline__ void rows_load(Frame& F, int m, f32x4 (&v)[4]) {
    const float* xrow = (m < M_TOK) ? F.x + (size_t)m * DM : F.ctx + (size_t)(m - M_TOK) * DM; const f32x4* xr = (const f32x4*)xrow + F.lane;
#pragma unroll
    for (int j = 0; j < 4; ++j) v[j] = xr[64 * j];
}
__device__ __forceinline__ void mod_vecs(Frame& F, int modr, f32x4 (&Gm)[4], f32x4 (&Sh)[4]) {
    const float* modrow = F.misc + MI_MOD + (0 * 9 + modr) * 3072;
#pragma unroll
    for (int j = 0; j < 4; ++j) { const int col = 4 * F.lane + 256 * j;
        Gm[j] = *(const f32x4*)(F.norm_gain + col) * (*(const f32x4*)(modrow + 1024 + col) + 1.f); Sh[j] = *(const f32x4*)(modrow + col); }
}
__device__ __forceinline__ void row_proc(Frame& F, int m, const f32x4 (&v)[4], const f32x4 (&Gm)[4], const f32x4 (&Sh)[4], bf16_t* XN, bf16_t* CN) {
    float s = 0.f;
#pragma unroll
    for (int j = 0; j < 4; ++j) s += (v[j].x * v[j].x + v[j].y * v[j].y) + (v[j].z * v[j].z + v[j].w * v[j].w);
    const float rstd = rsqrtf(wave_sum(s) * (1.f / DM) + EPS);
    bf16_t* orow = (m < M_TOK) ? XN + (size_t)m * DM + (size_t)(m >> 11) * 2097152 : XN + (size_t)((m - M_TOK) >> 8) * 4194304 + 2097152 + (size_t)((m - M_TOK) & 255) * DM;
    u32x2* o8 = (u32x2*)orow + F.lane;
#pragma unroll
    for (int j = 0; j < 4; ++j) { const f32x4 o = v[j] * rstd * Gm[j] + Sh[j]; u32x2 w; w.x = cvt_pk_bf16(o.x, o.y); w.y = cvt_pk_bf16(o.z, o.w); o8[64 * j] = w; }
}
__device__ __forceinline__ void p0b_phase(Frame& F) {
    const float* misc = F.misc;
    bf16_t* XN = (bf16_t*)(F.ws + WS_XN); bf16_t* CN = (bf16_t*)(F.ws + WS_CN);
    const int gw0 = F.vcu * NWAVES + F.wave;
    f32x4 ra[3][4], rb[3][4];
#pragma unroll
    for (int r = 0; r < 3; ++r) { rows_load(F, 8 * gw0 + r, ra[r]); rows_load(F, 8 * gw0 + 3 + r, rb[r]); }
    weight_copies(F, 0, gw0, F.G * NWAVES, 992);
    __syncthreads();
    if (F.wave == 0) { unsigned sp = 0u;
        while (__hip_atomic_load(F.ctl + CW_ADA, __ATOMIC_RELAXED, __HIP_MEMORY_SCOPE_AGENT) < 192u && ++sp < (1u << 22)) __builtin_amdgcn_s_sleep(2);
        __builtin_amdgcn_fence(__ATOMIC_ACQUIRE, "agent"); }
    __syncthreads();
    {
        LAS float* red = (LAS float*)F.lds;
        LAS float* shs = (LAS float*)(F.lds + 16384);
        const int cc = F.tid & 15, kp = F.tid >> 4;
        float acc[8];
#pragma unroll
        for (int b = 0; b < 8; ++b) acc[b] = 0.f;
        float wv[32];
        if (cc < 14) {
            const int d = F.vcu * 14 + cc; const int src = srcmap1(d & ~31) + (d & 31);
#pragma unroll
            for (int i = 0; i < 32; ++i) wv[i] = F.odd_w_in[(size_t)(kp * 32 + i) * OIN + src];
        } else {
#pragma unroll
            for (int i = 0; i < 32; ++i) wv[i] = 0.f;
        }
        { f32x4 sh4[4];
#pragma unroll
          for (int q = 0; q < 4; ++q) { const int i = F.tid + NTHR * q; const int b = i >> 8, c4 = i & 255; sh4[q] = *(const f32x4*)(misc + MI_MOD + (9 + b) * 3072 + 4 * c4); }
#pragma unroll
          for (int q = 0; q < 4; ++q) { const int i = F.tid + NTHR * q; const int b = i >> 8, c4 = i & 255; *(LAS f32x4*)(shs + b * 1024 + 4 * c4) = sh4[q]; } }
        __syncthreads();
#pragma unroll
        for (int b = 0; b < 8; ++b) {
#pragma unroll
            for (int i4 = 0; i4 < 8; ++i4) { const f32x4 sv = *(const LAS f32x4*)(shs + b * 1024 + kp * 32 + 4 * i4);
                acc[b] += sv.x * wv[4 * i4] + sv.y * wv[4 * i4 + 1] + sv.z * wv[4 * i4 + 2] + sv.w * wv[4 * i4 + 3]; }
        }
        __syncthreads();
#pragma unroll
        for (int b = 0; b < 8; ++b) red[(kp * 8 + b) * 16 + cc] = acc[b];
        __syncthreads();
        if (F.tid < 8 * 14) { const int b = F.tid / 14, c2 = F.tid % 14; float s = 0.f;
            for (int q = 0; q < 32; ++q) s += red[(q * 8 + b) * 16 + c2];
            F.misc[MI_BIAS1 + b * OIN + F.vcu * 14 + c2] = s; }
        __syncthreads();
    }
    {
        const int gw = gw0;
        f32x4 Gm[4], Sh[4];
        mod_vecs(F, (8 * gw) >> 11, Gm, Sh);
#pragma unroll
        for (int r = 0; r < 3; ++r) row_proc(F, 8 * gw + r, ra[r], Gm, Sh, XN, CN);
        rows_load(F, 8 * gw + 6, ra[0]); rows_load(F, 8 * gw + 7, ra[1]); rows_load(F, M_TOK + gw, ra[2]);
        __builtin_amdgcn_sched_barrier(0);
#pragma unroll
        for (int r = 0; r < 3; ++r) row_proc(F, 8 * gw + 3 + r, rb[r], Gm, Sh, XN, CN);
        row_proc(F, 8 * gw + 6, ra[0], Gm, Sh, XN, CN); row_proc(F, 8 * gw + 7, ra[1], Gm, Sh, XN, CN);
        mod_vecs(F, 8, Gm, Sh);
        row_proc(F, M_TOK + gw, ra[2], Gm, Sh, XN, CN);
    }
}

enum { T_Q = 0, T_K = 1, T_SILU = 2, T_PLAIN = 3, T_LF = 4, T_VT = 5 };
struct P1Order {
    int G, c;
    __device__ __forceinline__ bool next(int i, pg8::Unit& u) const {
        const int L = i * G + c;
        const char* wsb = (const char*)kargs()->ws; const char* XN = wsb + WS_XN; const char* CN = wsb + WS_CN; const char* Wt0 = wsb + WS_WT0;
        constexpr size_t TSTEP = (size_t)256 * DM * 2;
        if (L < 896) {
            constexpr int nwg = 896, nN = 14, q = nwg / 8;
            const int xcd = L % 8, offp = L / 8; const int wgid = xcd * q + offp;
            constexpr int nig = 8 * nN; const int gid = wgid / nig, fm = gid * 8;
            u.pm = fm + ((wgid % nig) % 8); u.pn = (wgid % nig) / 8;
            u.a = XN + (size_t)u.pm * TSTEP + (size_t)(u.pm >> 3) * (4u << 20); u.b = Wt0 + (size_t)u.pn * TSTEP; u.aux = 0;
            u.ty = (u.pn < 2) ? T_Q : (u.pn < 4) ? T_K : (u.pn < 6) ? T_SILU : (u.pn < 8) ? T_PLAIN : (u.pn < 12) ? T_LF : T_SILU;
            return true;
        }
        int r = L - 896;
        if (r < 256) { const int xcd = r % 8, j = r / 8; u.pn = xcd * 8 + j / 4; u.pm = j % 4; u.a = Wt0 + (size_t)(14 + u.pm) * TSTEP; u.b = XN + (size_t)u.pn * TSTEP + (size_t)(u.pn >> 3) * (4u << 20); u.ty = T_VT; u.aux = 0; return true; }
        r -= 256;
        if (r < 48) { const int pmc = r % 8, j = r / 8; const int pn = (j < 2) ? 2 + j : 6 + j;
            u.pm = pmc; u.pn = pn; u.a = XN + (size_t)pmc * (8u << 20) + (4u << 20); u.b = Wt0 + (size_t)pn * TSTEP; u.aux = 1; u.ty = (pn < 4) ? T_K : T_LF; return true; }
        r -= 48;
        if (r < 32) { u.pn = r % 8; u.pm = r / 8; u.a = Wt0 + (size_t)(14 + u.pm) * TSTEP; u.b = XN + (size_t)u.pn * (8u << 20) + (4u << 20); u.ty = T_VT; u.aux = 1; return true; }
        return false;
    }
};
struct EpiP1 {
    const LAS float* tab;
    __device__ __forceinline__ void operator()(const f32x4 (&acc)[2][2][4][2], const pg8::Unit& u, int wr, int wc, int fr, int fq, int lane) const {
        KArgsPtr ka = kargs(); unsigned char* wsb = ka->ws; const float* qk_gain = ka->in[9];
        bf16_t* Y = (bf16_t*)(wsb + WS_Y); bf16_t* Kc = (bf16_t*)(wsb + WS_KC); bf16_t* VT = (bf16_t*)(wsb + WS_VT); bf16_t* GA = (bf16_t*)(wsb + WS_GA); bf16_t* HVT = (bf16_t*)(wsb + WS_HVT); bf16_t* GB = (bf16_t*)(wsb + WS_GB);
        unsigned short* LF = (unsigned short*)(wsb + WS_LF); const float* miscp = (const float*)(wsb + WS_MISC); const float* CS = miscp + MI_CS; const float* SN = miscp + MI_SN; const float* LBV = miscp + MI_LBV;
        const int ty = u.ty, ctx = u.aux;
        if (ty == T_Q || ty == T_K) {
            const int seg = 4 * (u.pn & 1) + wc;
            const LAS float* gp = tab + 2048 + (ty == T_K ? 64 : 0) + 8 * fq;
            const f32x4 g00 = *(const LAS f32x4*)(gp), g01 = *(const LAS f32x4*)(gp + 4), g10 = *(const LAS f32x4*)(gp + 32), g11 = *(const LAS f32x4*)(gp + 36);
            const float osc = (ty == T_Q) ? 0.125f * LOG2E : 1.f;
#pragma unroll
            for (int ai = 0; ai < 2; ++ai)
#pragma unroll
                for (int m = 0; m < 4; ++m) {
                    const int rt = 128 * ai + 64 * wr + 16 * m + fr;
                    const int t = ((u.pm & 7) * 256 + rt);
                    float ss = 0.f;
#pragma unroll
                    for (int bj = 0; bj < 2; ++bj)
#pragma unroll
                        for (int n = 0; n < 2; ++n) { const f32x4 v = acc[ai][bj][m][n]; ss += (v.x * v.x + v.y * v.y) + (v.z * v.z + v.w * v.w); }
                    ss += __shfl_xor(ss, 16); ss += __shfl_xor(ss, 32);
                    const float rstd = rsqrtf(ss * (1.f / 64.f) + EPS);
                    f32x4 a0 = acc[ai][0][m][0] * rstd * g00, a1 = acc[ai][0][m][1] * rstd * g01, b0 = acc[ai][1][m][0] * rstd * g10, b1 = acc[ai][1][m][1] * rstd * g11;
                    if (!ctx) {
                        const int pos = (fq < 2) ? (t >> 6) : (t & 63);
                        const LAS float* cp = tab + pos * 16 + 8 * (fq & 1); const LAS float* sp = cp + 1024;
                        const f32x4 c0 = *(const LAS f32x4*)cp, c1 = *(const LAS f32x4*)(cp + 4), s0 = *(const LAS f32x4*)sp, s1 = *(const LAS f32x4*)(sp + 4);
                        const f32x4 o0 = a0 * c0 - b0 * s0, o1 = a1 * c1 - b1 * s1, p0 = a0 * s0 + b0 * c0, p1 = a1 * s1 + b1 * c1;
                        a0 = o0; a1 = o1; b0 = p0; b1 = p1;
                    }
                    a0 = a0 * osc; a1 = a1 * osc; b0 = b0 * osc; b1 = b1 * osc;
                    u32x4 w0, w1;
                    w0.x = cvt_pk_bf16(a0.x, a0.y); w0.y = cvt_pk_bf16(a0.z, a0.w); w0.z = cvt_pk_bf16(a1.x, a1.y); w0.w = cvt_pk_bf16(a1.z, a1.w);
                    w1.x = cvt_pk_bf16(b0.x, b0.y); w1.y = cvt_pk_bf16(b0.z, b0.w); w1.z = cvt_pk_bf16(b1.x, b1.y); w1.w = cvt_pk_bf16(b1.z, b1.w);
                    bf16_t* dst;
                    if (ty == T_Q) dst = Y + (size_t)(u.pm * 256 + rt) * 1024 + seg * 64 + 8 * fq;
                    else if (!ctx) dst = Kc + ((size_t)(u.pm >> 3) * KV + CTX + t) * 512 + seg * 64 + 8 * fq;
                    else dst = Kc + ((size_t)u.pm * KV + rt) * 512 + seg * 64 + 8 * fq;
                    *(u32x4*)dst = w0; *(u32x4*)(dst + 32) = w1;
                }
        } else if (ty == T_SILU || ty == T_PLAIN) {
            bf16_t* base; int pitch;
            if (ty == T_PLAIN) { base = Y + 512 + (u.pn - 6) * 256; pitch = 1024; }
            else if (u.pn < 6) { base = GA + (u.pn - 4) * 256; pitch = 512; }
            else { base = GB + (u.pn - 12) * 256; pitch = 512; }
#pragma unroll
            for (int ai = 0; ai < 2; ++ai)
#pragma unroll
                for (int m = 0; m < 4; ++m) {
                    const int rt = 128 * ai + 64 * wr + 16 * m + fr;
                    bf16_t* rowp = base + (size_t)(u.pm * 256 + rt) * pitch + 32 * wc + 8 * fq;
#pragma unroll
                    for (int bj = 0; bj < 2; ++bj) {
                        f32x4 v0 = acc[ai][bj][m][0], v1 = acc[ai][bj][m][1];
                        if (ty == T_SILU) { v0.x = silu_fast(v0.x); v0.y = silu_fast(v0.y); v0.z = silu_fast(v0.z); v0.w = silu_fast(v0.w); v1.x = silu_fast(v1.x); v1.y = silu_fast(v1.y); v1.z = silu_fast(v1.z); v1.w = silu_fast(v1.w); }
                        u32x4 w; w.x = cvt_pk_bf16(v0.x, v0.y); w.y = cvt_pk_bf16(v0.z, v0.w); w.z = cvt_pk_bf16(v1.x, v1.y); w.w = cvt_pk_bf16(v1.z, v1.w);
                        *(u32x4*)(rowp + 128 * bj) = w;
                    }
                }
        } else if (ty == T_LF) {
            const int dir = (u.pn >= 10) ? 1 : 0; const int pnr = (u.pn - 8) & 1;
            const int col0 = 256 * pnr + 32 * wc + 8 * fq;
            f32x4 lb[2][2];
#pragma unroll
            for (int bj = 0; bj < 2; ++bj)
#pragma unroll
                for (int n = 0; n < 2; ++n) lb[bj][n] = *(const LAS f32x4*)(tab + 2176 + dir * 512 + col0 + 128 * bj + 4 * n);
#pragma unroll
            for (int ai = 0; ai < 2; ++ai)
#pragma unroll
                for (int m = 0; m < 4; ++m) {
                    const int rt = 128 * ai + 64 * wr + 16 * m + fr;
                    size_t krow;
                    if (!ctx) krow = ((size_t)(dir * 8 + (u.pm >> 3)) * KV + CTX + (u.pm & 7) * 256 + rt);
                    else krow = ((size_t)(dir * 8 + u.pm) * KV + rt);
                    unsigned short* rowp = LF + krow * 512 + col0;
#pragma unroll
                    for (int bj = 0; bj < 2; ++bj) {
                        float o[8];
#pragma unroll
                        for (int n = 0; n < 2; ++n)
#pragma unroll
                            for (int j = 0; j < 4; ++j) { const float z = acc[ai][bj][m][n][j]; const float l = lb[bj][n][j]; const float f = l + (1.f - l) * __builtin_amdgcn_rcpf(1.f + __expf(-z)); o[4 * n + j] = __builtin_amdgcn_logf(f); }
                        u32x4 w; w.x = cvt_pk_f16(o[0], o[1]); w.y = cvt_pk_f16(o[2], o[3]); w.z = cvt_pk_f16(o[4], o[5]); w.w = cvt_pk_f16(o[6], o[7]);
                        *(u32x4*)(rowp + 128 * bj) = w;
                    }
                }
        } else {
#pragma unroll
            for (int ai = 0; ai < 2; ++ai)
#pragma unroll
                for (int m = 0; m < 4; ++m) {
                    const int f = u.pm * 256 + 128 * ai + 64 * wr + 16 * m + fr;
                    bf16_t* base = (f < 512) ? VT : HVT; const int hh = (f & 511) >> 7, dv = f & 127;
                    const int b = ctx ? u.pn : (u.pn >> 3);
                    const int key0 = ctx ? 0 : CTX + (u.pn & 7) * 256;
                    bf16_t* rowp = base + ((size_t)(b * 4 + hh) * 128 + dv) * KV + key0 + 32 * wc + 8 * fq;
#pragma unroll
                    for (int bj = 0; bj < 2; ++bj) {
                        const f32x4 v0 = acc[ai][bj][m][0], v1 = acc[ai][bj][m][1];
                        u32x4 w; w.x = cvt_pk_bf16(v0.x, v0.y); w.y = cvt_pk_bf16(v0.z, v0.w); w.z = cvt_pk_bf16(v1.x, v1.y); w.w = cvt_pk_bf16(v1.z, v1.w);
                        *(u32x4*)(rowp + 128 * bj) = w;
                    }
                }
        }
    }
};
namespace att {
constexpr int NSLOT = 4, SLOTB = 32768, VOFF = 16384, NT = KV / 64;
__device__ __forceinline__ void glds16s(const void* sbase, unsigned voff, unsigned lds_dst) {
    unsigned keep;
    asm volatile("s_mov_b32 %0, m0\n\ts_mov_b32 m0, %3\n\ts_nop 0\n\tglobal_load_lds_dwordx4 %1, %2\n\ts_mov_b32 m0, %0" : "=&s"(keep) : "v"(voff), "s"(sbase), "s"(lds_dst) : "memory");
}
__device__ __forceinline__ void glds16(const void* gsrc, unsigned lds_dst) {
    unsigned keep;
    asm volatile("s_mov_b32 %0, m0\n\ts_mov_b32 m0, %2\n\ts_nop 0\n\tglobal_load_lds_dwordx4 %1, off\n\ts_mov_b32 m0, %0" : "=&s"(keep) : "v"(gsrc), "s"(lds_dst) : "memory");
}
#define ATT_WAIT_BAR(N) asm volatile("s_waitcnt vmcnt(" #N ") lgkmcnt(0)\n\ts_barrier" ::: "memory")
__device__ __forceinline__ int crow(int r, int hi) { return (r & 3) + 8 * (r >> 2) + 4 * hi; }
#define MFMA32(a, b, c) __builtin_amdgcn_mfma_f32_32x32x16_bf16((a), (b), (c), 0, 0, 0)

__device__ __forceinline__ void attn_unit(int b, int h, int qb, bf16_t* Y, const bf16_t* Kc, const bf16_t* VT, const bf16_t* GA, const float* subln_g,
                                          float lam, float M2, LAS unsigned char* lds, const int wv, const bool dry = false, unsigned* qctr = nullptr) {
    const int lane = lane_id(), r32 = lane & 31, hi = lane >> 5;
    const int wid = wv;
    const int m = wid >> 2, qs = wid & 3;
    const unsigned lds0 = (unsigned)(uintptr_t)lds;
    const int tok0 = b * SEQ + qb * 128 + qs * 32;
    const bf16_t* Kb = Kc + (size_t)b * KV * 512 + h * 128;
    const bf16_t* Vb = VT + (size_t)(b * 4 + h) * 128 * KV;
    const int krow0 = 16 * (wid & 3) + (lane >> 3), krow1 = krow0 + 8;
    const bf16_t* ksrc0 = Kb + (size_t)krow0 * 512 + (wid >> 2) * 64 + 8 * ((lane & 7) ^ ((krow0 >> 1) & 7));
    const bf16_t* ksrc1 = Kb + (size_t)krow1 * 512 + (wid >> 2) * 64 + 8 * ((lane & 7) ^ ((krow1 >> 1) & 7));
    const int vrow0 = 16 * wid + (lane >> 3), vrow1 = vrow0 + 8;
    const bf16_t* vsrc0 = Vb + (size_t)vrow0 * KV + 8 * ((lane & 7) ^ ((vrow0 >> 1) & 7));
    const bf16_t* vsrc1 = Vb + (size_t)vrow1 * KV + 8 * ((lane & 7) ^ ((vrow1 >> 1) & 7));
    const unsigned kdst = lds0 + (2 * wid) * 1024, vdst = lds0 + VOFF + (2 * wid) * 1024;
#define ATT_DMA(t, slot) do { const unsigned so_ = (unsigned)(slot) * SLOTB; \
        glds16(ksrc0 + (size_t)(t) * 64 * 512, (unsigned)__builtin_amdgcn_readfirstlane(kdst + so_)); \
        glds16(ksrc1 + (size_t)(t) * 64 * 512, (unsigned)__builtin_amdgcn_readfirstlane(kdst + so_ + 1024)); \
        glds16(vsrc0 + (size_t)(t) * 64, (unsigned)__builtin_amdgcn_readfirstlane(vdst + so_)); \
        glds16(vsrc1 + (size_t)(t) * 64, (unsigned)__builtin_amdgcn_readfirstlane(vdst + so_ + 1024)); } while (0)
    const unsigned kvo0 = (unsigned)((const char*)ksrc0 - (const char*)Kb), kvo1 = (unsigned)((const char*)ksrc1 - (const char*)Kb);
    const unsigned vvo0 = (unsigned)((const char*)vsrc0 - (const char*)Vb), vvo1 = (unsigned)((const char*)vsrc1 - (const char*)Vb);
#define ATT_DMA1(t, slot, i) do { const unsigned so_ = (unsigned)(slot) * SLOTB; \
        if ((i) == 0) glds16s(Kb + (size_t)(t) * 64 * 512, kvo0, (unsigned)__builtin_amdgcn_readfirstlane(kdst + so_)); \
        if ((i) == 1) glds16s(Kb + (size_t)(t) * 64 * 512, kvo1, (unsigned)__builtin_amdgcn_readfirstlane(kdst + so_ + 1024)); \
        if ((i) == 2) glds16s(Vb + (size_t)(t) * 64, vvo0, (unsigned)__builtin_amdgcn_readfirstlane(vdst + so_)); \
        if ((i) == 3) glds16s(Vb + (size_t)(t) * 64, vvo1, (unsigned)__builtin_amdgcn_readfirstlane(vdst + so_ + 1024)); } while (0)
    bf16x8 qr[4];
    {
        const bf16_t* qp = Y + (size_t)(tok0 + r32) * 1024 + h * 128 + m * 64 + hi * 8;
#pragma unroll
        for (int d0 = 0; d0 < 4; ++d0) qr[d0] = *(const bf16x8*)(qp + d0 * 16);
    }
    __builtin_amdgcn_sched_barrier(0);
    ATT_DMA(0, 0);
    const int pi = (r32 & ~12) | ((r32 & 4) << 1) | ((r32 & 8) >> 1);
    int koff[4], voff[4];
#pragma unroll
    for (int d0 = 0; d0 < 4; ++d0) koff[d0] = m * 8192 + pi * 128 + (((2 * d0 + hi) ^ ((pi >> 1) & 7)) << 4);
    const int swz = (r32 >> 1) & 7;
#pragma unroll
    for (int s = 0; s < 4; ++s) voff[s] = VOFF + r32 * 128 + (((2 * s + hi) ^ swz) << 4);
    f32x16 o[4];
#pragma unroll
    for (int i = 0; i < 4; ++i)
#pragma unroll
        for (int r = 0; r < 16; ++r) o[i][r] = 0.f;
    float lsum = 0.f;
    f32x16 negm;
#pragma unroll
    for (int r = 0; r < 16; ++r) negm[r] = -M2;
    f32x16 pA0, pA1, pB0, pB1;
#define ATT_QK(N0, N1, sbk) do { N0 = negm; N1 = negm; \
        _Pragma("unroll") for (int d0 = 0; d0 < 4; ++d0) { \
            const bf16x8 k0_ = *(const LAS bf16x8*)((sbk) + koff[d0]); const bf16x8 k1_ = *(const LAS bf16x8*)((sbk) + koff[d0] + 4096); \
            N0 = MFMA32(k0_, qr[d0], N0); N1 = MFMA32(k1_, qr[d0], N1); } } while (0)
#define ATT_EXP(N0, N1) do { _Pragma("unroll") for (int r = 0; r < 16; ++r) { N0[r] = __builtin_amdgcn_exp2f(N0[r]); N1[r] = __builtin_amdgcn_exp2f(N1[r]); } } while (0)
#define ATT_PACK8(X, B) (u32x4){cvt_pk_bf16(X[B], X[B + 1]), cvt_pk_bf16(X[B + 2], X[B + 3]), cvt_pk_bf16(X[B + 4], X[B + 5]), cvt_pk_bf16(X[B + 6], X[B + 7])}
#define ATT_KRD(d0, half) (*(const LAS bf16x8*)(sbk_ + koff[d0] + (half) * 4096))
#define ATT_VRD(blk, s) (*(const LAS bf16x8*)(sbv_ + voff[s] + (blk) * 4096))
#define ATT_GAP() __builtin_amdgcn_sched_barrier(0)
#define ATT_E4(X, B) do { X[B] = __builtin_amdgcn_exp2f(X[B]); X[B + 1] = __builtin_amdgcn_exp2f(X[B + 1]); X[B + 2] = __builtin_amdgcn_exp2f(X[B + 2]); X[B + 3] = __builtin_amdgcn_exp2f(X[B + 3]); } while (0)
#define ATT_PVROW(blk, V0, V1, V2, V3, W0, W1, W2, W3, nb, F0, F1, F2, F3) do { \
        o[blk] = MFMA32(__builtin_bit_cast(bf16x8, pw0_), V0, o[blk]); if ((nb) < 4) W0 = ATT_VRD((nb) & 3, 0); F0; ATT_GAP(); \
        o[blk] = MFMA32(__builtin_bit_cast(bf16x8, pw1_), V1, o[blk]); if ((nb) < 4) W1 = ATT_VRD((nb) & 3, 1); F1; ATT_GAP(); \
        o[blk] = MFMA32(__builtin_bit_cast(bf16x8, pw2_), V2, o[blk]); if ((nb) < 4) W2 = ATT_VRD((nb) & 3, 2); F2; ATT_GAP(); \
        o[blk] = MFMA32(__builtin_bit_cast(bf16x8, pw3_), V3, o[blk]); if ((nb) < 4) W3 = ATT_VRD((nb) & 3, 3); F3; ATT_GAP(); } while (0)
#define ATT_S2(X, B) do { sacc_ += X[B]; sacc_ += X[B + 1]; } while (0)
#define ATT_STEP(N0, N1, P0, P1, t) do { \
        ATT_WAIT_BAR(4); const int tn_ = ((t) + 2 < NT) ? (t) + 2 : NT - 1;     \
        const LAS unsigned char* sbk_ = lds + ((t) & 3) * SLOTB; const LAS unsigned char* sbv_ = lds + (((t) - 1) & 3) * SLOTB; \
        bf16x8 ka_ = ATT_KRD(0, 0), kb_ = ATT_KRD(1, 0), kc_ = ATT_KRD(2, 0), kd_ = ATT_KRD(3, 0); \
        u32x4 pw0_, pw1_, pw2_, pw3_; bf16x8 ke_, kf_, kg_, kh_, va_, vb_, vc_, vd_, ve_, vf_, vg_, vh_; float sacc_ = 0.f; \
        ATT_GAP(); \
        N0 = MFMA32(ka_, qr[0], negm); pw0_ = ATT_PACK8(P0, 0); ke_ = ATT_KRD(0, 1); kf_ = ATT_KRD(1, 1); ATT_GAP(); \
        N0 = MFMA32(kb_, qr[1], N0);   pw1_ = ATT_PACK8(P0, 8); kg_ = ATT_KRD(2, 1); kh_ = ATT_KRD(3, 1); ATT_GAP(); \
        N0 = MFMA32(kc_, qr[2], N0);   pw2_ = ATT_PACK8(P1, 0); va_ = ATT_VRD(0, 0); vb_ = ATT_VRD(0, 1); ATT_GAP(); \
        N0 = MFMA32(kd_, qr[3], N0);   pw3_ = ATT_PACK8(P1, 8); vc_ = ATT_VRD(0, 2); vd_ = ATT_VRD(0, 3); ATT_GAP(); \
        N1 = MFMA32(ke_, qr[0], negm); ATT_S2(P0, 0); ATT_S2(P0, 2); ATT_S2(P0, 4); ATT_S2(P0, 6); ATT_GAP(); \
        N1 = MFMA32(kf_, qr[1], N1);   ATT_E4(N0, 0);  ATT_GAP(); \
        N1 = MFMA32(kg_, qr[2], N1);   ATT_E4(N0, 4);  ATT_GAP(); \
        N1 = MFMA32(kh_, qr[3], N1);   ATT_E4(N0, 8);  ATT_GAP(); \
        ATT_PVROW(0, va_, vb_, vc_, vd_, ve_, vf_, vg_, vh_, 1, ATT_E4(N0, 12), do { ATT_S2(P0, 8); ATT_S2(P0, 10); ATT_S2(P0, 12); ATT_S2(P0, 14); } while (0), ATT_E4(N1, 0), do { ATT_S2(P1, 0); ATT_S2(P1, 2); ATT_S2(P1, 4); } while (0)); \
        ATT_PVROW(1, ve_, vf_, vg_, vh_, va_, vb_, vc_, vd_, 2, ATT_E4(N1, 4), do { ATT_S2(P1, 6); ATT_S2(P1, 8); ATT_S2(P1, 10); } while (0), ATT_E4(N1, 8), do { ATT_S2(P1, 12); ATT_S2(P1, 14); } while (0)); \
        ATT_PVROW(2, va_, vb_, vc_, vd_, ve_, vf_, vg_, vh_, 3, ATT_E4(N1, 12), (void)0, (void)0, (void)0); \
        ATT_PVROW(3, ve_, vf_, vg_, vh_, va_, vb_, vc_, vd_, 4, ATT_DMA1(tn_, ((t) + 2) & 3, 0), ATT_DMA1(tn_, ((t) + 2) & 3, 1), ATT_DMA1(tn_, ((t) + 2) & 3, 2), ATT_DMA1(tn_, ((t) + 2) & 3, 3)); \
        lsum += sacc_; } while (0)
#define ATT_PV(O0, O1, sbv) do { float sa_ = 0.f, sb_ = 0.f; \
        _Pragma("unroll") for (int r = 0; r < 16; ++r) { sa_ += O0[r]; sb_ += O1[r]; } lsum += sa_ + sb_; \
        u32x4 pw_[4]; pw_[0] = ATT_PACK8(O0, 0); pw_[1] = ATT_PACK8(O0, 8); pw_[2] = ATT_PACK8(O1, 0); pw_[3] = ATT_PACK8(O1, 8); \
        _Pragma("unroll") for (int blk = 0; blk < 4; ++blk) _Pragma("unroll") for (int s = 0; s < 4; ++s) { \
            const bf16x8 vb_ = *(const LAS bf16x8*)((sbv) + voff[s] + blk * 4096); \
            o[blk] = MFMA32(__builtin_bit_cast(bf16x8, pw_[s]), vb_, o[blk]); } } while (0)
    ATT_WAIT_BAR(0);
#pragma unroll
    for (int d0 = 0; d0 < 4; ++d0) asm volatile("" : "+v"(qr[d0]));
    ATT_DMA(1, 1); ATT_DMA(2, 2);
    ATT_QK(pA0, pA1, lds); ATT_EXP(pA0, pA1);
    for (int t = 1; t + 1 < NT; t += 2) {
        ATT_STEP(pB0, pB1, pA0, pA1, t);
        ATT_STEP(pA0, pA1, pB0, pB1, t + 1);
    }
    unsigned tk;
    if (qctr != nullptr && wv == 0 && lane == 0) ticket_draw(qctr, tk);
    ATT_STEP(pB0, pB1, pA0, pA1, NT - 1);
    const int rowq = 16 * m + (lane >> 4), ch16 = lane & 15;
    u32x4 gav[4];
#pragma unroll
    for (int ps = 0; ps < 4; ++ps) gav[ps] = *(const u32x4*)(GA + (size_t)(tok0 + rowq + 4 * ps) * 512 + h * 128 + 8 * ch16);
    { const LAS unsigned char* sbv_ = lds + ((NT - 1) & 3) * SLOTB; ATT_PV(pB0, pB1, sbv_); }
#undef ATT_STEP
#undef ATT_PV
#undef ATT_EXP
#undef ATT_QK
#undef ATT_PVROW
#undef ATT_S2
#undef ATT_E4
#undef ATT_GAP
#undef ATT_KRD
#undef ATT_VRD
#undef ATT_PACK8
    lsum += shfl_xor_l(lsum, 32, lane);
    ATT_WAIT_BAR(0);
    LAS float* wl = (LAS float*)(lds + 131072) + wid * 32;
    LAS float* ex = (LAS float*)lds + qs * 4096;
    if (hi == 0) wl[r32] = lsum;
    LDS_WAIT();
    float rl[16];
#pragma unroll
    for (int r = 0; r < 16; ++r) rl[r] = __builtin_amdgcn_rcpf(wl[crow(r, hi)]) * (m ? lam : 1.f);
    if (m == 1) {
#pragma unroll
        for (int blk = 0; blk < 4; ++blk)
#pragma unroll
            for (int r = 0; r < 16; ++r) ex[crow(r, hi) * 128 + blk * 32 + r32] = o[blk][r] * rl[r];
    }
    ATT_WAIT_BAR(0);
    if (m == 0) {
        float ss[16];
#pragma unroll
        for (int r = 0; r < 16; ++r) ss[r] = 0.f;
#pragma unroll
        for (int blk = 0; blk < 4; ++blk)
#pragma unroll
            for (int r = 0; r < 16; ++r) { const float v = o[blk][r] * rl[r] - ex[crow(r, hi) * 128 + blk * 32 + r32]; o[blk][r] = v; ss[r] += v * v; }
#pragma unroll
        for (int r = 0; r < 16; ++r) {
            float s = ss[r];
            s += shfl_xor_l(s, 1, lane); s += shfl_xor_l(s, 2, lane); s += shfl_xor_l(s, 4, lane); s += shfl_xor_l(s, 8, lane); s += shfl_xor_l(s, 16, lane);
            ss[r] = rsqrtf(s * (1.f / 128.f) + EPS) * (1.f - LAM_INIT);
        }
#pragma unroll
        for (int blk = 0; blk < 4; ++blk) {
            const float g = subln_g[blk * 32 + r32];
#pragma unroll
            for (int r = 0; r < 16; ++r) ex[crow(r, hi) * 128 + blk * 32 + r32] = o[blk][r] * ss[r] * g;
        }
    }
    ATT_WAIT_BAR(0);
    {
#pragma unroll
        for (int ps = 0; ps < 4; ++ps) {
            const int row = rowq + 4 * ps;
            const f32x4 a = *(const LAS f32x4*)(ex + row * 128 + 8 * ch16), c = *(const LAS f32x4*)(ex + row * 128 + 8 * ch16 + 4);
            const u32x4 g4 = gav[ps];
            u32x4 w; w.x = cvt_pk_bf16(a.x * bflo(g4.x), a.y * bfhi(g4.x)); w.y = cvt_pk_bf16(a.z * bflo(g4.y), a.w * bfhi(g4.y));
            w.z = cvt_pk_bf16(c.x * bflo(g4.z), c.y * bfhi(g4.z)); w.w = cvt_pk_bf16(c.z * bflo(g4.w), c.w * bfhi(g4.w));
            if (!dry) *(u32x4*)(Y + (size_t)(tok0 + row) * 1024 + h * 128 + 8 * ch16) = w;
        }
    }
    if (qctr != nullptr && wv == 0 && lane == 0) { ticket_wait(tk); ((volatile LAS unsigned*)(lds + LDSCTL_OFF))[16] = tk; }
    ATT_WAIT_BAR(0);
#undef ATT_DMA
#undef ATT_DMA1
}
}
namespace hg {
#define HG_BAR() asm volatile("s_waitcnt vmcnt(0) lgkmcnt(0)\n\ts_barrier" ::: "memory")
#define HG_LBAR() asm volatile("s_waitcnt lgkmcnt(0)\n\ts_barrier" ::: "memory")
__device__ __forceinline__ float h2f(unsigned short h) { return (float)__builtin_bit_cast(_Float16, h); }
__device__ __forceinline__ int crow(int r, int hi) { return (r & 3) + 8 * (r >> 2) + 4 * hi; }
__device__ __forceinline__ int pi32(int x) { return (x & ~12) | ((x & 4) << 1) | ((x & 8) >> 1); }
__device__ __forceinline__ int sw64(int r, int c) { return r * 128 + ((c ^ ((r >> 1) & 7)) << 4); }
__device__ __forceinline__ int sw128(int r, int c) { return r * 256 + ((c ^ (r & 15)) << 4); }

__device__ __forceinline__ void state_chain(int b, int h, int dir, const unsigned short* LF, const bf16_t* HVT, bf16_t* ST, LAS unsigned char* lds, const int wv, unsigned* qctr = nullptr) {
    const int lane = lane_id(), tid = wv * 64 + lane, r32 = lane & 31, hi = lane >> 5;
    const int wid = wv;
    const int k = tid & 127, part = tid >> 7;
    const int vt = wid & 3, kh = wid >> 2;
    LAS unsigned char* KsT = lds;
    LAS float* dec = (LAS float*)(lds + 32768);
    LAS float* ptot = (LAS float*)(lds + 32768 + 1024);
    LAS unsigned char* stage = lds + 40960;
    const unsigned short* lfb = LF + ((size_t)(dir * 8 + b) * KV) * 512 + h * 128 + k;
    const bf16_t* vb = HVT + ((size_t)(b * 4 + h) * 128 + 32 * vt + r32) * KV + 8 * hi;
    f32x16 S[2];
#pragma unroll
    for (int i = 0; i < 2; ++i)
#pragma unroll
        for (int r = 0; r < 16; ++r) S[i][r] = 0.f;
    unsigned short lfr[16]; bf16x8 bv[4];
    auto ckof = [&](int n) { return dir ? (n < 4 ? 3 - n : 39 - n) : n; };
    {
        const int key0 = 64 * ckof(0);
#pragma unroll
        for (int j = 0; j < 16; ++j) lfr[j] = lfb[(size_t)(key0 + 16 * part + j) * 512];
#pragma unroll
        for (int s = 0; s < 4; ++s) bv[s] = *(const bf16x8*)(vb + key0 + 16 * s);
    }
    unsigned tk = 0u;
    for (int n = 0; n < 36; ++n) {
        const int p = n & 1, ck = ckof(n);
        if (n == 34 && qctr != nullptr && wv == 0 && lane == 0) tk = __hip_atomic_fetch_add(qctr, 1u, __ATOMIC_RELAXED, __HIP_MEMORY_SCOPE_AGENT);
        float lfv[16], c[16];
#pragma unroll
        for (int j = 0; j < 16; ++j) lfv[j] = h2f(lfr[j]);
        bf16x8 bcur[4];
#pragma unroll
        for (int s = 0; s < 4; ++s) bcur[s] = bv[s];
        if (n + 1 < 36) {
            const int key1 = 64 * ckof(n + 1);
#pragma unroll
            for (int j = 0; j < 16; ++j) lfr[j] = lfb[(size_t)(key1 + 16 * part + j) * 512];
#pragma unroll
            for (int s = 0; s < 4; ++s) bv[s] = *(const bf16x8*)(vb + key1 + 16 * s);
        }
        if (dir == 0) { float a = 0.f;
#pragma unroll
            for (int j = 0; j < 16; ++j) { a += lfv[j]; c[j] = a; } }
        else { float a = 0.f;
#pragma unroll
            for (int j = 15; j >= 0; --j) { a += lfv[j]; c[j] = a; } }
        const float T = dir ? c[0] : c[15];
        ptot[(p * 4 + part) * 128 + k] = T;
        HG_LBAR();
        float off = 0.f, gtot = 0.f;
        float pv4[4];
#pragma unroll
        for (int q = 0; q < 4; ++q) pv4[q] = ptot[(p * 4 + q) * 128 + k];
#pragma unroll
        for (int q = 0; q < 4; ++q) { gtot += pv4[q]; const bool take = dir ? (q > part) : (q < part); off += take ? pv4[q] : 0.f; }
        unsigned w[8];
#pragma unroll
        for (int j = 0; j < 16; j += 2) {
            const float k0 = (1.f - __builtin_amdgcn_exp2f(lfv[j])) * __builtin_amdgcn_exp2f(gtot - (c[j] + off));
            const float k1 = (1.f - __builtin_amdgcn_exp2f(lfv[j + 1])) * __builtin_amdgcn_exp2f(gtot - (c[j + 1] + off));
            w[j >> 1] = cvt_pk_bf16(k0, k1);
        }
        LAS unsigned char* kp = KsT + p * 16384;
        *(LAS u32x4*)(kp + sw64(k, 2 * part)) = (u32x4){w[0], w[1], w[2], w[3]};
        *(LAS u32x4*)(kp + sw64(k, 2 * part + 1)) = (u32x4){w[4], w[5], w[6], w[7]};
        if (part == 0) dec[p * 128 + k] = __builtin_amdgcn_exp2f(gtot);
        if (ck >= 4) {
#pragma unroll
            for (int kt = 0; kt < 2; ++kt)
#pragma unroll
                for (int g = 0; g < 4; ++g) {
                    u32x2 o; o.x = cvt_pk_bf16(S[kt][4 * g], S[kt][4 * g + 1]); o.y = cvt_pk_bf16(S[kt][4 * g + 2], S[kt][4 * g + 3]);
                    *(LAS u32x2*)(stage + sw128(32 * vt + r32, 8 * kh + 4 * kt + g) + 8 * hi) = o;
                }
        }
        HG_LBAR();
        if (ck >= 4) {
            bf16_t* sp = ST + ((size_t)((b * 4 + h) * 2 + dir) * 32 + (ck - 4)) * 16384;
            const int row = tid >> 2, q4 = tid & 3;
            u32x4 cv[4];
#pragma unroll
            for (int c = 0; c < 4; ++c) cv[c] = *(const LAS u32x4*)(stage + sw128(row, 4 * q4 + c));
#pragma unroll
            for (int c = 0; c < 4; ++c) *(u32x4*)(sp + row * 128 + (4 * q4 + c) * 8) = cv[c];
        }
        {
            bf16x8 af[2][4]; f32x4 dc[2][4];
#pragma unroll
            for (int kt = 0; kt < 2; ++kt) {
                const int krow = 32 * (2 * kh + kt);
#pragma unroll
                for (int g = 0; g < 4; ++g) dc[kt][g] = *(const LAS f32x4*)(dec + p * 128 + krow + 8 * g + 4 * hi);
#pragma unroll
                for (int s2 = 0; s2 < 4; ++s2) af[kt][s2] = *(const LAS bf16x8*)(kp + sw64(krow + r32, 2 * s2 + hi));
            }
#pragma unroll
            for (int kt = 0; kt < 2; ++kt) {
#pragma unroll
                for (int g = 0; g < 4; ++g) { S[kt][4 * g] *= dc[kt][g].x; S[kt][4 * g + 1] *= dc[kt][g].y; S[kt][4 * g + 2] *= dc[kt][g].z; S[kt][4 * g + 3] *= dc[kt][g].w; }
#pragma unroll
                for (int s2 = 0; s2 < 4; ++s2) S[kt] = __builtin_amdgcn_mfma_f32_32x32x16_bf16(af[kt][s2], bcur[s2], S[kt], 0, 0, 0);
            }
        }
    }
    if (qctr != nullptr && wv == 0 && lane == 0) ((volatile LAS unsigned*)(lds + LDSCTL_OFF))[16] = tk;
    HG_BAR();
}

struct OutPre { u32x4 sraw[2][4], vraw[2]; unsigned fa[8], fb[8], fq[8]; };
__device__ __forceinline__ void out_load(OutPre& P, int b, int h, int lc, const int wv) {
    unsigned char* wsb_ = kargs()->ws; const bf16_t* Y = (const bf16_t*)(wsb_ + WS_Y); const unsigned short* LF = (const unsigned short*)(wsb_ + WS_LF);
    const int tid = wv * 64 + lane_id();
    const int key0 = CTX + 64 * lc;
    const size_t tok0 = (size_t)b * SEQ + 64 * lc;
    { const bf16_t* ST = (const bf16_t*)(wsb_ + WS_ST); const bf16_t* HVT = (const bf16_t*)(wsb_ + WS_HVT);
      const int schunk = tid & 15, srow = tid >> 4;
#pragma unroll
      for (int dir = 0; dir < 2; ++dir) {
          const bf16_t* stp = ST + ((size_t)((b * 4 + h) * 2 + dir) * 32 + lc) * 16384;
#pragma unroll
          for (int i = 0; i < 4; ++i) P.sraw[dir][i] = *(const u32x4*)(stp + (size_t)(srow + 32 * i) * 128 + 8 * schunk);
      }
      const bf16_t* vtp = HVT + ((size_t)(b * 4 + h) * 128) * KV + key0;
#pragma unroll
      for (int i = 0; i < 2; ++i) P.vraw[i] = *(const u32x4*)(vtp + (size_t)((tid >> 3) + 64 * i) * KV + 8 * (tid & 7)); }
    const int kp2 = tid & 63, part8 = tid >> 6;
    const unsigned short* pf = LF + ((size_t)(0 * 8 + b) * KV + key0 + 8 * part8) * 512 + h * 128 + 2 * kp2;
    const unsigned short* pb = LF + ((size_t)(1 * 8 + b) * KV + key0 + 8 * part8) * 512 + h * 128 + 2 * kp2;
    const bf16_t* pq = Y + (tok0 + 8 * part8) * 1024 + 512 + h * 128 + 2 * kp2;
#pragma unroll
    for (int j = 0; j < 8; ++j) { P.fa[j] = *(const unsigned*)(pf + (size_t)j * 512); P.fb[j] = *(const unsigned*)(pb + (size_t)j * 512); P.fq[j] = *(const unsigned*)(pq + (size_t)j * 1024); }
}
__device__ __forceinline__ void out_settle(OutPre& P) {
#pragma unroll
    for (int d = 0; d < 2; ++d)
#pragma unroll
        for (int i = 0; i < 4; ++i) asm volatile("" : "+v"(P.sraw[d][i]));
    asm volatile("" : "+v"(P.vraw[0]), "+v"(P.vraw[1]));
#pragma unroll
    for (int j = 0; j < 8; ++j) asm volatile("" : "+v"(P.fa[j]), "+v"(P.fb[j]), "+v"(P.fq[j]));
}
__device__ __forceinline__ void out_unit(int b, int h, int lc, LAS unsigned char* lds, const int wv,
                                         OutPre& P, const bool pre_valid, const unsigned acq_mask, const int qoff, int& nidx, bool& npre, const bool dry = false, unsigned* qctr = nullptr) {
    const int lane = lane_id(), tid = wv * 64 + lane, r32 = lane & 31, hi = lane >> 5;
    const int wid = wv;
    const int tb = wid & 1, vt = wid >> 1;
    LAS unsigned char* STx = lds + 65536;
    LAS unsigned char* VTt = lds + 131072;
    LAS float* ptot = (LAS float*)(lds + 147456);
    LAS float* ssx = (LAS float*)(lds + 147456 + 8192);
    const size_t tok0 = (size_t)b * SEQ + 64 * lc;
    const int trow = 32 * tb + r32;
    const int schunk = tid & 15, srow = tid >> 4;
    if (!pre_valid) { out_load(P, b, h, lc, wv); asm volatile("s_waitcnt vmcnt(0)" ::: "memory"); out_settle(P); }
    unsigned tk;
    if (qctr != nullptr && wv == 0 && lane == 0) ticket_draw(qctr, tk);
    const int kp2 = tid & 63, part8 = tid >> 6;
    float lff[8][2], lfbw[8][2], qv[8][2];
#pragma unroll
    for (int j = 0; j < 8; ++j) {
        const unsigned a = P.fa[j], c2 = P.fb[j], d = P.fq[j];
        lff[j][0] = h2f((unsigned short)(a & 0xffffu)); lff[j][1] = h2f((unsigned short)(a >> 16));
        lfbw[j][0] = h2f((unsigned short)(c2 & 0xffffu)); lfbw[j][1] = h2f((unsigned short)(c2 >> 16));
        qv[j][0] = bflo(d); qv[j][1] = bfhi(d);
    }
    float cf[8][2], cb[8][2];
#pragma unroll
    for (int e = 0; e < 2; ++e) {
        float a = 0.f;
#pragma unroll
        for (int j = 0; j < 8; ++j) { a += lff[j][e]; cf[j][e] = a; }
        a = 0.f;
#pragma unroll
        for (int j = 7; j >= 0; --j) { a += lfbw[j][e]; cb[j][e] = a; }
    }
    *(LAS f32x2*)(ptot + (0 * 8 + part8) * 128 + 2 * kp2) = (f32x2){cf[7][0], cf[7][1]};
    *(LAS f32x2*)(ptot + (1 * 8 + part8) * 128 + 2 * kp2) = (f32x2){cb[0][0], cb[0][1]};
    HG_LBAR();
    f32x2 offf = {0.f, 0.f}, offb = {0.f, 0.f}, Rf = {0.f, 0.f}, Rb = {0.f, 0.f};
#pragma unroll
    for (int q = 0; q < 8; ++q) {
        const f32x2 pfq = *(const LAS f32x2*)(ptot + (0 * 8 + q) * 128 + 2 * kp2), pbq = *(const LAS f32x2*)(ptot + (1 * 8 + q) * 128 + 2 * kp2);
        if (q < 4) Rf += pfq; else Rb += pbq;
        offf += (q < part8) ? pfq : (f32x2){0.f, 0.f};
        offb += (q > part8) ? pbq : (f32x2){0.f, 0.f};
    }
#pragma unroll
    for (int j = 0; j < 8; ++j) {
        const int i = 8 * part8 + j;
        float v[4][2];
#pragma unroll
        for (int e = 0; e < 2; ++e) {
            const float gf = cf[j][e] + (e ? offf.y : offf.x), gb = cb[j][e] + (e ? offb.y : offb.x);
            const float kf = 1.f - __builtin_amdgcn_exp2f(lff[j][e]), kb = 1.f - __builtin_amdgcn_exp2f(lfbw[j][e]);
            const float df = fminf(fmaxf(gf - (e ? Rf.y : Rf.x), -100.f), 100.f), db = fminf(fmaxf(gb - (e ? Rb.y : Rb.x), -100.f), 100.f);
            const float q = qv[j][e];
            const float e1 = __builtin_amdgcn_exp2f(df), e2 = __builtin_amdgcn_exp2f(db);
            v[0][e] = q * e1; v[1][e] = kf * __builtin_amdgcn_rcpf(e1);
            v[2][e] = q * e2; v[3][e] = kb * __builtin_amdgcn_rcpf(e2);
        }
        const int o = sw128(i, kp2 >> 2) + (kp2 & 3) * 4;
#pragma unroll
        for (int mtx = 0; mtx < 4; ++mtx) *(LAS unsigned*)(lds + mtx * 16384 + o) = cvt_pk_bf16(v[mtx][0], v[mtx][1]);
    }
#pragma unroll
    for (int dir = 0; dir < 2; ++dir) {
        f32x4 ra = {0.f, 0.f, 0.f, 0.f}, rb2 = {0.f, 0.f, 0.f, 0.f};
#pragma unroll
        for (int q = 0; q < 4; ++q) { const LAS float* pp = ptot + (dir * 8 + 4 * dir + q) * 128 + 8 * schunk; ra += *(const LAS f32x4*)pp; rb2 += *(const LAS f32x4*)(pp + 4); }
        float er[8];
        er[0] = __builtin_amdgcn_exp2f(ra.x); er[1] = __builtin_amdgcn_exp2f(ra.y); er[2] = __builtin_amdgcn_exp2f(ra.z); er[3] = __builtin_amdgcn_exp2f(ra.w);
        er[4] = __builtin_amdgcn_exp2f(rb2.x); er[5] = __builtin_amdgcn_exp2f(rb2.y); er[6] = __builtin_amdgcn_exp2f(rb2.z); er[7] = __builtin_amdgcn_exp2f(rb2.w);
#pragma unroll
        for (int i = 0; i < 4; ++i) {
            const u32x4 r = P.sraw[dir][i]; u32x4 w;
            w.x = cvt_pk_bf16(bflo(r.x) * er[0], bfhi(r.x) * er[1]); w.y = cvt_pk_bf16(bflo(r.y) * er[2], bfhi(r.y) * er[3]);
            w.z = cvt_pk_bf16(bflo(r.z) * er[4], bfhi(r.z) * er[5]); w.w = cvt_pk_bf16(bflo(r.w) * er[6], bfhi(r.w) * er[7]);
            *(LAS u32x4*)(STx + dir * 32768 + sw128(srow + 32 * i, schunk)) = w;
        }
    }
#pragma unroll
    for (int i = 0; i < 2; ++i) *(LAS u32x4*)(VTt + sw64((tid >> 3) + 64 * i, tid & 7)) = P.vraw[i];
    if (qctr != nullptr && wv == 0 && lane == 0) { ticket_wait(tk); ((volatile LAS unsigned*)(lds + LDSCTL_OFF))[16] = tk; }
    HG_LBAR();
    u32x4 gbv[2];
#pragma unroll
    for (int i = 0; i < 2; ++i) gbv[i] = *(const u32x4*)((const bf16_t*)(kargs()->ws + WS_GB) + (tok0 + (tid >> 4) + 32 * i) * 512 + h * 128 + 8 * (tid & 15));
    nidx = -1; npre = false;
    if (qctr != nullptr) {
        nidx = (int)((volatile LAS unsigned*)(lds + LDSCTL_OFF))[16] + qoff;
        if (nidx >= 72 && nidx < 200) { const int nh = (nidx - 72) >> 5, nlc = (nidx - 72) & 31;
            if ((acq_mask >> nh) & 1u) { out_load(P, b, nh, nlc, wv); npre = true; } }
    }
    f32x16 o;
#pragma unroll
    for (int r = 0; r < 16; ++r) o[r] = 0.f;
    const int prow = pi32(r32), vrow = 32 * vt + r32;
    bf16x8 vd[2], vo[2];
#pragma unroll
    for (int s2 = 0; s2 < 2; ++s2) { vd[s2] = *(const LAS bf16x8*)(VTt + sw64(vrow, 4 * tb + 2 * s2 + hi)); vo[s2] = *(const LAS bf16x8*)(VTt + sw64(vrow, 4 * (1 - tb) + 2 * s2 + hi)); }
#pragma unroll
    for (int dir = 0; dir < 2; ++dir) {
        const LAS unsigned char* Qx = lds + (2 * dir + 0) * 16384; const LAS unsigned char* Kx = lds + (2 * dir + 1) * 16384; const LAS unsigned char* Sx = STx + dir * 32768;
        bf16x8 qf[8], kd[8], sf[8];
#pragma unroll
        for (int ks = 0; ks < 8; ++ks) { qf[ks] = *(const LAS bf16x8*)(Qx + sw128(trow, 2 * ks + hi)); kd[ks] = *(const LAS bf16x8*)(Kx + sw128(32 * tb + prow, 2 * ks + hi)); }
#pragma unroll
        for (int ks = 0; ks < 8; ++ks) sf[ks] = *(const LAS bf16x8*)(Sx + sw128(vrow, 2 * ks + hi));
        f32x16 at;
#pragma unroll
        for (int r = 0; r < 16; ++r) at[r] = 0.f;
#pragma unroll
        for (int ks = 0; ks < 8; ++ks) at = __builtin_amdgcn_mfma_f32_32x32x16_bf16(kd[ks], qf[ks], at, 0, 0, 0);
#pragma unroll
        for (int r = 0; r < 16; ++r) { const int sl = 16 * (r >> 3) + 8 * hi + (r & 7); const bool keep = dir ? (sl >= r32) : (sl <= r32); at[r] = keep ? at[r] : 0.f; }
#pragma unroll
        for (int s2 = 0; s2 < 2; ++s2) {
            const u32x4 pw = (u32x4){cvt_pk_bf16(at[8 * s2], at[8 * s2 + 1]), cvt_pk_bf16(at[8 * s2 + 2], at[8 * s2 + 3]), cvt_pk_bf16(at[8 * s2 + 4], at[8 * s2 + 5]), cvt_pk_bf16(at[8 * s2 + 6], at[8 * s2 + 7])};
            o = __builtin_amdgcn_mfma_f32_32x32x16_bf16(vd[s2], __builtin_bit_cast(bf16x8, pw), o, 0, 0, 0);
        }
        if (dir != tb) {
#pragma unroll
            for (int ks = 0; ks < 8; ++ks) kd[ks] = *(const LAS bf16x8*)(Kx + sw128(32 * (1 - tb) + prow, 2 * ks + hi));
#pragma unroll
            for (int r = 0; r < 16; ++r) at[r] = 0.f;
#pragma unroll
            for (int ks = 0; ks < 8; ++ks) at = __builtin_amdgcn_mfma_f32_32x32x16_bf16(kd[ks], qf[ks], at, 0, 0, 0);
#pragma unroll
            for (int s2 = 0; s2 < 2; ++s2) {
                const u32x4 pw = (u32x4){cvt_pk_bf16(at[8 * s2], at[8 * s2 + 1]), cvt_pk_bf16(at[8 * s2 + 2], at[8 * s2 + 3]), cvt_pk_bf16(at[8 * s2 + 4], at[8 * s2 + 5]), cvt_pk_bf16(at[8 * s2 + 6], at[8 * s2 + 7])};
                o = __builtin_amdgcn_mfma_f32_32x32x16_bf16(vo[s2], __builtin_bit_cast(bf16x8, pw), o, 0, 0, 0);
            }
        }
#pragma unroll
        for (int ks = 0; ks < 8; ++ks) o = __builtin_amdgcn_mfma_f32_32x32x16_bf16(sf[ks], qf[ks], o, 0, 0, 0);
    }
    float ss = 0.f;
#pragma unroll
    for (int r = 0; r < 16; ++r) ss += o[r] * o[r];
    ss += shfl_xor_l(ss, 32, lane);
    if (hi == 0) ssx[vt * 64 + trow] = ss;
    HG_LBAR();
    const float tot = ssx[trow] + ssx[64 + trow] + ssx[128 + trow] + ssx[192 + trow];
    const float rstd = rsqrtf(tot * (1.f / 128.f) + EPS);
    LAS float* og = (LAS float*)lds;
#pragma unroll
    for (int g = 0; g < 4; ++g) {
        const int v = 32 * vt + 8 * g + 4 * hi;
        const f32x4 gn = *(const LAS f32x4*)((const LAS float*)(lds + 156672) + v);
        *(LAS f32x4*)(og + trow * 132 + v) = (f32x4){o[4 * g] * rstd * gn.x, o[4 * g + 1] * rstd * gn.y, o[4 * g + 2] * rstd * gn.z, o[4 * g + 3] * rstd * gn.w};
    }
    HG_LBAR();
#pragma unroll
    for (int i = 0; i < 2; ++i) {
        const int row = (tid >> 4) + 32 * i, ch = tid & 15;
        const f32x4 a = *(const LAS f32x4*)(og + row * 132 + 8 * ch), c = *(const LAS f32x4*)(og + row * 132 + 8 * ch + 4);
        const u32x4 g4 = gbv[i];
        u32x4 w; w.x = cvt_pk_bf16(a.x * bflo(g4.x), a.y * bfhi(g4.x)); w.y = cvt_pk_bf16(a.z * bflo(g4.y), a.w * bfhi(g4.y));
        w.z = cvt_pk_bf16(c.x * bflo(g4.z), c.y * bfhi(g4.z)); w.w = cvt_pk_bf16(c.z * bflo(g4.w), c.w * bfhi(g4.w));
        if (!dry) *(u32x4*)((bf16_t*)(kargs()->ws + WS_Y) + (tok0 + row) * 1024 + 512 + h * 128 + 8 * ch) = w;
    }
    HG_BAR();
    if (npre) out_settle(P);
}
}
template <size_t OFFA, size_t OFFB> struct OutOrder {
    int G, c;
    __device__ __forceinline__ bool next(int i, pg8::Unit& u) const {
        const int L = i * G + c; if (L >= 256) return false;
        const char* wsb = (const char*)kargs()->ws; const char* A = wsb + OFFA; const char* Bt = wsb + OFFB;
        constexpr size_t TSTEP = (size_t)256 * DM * 2;
        const int xcd = L % 8, offp = L / 8; const int wgid = xcd * 32 + offp;
        u.pm = xcd * 8 + (wgid % 32) % 8; u.pn = (wgid % 32) / 8; u.a = A + (size_t)u.pm * TSTEP; u.b = Bt + (size_t)u.pn * TSTEP; u.ty = 0; u.aux = 0; return true;
    }
};
struct EpiP4 {
    __device__ __forceinline__ void operator()(const f32x4 (&acc)[2][2][4][2], const pg8::Unit& u, int wr, int wc, int fr, int fq, int lane) const {
        KArgsPtr ka = kargs(); unsigned char* wsb = ka->ws; const float* x = ka->in[0]; bf16_t* x1b = (bf16_t*)(wsb + WS_X1B); const float* gain1 = ka->in[4] + 1024;
        bf16_t* A1 = (bf16_t*)(wsb + WS_A1); float* SSQ1 = (float*)(wsb + WS_SSQ1); const float* mod = (const float*)(wsb + WS_MISC) + MI_MOD;
        const int b = u.pm >> 3;
        const int col0 = 256 * u.pn + 32 * wc + 8 * fq;
        f32x4 gt[2][2], gm[2][2];
#pragma unroll
        for (int bj = 0; bj < 2; ++bj)
#pragma unroll
            for (int n = 0; n < 2; ++n) { const int c = col0 + 128 * bj + 4 * n;
                gt[bj][n] = *(const f32x4*)(mod + (0 * 9 + b) * 3072 + 2048 + c);
                gm[bj][n] = *(const f32x4*)(gain1 + c) * (*(const f32x4*)(mod + (9 + b) * 3072 + 1024 + c) + 1.f); }
        const float* xbase = x + ((size_t)u.pm * 256 + 64 * wr + fr) * 1024 + col0;
        f32x4 xr[3][4];
#define P4_LDX(it) do { const float* xp_ = xbase + (size_t)(128 * ((it) >> 2) + 16 * ((it) & 3)) * 1024; \
            xr[(it) % 3][0] = *(const f32x4*)(xp_); xr[(it) % 3][1] = *(const f32x4*)(xp_ + 4); xr[(it) % 3][2] = *(const f32x4*)(xp_ + 128); xr[(it) % 3][3] = *(const f32x4*)(xp_ + 132); } while (0)
        P4_LDX(0); P4_LDX(1);
#pragma unroll
        for (int it = 0; it < 8; ++it) {
            if (it + 2 < 8) P4_LDX(it + 2);
            __builtin_amdgcn_sched_barrier(0);
            const int ai = it >> 2, m = it & 3;
            {
                const size_t row = (size_t)u.pm * 256 + 128 * ai + 64 * wr + 16 * m + fr;
                float ss = 0.f;
#pragma unroll
                for (int bj = 0; bj < 2; ++bj) {
                    const size_t o = row * 1024 + col0 + 128 * bj;
                    const f32x4 xa = xr[it % 3][2 * bj], xb = xr[it % 3][2 * bj + 1];
                    const f32x4 v0 = xa + gt[bj][0] * acc[ai][bj][m][0], v1 = xb + gt[bj][1] * acc[ai][bj][m][1];
                    { u32x4 xw; xw.x = cvt_pk_bf16(v0.x, v0.y); xw.y = cvt_pk_bf16(v0.z, v0.w); xw.z = cvt_pk_bf16(v1.x, v1.y); xw.w = cvt_pk_bf16(v1.z, v1.w); *(u32x4*)(x1b + o) = xw; }
                    ss += (v0.x * v0.x + v0.y * v0.y) + (v0.z * v0.z + v0.w * v0.w) + (v1.x * v1.x + v1.y * v1.y) + (v1.z * v1.z + v1.w * v1.w);
                    const f32x4 a0 = v0 * gm[bj][0], a1 = v1 * gm[bj][1];
                    u32x4 w; w.x = cvt_pk_bf16(a0.x, a0.y); w.y = cvt_pk_bf16(a0.z, a0.w); w.z = cvt_pk_bf16(a1.x, a1.y); w.w = cvt_pk_bf16(a1.z, a1.w);
                    *(u32x4*)(A1 + o) = w;
                }
                ss += __shfl_xor(ss, 16); ss += __shfl_xor(ss, 32);
                if (fq == 0) SSQ1[row * 16 + u.pn * 4 + wc] = ss;
            }
            __builtin_amdgcn_sched_barrier(0);
        }
#undef P4_LDX
    }
};
struct EpiP7 {
    __device__ __forceinline__ void operator()(const f32x4 (&acc)[2][2][4][2], const pg8::Unit& u, int wr, int wc, int fr, int fq, int lane) const {
        KArgsPtr ka = kargs(); float* outp = ka->out; const bf16_t* x1b = (const bf16_t*)(ka->ws + WS_X1B); const float* mod = (const float*)(ka->ws + WS_MISC) + MI_MOD;
        const int b = u.pm >> 3;
        const int col0 = 256 * u.pn + 32 * wc + 8 * fq;
        f32x4 gt[2][2];
#pragma unroll
        for (int bj = 0; bj < 2; ++bj)
#pragma unroll
            for (int n = 0; n < 2; ++n) gt[bj][n] = *(const f32x4*)(mod + (9 + b) * 3072 + 2048 + col0 + 128 * bj + 4 * n);
        u32x4 xq[8][2];
#pragma unroll
        for (int it = 0; it < 8; ++it)
#pragma unroll
            for (int bj = 0; bj < 2; ++bj) xq[it][bj] = *(const u32x4*)(x1b + ((size_t)u.pm * 256 + 128 * (it >> 2) + 64 * wr + 16 * (it & 3) + fr) * 1024 + col0 + 128 * bj);
        __builtin_amdgcn_sched_barrier(0);
#pragma unroll
        for (int ai = 0; ai < 2; ++ai)
#pragma unroll
            for (int m = 0; m < 4; ++m) {
                const size_t row = (size_t)u.pm * 256 + 128 * ai + 64 * wr + 16 * m + fr;
#pragma unroll
                for (int bj = 0; bj < 2; ++bj) {
                    const size_t o = row * 1024 + col0 + 128 * bj;
                    const u32x4 xw = xq[ai * 4 + m][bj];
                    const f32x4 xa = (f32x4){bflo(xw.x), bfhi(xw.x), bflo(xw.y), bfhi(xw.y)}, xb = (f32x4){bflo(xw.z), bfhi(xw.z), bflo(xw.w), bfhi(xw.w)};
                    *(f32x4*)(outp + o) = xa + gt[bj][0] * acc[ai][bj][m][0]; *(f32x4*)(outp + o + 4) = xb + gt[bj][1] * acc[ai][bj][m][1];
                }
            }
    }
};

struct P5Order {
    int G, c;
    __device__ __forceinline__ bool next(int i, pg8::Unit& u) const {
        const int L = i * G + c; if (L >= 768) return false;
        const char* wsb = (const char*)kargs()->ws; const char* A1 = wsb + WS_A1; const char* Wt1 = wsb + WS_WT1;
        constexpr size_t TSTEP = (size_t)256 * DM * 2;
        const int xcd = L % 8, offp = L / 8; const int wgid = xcd * 96 + offp;
        u.pm = xcd * 8 + (wgid % 96) % 8; u.pn = (wgid % 96) / 8; u.a = A1 + (size_t)u.pm * TSTEP; u.b = Wt1 + (size_t)u.pn * TSTEP; u.ty = 0; u.aux = 0; return true;
    }
};
struct P5HalfOrder {
    int G, c;
    __device__ __forceinline__ bool next(int i, pg8::Unit& u) const {
        const int L = i * G + c; if (L >= 256) return false;
        const char* wsb = (const char*)kargs()->ws; const char* A1 = wsb + WS_A1; const char* Wt1 = wsb + WS_WT1;
        constexpr size_t TSTEP = (size_t)256 * DM * 2;
        const int xcd = L % 8, j = L / 8; u.pn = xcd * 16 + j / 2; u.pm = j % 2;
        u.a = Wt1 + (size_t)(12 + u.pm) * TSTEP; u.b = A1 + (size_t)u.pn * (TSTEP / 2); u.ty = 1; u.aux = 0; return true;
    }
};
__device__ __forceinline__ float gelu_as(float v) {
    const float av = fabsf(v), t = __builtin_amdgcn_rcpf(av * 0.2316418882f + 1.0f);
    float q = t * 0.5307027145f + (-0.7265760135f); q = q * t + 0.7107068705f; q = q * t + (-0.142248368f); q = q * t + 0.127414796f; q = q * t;
    const float e = __builtin_amdgcn_exp2f((v * v) * (-0.72134752044f));
    const float mm = v * (q * e);
    return v < 0.f ? mm : v - mm;
}
__device__ __forceinline__ float rstd16(const float* SSQ1, size_t row) {
    const f32x4* p = (const f32x4*)(SSQ1 + row * 16);
    const f32x4 a = p[0], b = p[1], c = p[2], d = p[3];
    const float s = ((a.x + a.y) + (a.z + a.w)) + ((b.x + b.y) + (b.z + b.w)) + ((c.x + c.y) + (c.z + c.w)) + ((d.x + d.y) + (d.z + d.w));
    return rsqrtf(s * (1.f / 1024.f) + EPS);
}
struct EpiP5 {
    const LAS float* rst; int tpm;
    __device__ __forceinline__ void operator()(const f32x4 (&acc)[2][2][4][2], const pg8::Unit& u, int wr, int wc, int fr, int fq, int lane) const {
        unsigned char* wsb = kargs()->ws; bf16_t* UG = (bf16_t*)(wsb + WS_UG); bf16_t* GVT = (bf16_t*)(wsb + WS_GVT); float* GVSSQ = (float*)(wsb + WS_GVSSQ);
        const float* ssq1 = (const float*)(wsb + WS_SSQ1); const float* bias1 = (const float*)(wsb + WS_MISC) + MI_BIAS1;
        if (u.ty == 0) {
            const int b = u.pm >> 3;
            const int kind = u.pn >> 2, pq = u.pn & 3;
            const float* bp = bias1 + b * OIN + 256 * u.pn + 32 * wc + 8 * fq;
            bf16_t* base = UG + (size_t)kind * (8u << 20) + 128 * pq + 32 * wc + 8 * fq;
#pragma unroll
            for (int ai = 0; ai < 2; ++ai)
#pragma unroll
                for (int m = 0; m < 4; ++m) {
                    const size_t row = (size_t)u.pm * 256 + 128 * ai + 64 * wr + 16 * m + fr;
                    float rs = (u.pm == tpm) ? rst[128 * ai + 64 * wr + 16 * m + fr] : rstd16(ssq1, row); asm volatile("" : "+v"(rs));
                    f32x4 b00, b01, b10, b11;
                    if (u.pm == tpm) { const LAS float* bl = rst + 384 + 256 * u.pn + 32 * wc + 8 * fq; b00 = *(const LAS f32x4*)(bl); b01 = *(const LAS f32x4*)(bl + 4); b10 = *(const LAS f32x4*)(bl + 128); b11 = *(const LAS f32x4*)(bl + 132); }
                    else { b00 = *(const f32x4*)(bp); b01 = *(const f32x4*)(bp + 4); b10 = *(const f32x4*)(bp + 128); b11 = *(const f32x4*)(bp + 132); }
                    const f32x4 p0 = acc[ai][0][m][0] * rs + b00, p1 = acc[ai][0][m][1] * rs + b01, q0 = acc[ai][1][m][0] * rs + b10, q1 = acc[ai][1][m][1] * rs + b11;
                    float o[8];
#pragma unroll
                    for (int j = 0; j < 4; ++j) {
                        if (kind == 0) { o[j] = gelu_as(p0[j]) * silu_fast(q0[j]); o[4 + j] = gelu_as(p1[j]) * silu_fast(q1[j]); }
                        else if (kind == 1) { o[j] = p0[j] * silu_fast(q0[j]); o[4 + j] = p1[j] * silu_fast(q1[j]); }
                        else { o[j] = p0[j] * q0[j]; o[4 + j] = p1[j] * q1[j]; }
                    }
                    u32x4 w; w.x = cvt_pk_bf16(o[0], o[1]); w.y = cvt_pk_bf16(o[2], o[3]); w.z = cvt_pk_bf16(o[4], o[5]); w.w = cvt_pk_bf16(o[6], o[7]);
                    *(u32x4*)(base + row * 512) = w;
                    __builtin_amdgcn_sched_barrier(0);
                }
        }
    }
};
struct EpiP5H {
    const LAS float* rsth; int tpn, tpmh;
    __device__ __forceinline__ void operator()(const f32x4 (&acc)[2][2][4][2], const pg8::Unit& u, int wr, int wc, int fr, int fq, int lane) const {
        unsigned char* wsb = kargs()->ws; bf16_t* GVT = (bf16_t*)(wsb + WS_GVT); float* GVSSQ = (float*)(wsb + WS_GVSSQ);
        const float* ssq1 = (const float*)(wsb + WS_SSQ1); const float* bias1 = (const float*)(wsb + WS_MISC) + MI_BIAS1;
        {
            const int b = u.pn >> 4;
            { constexpr int bj = 0;
                int opq = 0; asm volatile("" : "+s"(opq));
                const size_t tokc = (size_t)u.pn * 128 + 32 * wc + 8 * fq + opq;
                float rs[8], gs[8];
                if (u.pn == tpn) {
#pragma unroll
                    for (int e = 0; e < 8; ++e) { rs[e] = rsth[32 * wc + 8 * fq + e]; gs[e] = 0.f; }
                } else {
#pragma unroll
                for (int e = 0; e < 8; ++e) { rs[e] = rstd16(ssq1, tokc + e); gs[e] = 0.f; asm volatile("" : "+v"(rs[e])); __builtin_amdgcn_sched_barrier(0); }
                }
#pragma unroll
                for (int ai = 0; ai < 2; ++ai)
#pragma unroll
                    for (int m = 0; m < 4; ++m) {
                        const int f = u.pm * 256 + 128 * ai + 64 * wr + 16 * m + fr + opq;
                        const float bias = (u.pn == tpn && u.pm == tpmh) ? rsth[128 + 3072 + 128 * ai + 64 * wr + 16 * m + fr] : bias1[b * OIN + 3072 + f];
                        bf16_t* rowp = GVT + ((size_t)(b * 4 + (f >> 7)) * 128 + (f & 127)) * GVP + (u.pn & 15) * 128 + 32 * wc + 8 * fq;
                        float o[8];
#pragma unroll
                        for (int n = 0; n < 2; ++n)
#pragma unroll
                            for (int j = 0; j < 4; ++j) { const float gv = gelu_as(acc[ai][bj][m][n][j] * rs[4 * n + j] + bias); o[4 * n + j] = gv; gs[4 * n + j] += gv * gv; }
                        u32x4 w; w.x = cvt_pk_bf16(o[0], o[1]); w.y = cvt_pk_bf16(o[2], o[3]); w.z = cvt_pk_bf16(o[4], o[5]); w.w = cvt_pk_bf16(o[6], o[7]);
                        *(u32x4*)(rowp) = w;
                        __builtin_amdgcn_sched_barrier(0);
                    }
#pragma unroll
                for (int e = 0; e < 8; ++e) {
                    float s = gs[e];
                    s += __shfl_xor(s, 1); s += __shfl_xor(s, 2); s += __shfl_xor(s, 4); s += __shfl_xor(s, 8);
                    if (fr == 0) GVSSQ[(tokc + e) * 4 + u.pm * 2 + wr] = s;
                    __builtin_amdgcn_sched_barrier(0);
                }
            }
        }
    }
};

__device__ __forceinline__ int gsw(int r, int c) { return r * 256 + ((c ^ (r & 15)) << 4); }
struct GmlpRegs { u32x4 ta[4], tw[4], tu[4]; f32x4 ssq; };
__device__ __forceinline__ void gmlp_load(GmlpRegs& R, int b, int ch, int g, const bf16_t* GVT, const float* GVSSQ, const bf16_t* Wsb, const bf16_t* UG, const int wv) {
    const int lane = lane_id(), tid = wv * 64 + lane;
    const size_t tokc = (size_t)b * SEQ + ch * 128;
    const int chunk = tid & 15, rb = tid >> 4;
#pragma unroll
    for (int i = 0; i < 4; ++i) { const int row = rb + 32 * i;
        R.ta[i] = *(const u32x4*)(GVT + ((size_t)(b * 4 + g) * 128 + row) * GVP + ch * 128 + 8 * chunk);
        R.tw[i] = *(const u32x4*)(Wsb + ((size_t)g * 128 + row) * 128 + 8 * chunk);
        R.tu[i] = *(const u32x4*)(UG + (tokc + row) * 512 + g * 128 + 8 * chunk); }
    R.ssq = *(const f32x4*)(GVSSQ + (tokc + (tid & 127)) * 4);
}
__device__ __forceinline__ void gmlp_unit(const GmlpRegs& R, int b, int ch, int g, const float* v_g, const float* b_s, bf16_t* Y1, LAS unsigned char* lds, const int wv) {
    const int lane = lane_id(), tid = wv * 64 + lane, r32 = lane & 31, hi = lane >> 5;
    const int wid = wv;
    const int dt = wid & 3, th = wid >> 2;
    LAS unsigned char* At = lds; LAS unsigned char* Wt = lds + 32768; LAS unsigned char* Ut = lds + 65536;
    LAS float* rsd = (LAS float*)(lds + 98304);
    const size_t tokc = (size_t)b * SEQ + ch * 128;
    {
        const int chunk = tid & 15, rb = tid >> 4;
        if (tid < 128) { const f32x4 p = R.ssq; rsd[tid] = rsqrtf(((p.x + p.y) + (p.z + p.w)) * (1.f / 512.f) + EPS); }
#pragma unroll
        for (int i = 0; i < 4; ++i) { const int row = rb + 32 * i; *(LAS u32x4*)(At + gsw(row, chunk)) = R.ta[i]; *(LAS u32x4*)(Wt + gsw(row, chunk)) = R.tw[i]; *(LAS u32x4*)(Ut + gsw(row, chunk)) = R.tu[i]; }
    }
    float bsf[2]; f32x4 vgf[4];
#pragma unroll
    for (int tt = 0; tt < 2; ++tt) bsf[tt] = b_s[g * 128 + 32 * (2 * th + tt) + r32];
#pragma unroll
    for (int q = 0; q < 4; ++q) vgf[q] = *(const f32x4*)(v_g + g * 128 + 32 * dt + 8 * q + 4 * hi);
    asm volatile("s_waitcnt lgkmcnt(0)\n\ts_barrier" ::: "memory");
    f32x16 acc[2];
#pragma unroll
    for (int i = 0; i < 2; ++i)
#pragma unroll
        for (int r = 0; r < 16; ++r) acc[i][r] = 0.f;
    bf16x8 af[8]; u32x4 wf[2][8];
#pragma unroll
    for (int ks = 0; ks < 8; ++ks) { af[ks] = *(const LAS bf16x8*)(At + gsw(32 * dt + r32, 2 * ks + hi));
#pragma unroll
        for (int tt = 0; tt < 2; ++tt) wf[tt][ks] = *(const LAS u32x4*)(Wt + gsw(32 * (2 * th + tt) + r32, 2 * ks + hi)); }
#pragma unroll
    for (int ks = 0; ks < 8; ++ks) {
        const f32x4 r0 = *(const LAS f32x4*)(rsd + 16 * ks + 8 * hi), r1 = *(const LAS f32x4*)(rsd + 16 * ks + 8 * hi + 4);
#pragma unroll
        for (int tt = 0; tt < 2; ++tt) {
            const u32x4 wv4 = wf[tt][ks];
            u32x4 ws2;
            ws2.x = cvt_pk_bf16(bflo(wv4.x) * r0.x, bfhi(wv4.x) * r0.y); ws2.y = cvt_pk_bf16(bflo(wv4.y) * r0.z, bfhi(wv4.y) * r0.w);
            ws2.z = cvt_pk_bf16(bflo(wv4.z) * r1.x, bfhi(wv4.z) * r1.y); ws2.w = cvt_pk_bf16(bflo(wv4.w) * r1.z, bfhi(wv4.w) * r1.w);
            acc[tt] = __builtin_amdgcn_mfma_f32_32x32x16_bf16(af[ks], __builtin_bit_cast(bf16x8, ws2), acc[tt], 0, 0, 0);
        }
    }
#pragma unroll
    for (int tt = 0; tt < 2; ++tt) {
        const int t = 32 * (2 * th + tt) + r32;
        const float bs = bsf[tt];
#pragma unroll
        for (int q = 0; q < 4; ++q) {
            LAS u32x2* up = (LAS u32x2*)(Ut + gsw(t, 4 * dt + q) + 8 * hi);
            const f32x4 vg = vgf[q];
            const u32x2 ug = *up;
            u32x2 w;
            w.x = cvt_pk_bf16(bflo(ug.x) * (vg.x * acc[tt][4 * q] + bs), bfhi(ug.x) * (vg.y * acc[tt][4 * q + 1] + bs));
            w.y = cvt_pk_bf16(bflo(ug.y) * (vg.z * acc[tt][4 * q + 2] + bs), bfhi(ug.y) * (vg.w * acc[tt][4 * q + 3] + bs));
            *up = w;
        }
    }
    asm volatile("s_waitcnt lgkmcnt(0)\n\ts_barrier" ::: "memory");
    {
        const int chunk = tid & 15, rb = tid >> 4;
#pragma unroll
        for (int i = 0; i < 4; ++i) { const int row = rb + 32 * i; *(u32x4*)(Y1 + (tokc + row) * 1024 + g * 128 + 8 * chunk) = *(const LAS u32x4*)(Ut + gsw(row, chunk)); }
    }
    asm volatile("s_waitcnt lgkmcnt(0)\n\ts_barrier" ::: "memory");
}
struct ConvRegs { u32x4 chv[10], bgv[8]; };
__device__ __forceinline__ void conv_load(ConvRegs& R, int row0, const bf16_t* BG, const bf16_t* CH, int lane) {
    const bool top = (row0 & 2047) == 0, bot = ((row0 + 7) & 2047) == 2047;
    R.chv[0] = *(const u32x4*)(CH + (size_t)(top ? row0 : row0 - 1) * 512 + 8 * lane);
#pragma unroll
    for (int i = 0; i < 8; ++i) { R.chv[i + 1] = *(const u32x4*)(CH + (size_t)(row0 + i) * 512 + 8 * lane); R.bgv[i] = *(const u32x4*)(BG + (size_t)(row0 + i) * 512 + 8 * lane); }
    R.chv[9] = *(const u32x4*)(CH + (size_t)(bot ? row0 + 7 : row0 + 8) * 512 + 8 * lane);
}
__device__ __forceinline__ void conv_finish(const ConvRegs& R, int row0, const float* conv_w, bf16_t* Y1, int lane) {
    const bool top = (row0 & 2047) == 0, bot = ((row0 + 7) & 2047) == 2047;
    float w[3][8];
#pragma unroll
    for (int j = 0; j < 3; ++j) { const f32x4 a = *(const f32x4*)(conv_w + j * 512 + 8 * lane), bq = *(const f32x4*)(conv_w + j * 512 + 8 * lane + 4);
        w[j][0] = a.x; w[j][1] = a.y; w[j][2] = a.z; w[j][3] = a.w; w[j][4] = bq.x; w[j][5] = bq.y; w[j][6] = bq.z; w[j][7] = bq.w; }
#pragma unroll
    for (int i = 0; i < 8; ++i) {
        float o[8];
#pragma unroll
        for (int e = 0; e < 4; ++e) {
            const unsigned pw = (i == 0 && top) ? 0u : R.chv[i][e], cw = R.chv[i + 1][e], nw = (i == 7 && bot) ? 0u : R.chv[i + 2][e], bw = R.bgv[i][e];
            o[2 * e] = bflo(bw) * (w[0][2 * e] * bflo(pw) + w[1][2 * e] * bflo(cw) + w[2][2 * e] * bflo(nw));
            o[2 * e + 1] = bfhi(bw) * (w[0][2 * e + 1] * bfhi(pw) + w[1][2 * e + 1] * bfhi(cw) + w[2][2 * e + 1] * bfhi(nw));
        }
        u32x4 wv; wv.x = cvt_pk_bf16(o[0], o[1]); wv.y = cvt_pk_bf16(o[2], o[3]); wv.z = cvt_pk_bf16(o[4], o[5]); wv.w = cvt_pk_bf16(o[6], o[7]);
        *(u32x4*)(Y1 + (size_t)(row0 + i) * 1024 + 512 + 8 * lane) = wv;
    }
}
#ifndef DIAG
#define DIAG 0
#endif
constexpr int N_PHASES = 9;
#ifndef REP
#define REP -1
#endif
#ifndef NDRY
#define NDRY 1
#endif

__global__ void __launch_bounds__(NTHR, 2) mk_fwd(Args args) {
    extern __shared__ __attribute__((aligned(16))) unsigned char lds_raw[];
    Frame F;
#define FRAME_LOAD() do { KArgsPtr ka_ = kargs(); \
    F.lds = (LAS unsigned char*)lds_raw; F.MISC = (volatile LAS unsigned*)(F.lds + LDSCTL_OFF); \
    F.wave = wave0; F.lane = lane_id(); F.tid = wave0 * 64 + F.lane; \
    F.G = gridDim.x; { const int bx = blockIdx.x; F.vcu = (F.G % 8 == 0) ? (bx % 8) * (F.G / 8) + bx / 8 : bx; } \
    F.ws = ka_->ws; F.ctl = (unsigned*)(F.ws + WS_CTL); F.misc = (float*)(F.ws + WS_MISC); F.out = ka_->out; \
    F.x = ka_->in[0]; F.c = ka_->in[1]; F.ctx = ka_->in[2]; F.c_ctx = ka_->in[3]; F.norm_gain = ka_->in[4]; F.ada_w = ka_->in[5]; F.ada_b = ka_->in[6]; \
    F.even_w_in = ka_->in[7]; F.even_w_out = ka_->in[8]; F.qk_gain = ka_->in[9]; F.lam_p = ka_->in[10]; F.subln_g = ka_->in[11]; F.lb_logits = ka_->in[12]; F.hgrn_g = ka_->in[13]; \
    F.odd_w_in = ka_->in[14]; F.odd_w_out = ka_->in[15]; F.v_g = ka_->in[16]; F.w_s = ka_->in[17]; F.b_s = ka_->in[18]; F.conv_w = ka_->in[19]; } while (0)
    const int wave0 = __builtin_amdgcn_readfirstlane(threadIdx.x >> 6);
    FRAME_LOAD();
    for (int u = F.tid; u < (LDS_BYTES - LDSCTL_OFF) / 4; u += NTHR) ((LAS unsigned*)(F.lds + LDSCTL_OFF))[u] = 0u;
    __syncthreads();
    XcdBarrier bar = xcd_barrier_post(F.ctl + CW_BAR, F.MISC + 8, F.tid);
    if (F.tid == 0) __hip_atomic_store(F.ctl + CW_XCC + (int)blockIdx.x, xb_xcc_id() + 1u, __ATOMIC_RELAXED, __HIP_MEMORY_SCOPE_AGENT);
    bool light_ok = false;
    const int lo = args.ph_lo, hi = args.ph_hi;
#ifdef ONLYPH
#define IN(k) ((k) == ONLYPH && lo <= (k) && (k) < hi)
#else
#define IN(k) (lo <= (k) && (k) < hi)
#endif
#define BOTH(k) (IN(k) && IN((k) + 1))
#if DIAG == 10
#define STAMP(k) do { if (blockIdx.x == 0 && wave0 == 0 && lane_id() == 0) ((unsigned long long*)(kargs()->ws + WS_CTL + 900000))[k] = __builtin_amdgcn_s_memrealtime(); } while (0)
#else
#define STAMP(k) do {} while (0)
#endif
#define GRID_BAR() xcd_barrier(bar, wave0 * 64 + lane_id())
#define LIGHT_BAR(site) do { if (light_ok) group_barrier_light((unsigned*)(kargs()->ws + WS_CTL) + CW_GRP + 128 * ((site) * 8 + ((int)blockIdx.x & 7)), 32u, wave0 * 64 + lane_id()); else xcd_barrier(bar, wave0 * 64 + lane_id()); } while (0)
    unsigned char* ws;

    STAMP(0);
    if (IN(0)) { for (int rep = 0; rep < (REP == 0 ? 2 : 1); ++rep) { FRAME_LOAD(); p0_prologue(F); if (REP == 0 && rep == 0) GRID_BAR(); } STAMP(1); }
    if (IN(1)) { for (int rep = 0; rep < (REP == 1 ? 2 : 1); ++rep) { FRAME_LOAD(); p0b_phase(F); if (REP == 1 && rep == 0) GRID_BAR(); } if (BOTH(1)) GRID_BAR(); STAMP(2); }
    if (IN(2)) {
        FRAME_LOAD(); ws = F.ws;
        if (BOTH(1)) {
            const int ln = lane_id(); bool bad = false;
#pragma unroll
            for (int q = 0; q < 4; ++q) { const int i = ln + 64 * q;
                const unsigned a = (i < (int)gridDim.x) ? __hip_atomic_load(F.ctl + CW_XCC + i, __ATOMIC_RELAXED, __HIP_MEMORY_SCOPE_AGENT) : 1u;
                const unsigned r = (i < (int)gridDim.x) ? __hip_atomic_load(F.ctl + CW_XCC + (i & 7), __ATOMIC_RELAXED, __HIP_MEMORY_SCOPE_AGENT) : 1u;
                bad = bad || (a != r) || (a == 0u); }
            light_ok = ((int)gridDim.x == 256) && (__builtin_amdgcn_ballot_w64(bad) == 0ull);
        }
        LAS float* tab = (LAS float*)(F.lds + 131072);
        { const float* miscp = (const float*)(ws + WS_MISC); const float* qkg = kargs()->in[9];
          float tv[6]; const float qg = qkg[F.tid & 127];
#pragma unroll
          for (int k = 0; k < 6; ++k) tv[k] = miscp[MI_CS + F.tid + 512 * k];
#pragma unroll
          for (int k = 0; k < 4; ++k) tab[F.tid + 512 * k] = tv[k];
          if (F.tid < 128) tab[2048 + F.tid] = qg;
          tab[2176 + F.tid] = tv[4]; tab[2176 + 512 + F.tid] = tv[5];
          __syncthreads(); }
        P1Order S{F.G, (int)blockIdx.x}; EpiP1 E{tab};
        for (int rep = 0; rep < (REP == 2 ? 2 : 1); ++rep) { pg8::gemm_phase<EpiP1, P1Order>(F.lds, DM, S, E, wave0); if (REP == 2 && rep == 0) GRID_BAR(); }
        if ((int)blockIdx.x >= 208) { FRAME_LOAD(); weight_copies(F, 1, ((int)blockIdx.x - 208) * NWAVES + F.wave, 48 * NWAVES); }
        if (BOTH(2)) LIGHT_BAR(3);
        STAMP(3);
    }
    if (IN(3)) {
        FRAME_LOAD(); ws = F.ws;
        const int g = blockIdx.x & 7;
        const float lam = __uint_as_float(__hip_atomic_load((unsigned*)(F.misc + MI_SCAL), __ATOMIC_RELAXED, __HIP_MEMORY_SCOPE_AGENT));
        const float M2 = __uint_as_float(__hip_atomic_load((unsigned*)(F.misc + MI_SCAL + 1), __ATOMIC_RELAXED, __HIP_MEMORY_SCOPE_AGENT));
        for (int rep = 0; rep < ((REP == 3 || REP == 30 || REP == 31) ? 2 : (REP == 32 ? 1 + NDRY : 1)); ++rep) {
        const bool dry = (REP == 3 || REP == 30 || REP == 31) ? (rep == 0) : (REP == 32 ? rep < NDRY : false);
        unsigned acq_mask = 0u;
        bool have = false;
        constexpr bool EARLY = (REP < 0 || REP == 32);
        int first_out = 200;
        const int QOFF = EARLY ? ((int)gridDim.x + 7 - g) / 8 : 0;
        bool first = EARLY;
        for (;;) {
            if (!have && !first) {
                if (wave0 == 0 && lane_id() == 0) ((volatile LAS unsigned*)((LAS unsigned char*)lds_raw + LDSCTL_OFF))[16] = __hip_atomic_fetch_add((unsigned*)(kargs()->ws + WS_CTL) + CW_QUEUE + 64 * (g + 8 * rep), 1u, __ATOMIC_RELAXED, __HIP_MEMORY_SCOPE_AGENT);
                __syncthreads();
            }
            const int idx = first ? ((int)blockIdx.x >> 3) : (int)((volatile LAS unsigned*)((LAS unsigned char*)lds_raw + LDSCTL_OFF))[16] + QOFF;
            if (!have && !first) __syncthreads();
            first = false;
            have = EARLY;
            unsigned* qc = EARLY ? (unsigned*)(kargs()->ws + WS_CTL) + CW_QUEUE + 64 * (g + 8 * rep) : nullptr;
            if (idx >= 72) { first_out = idx; break; }
            if (REP == 30 && rep == 0 && idx < 8) { have = false; continue; }
            if (REP == 32 && dry && idx < 72) { have = false; continue; }
            if (REP == 31 && rep == 0 && idx >= 8) break;
            if (idx < 8) {
                const int cch = g * 8 + idx;
                { unsigned char* w2 = kargs()->ws;
                  hg::state_chain(cch >> 3, (cch >> 1) & 3, cch & 1, (const unsigned short*)(w2 + WS_LF), (const bf16_t*)(w2 + WS_HVT), (bf16_t*)(w2 + WS_ST), (LAS unsigned char*)lds_raw, wave0, qc); }
                if (wave0 == 0 && lane_id() == 0) { __builtin_amdgcn_fence(__ATOMIC_RELEASE, "agent"); asm volatile("s_waitcnt vmcnt(0)" ::: "memory");
                    __hip_atomic_store((unsigned*)(kargs()->ws + WS_CTL) + CW_FLAG + 64 * cch + 16 * rep, 1u, __ATOMIC_RELAXED, __HIP_MEMORY_SCOPE_AGENT); }
            } else {
                const int j = idx - 8; const int pair = g * 4 + (j >> 4), qb = j & 15;
                KArgsPtr ka2 = kargs(); unsigned char* w2 = ka2->ws;
                att::attn_unit(pair >> 2, pair & 3, qb, (bf16_t*)(w2 + WS_Y), (const bf16_t*)(w2 + WS_KC), (const bf16_t*)(w2 + WS_VT), (const bf16_t*)(w2 + WS_GA), ka2->in[11], lam, M2, (LAS unsigned char*)lds_raw, wave0, dry, qc);
            }
        }
        if (first_out < 200 && !((REP == 30 || REP == 31) && rep == 0)) {
            unsigned* qc = EARLY ? (unsigned*)(kargs()->ws + WS_CTL) + CW_QUEUE + 64 * (g + 8 * rep) : nullptr;
            hg::OutPre P; bool pre = false; int cur = first_out;
            { unsigned z0 = 0u; asm volatile("" : "+v"(z0));
#pragma unroll
              for (int j0 = 0; j0 < 8; ++j0) { P.fa[j0] = z0; P.fb[j0] = z0; P.fq[j0] = z0; P.sraw[j0 >> 2][j0 & 3] = (u32x4){z0, z0, z0, z0}; if (j0 < 2) P.vraw[j0] = (u32x4){z0, z0, z0, z0}; } }
            { const float* hg_g = kargs()->in[13]; if (wave0 < 2) ((LAS float*)((LAS unsigned char*)lds_raw + 156672))[wave0 * 64 + lane_id()] = hg_g[wave0 * 64 + lane_id()]; __syncthreads(); }
            for (;;) {
                const int j = cur - 72; const int hh = j >> 5, lc = j & 31;
                if (!((acq_mask >> hh) & 1u) && !(REP == 32 && dry)) {
                acq_mask |= 1u << hh;
                if (wave0 == 0) {
                    unsigned* f0 = (unsigned*)(kargs()->ws + WS_CTL) + CW_FLAG + 64 * (g * 8 + 2 * hh) + 16 * rep; unsigned sp = 0;
                    while ((__hip_atomic_load(f0, __ATOMIC_RELAXED, __HIP_MEMORY_SCOPE_AGENT) == 0u || __hip_atomic_load(f0 + 64, __ATOMIC_RELAXED, __HIP_MEMORY_SCOPE_AGENT) == 0u) && ++sp < (1u << 22)) __builtin_amdgcn_s_sleep(8);
                    __builtin_amdgcn_fence(__ATOMIC_ACQUIRE, "agent");
                    asm volatile("s_waitcnt vmcnt(0)" ::: "memory");
                }
                __syncthreads();
                }
                int nidx = -1; bool npre = false;
                hg::out_unit(g, hh, lc, (LAS unsigned char*)lds_raw, wave0, P, pre, acq_mask, QOFF, nidx, npre, dry, qc);
                if (!EARLY) {
                    if (wave0 == 0 && lane_id() == 0) ((volatile LAS unsigned*)((LAS unsigned char*)lds_raw + LDSCTL_OFF))[16] = __hip_atomic_fetch_add((unsigned*)(kargs()->ws + WS_CTL) + CW_QUEUE + 64 * (g + 8 * rep), 1u, __ATOMIC_RELAXED, __HIP_MEMORY_SCOPE_AGENT);
                    __syncthreads();
                    nidx = (int)((volatile LAS unsigned*)((LAS unsigned char*)lds_raw + LDSCTL_OFF))[16]; npre = false;
                    __syncthreads();
                }
                cur = nidx; pre = npre;
                if (cur >= 200) break;
            }
        }
        if (dry) GRID_BAR();
        }
        if (BOTH(3)) GRID_BAR();
        STAMP(4);
    }
    if (IN(5)) {
        FRAME_LOAD(); ws = F.ws;
        OutOrder<WS_Y, WS_WO0> S{F.G, (int)blockIdx.x}; EpiP4 E;
        for (int rep = 0; rep < (REP == 5 ? 2 : 1); ++rep) { pg8::gemm_phase<EpiP4, OutOrder<WS_Y, WS_WO0>>(F.lds, DM, S, E, wave0); if (REP == 5 && rep == 0) GRID_BAR(); }
        if (BOTH(5)) LIGHT_BAR(0);
        STAMP(6);
    }
    if (IN(6)) {
        FRAME_LOAD(); ws = F.ws;
        P5Order S{F.G, (int)blockIdx.x}; P5HalfOrder SH{F.G, (int)blockIdx.x};
        LAS float* rst = (LAS float*)(F.lds + 131072);
        int tpm = -1, tpn = -1, tpmh = -1;
        { pg8::Unit u0; if (S.next(0, u0)) tpm = u0.pm; if (SH.next(0, u0)) { tpn = u0.pn; tpmh = u0.pm; }
          const float* ssq1 = (const float*)(ws + WS_SSQ1); const float* bias1 = (const float*)(ws + WS_MISC) + MI_BIAS1;
          const int r = F.tid; const bool full = r < 256; const int blk = full ? tpm : tpn; const int blkc = blk < 0 ? 0 : blk;
          const size_t row = full ? (size_t)blkc * 256 + r : (size_t)blkc * 128 + ((r - 256) & 127);
          const f32x4* pp = (const f32x4*)(ssq1 + row * 16); const f32x4 qa = pp[0], qb = pp[1], qc4 = pp[2], qd = pp[3];
          const int bb = (tpm < 0 ? 0 : tpm) >> 3, bh = (tpn < 0 ? 0 : tpn) >> 4, pmh = tpmh < 0 ? 0 : tpmh;
          float bv[6];
#pragma unroll
          for (int k = 0; k < 6; ++k) bv[k] = bias1[bb * OIN + F.tid + 512 * k];
          const float bhv = bias1[bh * OIN + 3072 + pmh * 256 + (F.tid & 255)];
          if (F.tid < 384 && blk >= 0) rst[r] = rsqrtf((((qa.x + qa.y) + (qa.z + qa.w)) + ((qb.x + qb.y) + (qb.z + qb.w)) + ((qc4.x + qc4.y) + (qc4.z + qc4.w)) + ((qd.x + qd.y) + (qd.z + qd.w))) * (1.f / 1024.f) + EPS);
#pragma unroll
          for (int k = 0; k < 6; ++k) rst[384 + F.tid + 512 * k] = bv[k];
          if (F.tid < 256) rst[384 + 3072 + F.tid] = bhv;
          __syncthreads(); }
        EpiP5 E{rst, tpm};
        for (int rep = 0; rep < (REP == 6 ? 2 : 1); ++rep) {
            pg8::gemm_phase<EpiP5, P5Order>(F.lds, DM, S, E, wave0);
            { EpiP5H EH{rst + 256, tpn, tpmh}; pg8::gemm_phase<EpiP5H, P5HalfOrder, true>(F.lds, DM, SH, EH, wave0); }
            if (REP == 6 && rep == 0) GRID_BAR(); }
        if (BOTH(6)) LIGHT_BAR(1);
        STAMP(7);
    }
    if (IN(7)) {
        FRAME_LOAD(); ws = F.ws;
        for (int rep = 0; rep < (REP == 7 ? 2 : 1); ++rep) {
        const int uA = (F.vcu >> 5) * 64 + (F.vcu & 31), uB = uA + 32;
        const int row0 = (F.vcu * NWAVES + F.wave) * 8;
        GmlpRegs GR; ConvRegs CR;
        gmlp_load(GR, uA >> 6, (uA >> 2) & 15, uA & 3, (const bf16_t*)(ws + WS_GVT), (const float*)(ws + WS_GVSSQ), (const bf16_t*)(ws + WS_WS), (const bf16_t*)(ws + WS_UG), wave0);
        conv_load(CR, row0, (const bf16_t*)(ws + WS_BG), (const bf16_t*)(ws + WS_CH), F.lane);
        gmlp_unit(GR, uA >> 6, (uA >> 2) & 15, uA & 3, F.v_g, F.b_s, (bf16_t*)(ws + WS_Y), F.lds, wave0);
        gmlp_load(GR, uB >> 6, (uB >> 2) & 15, uB & 3, (const bf16_t*)(ws + WS_GVT), (const float*)(ws + WS_GVSSQ), (const bf16_t*)(ws + WS_WS), (const bf16_t*)(ws + WS_UG), wave0);
        conv_finish(CR, row0, F.conv_w, (bf16_t*)(ws + WS_Y), F.lane);
        gmlp_unit(GR, uB >> 6, (uB >> 2) & 15, uB & 3, F.v_g, F.b_s, (bf16_t*)(ws + WS_Y), F.lds, wave0);
        if (REP == 7 && rep == 0) GRID_BAR();
        }
        if (BOTH(7)) LIGHT_BAR(2);
        STAMP(8);
    }
    if (IN(8)) {
        FRAME_LOAD(); ws = F.ws;
        OutOrder<WS_Y, WS_WO1> S{F.G, (int)blockIdx.x}; EpiP7 E;
        pg8::gemm_phase<EpiP7, OutOrder<WS_Y, WS_WO1>>(F.lds, DM, S, E, wave0);
        STAMP(9);
    }
#undef IN
#undef BOTH
}

#if DIAG

#endif

extern "C" void kernel_launch(void* const* d_in, const int* in_sizes, int n_in, void* d_out, int out_size, void* d_ws, size_t ws_size, hipStream_t stream) {
    static int grid = 0;
    if (grid == 0) {
        int dev = 0, cus = 0;
        if (hipGetDevice(&dev) != hipSuccess || hipDeviceGetAttribute(&cus, hipDeviceAttributeMultiprocessorCount, dev) != hipSuccess) { fprintf(stderr, "kernel_launch: device query failed\n"); grid = -1; return; }
        if (hipFuncSetAttribute((const void*)mk_fwd, hipFuncAttributeMaxDynamicSharedMemorySize, LDS_BYTES) != hipSuccess) { fprintf(stderr, "kernel_launch: hipFuncSetAttribute failed\n"); grid = -1; return; }
        int per_cu = 0;
        if (hipOccupancyMaxActiveBlocksPerMultiprocessor(&per_cu, (const void*)mk_fwd, NTHR, LDS_BYTES) != hipSuccess || per_cu < 1) { fprintf(stderr, "kernel_launch: occupancy query says %d blocks/CU\n", per_cu); }
        (void)hipGetLastError();
        grid = cus;
        if (ws_size < WS_END) { fprintf(stderr, "kernel_launch: workspace too small\n"); grid = -1; return; }
    }
    if (grid < 0) return;
    (void)hipMemsetAsync((char*)d_ws + WS_CTL, 0, CTL_ZERO_BYTES, stream);
    Args a{};
    for (int i = 0; i < 20; ++i) a.in[i] = (const float*)d_in[i];
    a.out = (float*)d_out; a.ws = (unsigned char*)d_ws;
#ifdef OUT_SKIP
    a.dbg = OUT_SKIP;
#endif
#if DIAG
    diag_launch(a, grid, d_in, d_out, d_ws, stream);
#else
#if REP >= 91 && REP <= 98
    a.ph_lo = 0; a.ph_hi = REP - 90;
    hipLaunchKernelGGL(mk_fwd, dim3(grid), dim3(NTHR), LDS_BYTES, stream, a);
    (void)hipMemsetAsync((char*)d_ws + WS_CTL, 0, CTL_ZERO_BYTES, stream);
#endif
    a.ph_lo = 0; a.ph_hi = N_PHASES;
    hipLaunchKernelGGL(mk_fwd, dim3(grid), dim3(NTHR), LDS_BYTES, stream, a);
#endif
}
```

```cpp
#define DIAG 0
#define DSEL -1
#include <hip/hip_runtime.h>
#include <math.h>
#include <stdint.h>
#include <cstdio>

#define LAS __attribute__((address_space(3)))
#define GAS __attribute__((address_space(1)))
typedef unsigned short bf16_t;
typedef short bf16x8 __attribute__((ext_vector_type(8)));
typedef short s16x4 __attribute__((ext_vector_type(4)));
typedef float f32x2 __attribute__((ext_vector_type(2)));
typedef float f32x4 __attribute__((ext_vector_type(4)));
typedef float f32x16 __attribute__((ext_vector_type(16)));
typedef unsigned u32x2 __attribute__((ext_vector_type(2)));
typedef unsigned u32x4 __attribute__((ext_vector_type(4)));
typedef _Float16 f16x2_t __attribute__((ext_vector_type(2)));
typedef __bf16 bf16x2_t __attribute__((ext_vector_type(2)));

constexpr int DM = 1024, NB = 8, SEQ = 2048, CTX = 256, KV = SEQ + CTX  , M_TOK = NB * SEQ  , M_CTX = NB * CTX  ;
constexpr int EIN = 4608, OIN = 3584;
constexpr float EPS = 1e-6f;
constexpr float LOG2E = 1.4426950408889634f;
constexpr float LAM_INIT = 0.2f;

constexpr size_t MiB = 1u << 20;
constexpr size_t WS_CTL = 0, CTL_ZERO_BYTES = 1 * MiB;
constexpr size_t WS_MISC = 1 * MiB;
constexpr size_t WS_WT0 = 2 * MiB;
constexpr size_t WS_WO0 = 11 * MiB;
constexpr size_t WS_WT1 = 13 * MiB;
constexpr size_t WS_WO1 = 20 * MiB;
constexpr size_t WS_WS = 22 * MiB;
constexpr size_t WS_SSQ1 = 23 * MiB;
constexpr size_t WS_RA = 24 * MiB;
constexpr size_t WS_XN = WS_RA, WS_CN = WS_RA + 32 * MiB, WS_ST = WS_RA, WS_A1 = WS_RA, WS_X1B = WS_RA + 32 * MiB;
constexpr size_t WS_Y = 88 * MiB;
constexpr size_t WS_KC = 120 * MiB;
constexpr size_t WS_VT = 138 * MiB;
constexpr size_t WS_GA = 156 * MiB;
constexpr size_t WS_HVT = 172 * MiB;
constexpr size_t WS_LF = 190 * MiB;
constexpr size_t WS_GB = 226 * MiB;
constexpr size_t WS_END = 242 * MiB;
constexpr size_t WS_UG = 120 * MiB;
constexpr size_t WS_BG = 136 * MiB;
constexpr size_t WS_CH = 152 * MiB;
constexpr size_t WS_GVT = 168 * MiB;
constexpr size_t WS_GVSSQ = 186 * MiB;
constexpr int GVP = SEQ + 64;
constexpr int MI_MOD = 0;
constexpr int MI_CS = 55296, MI_SN = MI_CS + 1024, MI_LBV = MI_SN + 1024, MI_SCAL = MI_LBV + 1024, MI_BIAS1 = MI_SCAL + 64;
constexpr int CW_BAR = 4096;
constexpr int CW_QUEUE = 16384;
constexpr int CW_FLAG = 32768;
constexpr int CW_XCC = 45056;
constexpr int CW_UNCLEAN = 45056 + 1024;
constexpr int CW_GRP = 49152;
constexpr int CW_W0 = 40960 + 64;
constexpr int CW_ADA = 40960;

__device__ __forceinline__ unsigned cvt_pk_bf16(float lo, float hi) { f32x2 v = {lo, hi}; bf16x2_t b = __builtin_convertvector(v, bf16x2_t); return __builtin_bit_cast(unsigned, b); }
__device__ __forceinline__ unsigned cvt_pk_f16(float lo, float hi) { f32x2 v = {lo, hi}; f16x2_t b = __builtin_convertvector(v, f16x2_t); return __builtin_bit_cast(unsigned, b); }
__device__ __forceinline__ float bf2f(unsigned short h) { return __uint_as_float(((unsigned)h) << 16); }
__device__ __forceinline__ float bflo(unsigned w) { return __uint_as_float(w << 16); }
__device__ __forceinline__ float bfhi(unsigned w) { return __uint_as_float(w & 0xffff0000u); }
__device__ __forceinline__ float silu_fast(float v) { return v * __builtin_amdgcn_rcpf(1.f + __expf(-v)); }
__device__ __forceinline__ float gelu_erf(float v) { return 0.5f * v * (1.f + erff(v * 0.70710678118654752f)); }
__device__ __forceinline__ float wave_sum(float v) {
#pragma unroll
  for (int o = 1; o < 64; o <<= 1) v += __shfl_xor(v, o);
  return v;
}
__device__ __forceinline__ int lane_id() { int l = (int)__builtin_amdgcn_mbcnt_hi(~0u, __builtin_amdgcn_mbcnt_lo(~0u, 0u)); asm volatile("" : "+v"(l)); return l; }
__device__ __forceinline__ float shfl_xor_l(float v, int mask, int lane) { return __int_as_float(__builtin_amdgcn_ds_bpermute((lane ^ mask) << 2, __float_as_int(v))); }
#define LDS_WAIT() asm volatile("s_waitcnt lgkmcnt(0)" ::: "memory")
#define VM_WAIT() asm volatile("s_waitcnt vmcnt(0)" ::: "memory")

namespace pg8 {
constexpr int BM = 256, BK = 64, HALF = 128, HTB = HALF * BK * 2, STAGE_BYTES = 8 * HTB;
__host__ __device__ __forceinline__ int lds_byte(int r, int c) { const int st = (r >> 4) * 2 + (c >> 5), rr = r & 15, cc = c & 31, ob = rr * 64 + cc * 2; return st * 1024 + (ob ^ (((ob >> 9) & 1) << 5)); }
__host__ __device__ __forceinline__ void stage_rc(int b, int& R, int& C) { const int st = b / 1024, sb = b % 1024, swz = sb ^ (((sb >> 9) & 1) << 5); R = (st >> 1) * 16 + swz / 64; C = (st & 1) * 32 + (swz % 64) / 2; }
__host__ __device__ __forceinline__ int perm32(int rho) { const int n = rho >> 4, i = rho & 15; return 8 * (i >> 2) + 4 * n + (i & 3); }

struct Unit { const char* a; const char* b; int ty, pm, pn, aux; };

template <class Epi, class Sched, bool HALFN = false>
__device__ __forceinline__ void gemm_phase(LAS unsigned char* lds, const int K, const Sched& S, const Epi& E, const int wv) {
    const int lane = lane_id(), tid = wv * 64 + lane, wid = wv, wr = wid >> 2, wc = wid & 3, fr = lane & 15, fq = lane >> 4;
    const int nt = K / BK;
    unsigned voffA[2], voffB[2];
#pragma unroll
    for (int i = 0; i < 2; ++i) { int R, C; stage_rc(tid * 16 + i * 8192, R, C); const int Rb = (R & ~31) + perm32(R & 31);
        voffA[i] = (unsigned)(R * K + C) * 2u; voffB[i] = (unsigned)(Rb * K + C) * 2u; }
    const size_t kstep = (size_t)(BK * 2);
    const size_t hstep = (size_t)HALF * K * 2;
    const unsigned ldsw = (unsigned)wid * 1024u;
    const int aoff = lds_byte(wr * 64 + fr, fq * 8), boff = lds_byte(wc * 32 + fr, fq * 8);
#define PG8_SA(b, h) (((b) * 2 + (h)) * HTB)
#define PG8_SB(b, h) ((4 + (b) * 2 + (h)) * HTB)
#define PG8_STAGE(bufoff, gbase, voff) do { _Pragma("unroll") for (int _i = 0; _i < 2; ++_i) \
        __builtin_amdgcn_global_load_lds((const unsigned*)((const char*)(gbase) + (voff)[_i]), (LAS unsigned*)(lds + (bufoff) + ldsw + _i * 8192), 16, 0, 0); } while (0)
#define PG8_LDA(dst, b, h) do { _Pragma("unroll") for (int m = 0; m < 4; ++m) _Pragma("unroll") for (int k = 0; k < 2; ++k) dst[m][k] = *(const LAS bf16x8*)(lds + PG8_SA(b, h) + aoff + m * 2048 + k * 1024); } while (0)
#define PG8_LDB(dst, b, h) do { _Pragma("unroll") for (int n = 0; n < 2; ++n) _Pragma("unroll") for (int k = 0; k < 2; ++k) dst[n][k] = *(const LAS bf16x8*)(lds + PG8_SB(b, h) + boff + n * 2048 + k * 1024); } while (0)
#define PG8_MMA(ai, bj, At, Bt) do { __builtin_amdgcn_s_setprio(1); _Pragma("unroll") for (int m = 0; m < 4; ++m) _Pragma("unroll") for (int n = 0; n < 2; ++n) _Pragma("unroll") for (int k = 0; k < 2; ++k) \
        acc[ai][bj][m][n] = __builtin_amdgcn_mfma_f32_16x16x32_bf16(Bt[n][k], At[m][k], acc[ai][bj][m][n], 0, 0, 0); __builtin_amdgcn_s_setprio(0); } while (0)
#define PG8_WAIT_V(n) asm volatile("s_waitcnt vmcnt(" #n ")" ::: "memory")
#define PG8_WAIT_L(n) asm volatile("s_waitcnt lgkmcnt(" #n ")" ::: "memory")
#define PG8_BAR __builtin_amdgcn_s_barrier()
#define PG8_SCHED __builtin_amdgcn_sched_barrier(0)
    Unit cur, nxt; int ui = 0;
    if (!S.next(0, cur)) return;
    f32x4 acc[2][2][4][2];
#pragma unroll
    for (int a = 0; a < 2; ++a)
#pragma unroll
        for (int b = 0; b < 2; ++b)
#pragma unroll
            for (int m = 0; m < 4; ++m)
#pragma unroll
                for (int n = 0; n < 2; ++n) acc[a][b][m][n] = (f32x4){0.f, 0.f, 0.f, 0.f};
    bf16x8 At[4][2], B0[2][2], B1[2][2];
    const char* cA = cur.a; const char* cB = cur.b;
    PG8_STAGE(PG8_SB(0, 0), cB, voffB); if (!HALFN) PG8_STAGE(PG8_SB(0, 1), cB + hstep, voffB); PG8_STAGE(PG8_SA(0, 0), cA, voffA); PG8_STAGE(PG8_SA(0, 1), cA + hstep, voffA);
    if (wr == 1) PG8_BAR;
    PG8_WAIT_V(2); PG8_BAR;
    PG8_STAGE(PG8_SB(1, 0), cB + kstep, voffB); PG8_STAGE(PG8_SA(1, 0), cA + kstep, voffA); if (!HALFN) PG8_STAGE(PG8_SB(1, 1), cB + hstep + kstep, voffB);
    if (HALFN) PG8_WAIT_V(4); else PG8_WAIT_V(6); PG8_BAR;
    for (;;) {
        const bool has_next = S.next(ui + 1, nxt);
        const char* nA = has_next ? nxt.a : cA; const char* nB = has_next ? nxt.b : cB;
        for (int t = 0; t < nt; t += 2) {
            const bool last = (t == nt - 2);
            const char* a1 = cA + (size_t)(t + 1) * kstep;
            const char* a2 = last ? nA : cA + (size_t)(t + 2) * kstep; const char* b2 = last ? nB : cB + (size_t)(t + 2) * kstep;
            const char* a3 = a2 + kstep; const char* b3 = b2 + kstep;
#define PG8_WAIT_VK() do { if (HALFN) PG8_WAIT_V(6); else PG8_WAIT_V(8); } while (0)
            PG8_LDB(B0, 0, 0); if (!HALFN) PG8_LDB(B1, 0, 1); PG8_SCHED; PG8_LDA(At, 0, 0); PG8_STAGE(PG8_SA(1, 1), a1 + hstep, voffA);
            PG8_WAIT_VK(); PG8_WAIT_L(0); PG8_BAR; PG8_MMA(0, 0, At, B0); if (!HALFN) PG8_MMA(0, 1, At, B1); PG8_BAR; PG8_SCHED;
            PG8_LDA(At, 0, 1); PG8_STAGE(PG8_SB(0, 0), b2, voffB); if (!HALFN) PG8_STAGE(PG8_SB(0, 1), b2 + hstep, voffB); PG8_STAGE(PG8_SA(0, 0), a2, voffA);
            PG8_WAIT_VK(); PG8_WAIT_L(0); PG8_BAR; PG8_MMA(1, 0, At, B0); if (!HALFN) PG8_MMA(1, 1, At, B1); PG8_BAR; PG8_SCHED;
            PG8_LDB(B0, 1, 0); if (!HALFN) PG8_LDB(B1, 1, 1); PG8_SCHED; PG8_LDA(At, 1, 0); PG8_STAGE(PG8_SA(0, 1), a2 + hstep, voffA);
            PG8_WAIT_VK(); PG8_WAIT_L(0); PG8_BAR; PG8_MMA(0, 0, At, B0); if (!HALFN) PG8_MMA(0, 1, At, B1); PG8_BAR; PG8_SCHED;
            PG8_LDA(At, 1, 1); PG8_STAGE(PG8_SB(1, 0), b3, voffB); if (!HALFN) PG8_STAGE(PG8_SB(1, 1), b3 + hstep, voffB); PG8_STAGE(PG8_SA(1, 0), a3, voffA);
            PG8_WAIT_VK(); PG8_WAIT_L(0); PG8_BAR; PG8_MMA(1, 0, At, B0); if (!HALFN) PG8_MMA(1, 1, At, B1); PG8_BAR; PG8_SCHED;
#undef PG8_WAIT_VK
        }
        if (wr == 0) PG8_BAR;
        { int ln_ = (int)__builtin_amdgcn_mbcnt_hi(~0u, __builtin_amdgcn_mbcnt_lo(~0u, 0u)); asm volatile("" : "+v"(ln_));
          E(acc, cur, wr, wc, ln_ & 15, ln_ >> 4, ln_); }
        if (!has_next) break;
#pragma unroll
        for (int a = 0; a < 2; ++a)
#pragma unroll
            for (int b = 0; b < 2; ++b)
#pragma unroll
                for (int m = 0; m < 4; ++m)
#pragma unroll
                    for (int n = 0; n < 2; ++n) acc[a][b][m][n] = (f32x4){0.f, 0.f, 0.f, 0.f};
        cur = nxt; cA = nA; cB = nB; ++ui;
        if (wr == 1) PG8_BAR;
    }
    PG8_WAIT_V(0);
    PG8_BAR;
#undef PG8_SA
#undef PG8_SB
#undef PG8_STAGE
#undef PG8_LDA
#undef PG8_LDB
#undef PG8_MMA
#undef PG8_WAIT_V
#undef PG8_WAIT_L
#undef PG8_BAR
#undef PG8_SCHED
}
}

__device__ __forceinline__ void ticket_draw(unsigned* qctr, unsigned& tk) {
    const unsigned one = 1u;
    asm volatile("global_atomic_add %0, %1, %2, off sc0" : "=v"(tk) : "v"(qctr), "v"(one) : "memory");
}
__device__ __forceinline__ void ticket_wait(unsigned& tk) { asm volatile("s_waitcnt vmcnt(0)" : "+v"(tk) :: "memory"); }
__device__ __forceinline__ void group_barrier_light(unsigned* cnt, unsigned target, int tid) {
    asm volatile("s_waitcnt vmcnt(0)" ::: "memory");
    __syncthreads();
    if (tid == 0) {
        const unsigned old = __hip_atomic_fetch_add(cnt, 1u, __ATOMIC_RELAXED, __HIP_MEMORY_SCOPE_AGENT);
        if (old + 1u == target) __hip_atomic_store(cnt + 64, 1u, __ATOMIC_RELAXED, __HIP_MEMORY_SCOPE_AGENT);
        else { unsigned sp = 0u; while (__hip_atomic_load(cnt + 64, __ATOMIC_RELAXED, __HIP_MEMORY_SCOPE_AGENT) == 0u && ++sp < (1u << 22)) __builtin_amdgcn_s_sleep(1); }
        __builtin_amdgcn_fence(__ATOMIC_ACQUIRE, "agent");
        asm volatile("s_waitcnt vmcnt(0)" ::: "memory");
    }
    __syncthreads();
}
#define XB_TMO      128
#define XB_XCNT(j)  (256  + 64 * (j))
#define XB_XSUB(j)  (1280 + 64 * (j))
#define XB_XGEN(j)  (2304 + 64 * (j))
#define XB_TOP      3328
#define XB_TOPGEN   3392
#define XCD_BAR_WORDS 3456
#define XB_SPIN_CAP (1u << 18)
__device__ __forceinline__ unsigned xb_ld(unsigned* p)              { return __hip_atomic_load(p, __ATOMIC_RELAXED, __HIP_MEMORY_SCOPE_AGENT); }
__device__ __forceinline__ unsigned xb_add(unsigned* p, unsigned v) { return __hip_atomic_fetch_add(p, v, __ATOMIC_RELAXED, __HIP_MEMORY_SCOPE_AGENT); }
__device__ __forceinline__ unsigned xb_xcc_id() { return (unsigned)__builtin_amdgcn_s_getreg((3 << 11) | 20) & 0xFu; }
#define XB_SPIN(cond, bar) do { unsigned _sp = 0; while (cond) { __builtin_amdgcn_s_sleep(1); \
    if ((++_sp & 255u) == 0u) { if (xb_ld(&(bar)[XB_TMO])) break; if (_sp > XB_SPIN_CAP) { atomicAdd(&(bar)[XB_TMO], 1u); break; } } } } while (0)
struct XcdBarrier { unsigned* bar; unsigned x; volatile LAS unsigned* st; };
__device__ __forceinline__ XcdBarrier xcd_barrier_post(unsigned* bar, volatile LAS unsigned* st, int tid) {
    XcdBarrier b; b.bar = bar; b.x = xb_xcc_id(); b.st = st;
    if (tid == 0) (void)xb_add(&bar[XB_XCNT(b.x)], 1u);
    return b;
}
__device__ __forceinline__ void xcd_barrier_complete(unsigned* bar, unsigned x, unsigned& nloc, unsigned& nx) {
    const unsigned G = gridDim.x * gridDim.y * gridDim.z;
    unsigned sum, cnt, mine, sp = 0u;
    for (;;) {
        sum = 0u; cnt = 0u; mine = 0u;
#pragma unroll
        for (unsigned j = 0; j < 16; ++j) { const unsigned c = xb_ld(&bar[XB_XCNT(j)]); sum += c; cnt += (c > 0u) ? 1u : 0u; mine = (j == x) ? c : mine; }
        if (sum == G) break;
        __builtin_amdgcn_s_sleep(1);
        if ((++sp & 255u) == 0u) { if (xb_ld(&bar[XB_TMO])) break; if (sp > XB_SPIN_CAP) { atomicAdd(&bar[XB_TMO], 1u); break; } }
    }
    nloc = mine > 0u ? mine : 1u; nx = cnt > 0u ? cnt : 1u;
}
__device__ __forceinline__ void xcd_barrier(const XcdBarrier& b, int tid, const bool light = false) {
    asm volatile("s_waitcnt vmcnt(0)" ::: "memory");
    __syncthreads();
    if (tid == 0) {
        unsigned* bar = b.bar;
        __builtin_amdgcn_s_waitcnt(0);
        unsigned nloc = b.st[0], nx = b.st[1];
        if (nloc == 0u) { xcd_barrier_complete(bar, b.x, nloc, nx); b.st[0] = nloc; b.st[1] = nx; }
        const unsigned old = xb_add(&bar[XB_XSUB(b.x)], 1u);
        const unsigned gen = old / nloc;
        if (old + 1u == (gen + 1u) * nloc) {
            if (!light) __builtin_amdgcn_fence(__ATOMIC_RELEASE, "agent");
            asm volatile("s_waitcnt vmcnt(0)" ::: "memory");
            const unsigned og = xb_add(&bar[XB_TOP], 1u);
            const unsigned tg = og / nx;
            if (og + 1u == (tg + 1u) * nx) xb_add(&bar[XB_TOPGEN], 1u);
            else XB_SPIN(xb_ld(&bar[XB_TOPGEN]) == tg, bar);
            __builtin_amdgcn_fence(__ATOMIC_ACQUIRE, "agent");
            xb_add(&bar[XB_XGEN(b.x)], 1u);
            asm volatile("s_waitcnt vmcnt(0)" ::: "memory");
        } else {
            XB_SPIN(xb_ld(&bar[XB_XGEN(b.x)]) == gen, bar);
            __builtin_amdgcn_fence(__ATOMIC_ACQUIRE, "agent");
            asm volatile("s_waitcnt vmcnt(0)" ::: "memory");
        }
    }
    __syncthreads();
}
constexpr int NWAVES = 8, NTHR = 512;
constexpr int RING_BYTES = 131072;
constexpr int LDSX_OFF = RING_BYTES;
constexpr int LDSCTL_OFF = 162816;
constexpr int LDS_BYTES = 163840;

struct Args {
    const float* in[20]; float* out; unsigned char* ws; int ph_lo, ph_hi, dbg, pad;
};
typedef const __attribute__((address_space(4))) Args* KArgsPtr;
__device__ __forceinline__ KArgsPtr kargs() { KArgsPtr p = (KArgsPtr)__builtin_amdgcn_kernarg_segment_ptr(); asm volatile("" : "+s"(p)); return p; }
struct Frame {
    LAS unsigned char* lds;
    volatile LAS unsigned* MISC;
    unsigned* ctl;
    int tid, lane, wave, vcu, G;
    const float *x, *c, *ctx, *c_ctx, *norm_gain, *ada_w, *ada_b, *even_w_in, *even_w_out, *qk_gain, *lam_p, *subln_g, *lb_logits, *hgrn_g,
                *odd_w_in, *odd_w_out, *v_g, *w_s, *b_s, *conv_w;
    float* out; unsigned char* ws; float* misc;
};

__host__ __device__ __forceinline__ int srcmap0(int d) {
    if (d < 1024) { const int base = d < 512 ? 0 : 512; const int e = d & 511; const int pn = e >> 8, rho = e & 255, bj = rho >> 7, wc = (rho >> 5) & 3; return base + (4 * pn + wc) * 64 + 32 * bj + (rho & 31); }
    if (d < 1536) return 1536 + (d - 1024);
    if (d < 2048) return 2048 + (d - 1536);
    if (d < 2560) return 3072 + (d - 2048);
    if (d < 3072) return 3584 + (d - 2560);
    if (d < 3584) return 4096 + (d - 3072);
    if (d < 4096) return 1024 + (d - 3584);
    return 2560 + (d - 4096);
}
__host__ __device__ __forceinline__ int srcmap1(int d) {
    if (d < 1024) { const int t = d >> 8, rho = d & 255, bj = rho >> 7, o = rho & 127; return (bj ? 1024 : 0) + 128 * t + o; }
    if (d < 2048) { const int e = d - 1024; const int t = e >> 8, rho = e & 255, bj = rho >> 7, o = rho & 127; return (bj ? 3072 : 1536) + 128 * t + o; }
    if (d < 3072) { const int e = d - 2048; const int t = e >> 8, rho = e & 255, bj = rho >> 7, o = rho & 127; return (bj ? 2560 : 2048) + 128 * t + o; }
    return 512 + (d - 3072);
}

__device__ __forceinline__ void p0_transpose_item(const float* W, int K, int N, bf16_t* WT, int drow0, int n_src, int k0, LAS float* scr, int lane) {
    float tv[32];
#pragma unroll
    for (int i = 0; i < 32; ++i) { const int kk = 2 * i + (lane >> 5); tv[i] = W[(size_t)(k0 + kk) * N + n_src + (lane & 31)]; }
#pragma unroll
    for (int i = 0; i < 32; ++i) { const int kk = 2 * i + (lane >> 5); scr[kk * 33 + (lane & 31)] = tv[i]; }
    LDS_WAIT(); asm volatile("" ::: "memory");
    const int c = lane & 7;
#pragma unroll
    for (int j = 0; j < 4; ++j) { const int n = (lane >> 3) + 8 * j; const LAS float* s = scr + (8 * c) * 33 + n;
        u32x4 o; o.x = cvt_pk_bf16(s[0 * 33], s[1 * 33]); o.y = cvt_pk_bf16(s[2 * 33], s[3 * 33]); o.z = cvt_pk_bf16(s[4 * 33], s[5 * 33]); o.w = cvt_pk_bf16(s[6 * 33], s[7 * 33]);
        *(u32x4*)(WT + (size_t)(drow0 + n) * K + k0 + 8 * c) = o; }
    LDS_WAIT(); asm volatile("" ::: "memory");
}

__device__ __forceinline__ void weight_copies(Frame& F, int which, int gw, int NGW, int sub_lo = 0, int sub_hi = 1 << 30) {
    LAS float* scr = (LAS float*)(F.lds + F.wave * 16384);
    constexpr int I0 = 16 * (EIN / 32), I1 = 16 * 32, I2 = 16 * (OIN / 32), I3 = 16 * 32, I4 = 128;
    bf16_t* Wt0 = (bf16_t*)(F.ws + WS_WT0); bf16_t* Wo0 = (bf16_t*)(F.ws + WS_WO0); bf16_t* Wt1 = (bf16_t*)(F.ws + WS_WT1); bf16_t* Wo1 = (bf16_t*)(F.ws + WS_WO1); bf16_t* Wsb = (bf16_t*)(F.ws + WS_WS);
    const int lo = (which ? I0 + I1 : 0) + sub_lo, hi0 = which ? I0 + I1 + I2 + I3 + I4 : I0 + I1; const int hi = (lo - sub_lo + sub_hi < hi0) ? lo - sub_lo + sub_hi : hi0;
    for (int it = lo + gw; it < hi; it += NGW) {
        int r = it;
        if (r < I0) { const int kb = r / (EIN / 32), dg = r % (EIN / 32); p0_transpose_item(F.even_w_in, DM, EIN, Wt0, dg * 32, srcmap0(dg * 32), kb * 64, scr, F.lane); continue; } r -= I0;
        if (r < I1) { const int kb = r / 32, dg = r % 32; p0_transpose_item(F.even_w_out, DM, DM, Wo0, dg * 32, dg * 32, kb * 64, scr, F.lane); continue; } r -= I1;
        if (r < I2) { const int kb = r / (OIN / 32), dg = r % (OIN / 32); p0_transpose_item(F.odd_w_in, DM, OIN, Wt1, dg * 32, srcmap1(dg * 32), kb * 64, scr, F.lane); continue; } r -= I2;
        if (r < I3) { const int kb = r / 32, dg = r % 32; p0_transpose_item(F.odd_w_out, DM, DM, Wo1, dg * 32, dg * 32, kb * 64, scr, F.lane); continue; } r -= I3;
        { const int e0 = r * 512 + F.lane * 8; const f32x4 a = *(const f32x4*)(F.w_s + e0), b = *(const f32x4*)(F.w_s + e0 + 4);
          u32x4 o; o.x = cvt_pk_bf16(a.x, a.y); o.y = cvt_pk_bf16(a.z, a.w); o.z = cvt_pk_bf16(b.x, b.y); o.w = cvt_pk_bf16(b.z, b.w); *(u32x4*)(Wsb + e0) = o; }
    }
}
__device__ __forceinline__ void p0_prologue(Frame& F) {
    float* misc = F.misc;
    if (F.vcu < 192) {
        LAS float* sl = (LAS float*)F.lds;
        LAS float* red = (LAS float*)(F.lds + 36864);
        const int cc = F.tid & 31, kp = F.tid >> 5;
        const int gcol = F.vcu * 32 + cc;
        const int l = gcol / 3072, col = gcol % 3072;
        const float* w = F.ada_w + (size_t)l * 1024 * 3072 + col;
        float wv[64];
#pragma unroll
        for (int i = 0; i < 64; ++i) wv[i] = w[(size_t)(kp * 64 + i) * 3072];
        for (int i = F.tid; i < 9 * 1024; i += NTHR) { const int r = i >> 10, k = i & 1023; const float v = (r < 8) ? F.c[r * 1024 + k] : F.c_ctx[k]; sl[i] = v / (1.f + __expf(-v)); }
        __syncthreads();
#pragma unroll
        for (int r = 0; r < 9; ++r) {
            float a = 0.f;
#pragma unroll
            for (int i4 = 0; i4 < 16; ++i4) { const f32x4 sv = *(const LAS f32x4*)(sl + r * 1024 + kp * 64 + 4 * i4);
                a += sv.x * wv[4 * i4] + sv.y * wv[4 * i4 + 1] + sv.z * wv[4 * i4 + 2] + sv.w * wv[4 * i4 + 3]; }
            red[(kp * 9 + r) * 32 + cc] = a;
        }
        __syncthreads();
        if (F.tid < 9 * 32) { const int r = F.tid >> 5, c2 = F.tid & 31; const int gc = F.vcu * 32 + c2; const int l2 = gc / 3072, col2 = gc % 3072;
            float sacc = F.ada_b[l2 * 3072 + col2];
#pragma unroll
            for (int q = 0; q < 16; ++q) sacc += red[(q * 9 + r) * 32 + c2];
            misc[MI_MOD + (l2 * 9 + r) * 3072 + col2] = sacc; }
        asm volatile("s_waitcnt vmcnt(0)" ::: "memory");
        __syncthreads();
        if (F.tid == 0) { __builtin_amdgcn_fence(__ATOMIC_RELEASE, "agent"); __hip_atomic_fetch_add(F.ctl + CW_ADA, 1u, __ATOMIC_RELAXED, __HIP_MEMORY_SCOPE_AGENT); }
    }
    if (F.vcu == 192) {
        for (int i = F.tid; i < 1024; i += NTHR) { const int pos = i >> 4, f = i & 15; const float inv = powf(10000.f, -(float)f / 16.f); const float ang = (float)pos * inv;
            misc[MI_CS + i] = cosf(ang); misc[MI_SN + i] = sinf(ang); }
    }
    if (F.vcu == 193) {
        for (int i = F.tid; i < 1024; i += NTHR) { const int dir = i >> 9, ch = i & 511; const float l0 = F.lb_logits[(dir * 2 + 0) * 512 + ch], l1 = F.lb_logits[(dir * 2 + 1) * 512 + ch];
            const float mx = fmaxf(l0, l1); const float e0 = expf(l0 - mx), e1 = expf(l1 - mx); misc[MI_LBV + i] = e0 / (e0 + e1); }
        if (F.wave == 0) {
            const int i = F.lane;
            float a = F.lam_p[i] * F.lam_p[64 + i], b = F.lam_p[128 + i] * F.lam_p[192 + i], gq = fabsf(F.qk_gain[i]), gk = fabsf(F.qk_gain[64 + i]);
#pragma unroll
            for (int o = 1; o < 64; o <<= 1) { a += __shfl_xor(a, o); b += __shfl_xor(b, o); gq = fmaxf(gq, __shfl_xor(gq, o)); gk = fmaxf(gk, __shfl_xor(gk, o)); }
            if (i == 0) {
                misc[MI_SCAL + 0] = expf(a) - expf(b) + LAM_INIT;
                misc[MI_SCAL + 1] = 8.0f * gq * gk * LOG2E * 1.0001f + 0.01f;
            }
        }
    }
    if (F.vcu >= 194) weight_copies(F, 0, (F.vcu - 194) * NWAVES + F.wave, 62 * NWAVES);
    if (F.vcu >= 192) {
        asm volatile("s_waitcnt vmcnt(0)" ::: "memory");
        __syncthreads();
        if (F.tid == 0) { __builtin_amdgcn_fence(__ATOMIC_RELEASE, "agent"); __hip_atomic_fetch_add(F.ctl + CW_W0, 1u, __ATOMIC_RELAXED, __HIP_MEMORY_SCOPE_AGENT); }
    }
}

__device__ __forceinline__ void mod_rows3(Frame& F, int ma, int mb, int mc, bf16_t* XN, bf16_t* CN) {
    const float* misc = F.misc; const int lane = F.lane;
    f32x4 v[3][4];
#pragma unroll
    for (int r = 0; r < 3; ++r) { const int m = (r == 0) ? ma : (r == 1) ? mb : mc; const float* xrow = (m < M_TOK) ? F.x + (size_t)m * DM : F.ctx + (size_t)(m - M_TOK) * DM; const f32x4* xr = (const f32x4*)xrow + lane;
#pragma unroll
        for (int j = 0; j < 4; ++j) v[r][j] = xr[64 * j]; }
#pragma unroll
    for (int r = 0; r < 3; ++r) {
        const int m = (r == 0) ? ma : (r == 1) ? mb : mc;
        float s = 0.f;
#pragma unroll
        for (int j = 0; j < 4; ++j) s += (v[r][j].x * v[r][j].x + v[r][j].y * v[r][j].y) + (v[r][j].z * v[r][j].z + v[r][j].w * v[r][j].w);
        const float rstd = rsqrtf(wave_sum(s) * (1.f / DM) + EPS);
        const float* modrow = misc + MI_MOD + (0 * 9 + ((m < M_TOK) ? (m >> 11) : 8)) * 3072;
        bf16_t* orow = (m < M_TOK) ? XN + (size_t)m * DM : CN + (size_t)(m - M_TOK) * DM;
        u32x2* o8 = (u32x2*)orow + lane;
#pragma unroll
        for (int j = 0; j < 4; ++j) {
            const int col = 4 * lane + 256 * j;
            const f32x4 g = *(const f32x4*)(F.norm_gain + col), sh = *(const f32x4*)(modrow + col), sc = *(const f32x4*)(modrow + 1024 + col);
            const f32x4 o = v[r][j] * rstd * g * (sc + 1.f) + sh;
            u32x2 w; w.x = cvt_pk_bf16(o.x, o.y); w.y = cvt_pk_bf16(o.z, o.w); o8[64 * j] = w;
        }
    }
}
__device__ __forceinline__ void rows_load(Frame& F, int m, f32x4 (&v)[4]) {
    const float* xrow = (m < M_TOK) ? F.x + (size_t)m * DM : F.ctx + (size_t)(m - M_TOK) * DM; const f32x4* xr = (const f32x4*)xrow + F.lane;
#pragma unroll
    for (int j = 0; j < 4; ++j) v[j] = xr[64 * j];
}
__device__ __forceinline__ void mod_vecs(Frame& F, int modr, f32x4 (&Gm)[4], f32x4 (&Sh)[4]) {
    const float* modrow = F.misc + MI_MOD + (0 * 9 + modr) * 3072;
#pragma unroll
    for (int j = 0; j < 4; ++j) { const int col = 4 * F.lane + 256 * j;
        Gm[j] = *(const f32x4*)(F.norm_gain + col) * (*(const f32x4*)(modrow + 1024 + col) + 1.f); Sh[j] = *(const f32x4*)(modrow + col); }
}
__device__ __forceinline__ void row_proc(Frame& F, int m, const f32x4 (&v)[4], const f32x4 (&Gm)[4], const f32x4 (&Sh)[4], bf16_t* XN, bf16_t* CN) {
    float s = 0.f;
#pragma unroll
    for (int j = 0; j < 4; ++j) s += (v[j].x * v[j].x + v[j].y * v[j].y) + (v[j].z * v[j].z + v[j].w * v[j].w);
    const float rstd = rsqrtf(wave_sum(s) * (1.f / DM) + EPS);
    bf16_t* orow = (m < M_TOK) ? XN + (size_t)m * DM + (size_t)(m >> 11) * 2097152 : XN + (size_t)((m - M_TOK) >> 8) * 4194304 + 2097152 + (size_t)((m - M_TOK) & 255) * DM;
    u32x2* o8 = (u32x2*)orow + F.lane;
#pragma unroll
    for (int j = 0; j < 4; ++j) { const f32x4 o = v[j] * rstd * Gm[j] + Sh[j]; u32x2 w; w.x = cvt_pk_bf16(o.x, o.y); w.y = cvt_pk_bf16(o.z, o.w); o8[64 * j] = w; }
}
__device__ __forceinline__ void p0b_phase(Frame& F) {
    const float* misc = F.misc;
    bf16_t* XN = (bf16_t*)(F.ws + WS_XN); bf16_t* CN = (bf16_t*)(F.ws + WS_CN);
    const int gw0 = F.vcu * NWAVES + F.wave;
    f32x4 ra[3][4], rb[3][4];
#pragma unroll
    for (int r = 0; r < 3; ++r) { rows_load(F, 8 * gw0 + r, ra[r]); rows_load(F, 8 * gw0 + 3 + r, rb[r]); }
    if (F.wave == 0) { unsigned sp = 0u;
        while (__hip_atomic_load(F.ctl + CW_ADA, __ATOMIC_RELAXED, __HIP_MEMORY_SCOPE_AGENT) < 192u && ++sp < (1u << 22)) __builtin_amdgcn_s_sleep(2);
        __builtin_amdgcn_fence(__ATOMIC_ACQUIRE, "agent"); }
    __syncthreads();
    {
        LAS float* red = (LAS float*)F.lds;
        LAS float* shs = (LAS float*)(F.lds + 16384);
        const int cc = F.tid & 15, kp = F.tid >> 4;
        float acc[8];
#pragma unroll
        for (int b = 0; b < 8; ++b) acc[b] = 0.f;
        float wv[32];
        if (cc < 14) {
            const int d = F.vcu * 14 + cc; const int src = srcmap1(d & ~31) + (d & 31);
#pragma unroll
            for (int i = 0; i < 32; ++i) wv[i] = F.odd_w_in[(size_t)(kp * 32 + i) * OIN + src];
        } else {
#pragma unroll
            for (int i = 0; i < 32; ++i) wv[i] = 0.f;
        }
        { f32x4 sh4[4];
#pragma unroll
          for (int q = 0; q < 4; ++q) { const int i = F.tid + NTHR * q; const int b = i >> 8, c4 = i & 255; sh4[q] = *(const f32x4*)(misc + MI_MOD + (9 + b) * 3072 + 4 * c4); }
#pragma unroll
          for (int q = 0; q < 4; ++q) { const int i = F.tid + NTHR * q; const int b = i >> 8, c4 = i & 255; *(LAS f32x4*)(shs + b * 1024 + 4 * c4) = sh4[q]; } }
        __syncthreads();
#pragma unroll
        for (int b = 0; b < 8; ++b) {
#pragma unroll
            for (int i4 = 0; i4 < 8; ++i4) { const f32x4 sv = *(const LAS f32x4*)(shs + b * 1024 + kp * 32 + 4 * i4);
                acc[b] += sv.x * wv[4 * i4] + sv.y * wv[4 * i4 + 1] + sv.z * wv[4 * i4 + 2] + sv.w * wv[4 * i4 + 3]; }
        }
        __syncthreads();
#pragma unroll
        for (int b = 0; b < 8; ++b) red[(kp * 8 + b) * 16 + cc] = acc[b];
        __syncthreads();
        if (F.tid < 8 * 14) { const int b = F.tid / 14, c2 = F.tid % 14; float s = 0.f;
            for (int q = 0; q < 32; ++q) s += red[(q * 8 + b) * 16 + c2];
            F.misc[MI_BIAS1 + b * OIN + F.vcu * 14 + c2] = s; }
        __syncthreads();
    }
    {
        const int gw = gw0;
        f32x4 Gm[4], Sh[4];
        mod_vecs(F, (8 * gw) >> 11, Gm, Sh);
#pragma unroll
        for (int r = 0; r < 3; ++r) row_proc(F, 8 * gw + r, ra[r], Gm, Sh, XN, CN);
        rows_load(F, 8 * gw + 6, ra[0]); rows_load(F, 8 * gw + 7, ra[1]); rows_load(F, M_TOK + gw, ra[2]);
        __builtin_amdgcn_sched_barrier(0);
#pragma unroll
        for (int r = 0; r < 3; ++r) row_proc(F, 8 * gw + 3 + r, rb[r], Gm, Sh, XN, CN);
        row_proc(F, 8 * gw + 6, ra[0], Gm, Sh, XN, CN); row_proc(F, 8 * gw + 7, ra[1], Gm, Sh, XN, CN);
        mod_vecs(F, 8, Gm, Sh);
        row_proc(F, M_TOK + gw, ra[2], Gm, Sh, XN, CN);
    }
}

enum { T_Q = 0, T_K = 1, T_SILU = 2, T_PLAIN = 3, T_LF = 4, T_VT = 5 };
struct P1Order {
    int G, c;
    __device__ __forceinline__ bool next(int i, pg8::Unit& u) const {
        const int L = i * G + c;
        const char* wsb = (const char*)kargs()->ws; const char* XN = wsb + WS_XN; const char* CN = wsb + WS_CN; const char* Wt0 = wsb + WS_WT0;
        constexpr size_t TSTEP = (size_t)256 * DM * 2;
        if (L < 896) {
            constexpr int nwg = 896, nN = 14, q = nwg / 8;
            const int xcd = L % 8, offp = L / 8; const int wgid = xcd * q + offp;
            constexpr int nig = 8 * nN; const int gid = wgid / nig, fm = gid * 8;
            u.pm = fm + ((wgid % nig) % 8); u.pn = (wgid % nig) / 8;
            u.a = XN + (size_t)u.pm * TSTEP + (size_t)(u.pm >> 3) * (4u << 20); u.b = Wt0 + (size_t)u.pn * TSTEP; u.aux = 0;
            u.ty = (u.pn < 2) ? T_Q : (u.pn < 4) ? T_K : (u.pn < 6) ? T_SILU : (u.pn < 8) ? T_PLAIN : (u.pn < 12) ? T_LF : T_SILU;
            return true;
        }
        int r = L - 896;
        if (r < 256) { const int xcd = r % 8, j = r / 8; u.pn = xcd * 8 + j / 4; u.pm = j % 4; u.a = Wt0 + (size_t)(14 + u.pm) * TSTEP; u.b = XN + (size_t)u.pn * TSTEP + (size_t)(u.pn >> 3) * (4u << 20); u.ty = T_VT; u.aux = 0; return true; }
        r -= 256;
        if (r < 48) { const int pmc = r % 8, j = r / 8; const int pn = (j < 2) ? 2 + j : 6 + j;
            u.pm = pmc; u.pn = pn; u.a = XN + (size_t)pmc * (8u << 20) + (4u << 20); u.b = Wt0 + (size_t)pn * TSTEP; u.aux = 1; u.ty = (pn < 4) ? T_K : T_LF; return true; }
        r -= 48;
        if (r < 32) { u.pn = r % 8; u.pm = r / 8; u.a = Wt0 + (size_t)(14 + u.pm) * TSTEP; u.b = XN + (size_t)u.pn * (8u << 20) + (4u << 20); u.ty = T_VT; u.aux = 1; return true; }
        return false;
    }
};
struct EpiP1 {
    const LAS float* tab;
    __device__ __forceinline__ void operator()(const f32x4 (&acc)[2][2][4][2], const pg8::Unit& u, int wr, int wc, int fr, int fq, int lane) const {
        KArgsPtr ka = kargs(); unsigned char* wsb = ka->ws; const float* qk_gain = ka->in[9];
        bf16_t* Y = (bf16_t*)(wsb + WS_Y); bf16_t* Kc = (bf16_t*)(wsb + WS_KC); bf16_t* VT = (bf16_t*)(wsb + WS_VT); bf16_t* GA = (bf16_t*)(wsb + WS_GA); bf16_t* HVT = (bf16_t*)(wsb + WS_HVT); bf16_t* GB = (bf16_t*)(wsb + WS_GB);
        unsigned short* LF = (unsigned short*)(wsb + WS_LF); const float* miscp = (const float*)(wsb + WS_MISC); const float* CS = miscp + MI_CS; const float* SN = miscp + MI_SN; const float* LBV = miscp + MI_LBV;
        const int ty = u.ty, ctx = u.aux;
        if (ty == T_Q || ty == T_K) {
            const int seg = 4 * (u.pn & 1) + wc;
            const LAS float* gp = tab + 2048 + (ty == T_K ? 64 : 0) + 8 * fq;
            const f32x4 g00 = *(const LAS f32x4*)(gp), g01 = *(const LAS f32x4*)(gp + 4), g10 = *(const LAS f32x4*)(gp + 32), g11 = *(const LAS f32x4*)(gp + 36);
            const float osc = (ty == T_Q) ? 0.125f * LOG2E : 1.f;
#pragma unroll
            for (int ai = 0; ai < 2; ++ai)
#pragma unroll
                for (int m = 0; m < 4; ++m) {
                    const int rt = 128 * ai + 64 * wr + 16 * m + fr;
                    const int t = ((u.pm & 7) * 256 + rt);
                    float ss = 0.f;
#pragma unroll
                    for (int bj = 0; bj < 2; ++bj)
#pragma unroll
                        for (int n = 0; n < 2; ++n) { const f32x4 v = acc[ai][bj][m][n]; ss += (v.x * v.x + v.y * v.y) + (v.z * v.z + v.w * v.w); }
                    ss += __shfl_xor(ss, 16); ss += __shfl_xor(ss, 32);
                    const float rstd = rsqrtf(ss * (1.f / 64.f) + EPS);
                    f32x4 a0 = acc[ai][0][m][0] * rstd * g00, a1 = acc[ai][0][m][1] * rstd * g01, b0 = acc[ai][1][m][0] * rstd * g10, b1 = acc[ai][1][m][1] * rstd * g11;
                    if (!ctx) {
                        const int pos = (fq < 2) ? (t >> 6) : (t & 63);
                        const LAS float* cp = tab + pos * 16 + 8 * (fq & 1); const LAS float* sp = cp + 1024;
                        const f32x4 c0 = *(const LAS f32x4*)cp, c1 = *(const LAS f32x4*)(cp + 4), s0 = *(const LAS f32x4*)sp, s1 = *(const LAS f32x4*)(sp + 4);
                        const f32x4 o0 = a0 * c0 - b0 * s0, o1 = a1 * c1 - b1 * s1, p0 = a0 * s0 + b0 * c0, p1 = a1 * s1 + b1 * c1;
                        a0 = o0; a1 = o1; b0 = p0; b1 = p1;
                    }
                    a0 = a0 * osc; a1 = a1 * osc; b0 = b0 * osc; b1 = b1 * osc;
                    u32x4 w0, w1;
                    w0.x = cvt_pk_bf16(a0.x, a0.y); w0.y = cvt_pk_bf16(a0.z, a0.w); w0.z = cvt_pk_bf16(a1.x, a1.y); w0.w = cvt_pk_bf16(a1.z, a1.w);
                    w1.x = cvt_pk_bf16(b0.x, b0.y); w1.y = cvt_pk_bf16(b0.z, b0.w); w1.z = cvt_pk_bf16(b1.x, b1.y); w1.w = cvt_pk_bf16(b1.z, b1.w);
                    bf16_t* dst;
                    if (ty == T_Q) dst = Y + (size_t)(u.pm * 256 + rt) * 1024 + seg * 64 + 8 * fq;
                    else if (!ctx) dst = Kc + ((size_t)(u.pm >> 3) * KV + CTX + t) * 512 + seg * 64 + 8 * fq;
                    else dst = Kc + ((size_t)u.pm * KV + rt) * 512 + seg * 64 + 8 * fq;
                    *(u32x4*)dst = w0; *(u32x4*)(dst + 32) = w1;
                }
        } else if (ty == T_SILU || ty == T_PLAIN) {
            bf16_t* base; int pitch;
            if (ty == T_PLAIN) { base = Y + 512 + (u.pn - 6) * 256; pitch = 1024; }
            else if (u.pn < 6) { base = GA + (u.pn - 4) * 256; pitch = 512; }
            else { base = GB + (u.pn - 12) * 256; pitch = 512; }
#pragma unroll
            for (int ai = 0; ai < 2; ++ai)
#pragma unroll
                for (int m = 0; m < 4; ++m) {
                    const int rt = 128 * ai + 64 * wr + 16 * m + fr;
                    bf16_t* rowp = base + (size_t)(u.pm * 256 + rt) * pitch + 32 * wc + 8 * fq;
#pragma unroll
                    for (int bj = 0; bj < 2; ++bj) {
                        f32x4 v0 = acc[ai][bj][m][0], v1 = acc[ai][bj][m][1];
                        if (ty == T_SILU) { v0.x = silu_fast(v0.x); v0.y = silu_fast(v0.y); v0.z = silu_fast(v0.z); v0.w = silu_fast(v0.w); v1.x = silu_fast(v1.x); v1.y = silu_fast(v1.y); v1.z = silu_fast(v1.z); v1.w = silu_fast(v1.w); }
                        u32x4 w; w.x = cvt_pk_bf16(v0.x, v0.y); w.y = cvt_pk_bf16(v0.z, v0.w); w.z = cvt_pk_bf16(v1.x, v1.y); w.w = cvt_pk_bf16(v1.z, v1.w);
                        *(u32x4*)(rowp + 128 * bj) = w;
                    }
                }
        } else if (ty == T_LF) {
            const int dir = (u.pn >= 10) ? 1 : 0; const int pnr = (u.pn - 8) & 1;
            const int col0 = 256 * pnr + 32 * wc + 8 * fq;
            f32x4 lb[2][2];
#pragma unroll
            for (int bj = 0; bj < 2; ++bj)
#pragma unroll
                for (int n = 0; n < 2; ++n) lb[bj][n] = *(const LAS f32x4*)(tab + 2176 + dir * 512 + col0 + 128 * bj + 4 * n);
#pragma unroll
            for (int ai = 0; ai < 2; ++ai)
#pragma unroll
                for (int m = 0; m < 4; ++m) {
                    const int rt = 128 * ai + 64 * wr + 16 * m + fr;
                    size_t krow;
                    if (!ctx) krow = ((size_t)(dir * 8 + (u.pm >> 3)) * KV + CTX + (u.pm & 7) * 256 + rt);
                    else krow = ((size_t)(dir * 8 + u.pm) * KV + rt);
                    unsigned short* rowp = LF + krow * 512 + col0;
#pragma unroll
                    for (int bj = 0; bj < 2; ++bj) {
                        float o[8];
#pragma unroll
                        for (int n = 0; n < 2; ++n)
#pragma unroll
                            for (int j = 0; j < 4; ++j) { const float z = acc[ai][bj][m][n][j]; const float l = lb[bj][n][j]; const float f = l + (1.f - l) * __builtin_amdgcn_rcpf(1.f + __expf(-z)); o[4 * n + j] = __builtin_amdgcn_logf(f); }
                        u32x4 w; w.x = cvt_pk_f16(o[0], o[1]); w.y = cvt_pk_f16(o[2], o[3]); w.z = cvt_pk_f16(o[4], o[5]); w.w = cvt_pk_f16(o[6], o[7]);
                        *(u32x4*)(rowp + 128 * bj) = w;
                    }
                }
        } else {
#pragma unroll
            for (int ai = 0; ai < 2; ++ai)
#pragma unroll
                for (int m = 0; m < 4; ++m) {
                    const int f = u.pm * 256 + 128 * ai + 64 * wr + 16 * m + fr;
                    bf16_t* base = (f < 512) ? VT : HVT; const int hh = (f & 511) >> 7, dv = f & 127;
                    const int b = ctx ? u.pn : (u.pn >> 3);
                    const int key0 = ctx ? 0 : CTX + (u.pn & 7) * 256;
                    bf16_t* rowp = base + ((size_t)(b * 4 + hh) * 128 + dv) * KV + key0 + 32 * wc + 8 * fq;
#pragma unroll
                    for (int bj = 0; bj < 2; ++bj) {
                        const f32x4 v0 = acc[ai][bj][m][0], v1 = acc[ai][bj][m][1];
                        u32x4 w; w.x = cvt_pk_bf16(v0.x, v0.y); w.y = cvt_pk_bf16(v0.z, v0.w); w.z = cvt_pk_bf16(v1.x, v1.y); w.w = cvt_pk_bf16(v1.z, v1.w);
                        *(u32x4*)(rowp + 128 * bj) = w;
                    }
                }
        }
    }
};
namespace att {
constexpr int NSLOT = 4, SLOTB = 32768, VOFF = 16384, NT = KV / 64;
__device__ __forceinline__ void glds16s(const void* sbase, unsigned voff, unsigned lds_dst) {
    unsigned keep;
    asm volatile("s_mov_b32 %0, m0\n\ts_mov_b32 m0, %3\n\ts_nop 0\n\tglobal_load_lds_dwordx4 %1, %2\n\ts_mov_b32 m0, %0" : "=&s"(keep) : "v"(voff), "s"(sbase), "s"(lds_dst) : "memory");
}
__device__ __forceinline__ void glds16(const void* gsrc, unsigned lds_dst) {
    unsigned keep;
    asm volatile("s_mov_b32 %0, m0\n\ts_mov_b32 m0, %2\n\ts_nop 0\n\tglobal_load_lds_dwordx4 %1, off\n\ts_mov_b32 m0, %0" : "=&s"(keep) : "v"(gsrc), "s"(lds_dst) : "memory");
}
#define ATT_WAIT_BAR(N) asm volatile("s_waitcnt vmcnt(" #N ") lgkmcnt(0)\n\ts_barrier" ::: "memory")
__device__ __forceinline__ int crow(int r, int hi) { return (r & 3) + 8 * (r >> 2) + 4 * hi; }
#define MFMA32(a, b, c) __builtin_amdgcn_mfma_f32_32x32x16_bf16((a), (b), (c), 0, 0, 0)

__device__ __forceinline__ void attn_unit(int b, int h, int qb, bf16_t* Y, const bf16_t* Kc, const bf16_t* VT, const bf16_t* GA, const float* subln_g,
                                          float lam, float M2, LAS unsigned char* lds, const int wv, const bool dry = false, unsigned* qctr = nullptr) {
    const int lane = lane_id(), r32 = lane & 31, hi = lane >> 5;
    const int wid = wv;
    const int m = wid >> 2, qs = wid & 3;
    const unsigned lds0 = (unsigned)(uintptr_t)lds;
    const int tok0 = b * SEQ + qb * 128 + qs * 32;
    const bf16_t* Kb = Kc + (size_t)b * KV * 512 + h * 128;
    const bf16_t* Vb = VT + (size_t)(b * 4 + h) * 128 * KV;
    const int krow0 = 16 * (wid & 3) + (lane >> 3), krow1 = krow0 + 8;
    const bf16_t* ksrc0 = Kb + (size_t)krow0 * 512 + (wid >> 2) * 64 + 8 * ((lane & 7) ^ ((krow0 >> 1) & 7));
    const bf16_t* ksrc1 = Kb + (size_t)krow1 * 512 + (wid >> 2) * 64 + 8 * ((lane & 7) ^ ((krow1 >> 1) & 7));
    const int vrow0 = 16 * wid + (lane >> 3), vrow1 = vrow0 + 8;
    const bf16_t* vsrc0 = Vb + (size_t)vrow0 * KV + 8 * ((lane & 7) ^ ((vrow0 >> 1) & 7));
    const bf16_t* vsrc1 = Vb + (size_t)vrow1 * KV + 8 * ((lane & 7) ^ ((vrow1 >> 1) & 7));
    const unsigned kdst = lds0 + (2 * wid) * 1024, vdst = lds0 + VOFF + (2 * wid) * 1024;
#define ATT_DMA(t, slot) do { const unsigned so_ = (unsigned)(slot) * SLOTB; \
        glds16(ksrc0 + (size_t)(t) * 64 * 512, (unsigned)__builtin_amdgcn_readfirstlane(kdst + so_)); \
        glds16(ksrc1 + (size_t)(t) * 64 * 512, (unsigned)__builtin_amdgcn_readfirstlane(kdst + so_ + 1024)); \
        glds16(vsrc0 + (size_t)(t) * 64, (unsigned)__builtin_amdgcn_readfirstlane(vdst + so_)); \
        glds16(vsrc1 + (size_t)(t) * 64, (unsigned)__builtin_amdgcn_readfirstlane(vdst + so_ + 1024)); } while (0)
    const unsigned kvo0 = (unsigned)((const char*)ksrc0 - (const char*)Kb), kvo1 = (unsigned)((const char*)ksrc1 - (const char*)Kb);
    const unsigned vvo0 = (unsigned)((const char*)vsrc0 - (const char*)Vb), vvo1 = (unsigned)((const char*)vsrc1 - (const char*)Vb);
#define ATT_DMA1(t, slot, i) do { const unsigned so_ = (unsigned)(slot) * SLOTB; \
        if ((i) == 0) glds16s(Kb + (size_t)(t) * 64 * 512, kvo0, (unsigned)__builtin_amdgcn_readfirstlane(kdst + so_)); \
        if ((i) == 1) glds16s(Kb + (size_t)(t) * 64 * 512, kvo1, (unsigned)__builtin_amdgcn_readfirstlane(kdst + so_ + 1024)); \
        if ((i) == 2) glds16s(Vb + (size_t)(t) * 64, vvo0, (unsigned)__builtin_amdgcn_readfirstlane(vdst + so_)); \
        if ((i) == 3) glds16s(Vb + (size_t)(t) * 64, vvo1, (unsigned)__builtin_amdgcn_readfirstlane(vdst + so_ + 1024)); } while (0)
    bf16x8 qr[4];
    {
        const bf16_t* qp = Y + (size_t)(tok0 + r32) * 1024 + h * 128 + m * 64 + hi * 8;
#pragma unroll
        for (int d0 = 0; d0 < 4; ++d0) qr[d0] = *(const bf16x8*)(qp + d0 * 16);
    }
    __builtin_amdgcn_sched_barrier(0);
    ATT_DMA(0, 0);
    const int pi = (r32 & ~12) | ((r32 & 4) << 1) | ((r32 & 8) >> 1);
    int koff[4], voff[4];
#pragma unroll
    for (int d0 = 0; d0 < 4; ++d0) koff[d0] = m * 8192 + pi * 128 + (((2 * d0 + hi) ^ ((pi >> 1) & 7)) << 4);
    const int swz = (r32 >> 1) & 7;
#pragma unroll
    for (int s = 0; s < 4; ++s) voff[s] = VOFF + r32 * 128 + (((2 * s + hi) ^ swz) << 4);
    f32x16 o[4];
#pragma unroll
    for (int i = 0; i < 4; ++i)
#pragma unroll
        for (int r = 0; r < 16; ++r) o[i][r] = 0.f;
    float lsum = 0.f;
    f32x16 negm;
#pragma unroll
    for (int r = 0; r < 16; ++r) negm[r] = -M2;
    f32x16 pA0, pA1, pB0, pB1;
#define ATT_QK(N0, N1, sbk) do { N0 = negm; N1 = negm; \
        _Pragma("unroll") for (int d0 = 0; d0 < 4; ++d0) { \
            const bf16x8 k0_ = *(const LAS bf16x8*)((sbk) + koff[d0]); const bf16x8 k1_ = *(const LAS bf16x8*)((sbk) + koff[d0] + 4096); \
            N0 = MFMA32(k0_, qr[d0], N0); N1 = MFMA32(k1_, qr[d0], N1); } } while (0)
#define ATT_EXP(N0, N1) do { _Pragma("unroll") for (int r = 0; r < 16; ++r) { N0[r] = __builtin_amdgcn_exp2f(N0[r]); N1[r] = __builtin_amdgcn_exp2f(N1[r]); } } while (0)
#define ATT_PACK8(X, B) (u32x4){cvt_pk_bf16(X[B], X[B + 1]), cvt_pk_bf16(X[B + 2], X[B + 3]), cvt_pk_bf16(X[B + 4], X[B + 5]), cvt_pk_bf16(X[B + 6], X[B + 7])}
#define ATT_KRD(d0, half) (*(const LAS bf16x8*)(sbk_ + koff[d0] + (half) * 4096))
#define ATT_VRD(blk, s) (*(const LAS bf16x8*)(sbv_ + voff[s] + (blk) * 4096))
#define ATT_GAP() __builtin_amdgcn_sched_barrier(0)
#define ATT_E4(X, B) do { X[B] = __builtin_amdgcn_exp2f(X[B]); X[B + 1] = __builtin_amdgcn_exp2f(X[B + 1]); X[B + 2] = __builtin_amdgcn_exp2f(X[B + 2]); X[B + 3] = __builtin_amdgcn_exp2f(X[B + 3]); } while (0)
#define ATT_PVROW(blk, V0, V1, V2, V3, W0, W1, W2, W3, nb, F0, F1, F2, F3) do { \
        o[blk] = MFMA32(__builtin_bit_cast(bf16x8, pw0_), V0, o[blk]); if ((nb) < 4) W0 = ATT_VRD((nb) & 3, 0); F0; ATT_GAP(); \
        o[blk] = MFMA32(__builtin_bit_cast(bf16x8, pw1_), V1, o[blk]); if ((nb) < 4) W1 = ATT_VRD((nb) & 3, 1); F1; ATT_GAP(); \
        o[blk] = MFMA32(__builtin_bit_cast(bf16x8, pw2_), V2, o[blk]); if ((nb) < 4) W2 = ATT_VRD((nb) & 3, 2); F2; ATT_GAP(); \
        o[blk] = MFMA32(__builtin_bit_cast(bf16x8, pw3_), V3, o[blk]); if ((nb) < 4) W3 = ATT_VRD((nb) & 3, 3); F3; ATT_GAP(); } while (0)
#define ATT_S2(X, B) do { sacc_ += X[B]; sacc_ += X[B + 1]; } while (0)
#define ATT_STEP(N0, N1, P0, P1, t) do { \
        ATT_WAIT_BAR(4); const int tn_ = ((t) + 2 < NT) ? (t) + 2 : NT - 1;     \
        const LAS unsigned char* sbk_ = lds + ((t) & 3) * SLOTB; const LAS unsigned char* sbv_ = lds + (((t) - 1) & 3) * SLOTB; \
        bf16x8 ka_ = ATT_KRD(0, 0), kb_ = ATT_KRD(1, 0), kc_ = ATT_KRD(2, 0), kd_ = ATT_KRD(3, 0); \
        u32x4 pw0_, pw1_, pw2_, pw3_; bf16x8 ke_, kf_, kg_, kh_, va_, vb_, vc_, vd_, ve_, vf_, vg_, vh_; float sacc_ = 0.f; \
        ATT_GAP(); \
        N0 = MFMA32(ka_, qr[0], negm); pw0_ = ATT_PACK8(P0, 0); ke_ = ATT_KRD(0, 1); kf_ = ATT_KRD(1, 1); ATT_GAP(); \
        N0 = MFMA32(kb_, qr[1], N0);   pw1_ = ATT_PACK8(P0, 8); kg_ = ATT_KRD(2, 1); kh_ = ATT_KRD(3, 1); ATT_GAP(); \
        N0 = MFMA32(kc_, qr[2], N0);   pw2_ = ATT_PACK8(P1, 0); va_ = ATT_VRD(0, 0); vb_ = ATT_VRD(0, 1); ATT_GAP(); \
        N0 = MFMA32(kd_, qr[3], N0);   pw3_ = ATT_PACK8(P1, 8); vc_ = ATT_VRD(0, 2); vd_ = ATT_VRD(0, 3); ATT_GAP(); \
        N1 = MFMA32(ke_, qr[0], negm); ATT_S2(P0, 0); ATT_S2(P0, 2); ATT_S2(P0, 4); ATT_S2(P0, 6); ATT_GAP(); \
        N1 = MFMA32(kf_, qr[1], N1);   ATT_E4(N0, 0);  ATT_GAP(); \
        N1 = MFMA32(kg_, qr[2], N1);   ATT_E4(N0, 4);  ATT_GAP(); \
        N1 = MFMA32(kh_, qr[3], N1);   ATT_E4(N0, 8);  ATT_GAP(); \
        ATT_PVROW(0, va_, vb_, vc_, vd_, ve_, vf_, vg_, vh_, 1, ATT_E4(N0, 12), do { ATT_S2(P0, 8); ATT_S2(P0, 10); ATT_S2(P0, 12); ATT_S2(P0, 14); } while (0), ATT_E4(N1, 0), do { ATT_S2(P1, 0); ATT_S2(P1, 2); ATT_S2(P1, 4); } while (0)); \
        ATT_PVROW(1, ve_, vf_, vg_, vh_, va_, vb_, vc_, vd_, 2, ATT_E4(N1, 4), do { ATT_S2(P1, 6); ATT_S2(P1, 8); ATT_S2(P1, 10); } while (0), ATT_E4(N1, 8), do { ATT_S2(P1, 12); ATT_S2(P1, 14); } while (0)); \
        ATT_PVROW(2, va_, vb_, vc_, vd_, ve_, vf_, vg_, vh_, 3, ATT_E4(N1, 12), (void)0, (void)0, (void)0); \
        ATT_PVROW(3, ve_, vf_, vg_, vh_, va_, vb_, vc_, vd_, 4, ATT_DMA1(tn_, ((t) + 2) & 3, 0), ATT_DMA1(tn_, ((t) + 2) & 3, 1), ATT_DMA1(tn_, ((t) + 2) & 3, 2), ATT_DMA1(tn_, ((t) + 2) & 3, 3)); \
        lsum += sacc_; } while (0)
#define ATT_PV(O0, O1, sbv) do { float sa_ = 0.f, sb_ = 0.f; \
        _Pragma("unroll") for (int r = 0; r < 16; ++r) { sa_ += O0[r]; sb_ += O1[r]; } lsum += sa_ + sb_; \
        u32x4 pw_[4]; pw_[0] = ATT_PACK8(O0, 0); pw_[1] = ATT_PACK8(O0, 8); pw_[2] = ATT_PACK8(O1, 0); pw_[3] = ATT_PACK8(O1, 8); \
        _Pragma("unroll") for (int blk = 0; blk < 4; ++blk) _Pragma("unroll") for (int s = 0; s < 4; ++s) { \
            const bf16x8 vb_ = *(const LAS bf16x8*)((sbv) + voff[s] + blk * 4096); \
            o[blk] = MFMA32(__builtin_bit_cast(bf16x8, pw_[s]), vb_, o[blk]); } } while (0)
    ATT_WAIT_BAR(0);
#pragma unroll
    for (int d0 = 0; d0 < 4; ++d0) asm volatile("" : "+v"(qr[d0]));
    ATT_DMA(1, 1); ATT_DMA(2, 2);
    ATT_QK(pA0, pA1, lds); ATT_EXP(pA0, pA1);
    for (int t = 1; t + 1 < NT; t += 2) {
        ATT_STEP(pB0, pB1, pA0, pA1, t);
        ATT_STEP(pA0, pA1, pB0, pB1, t + 1);
    }
    unsigned tk;
    if (qctr != nullptr && wv == 0 && lane == 0) ticket_draw(qctr, tk);
    ATT_STEP(pB0, pB1, pA0, pA1, NT - 1);
    const int rowq = 16 * m + (lane >> 4), ch16 = lane & 15;
    u32x4 gav[4];
#pragma unroll
    for (int ps = 0; ps < 4; ++ps) gav[ps] = *(const u32x4*)(GA + (size_t)(tok0 + rowq + 4 * ps) * 512 + h * 128 + 8 * ch16);
    { const LAS unsigned char* sbv_ = lds + ((NT - 1) & 3) * SLOTB; ATT_PV(pB0, pB1, sbv_); }
#undef ATT_STEP
#undef ATT_PV
#undef ATT_EXP
#undef ATT_QK
#undef ATT_PVROW
#undef ATT_S2
#undef ATT_E4
#undef ATT_GAP
#undef ATT_KRD
#undef ATT_VRD
#undef ATT_PACK8
    lsum += shfl_xor_l(lsum, 32, lane);
    ATT_WAIT_BAR(0);
    LAS float* wl = (LAS float*)(lds + 131072) + wid * 32;
    LAS float* ex = (LAS float*)lds + qs * 4096;
    if (hi == 0) wl[r32] = lsum;
    LDS_WAIT();
    float rl[16];
#pragma unroll
    for (int r = 0; r < 16; ++r) rl[r] = __builtin_amdgcn_rcpf(wl[crow(r, hi)]) * (m ? lam : 1.f);
    if (m == 1) {
#pragma unroll
        for (int blk = 0; blk < 4; ++blk)
#pragma unroll
            for (int r = 0; r < 16; ++r) ex[crow(r, hi) * 128 + blk * 32 + r32] = o[blk][r] * rl[r];
    }
    ATT_WAIT_BAR(0);
    if (m == 0) {
        float ss[16];
#pragma unroll
        for (int r = 0; r < 16; ++r) ss[r] = 0.f;
#pragma unroll
        for (int blk = 0; blk < 4; ++blk)
#pragma unroll
            for (int r = 0; r < 16; ++r) { const float v = o[blk][r] * rl[r] - ex[crow(r, hi) * 128 + blk * 32 + r32]; o[blk][r] = v; ss[r] += v * v; }
#pragma unroll
        for (int r = 0; r < 16; ++r) {
            float s = ss[r];
            s += shfl_xor_l(s, 1, lane); s += shfl_xor_l(s, 2, lane); s += shfl_xor_l(s, 4, lane); s += shfl_xor_l(s, 8, lane); s += shfl_xor_l(s, 16, lane);
            ss[r] = rsqrtf(s * (1.f / 128.f) + EPS) * (1.f - LAM_INIT);
        }
#pragma unroll
        for (int blk = 0; blk < 4; ++blk) {
            const float g = subln_g[blk * 32 + r32];
#pragma unroll
            for (int r = 0; r < 16; ++r) ex[crow(r, hi) * 128 + blk * 32 + r32] = o[blk][r] * ss[r] * g;
        }
    }
    ATT_WAIT_BAR(0);
    {
#pragma unroll
        for (int ps = 0; ps < 4; ++ps) {
            const int row = rowq + 4 * ps;
            const f32x4 a = *(const LAS f32x4*)(ex + row * 128 + 8 * ch16), c = *(const LAS f32x4*)(ex + row * 128 + 8 * ch16 + 4);
            const u32x4 g4 = gav[ps];
            u32x4 w; w.x = cvt_pk_bf16(a.x * bflo(g4.x), a.y * bfhi(g4.x)); w.y = cvt_pk_bf16(a.z * bflo(g4.y), a.w * bfhi(g4.y));
            w.z = cvt_pk_bf16(c.x * bflo(g4.z), c.y * bfhi(g4.z)); w.w = cvt_pk_bf16(c.z * bflo(g4.w), c.w * bfhi(g4.w));
            if (!dry) *(u32x4*)(Y + (size_t)(tok0 + row) * 1024 + h * 128 + 8 * ch16) = w;
        }
    }
    if (qctr != nullptr && wv == 0 && lane == 0) { ticket_wait(tk); ((volatile LAS unsigned*)(lds + LDSCTL_OFF))[16] = tk; }
    ATT_WAIT_BAR(0);
#undef ATT_DMA
#undef ATT_DMA1
}
}
namespace hg {
#define HG_BAR() asm volatile("s_waitcnt vmcnt(0) lgkmcnt(0)\n\ts_barrier" ::: "memory")
#define HG_LBAR() asm volatile("s_waitcnt lgkmcnt(0)\n\ts_barrier" ::: "memory")
__device__ __forceinline__ float h2f(unsigned short h) { return (float)__builtin_bit_cast(_Float16, h); }
__device__ __forceinline__ int crow(int r, int hi) { return (r & 3) + 8 * (r >> 2) + 4 * hi; }
__device__ __forceinline__ int pi32(int x) { return (x & ~12) | ((x & 4) << 1) | ((x & 8) >> 1); }
__device__ __forceinline__ int sw64(int r, int c) { return r * 128 + ((c ^ ((r >> 1) & 7)) << 4); }
__device__ __forceinline__ int sw128(int r, int c) { return r * 256 + ((c ^ (r & 15)) << 4); }

__device__ __forceinline__ void state_chain(int b, int h, int dir, const unsigned short* LF, const bf16_t* HVT, bf16_t* ST, LAS unsigned char* lds, const int wv, unsigned* qctr = nullptr) {
    const int lane = lane_id(), tid = wv * 64 + lane, r32 = lane & 31, hi = lane >> 5;
    const int wid = wv;
    const int k = tid & 127, part = tid >> 7;
    const int vt = wid & 3, kh = wid >> 2;
    LAS unsigned char* KsT = lds;
    LAS float* dec = (LAS float*)(lds + 32768);
    LAS float* ptot = (LAS float*)(lds + 32768 + 1024);
    LAS unsigned char* stage = lds + 40960;
    const unsigned short* lfb = LF + ((size_t)(dir * 8 + b) * KV) * 512 + h * 128 + k;
    const bf16_t* vb = HVT + ((size_t)(b * 4 + h) * 128 + 32 * vt + r32) * KV + 8 * hi;
    f32x16 S[2];
#pragma unroll
    for (int i = 0; i < 2; ++i)
#pragma unroll
        for (int r = 0; r < 16; ++r) S[i][r] = 0.f;
    unsigned short lfr[16]; bf16x8 bv[4];
    auto ckof = [&](int n) { return dir ? (n < 4 ? 3 - n : 39 - n) : n; };
    {
        const int key0 = 64 * ckof(0);
#pragma unroll
        for (int j = 0; j < 16; ++j) lfr[j] = lfb[(size_t)(key0 + 16 * part + j) * 512];
#pragma unroll
        for (int s = 0; s < 4; ++s) bv[s] = *(const bf16x8*)(vb + key0 + 16 * s);
    }
    unsigned tk = 0u;
    for (int n = 0; n < 36; ++n) {
        const int p = n & 1, ck = ckof(n);
        if (n == 34 && qctr != nullptr && wv == 0 && lane == 0) tk = __hip_atomic_fetch_add(qctr, 1u, __ATOMIC_RELAXED, __HIP_MEMORY_SCOPE_AGENT);
        float lfv[16], c[16];
#pragma unroll
        for (int j = 0; j < 16; ++j) lfv[j] = h2f(lfr[j]);
        bf16x8 bcur[4];
#pragma unroll
        for (int s = 0; s < 4; ++s) bcur[s] = bv[s];
        if (n + 1 < 36) {
            const int key1 = 64 * ckof(n + 1);
#pragma unroll
            for (int j = 0; j < 16; ++j) lfr[j] = lfb[(size_t)(key1 + 16 * part + j) * 512];
#pragma unroll
            for (int s = 0; s < 4; ++s) bv[s] = *(const bf16x8*)(vb + key1 + 16 * s);
        }
        if (dir == 0) { float a = 0.f;
#pragma unroll
            for (int j = 0; j < 16; ++j) { a += lfv[j]; c[j] = a; } }
        else { float a = 0.f;
#pragma unroll
            for (int j = 15; j >= 0; --j) { a += lfv[j]; c[j] = a; } }
        const float T = dir ? c[0] : c[15];
        ptot[(p * 4 + part) * 128 + k] = T;
        HG_LBAR();
        float off = 0.f, gtot = 0.f;
        float pv4[4];
#pragma unroll
        for (int q = 0; q < 4; ++q) pv4[q] = ptot[(p * 4 + q) * 128 + k];
#pragma unroll
        for (int q = 0; q < 4; ++q) { gtot += pv4[q]; const bool take = dir ? (q > part) : (q < part); off += take ? pv4[q] : 0.f; }
        unsigned w[8];
#pragma unroll
        for (int j = 0; j < 16; j += 2) {
            const float k0 = (1.f - __builtin_amdgcn_exp2f(lfv[j])) * __builtin_amdgcn_exp2f(gtot - (c[j] + off));
            const float k1 = (1.f - __builtin_amdgcn_exp2f(lfv[j + 1])) * __builtin_amdgcn_exp2f(gtot - (c[j + 1] + off));
            w[j >> 1] = cvt_pk_bf16(k0, k1);
        }
        LAS unsigned char* kp = KsT + p * 16384;
        *(LAS u32x4*)(kp + sw64(k, 2 * part)) = (u32x4){w[0], w[1], w[2], w[3]};
        *(LAS u32x4*)(kp + sw64(k, 2 * part + 1)) = (u32x4){w[4], w[5], w[6], w[7]};
        if (part == 0) dec[p * 128 + k] = __builtin_amdgcn_exp2f(gtot);
        if (ck >= 4) {
#pragma unroll
            for (int kt = 0; kt < 2; ++kt)
#pragma unroll
                for (int g = 0; g < 4; ++g) {
                    u32x2 o; o.x = cvt_pk_bf16(S[kt][4 * g], S[kt][4 * g + 1]); o.y = cvt_pk_bf16(S[kt][4 * g + 2], S[kt][4 * g + 3]);
                    *(LAS u32x2*)(stage + sw128(32 * vt + r32, 8 * kh + 4 * kt + g) + 8 * hi) = o;
                }
        }
        HG_LBAR();
        if (ck >= 4) {
            bf16_t* sp = ST + ((size_t)((b * 4 + h) * 2 + dir) * 32 + (ck - 4)) * 16384;
            const int row = tid >> 2, q4 = tid & 3;
            u32x4 cv[4];
#pragma unroll
            for (int c = 0; c < 4; ++c) cv[c] = *(const LAS u32x4*)(stage + sw128(row, 4 * q4 + c));
#pragma unroll
            for (int c = 0; c < 4; ++c) *(u32x4*)(sp + row * 128 + (4 * q4 + c) * 8) = cv[c];
        }
        {
            bf16x8 af[2][4]; f32x4 dc[2][4];
#pragma unroll
            for (int kt = 0; kt < 2; ++kt) {
                const int krow = 32 * (2 * kh + kt);
#pragma unroll
                for (int g = 0; g < 4; ++g) dc[kt][g] = *(const LAS f32x4*)(dec + p * 128 + krow + 8 * g + 4 * hi);
#pragma unroll
                for (int s2 = 0; s2 < 4; ++s2) af[kt][s2] = *(const LAS bf16x8*)(kp + sw64(krow + r32, 2 * s2 + hi));
            }
#pragma unroll
            for (int kt = 0; kt < 2; ++kt) {
#pragma unroll
                for (int g = 0; g < 4; ++g) { S[kt][4 * g] *= dc[kt][g].x; S[kt][4 * g + 1] *= dc[kt][g].y; S[kt][4 * g + 2] *= dc[kt][g].z; S[kt][4 * g + 3] *= dc[kt][g].w; }
#pragma unroll
                for (int s2 = 0; s2 < 4; ++s2) S[kt] = __builtin_amdgcn_mfma_f32_32x32x16_bf16(af[kt][s2], bcur[s2], S[kt], 0, 0, 0);
            }
        }
    }
    if (qctr != nullptr && wv == 0 && lane == 0) ((volatile LAS unsigned*)(lds + LDSCTL_OFF))[16] = tk;
    HG_BAR();
}

struct OutPre { u32x4 sraw[2][4], vraw[2]; unsigned fa[8], fb[8], fq[8]; };
__device__ __forceinline__ void out_load(OutPre& P, int b, int h, int lc, const int wv) {
    unsigned char* wsb_ = kargs()->ws; const bf16_t* Y = (const bf16_t*)(wsb_ + WS_Y); const unsigned short* LF = (const unsigned short*)(wsb_ + WS_LF);
    const int tid = wv * 64 + lane_id();
    const int key0 = CTX + 64 * lc;
    const size_t tok0 = (size_t)b * SEQ + 64 * lc;
    { const bf16_t* ST = (const bf16_t*)(wsb_ + WS_ST); const bf16_t* HVT = (const bf16_t*)(wsb_ + WS_HVT);
      const int schunk = tid & 15, srow = tid >> 4;
#pragma unroll
      for (int dir = 0; dir < 2; ++dir) {
          const bf16_t* stp = ST + ((size_t)((b * 4 + h) * 2 + dir) * 32 + lc) * 16384;
#pragma unroll
          for (int i = 0; i < 4; ++i) P.sraw[dir][i] = *(const u32x4*)(stp + (size_t)(srow + 32 * i) * 128 + 8 * schunk);
      }
      const bf16_t* vtp = HVT + ((size_t)(b * 4 + h) * 128) * KV + key0;
#pragma unroll
      for (int i = 0; i < 2; ++i) P.vraw[i] = *(const u32x4*)(vtp + (size_t)((tid >> 3) + 64 * i) * KV + 8 * (tid & 7)); }
    const int kp2 = tid & 63, part8 = tid >> 6;
    const unsigned short* pf = LF + ((size_t)(0 * 8 + b) * KV + key0 + 8 * part8) * 512 + h * 128 + 2 * kp2;
    const unsigned short* pb = LF + ((size_t)(1 * 8 + b) * KV + key0 + 8 * part8) * 512 + h * 128 + 2 * kp2;
    const bf16_t* pq = Y + (tok0 + 8 * part8) * 1024 + 512 + h * 128 + 2 * kp2;
#pragma unroll
    for (int j = 0; j < 8; ++j) { P.fa[j] = *(const unsigned*)(pf + (size_t)j * 512); P.fb[j] = *(const unsigned*)(pb + (size_t)j * 512); P.fq[j] = *(const unsigned*)(pq + (size_t)j * 1024); }
}
__device__ __forceinline__ void out_settle(OutPre& P) {
#pragma unroll
    for (int d = 0; d < 2; ++d)
#pragma unroll
        for (int i = 0; i < 4; ++i) asm volatile("" : "+v"(P.sraw[d][i]));
    asm volatile("" : "+v"(P.vraw[0]), "+v"(P.vraw[1]));
#pragma unroll
    for (int j = 0; j < 8; ++j) asm volatile("" : "+v"(P.fa[j]), "+v"(P.fb[j]), "+v"(P.fq[j]));
}
__device__ __forceinline__ void out_unit(int b, int h, int lc, LAS unsigned char* lds, const int wv,
                                         OutPre& P, const bool pre_valid, const unsigned acq_mask, const int qoff, int& nidx, bool& npre, const bool dry = false, unsigned* qctr = nullptr) {
    const int lane = lane_id(), tid = wv * 64 + lane, r32 = lane & 31, hi = lane >> 5;
    const int wid = wv;
    const int tb = wid & 1, vt = wid >> 1;
    LAS unsigned char* STx = lds + 65536;
    LAS unsigned char* VTt = lds + 131072;
    LAS float* ptot = (LAS float*)(lds + 147456);
    LAS float* ssx = (LAS float*)(lds + 147456 + 8192);
    const size_t tok0 = (size_t)b * SEQ + 64 * lc;
    const int trow = 32 * tb + r32;
    const int schunk = tid & 15, srow = tid >> 4;
    if (!pre_valid) { out_load(P, b, h, lc, wv); asm volatile("s_waitcnt vmcnt(0)" ::: "memory"); out_settle(P); }
    unsigned tk;
    if (qctr != nullptr && wv == 0 && lane == 0) ticket_draw(qctr, tk);
    const int kp2 = tid & 63, part8 = tid >> 6;
    float lff[8][2], lfbw[8][2], qv[8][2];
#pragma unroll
    for (int j = 0; j < 8; ++j) {
        const unsigned a = P.fa[j], c2 = P.fb[j], d = P.fq[j];
        lff[j][0] = h2f((unsigned short)(a & 0xffffu)); lff[j][1] = h2f((unsigned short)(a >> 16));
        lfbw[j][0] = h2f((unsigned short)(c2 & 0xffffu)); lfbw[j][1] = h2f((unsigned short)(c2 >> 16));
        qv[j][0] = bflo(d); qv[j][1] = bfhi(d);
    }
    float cf[8][2], cb[8][2];
#pragma unroll
    for (int e = 0; e < 2; ++e) {
        float a = 0.f;
#pragma unroll
        for (int j = 0; j < 8; ++j) { a += lff[j][e]; cf[j][e] = a; }
        a = 0.f;
#pragma unroll
        for (int j = 7; j >= 0; --j) { a += lfbw[j][e]; cb[j][e] = a; }
    }
    *(LAS f32x2*)(ptot + (0 * 8 + part8) * 128 + 2 * kp2) = (f32x2){cf[7][0], cf[7][1]};
    *(LAS f32x2*)(ptot + (1 * 8 + part8) * 128 + 2 * kp2) = (f32x2){cb[0][0], cb[0][1]};
    HG_LBAR();
    f32x2 offf = {0.f, 0.f}, offb = {0.f, 0.f}, Rf = {0.f, 0.f}, Rb = {0.f, 0.f};
#pragma unroll
    for (int q = 0; q < 8; ++q) {
        const f32x2 pfq = *(const LAS f32x2*)(ptot + (0 * 8 + q) * 128 + 2 * kp2), pbq = *(const LAS f32x2*)(ptot + (1 * 8 + q) * 128 + 2 * kp2);
        if (q < 4) Rf += pfq; else Rb += pbq;
        offf += (q < part8) ? pfq : (f32x2){0.f, 0.f};
        offb += (q > part8) ? pbq : (f32x2){0.f, 0.f};
    }
#pragma unroll
    for (int j = 0; j < 8; ++j) {
        const int i = 8 * part8 + j;
        float v[4][2];
#pragma unroll
        for (int e = 0; e < 2; ++e) {
            const float gf = cf[j][e] + (e ? offf.y : offf.x), gb = cb[j][e] + (e ? offb.y : offb.x);
            const float kf = 1.f - __builtin_amdgcn_exp2f(lff[j][e]), kb = 1.f - __builtin_amdgcn_exp2f(lfbw[j][e]);
            const float df = fminf(fmaxf(gf - (e ? Rf.y : Rf.x), -100.f), 100.f), db = fminf(fmaxf(gb - (e ? Rb.y : Rb.x), -100.f), 100.f);
            const float q = qv[j][e];
            const float e1 = __builtin_amdgcn_exp2f(df), e2 = __builtin_amdgcn_exp2f(db);
            v[0][e] = q * e1; v[1][e] = kf * __builtin_amdgcn_rcpf(e1);
            v[2][e] = q * e2; v[3][e] = kb * __builtin_amdgcn_rcpf(e2);
        }
        const int o = sw128(i, kp2 >> 2) + (kp2 & 3) * 4;
#pragma unroll
        for (int mtx = 0; mtx < 4; ++mtx) *(LAS unsigned*)(lds + mtx * 16384 + o) = cvt_pk_bf16(v[mtx][0], v[mtx][1]);
    }
#pragma unroll
    for (int dir = 0; dir < 2; ++dir) {
        f32x4 ra = {0.f, 0.f, 0.f, 0.f}, rb2 = {0.f, 0.f, 0.f, 0.f};
#pragma unroll
        for (int q = 0; q < 4; ++q) { const LAS float* pp = ptot + (dir * 8 + 4 * dir + q) * 128 + 8 * schunk; ra += *(const LAS f32x4*)pp; rb2 += *(const LAS f32x4*)(pp + 4); }
        float er[8];
        er[0] = __builtin_amdgcn_exp2f(ra.x); er[1] = __builtin_amdgcn_exp2f(ra.y); er[2] = __builtin_amdgcn_exp2f(ra.z); er[3] = __builtin_amdgcn_exp2f(ra.w);
        er[4] = __builtin_amdgcn_exp2f(rb2.x); er[5] = __builtin_amdgcn_exp2f(rb2.y); er[6] = __builtin_amdgcn_exp2f(rb2.z); er[7] = __builtin_amdgcn_exp2f(rb2.w);
#pragma unroll
        for (int i = 0; i < 4; ++i) {
            const u32x4 r = P.sraw[dir][i]; u32x4 w;
            w.x = cvt_pk_bf16(bflo(r.x) * er[0], bfhi(r.x) * er[1]); w.y = cvt_pk_bf16(bflo(r.y) * er[2], bfhi(r.y) * er[3]);
            w.z = cvt_pk_bf16(bflo(r.z) * er[4], bfhi(r.z) * er[5]); w.w = cvt_pk_bf16(bflo(r.w) * er[6], bfhi(r.w) * er[7]);
            *(LAS u32x4*)(STx + dir * 32768 + sw128(srow + 32 * i, schunk)) = w;
        }
    }
#pragma unroll
    for (int i = 0; i < 2; ++i) *(LAS u32x4*)(VTt + sw64((tid >> 3) + 64 * i, tid & 7)) = P.vraw[i];
    if (qctr != nullptr && wv == 0 && lane == 0) { ticket_wait(tk); ((volatile LAS unsigned*)(lds + LDSCTL_OFF))[16] = tk; }
    HG_LBAR();
    u32x4 gbv[2];
#pragma unroll
    for (int i = 0; i < 2; ++i) gbv[i] = *(const u32x4*)((const bf16_t*)(kargs()->ws + WS_GB) + (tok0 + (tid >> 4) + 32 * i) * 512 + h * 128 + 8 * (tid & 15));
    nidx = -1; npre = false;
    if (qctr != nullptr) {
        nidx = (int)((volatile LAS unsigned*)(lds + LDSCTL_OFF))[16] + qoff;
        if (nidx >= 72 && nidx < 200) { const int nh = (nidx - 72) >> 5, nlc = (nidx - 72) & 31;
            if ((acq_mask >> nh) & 1u) { out_load(P, b, nh, nlc, wv); npre = true; } }
    }
    f32x16 o;
#pragma unroll
    for (int r = 0; r < 16; ++r) o[r] = 0.f;
    const int prow = pi32(r32), vrow = 32 * vt + r32;
    bf16x8 vd[2], vo[2];
#pragma unroll
    for (int s2 = 0; s2 < 2; ++s2) { vd[s2] = *(const LAS bf16x8*)(VTt + sw64(vrow, 4 * tb + 2 * s2 + hi)); vo[s2] = *(const LAS bf16x8*)(VTt + sw64(vrow, 4 * (1 - tb) + 2 * s2 + hi)); }
#pragma unroll
    for (int dir = 0; dir < 2; ++dir) {
        const LAS unsigned char* Qx = lds + (2 * dir + 0) * 16384; const LAS unsigned char* Kx = lds + (2 * dir + 1) * 16384; const LAS unsigned char* Sx = STx + dir * 32768;
        bf16x8 qf[8], kd[8], sf[8];
#pragma unroll
        for (int ks = 0; ks < 8; ++ks) { qf[ks] = *(const LAS bf16x8*)(Qx + sw128(trow, 2 * ks + hi)); kd[ks] = *(const LAS bf16x8*)(Kx + sw128(32 * tb + prow, 2 * ks + hi)); }
#pragma unroll
        for (int ks = 0; ks < 8; ++ks) sf[ks] = *(const LAS bf16x8*)(Sx + sw128(vrow, 2 * ks + hi));
        f32x16 at;
#pragma unroll
        for (int r = 0; r < 16; ++r) at[r] = 0.f;
#pragma unroll
        for (int ks = 0; ks < 8; ++ks) at = __builtin_amdgcn_mfma_f32_32x32x16_bf16(kd[ks], qf[ks], at, 0, 0, 0);
#pragma unroll
        for (int r = 0; r < 16; ++r) { const int sl = 16 * (r >> 3) + 8 * hi + (r & 7); const bool keep = dir ? (sl >= r32) : (sl <= r32); at[r] = keep ? at[r] : 0.f; }
#pragma unroll
        for (int s2 = 0; s2 < 2; ++s2) {
            const u32x4 pw = (u32x4){cvt_pk_bf16(at[8 * s2], at[8 * s2 + 1]), cvt_pk_bf16(at[8 * s2 + 2], at[8 * s2 + 3]), cvt_pk_bf16(at[8 * s2 + 4], at[8 * s2 + 5]), cvt_pk_bf16(at[8 * s2 + 6], at[8 * s2 + 7])};
            o = __builtin_amdgcn_mfma_f32_32x32x16_bf16(vd[s2], __builtin_bit_cast(bf16x8, pw), o, 0, 0, 0);
        }
        if (dir != tb) {
#pragma unroll
            for (int ks = 0; ks < 8; ++ks) kd[ks] = *(const LAS bf16x8*)(Kx + sw128(32 * (1 - tb) + prow, 2 * ks + hi));
#pragma unroll
            for (int r = 0; r < 16; ++r) at[r] = 0.f;
#pragma unroll
            for (int ks = 0; ks < 8; ++ks) at = __builtin_amdgcn_mfma_f32_32x32x16_bf16(kd[ks], qf[ks], at, 0, 0, 0);
#pragma unroll
            for (int s2 = 0; s2 < 2; ++s2) {
                const u32x4 pw = (u32x4){cvt_pk_bf16(at[8 * s2], at[8 * s2 + 1]), cvt_pk_bf16(at[8 * s2 + 2], at[8 * s2 + 3]), cvt_pk_bf16(at[8 * s2 + 4], at[8 * s2 + 5]), cvt_pk_bf16(at[8 * s2 + 6], at[8 * s2 + 7])};
                o = __builtin_amdgcn_mfma_f32_32x32x16_bf16(vo[s2], __builtin_bit_cast(bf16x8, pw), o, 0, 0, 0);
            }
        }
#pragma unroll
        for (int ks = 0; ks < 8; ++ks) o = __builtin_amdgcn_mfma_f32_32x32x16_bf16(sf[ks], qf[ks], o, 0, 0, 0);
    }
    float ss = 0.f;
#pragma unroll
    for (int r = 0; r < 16; ++r) ss += o[r] * o[r];
    ss += shfl_xor_l(ss, 32, lane);
    if (hi == 0) ssx[vt * 64 + trow] = ss;
    HG_LBAR();
    const float tot = ssx[trow] + ssx[64 + trow] + ssx[128 + trow] + ssx[192 + trow];
    const float rstd = rsqrtf(tot * (1.f / 128.f) + EPS);
    LAS float* og = (LAS float*)lds;
#pragma unroll
    for (int g = 0; g < 4; ++g) {
        const int v = 32 * vt + 8 * g + 4 * hi;
        const f32x4 gn = *(const LAS f32x4*)((const LAS float*)(lds + 156672) + v);
        *(LAS f32x4*)(og + trow * 132 + v) = (f32x4){o[4 * g] * rstd * gn.x, o[4 * g + 1] * rstd * gn.y, o[4 * g + 2] * rstd * gn.z, o[4 * g + 3] * rstd * gn.w};
    }
    HG_LBAR();
#pragma unroll
    for (int i = 0; i < 2; ++i) {
        const int row = (tid >> 4) + 32 * i, ch = tid & 15;
        const f32x4 a = *(const LAS f32x4*)(og + row * 132 + 8 * ch), c = *(const LAS f32x4*)(og + row * 132 + 8 * ch + 4);
        const u32x4 g4 = gbv[i];
        u32x4 w; w.x = cvt_pk_bf16(a.x * bflo(g4.x), a.y * bfhi(g4.x)); w.y = cvt_pk_bf16(a.z * bflo(g4.y), a.w * bfhi(g4.y));
        w.z = cvt_pk_bf16(c.x * bflo(g4.z), c.y * bfhi(g4.z)); w.w = cvt_pk_bf16(c.z * bflo(g4.w), c.w * bfhi(g4.w));
        if (!dry) *(u32x4*)((bf16_t*)(kargs()->ws + WS_Y) + (tok0 + row) * 1024 + 512 + h * 128 + 8 * ch) = w;
    }
    HG_BAR();
    if (npre) out_settle(P);
}
}
template <size_t OFFA, size_t OFFB> struct OutOrder {
    int G, c;
    __device__ __forceinline__ bool next(int i, pg8::Unit& u) const {
        const int L = i * G + c; if (L >= 256) return false;
        const char* wsb = (const char*)kargs()->ws; const char* A = wsb + OFFA; const char* Bt = wsb + OFFB;
        constexpr size_t TSTEP = (size_t)256 * DM * 2;
        const int xcd = L % 8, offp = L / 8; const int wgid = xcd * 32 + offp;
        u.pm = xcd * 8 + (wgid % 32) % 8; u.pn = (wgid % 32) / 8; u.a = A + (size_t)u.pm * TSTEP; u.b = Bt + (size_t)u.pn * TSTEP; u.ty = 0; u.aux = 0; return true;
    }
};
struct EpiP4 {
    __device__ __forceinline__ void operator()(const f32x4 (&acc)[2][2][4][2], const pg8::Unit& u, int wr, int wc, int fr, int fq, int lane) const {
        KArgsPtr ka = kargs(); unsigned char* wsb = ka->ws; const float* x = ka->in[0]; bf16_t* x1b = (bf16_t*)(wsb + WS_X1B); const float* gain1 = ka->in[4] + 1024;
        bf16_t* A1 = (bf16_t*)(wsb + WS_A1); float* SSQ1 = (float*)(wsb + WS_SSQ1); const float* mod = (const float*)(wsb + WS_MISC) + MI_MOD;
        const int b = u.pm >> 3;
        const int col0 = 256 * u.pn + 32 * wc + 8 * fq;
        f32x4 gt[2][2], gm[2][2];
#pragma unroll
        for (int bj = 0; bj < 2; ++bj)
#pragma unroll
            for (int n = 0; n < 2; ++n) { const int c = col0 + 128 * bj + 4 * n;
                gt[bj][n] = *(const f32x4*)(mod + (0 * 9 + b) * 3072 + 2048 + c);
                gm[bj][n] = *(const f32x4*)(gain1 + c) * (*(const f32x4*)(mod + (9 + b) * 3072 + 1024 + c) + 1.f); }
        const float* xbase = x + ((size_t)u.pm * 256 + 64 * wr + fr) * 1024 + col0;
        f32x4 xr[3][4];
#define P4_LDX(it) do { const float* xp_ = xbase + (size_t)(128 * ((it) >> 2) + 16 * ((it) & 3)) * 1024; \
            xr[(it) % 3][0] = *(const f32x4*)(xp_); xr[(it) % 3][1] = *(const f32x4*)(xp_ + 4); xr[(it) % 3][2] = *(const f32x4*)(xp_ + 128); xr[(it) % 3][3] = *(const f32x4*)(xp_ + 132); } while (0)
        P4_LDX(0); P4_LDX(1);
#pragma unroll
        for (int it = 0; it < 8; ++it) {
            if (it + 2 < 8) P4_LDX(it + 2);
            __builtin_amdgcn_sched_barrier(0);
            const int ai = it >> 2, m = it & 3;
            {
                const size_t row = (size_t)u.pm * 256 + 128 * ai + 64 * wr + 16 * m + fr;
                float ss = 0.f;
#pragma unroll
                for (int bj = 0; bj < 2; ++bj) {
                    const size_t o = row * 1024 + col0 + 128 * bj;
                    const f32x4 xa = xr[it % 3][2 * bj], xb = xr[it % 3][2 * bj + 1];
                    const f32x4 v0 = xa + gt[bj][0] * acc[ai][bj][m][0], v1 = xb + gt[bj][1] * acc[ai][bj][m][1];
                    { u32x4 xw; xw.x = cvt_pk_bf16(v0.x, v0.y); xw.y = cvt_pk_bf16(v0.z, v0.w); xw.z = cvt_pk_bf16(v1.x, v1.y); xw.w = cvt_pk_bf16(v1.z, v1.w); *(u32x4*)(x1b + o) = xw; }
                    ss += (v0.x * v0.x + v0.y * v0.y) + (v0.z * v0.z + v0.w * v0.w) + (v1.x * v1.x + v1.y * v1.y) + (v1.z * v1.z + v1.w * v1.w);
                    const f32x4 a0 = v0 * gm[bj][0], a1 = v1 * gm[bj][1];
                    u32x4 w; w.x = cvt_pk_bf16(a0.x, a0.y); w.y = cvt_pk_bf16(a0.z, a0.w); w.z = cvt_pk_bf16(a1.x, a1.y); w.w = cvt_pk_bf16(a1.z, a1.w);
                    *(u32x4*)(A1 + o) = w;
                }
                ss += __shfl_xor(ss, 16); ss += __shfl_xor(ss, 32);
                if (fq == 0) SSQ1[row * 16 + u.pn * 4 + wc] = ss;
            }
            __builtin_amdgcn_sched_barrier(0);
        }
#undef P4_LDX
    }
};
struct EpiP7 {
    __device__ __forceinline__ void operator()(const f32x4 (&acc)[2][2][4][2], const pg8::Unit& u, int wr, int wc, int fr, int fq, int lane) const {
        KArgsPtr ka = kargs(); float* outp = ka->out; const bf16_t* x1b = (const bf16_t*)(ka->ws + WS_X1B); const float* mod = (const float*)(ka->ws + WS_MISC) + MI_MOD;
        const int b = u.pm >> 3;
        const int col0 = 256 * u.pn + 32 * wc + 8 * fq;
        f32x4 gt[2][2];
#pragma unroll
        for (int bj = 0; bj < 2; ++bj)
#pragma unroll
            for (int n = 0; n < 2; ++n) gt[bj][n] = *(const f32x4*)(mod + (9 + b) * 3072 + 2048 + col0 + 128 * bj + 4 * n);
        u32x4 xq[8][2];
#pragma unroll
        for (int it = 0; it < 8; ++it)
#pragma unroll
            for (int bj = 0; bj < 2; ++bj) xq[it][bj] = *(const u32x4*)(x1b + ((size_t)u.pm * 256 + 128 * (it >> 2) + 64 * wr + 16 * (it & 3) + fr) * 1024 + col0 + 128 * bj);
        __builtin_amdgcn_sched_barrier(0);
#pragma unroll
        for (int ai = 0; ai < 2; ++ai)
#pragma unroll
            for (int m = 0; m < 4; ++m) {
                const size_t row = (size_t)u.pm * 256 + 128 * ai + 64 * wr + 16 * m + fr;
#pragma unroll
                for (int bj = 0; bj < 2; ++bj) {
                    const size_t o = row * 1024 + col0 + 128 * bj;
                    const u32x4 xw = xq[ai * 4 + m][bj];
                    const f32x4 xa = (f32x4){bflo(xw.x), bfhi(xw.x), bflo(xw.y), bfhi(xw.y)}, xb = (f32x4){bflo(xw.z), bfhi(xw.z), bflo(xw.w), bfhi(xw.w)};
                    *(f32x4*)(outp + o) = xa + gt[bj][0] * acc[ai][bj][m][0]; *(f32x4*)(outp + o + 4) = xb + gt[bj][1] * acc[ai][bj][m][1];
                }
            }
    }
};

struct P5Order {
    int G, c;
    __device__ __forceinline__ bool next(int i, pg8::Unit& u) const {
        const int L = i * G + c; if (L >= 768) return false;
        const char* wsb = (const char*)kargs()->ws; const char* A1 = wsb + WS_A1; const char* Wt1 = wsb + WS_WT1;
        constexpr size_t TSTEP = (size_t)256 * DM * 2;
        const int xcd = L % 8, offp = L / 8; const int wgid = xcd * 96 + offp;
        u.pm = xcd * 8 + (wgid % 96) % 8; u.pn = (wgid % 96) / 8; u.a = A1 + (size_t)u.pm * TSTEP; u.b = Wt1 + (size_t)u.pn * TSTEP; u.ty = 0; u.aux = 0; return true;
    }
};
struct P5HalfOrder {
    int G, c;
    __device__ __forceinline__ bool next(int i, pg8::Unit& u) const {
        const int L = i * G + c; if (L >= 256) return false;
        const char* wsb = (const char*)kargs()->ws; const char* A1 = wsb + WS_A1; const char* Wt1 = wsb + WS_WT1;
        constexpr size_t TSTEP = (size_t)256 * DM * 2;
        const int xcd = L % 8, j = L / 8; u.pn = xcd * 16 + j / 2; u.pm = j % 2;
        u.a = Wt1 + (size_t)(12 + u.pm) * TSTEP; u.b = A1 + (size_t)u.pn * (TSTEP / 2); u.ty = 1; u.aux = 0; return true;
    }
};
__device__ __forceinline__ float gelu_as(float v) {
    const float av = fabsf(v), t = __builtin_amdgcn_rcpf(av * 0.2316418882f + 1.0f);
    float q = t * 0.5307027145f + (-0.7265760135f); q = q * t + 0.7107068705f; q = q * t + (-0.142248368f); q = q * t + 0.127414796f; q = q * t;
    const float e = __builtin_amdgcn_exp2f((v * v) * (-0.72134752044f));
    const float mm = v * (q * e);
    return v < 0.f ? mm : v - mm;
}
__device__ __forceinline__ float rstd16(const float* SSQ1, size_t row) {
    const f32x4* p = (const f32x4*)(SSQ1 + row * 16);
    const f32x4 a = p[0], b = p[1], c = p[2], d = p[3];
    const float s = ((a.x + a.y) + (a.z + a.w)) + ((b.x + b.y) + (b.z + b.w)) + ((c.x + c.y) + (c.z + c.w)) + ((d.x + d.y) + (d.z + d.w));
    return rsqrtf(s * (1.f / 1024.f) + EPS);
}
struct EpiP5 {
    const LAS float* rst; int tpm;
    __device__ __forceinline__ void operator()(const f32x4 (&acc)[2][2][4][2], const pg8::Unit& u, int wr, int wc, int fr, int fq, int lane) const {
        unsigned char* wsb = kargs()->ws; bf16_t* UG = (bf16_t*)(wsb + WS_UG); bf16_t* GVT = (bf16_t*)(wsb + WS_GVT); float* GVSSQ = (float*)(wsb + WS_GVSSQ);
        const float* ssq1 = (const float*)(wsb + WS_SSQ1); const float* bias1 = (const float*)(wsb + WS_MISC) + MI_BIAS1;
        if (u.ty == 0) {
            const int b = u.pm >> 3;
            const int kind = u.pn >> 2, pq = u.pn & 3;
            const float* bp = bias1 + b * OIN + 256 * u.pn + 32 * wc + 8 * fq;
            bf16_t* base = UG + (size_t)kind * (8u << 20) + 128 * pq + 32 * wc + 8 * fq;
#pragma unroll
            for (int ai = 0; ai < 2; ++ai)
#pragma unroll
                for (int m = 0; m < 4; ++m) {
                    const size_t row = (size_t)u.pm * 256 + 128 * ai + 64 * wr + 16 * m + fr;
                    float rs = (u.pm == tpm) ? rst[128 * ai + 64 * wr + 16 * m + fr] : rstd16(ssq1, row); asm volatile("" : "+v"(rs));
                    f32x4 b00, b01, b10, b11;
                    if (u.pm == tpm) { const LAS float* bl = rst + 384 + 256 * u.pn + 32 * wc + 8 * fq; b00 = *(const LAS f32x4*)(bl); b01 = *(const LAS f32x4*)(bl + 4); b10 = *(const LAS f32x4*)(bl + 128); b11 = *(const LAS f32x4*)(bl + 132); }
                    else { b00 = *(const f32x4*)(bp); b01 = *(const f32x4*)(bp + 4); b10 = *(const f32x4*)(bp + 128); b11 = *(const f32x4*)(bp + 132); }
                    const f32x4 p0 = acc[ai][0][m][0] * rs + b00, p1 = acc[ai][0][m][1] * rs + b01, q0 = acc[ai][1][m][0] * rs + b10, q1 = acc[ai][1][m][1] * rs + b11;
                    float o[8];
#pragma unroll
                    for (int j = 0; j < 4; ++j) {
                        if (kind == 0) { o[j] = gelu_as(p0[j]) * silu_fast(q0[j]); o[4 + j] = gelu_as(p1[j]) * silu_fast(q1[j]); }
                        else if (kind == 1) { o[j] = p0[j] * silu_fast(q0[j]); o[4 + j] = p1[j] * silu_fast(q1[j]); }
                        else { o[j] = p0[j] * q0[j]; o[4 + j] = p1[j] * q1[j]; }
                    }
                    u32x4 w; w.x = cvt_pk_bf16(o[0], o[1]); w.y = cvt_pk_bf16(o[2], o[3]); w.z = cvt_pk_bf16(o[4], o[5]); w.w = cvt_pk_bf16(o[6], o[7]);
                    *(u32x4*)(base + row * 512) = w;
                    __builtin_amdgcn_sched_barrier(0);
                }
        }
    }
};
struct EpiP5H {
    const LAS float* rsth; int tpn, tpmh;
    __device__ __forceinline__ void operator()(const f32x4 (&acc)[2][2][4][2], const pg8::Unit& u, int wr, int wc, int fr, int fq, int lane) const {
        unsigned char* wsb = kargs()->ws; bf16_t* GVT = (bf16_t*)(wsb + WS_GVT); float* GVSSQ = (float*)(wsb + WS_GVSSQ);
        const float* ssq1 = (const float*)(wsb + WS_SSQ1); const float* bias1 = (const float*)(wsb + WS_MISC) + MI_BIAS1;
        {
            const int b = u.pn >> 4;
            { constexpr int bj = 0;
                int opq = 0; asm volatile("" : "+s"(opq));
                const size_t tokc = (size_t)u.pn * 128 + 32 * wc + 8 * fq + opq;
                float rs[8], gs[8];
                if (u.pn == tpn) {
#pragma unroll
                    for (int e = 0; e < 8; ++e) { rs[e] = rsth[32 * wc + 8 * fq + e]; gs[e] = 0.f; }
                } else {
#pragma unroll
                for (int e = 0; e < 8; ++e) { rs[e] = rstd16(ssq1, tokc + e); gs[e] = 0.f; asm volatile("" : "+v"(rs[e])); __builtin_amdgcn_sched_barrier(0); }
                }
#pragma unroll
                for (int ai = 0; ai < 2; ++ai)
#pragma unroll
                    for (int m = 0; m < 4; ++m) {
                        const int f = u.pm * 256 + 128 * ai + 64 * wr + 16 * m + fr + opq;
                        const float bias = (u.pn == tpn && u.pm == tpmh) ? rsth[128 + 3072 + 128 * ai + 64 * wr + 16 * m + fr] : bias1[b * OIN + 3072 + f];
                        bf16_t* rowp = GVT + ((size_t)(b * 4 + (f >> 7)) * 128 + (f & 127)) * GVP + (u.pn & 15) * 128 + 32 * wc + 8 * fq;
                        float o[8];
#pragma unroll
                        for (int n = 0; n < 2; ++n)
#pragma unroll
                            for (int j = 0; j < 4; ++j) { const float gv = gelu_as(acc[ai][bj][m][n][j] * rs[4 * n + j] + bias); o[4 * n + j] = gv; gs[4 * n + j] += gv * gv; }
                        u32x4 w; w.x = cvt_pk_bf16(o[0], o[1]); w.y = cvt_pk_bf16(o[2], o[3]); w.z = cvt_pk_bf16(o[4], o[5]); w.w = cvt_pk_bf16(o[6], o[7]);
                        *(u32x4*)(rowp) = w;
                        __builtin_amdgcn_sched_barrier(0);
                    }
#pragma unroll
                for (int e = 0; e < 8; ++e) {
                    float s = gs[e];
                    s += __shfl_xor(s, 1); s += __shfl_xor(s, 2); s += __shfl_xor(s, 4); s += __shfl_xor(s, 8);
                    if (fr == 0) GVSSQ[(tokc + e) * 4 + u.pm * 2 + wr] = s;
                    __builtin_amdgcn_sched_barrier(0);
                }
            }
        }
    }
};

__device__ __forceinline__ int gsw(int r, int c) { return r * 256 + ((c ^ (r & 15)) << 4); }
struct GmlpRegs { u32x4 ta[4], tw[4], tu[4]; f32x4 ssq; };
__device__ __forceinline__ void gmlp_load(GmlpRegs& R, int b, int ch, int g, const bf16_t* GVT, const float* GVSSQ, const bf16_t* Wsb, const bf16_t* UG, const int wv) {
    const int lane = lane_id(), tid = wv * 64 + lane;
    const size_t tokc = (size_t)b * SEQ + ch * 128;
    const int chunk = tid & 15, rb = tid >> 4;
#pragma unroll
    for (int i = 0; i < 4; ++i) { const int row = rb + 32 * i;
        R.ta[i] = *(const u32x4*)(GVT + ((size_t)(b * 4 + g) * 128 + row) * GVP + ch * 128 + 8 * chunk);
        R.tw[i] = *(const u32x4*)(Wsb + ((size_t)g * 128 + row) * 128 + 8 * chunk);
        R.tu[i] = *(const u32x4*)(UG + (tokc + row) * 512 + g * 128 + 8 * chunk); }
    R.ssq = *(const f32x4*)(GVSSQ + (tokc + (tid & 127)) * 4);
}
__device__ __forceinline__ void gmlp_unit(const GmlpRegs& R, int b, int ch, int g, const float* v_g, const float* b_s, bf16_t* Y1, LAS unsigned char* lds, const int wv) {
    const int lane = lane_id(), tid = wv * 64 + lane, r32 = lane & 31, hi = lane >> 5;
    const int wid = wv;
    const int dt = wid & 3, th = wid >> 2;
    LAS unsigned char* At = lds; LAS unsigned char* Wt = lds + 32768; LAS unsigned char* Ut = lds + 65536;
    LAS float* rsd = (LAS float*)(lds + 98304);
    const size_t tokc = (size_t)b * SEQ + ch * 128;
    {
        const int chunk = tid & 15, rb = tid >> 4;
        if (tid < 128) { const f32x4 p = R.ssq; rsd[tid] = rsqrtf(((p.x + p.y) + (p.z + p.w)) * (1.f / 512.f) + EPS); }
#pragma unroll
        for (int i = 0; i < 4; ++i) { const int row = rb + 32 * i; *(LAS u32x4*)(At + gsw(row, chunk)) = R.ta[i]; *(LAS u32x4*)(Wt + gsw(row, chunk)) = R.tw[i]; *(LAS u32x4*)(Ut + gsw(row, chunk)) = R.tu[i]; }
    }
    float bsf[2]; f32x4 vgf[4];
#pragma unroll
    for (int tt = 0; tt < 2; ++tt) bsf[tt] = b_s[g * 128 + 32 * (2 * th + tt) + r32];
#pragma unroll
    for (int q = 0; q < 4; ++q) vgf[q] = *(const f32x4*)(v_g + g * 128 + 32 * dt + 8 * q + 4 * hi);
    asm volatile("s_waitcnt lgkmcnt(0)\n\ts_barrier" ::: "memory");
    f32x16 acc[2];
#pragma unroll
    for (int i = 0; i < 2; ++i)
#pragma unroll
        for (int r = 0; r < 16; ++r) acc[i][r] = 0.f;
    bf16x8 af[8]; u32x4 wf[2][8];
#pragma unroll
    for (int ks = 0; ks < 8; ++ks) { af[ks] = *(const LAS bf16x8*)(At + gsw(32 * dt + r32, 2 * ks + hi));
#pragma unroll
        for (int tt = 0; tt < 2; ++tt) wf[tt][ks] = *(const LAS u32x4*)(Wt + gsw(32 * (2 * th + tt) + r32, 2 * ks + hi)); }
#pragma unroll
    for (int ks = 0; ks < 8; ++ks) {
        const f32x4 r0 = *(const LAS f32x4*)(rsd + 16 * ks + 8 * hi), r1 = *(const LAS f32x4*)(rsd + 16 * ks + 8 * hi + 4);
#pragma unroll
        for (int tt = 0; tt < 2; ++tt) {
            const u32x4 wv4 = wf[tt][ks];
            u32x4 ws2;
            ws2.x = cvt_pk_bf16(bflo(wv4.x) * r0.x, bfhi(wv4.x) * r0.y); ws2.y = cvt_pk_bf16(bflo(wv4.y) * r0.z, bfhi(wv4.y) * r0.w);
            ws2.z = cvt_pk_bf16(bflo(wv4.z) * r1.x, bfhi(wv4.z) * r1.y); ws2.w = cvt_pk_bf16(bflo(wv4.w) * r1.z, bfhi(wv4.w) * r1.w);
            acc[tt] = __builtin_amdgcn_mfma_f32_32x32x16_bf16(af[ks], __builtin_bit_cast(bf16x8, ws2), acc[tt], 0, 0, 0);
        }
    }
#pragma unroll
    for (int tt = 0; tt < 2; ++tt) {
        const int t = 32 * (2 * th + tt) + r32;
        const float bs = bsf[tt];
#pragma unroll
        for (int q = 0; q < 4; ++q) {
            LAS u32x2* up = (LAS u32x2*)(Ut + gsw(t, 4 * dt + q) + 8 * hi);
            const f32x4 vg = vgf[q];
            const u32x2 ug = *up;
            u32x2 w;
            w.x = cvt_pk_bf16(bflo(ug.x) * (vg.x * acc[tt][4 * q] + bs), bfhi(ug.x) * (vg.y * acc[tt][4 * q + 1] + bs));
            w.y = cvt_pk_bf16(bflo(ug.y) * (vg.z * acc[tt][4 * q + 2] + bs), bfhi(ug.y) * (vg.w * acc[tt][4 * q + 3] + bs));
            *up = w;
        }
    }
    asm volatile("s_waitcnt lgkmcnt(0)\n\ts_barrier" ::: "memory");
    {
        const int chunk = tid & 15, rb = tid >> 4;
#pragma unroll
        for (int i = 0; i < 4; ++i) { const int row = rb + 32 * i; *(u32x4*)(Y1 + (tokc + row) * 1024 + g * 128 + 8 * chunk) = *(const LAS u32x4*)(Ut + gsw(row, chunk)); }
    }
    asm volatile("s_waitcnt lgkmcnt(0)\n\ts_barrier" ::: "memory");
}
struct ConvRegs { u32x4 chv[10], bgv[8]; };
__device__ __forceinline__ void conv_load(ConvRegs& R, int row0, const bf16_t* BG, const bf16_t* CH, int lane) {
    const bool top = (row0 & 2047) == 0, bot = ((row0 + 7) & 2047) == 2047;
    R.chv[0] = *(const u32x4*)(CH + (size_t)(top ? row0 : row0 - 1) * 512 + 8 * lane);
#pragma unroll
    for (int i = 0; i < 8; ++i) { R.chv[i + 1] = *(const u32x4*)(CH + (size_t)(row0 + i) * 512 + 8 * lane); R.bgv[i] = *(const u32x4*)(BG + (size_t)(row0 + i) * 512 + 8 * lane); }
    R.chv[9] = *(const u32x4*)(CH + (size_t)(bot ? row0 + 7 : row0 + 8) * 512 + 8 * lane);
}
__device__ __forceinline__ void conv_finish(const ConvRegs& R, int row0, const float* conv_w, bf16_t* Y1, int lane) {
    const bool top = (row0 & 2047) == 0, bot = ((row0 + 7) & 2047) == 2047;
    float w[3][8];
#pragma unroll
    for (int j = 0; j < 3; ++j) { const f32x4 a = *(const f32x4*)(conv_w + j * 512 + 8 * lane), bq = *(const f32x4*)(conv_w + j * 512 + 8 * lane + 4);
        w[j][0] = a.x; w[j][1] = a.y; w[j][2] = a.z; w[j][3] = a.w; w[j][4] = bq.x; w[j][5] = bq.y; w[j][6] = bq.z; w[j][7] = bq.w; }
#pragma unroll
    for (int i = 0; i < 8; ++i) {
        float o[8];
#pragma unroll
        for (int e = 0; e < 4; ++e) {
            const unsigned pw = (i == 0 && top) ? 0u : R.chv[i][e], cw = R.chv[i + 1][e], nw = (i == 7 && bot) ? 0u : R.chv[i + 2][e], bw = R.bgv[i][e];
            o[2 * e] = bflo(bw) * (w[0][2 * e] * bflo(pw) + w[1][2 * e] * bflo(cw) + w[2][2 * e] * bflo(nw));
            o[2 * e + 1] = bfhi(bw) * (w[0][2 * e + 1] * bfhi(pw) + w[1][2 * e + 1] * bfhi(cw) + w[2][2 * e + 1] * bfhi(nw));
        }
        u32x4 wv; wv.x = cvt_pk_bf16(o[0], o[1]); wv.y = cvt_pk_bf16(o[2], o[3]); wv.z = cvt_pk_bf16(o[4], o[5]); wv.w = cvt_pk_bf16(o[6], o[7]);
        *(u32x4*)(Y1 + (size_t)(row0 + i) * 1024 + 512 + 8 * lane) = wv;
    }
}
#ifndef DIAG
#define DIAG 0
#endif
constexpr int N_PHASES = 9;
#ifndef REP
#define REP -1
#endif
#ifndef NDRY
#define NDRY 1
#endif

__global__ void __launch_bounds__(NTHR, 2) mk_fwd(Args args) {
    extern __shared__ __attribute__((aligned(16))) unsigned char lds_raw[];
    Frame F;
#define FRAME_LOAD() do { KArgsPtr ka_ = kargs(); \
    F.lds = (LAS unsigned char*)lds_raw; F.MISC = (volatile LAS unsigned*)(F.lds + LDSCTL_OFF); \
    F.wave = wave0; F.lane = lane_id(); F.tid = wave0 * 64 + F.lane; \
    F.G = gridDim.x; { const int bx = blockIdx.x; F.vcu = (F.G % 8 == 0) ? (bx % 8) * (F.G / 8) + bx / 8 : bx; } \
    F.ws = ka_->ws; F.ctl = (unsigned*)(F.ws + WS_CTL); F.misc = (float*)(F.ws + WS_MISC); F.out = ka_->out; \
    F.x = ka_->in[0]; F.c = ka_->in[1]; F.ctx = ka_->in[2]; F.c_ctx = ka_->in[3]; F.norm_gain = ka_->in[4]; F.ada_w = ka_->in[5]; F.ada_b = ka_->in[6]; \
    F.even_w_in = ka_->in[7]; F.even_w_out = ka_->in[8]; F.qk_gain = ka_->in[9]; F.lam_p = ka_->in[10]; F.subln_g = ka_->in[11]; F.lb_logits = ka_->in[12]; F.hgrn_g = ka_->in[13]; \
    F.odd_w_in = ka_->in[14]; F.odd_w_out = ka_->in[15]; F.v_g = ka_->in[16]; F.w_s = ka_->in[17]; F.b_s = ka_->in[18]; F.conv_w = ka_->in[19]; } while (0)
    const int wave0 = __builtin_amdgcn_readfirstlane(threadIdx.x >> 6);
    FRAME_LOAD();
    for (int u = F.tid; u < (LDS_BYTES - LDSCTL_OFF) / 4; u += NTHR) ((LAS unsigned*)(F.lds + LDSCTL_OFF))[u] = 0u;
    __syncthreads();
    XcdBarrier bar = xcd_barrier_post(F.ctl + CW_BAR, F.MISC + 8, F.tid);
    if (F.tid == 0) __hip_atomic_store(F.ctl + CW_XCC + (int)blockIdx.x, xb_xcc_id() + 1u, __ATOMIC_RELAXED, __HIP_MEMORY_SCOPE_AGENT);
    bool light_ok = false;
    const int lo = args.ph_lo, hi = args.ph_hi;
#ifdef ONLYPH
#define IN(k) ((k) == ONLYPH && lo <= (k) && (k) < hi)
#else
#define IN(k) (lo <= (k) && (k) < hi)
#endif
#define BOTH(k) (IN(k) && IN((k) + 1))
#if DIAG == 10
#define STAMP(k) do { if (blockIdx.x == 0 && wave0 == 0 && lane_id() == 0) ((unsigned long long*)(kargs()->ws + WS_CTL + 900000))[k] = __builtin_amdgcn_s_memrealtime(); } while (0)
#else
#define STAMP(k) do {} while (0)
#endif
#define GRID_BAR() xcd_barrier(bar, wave0 * 64 + lane_id())
#define LIGHT_BAR(site) do { if (light_ok) group_barrier_light((unsigned*)(kargs()->ws + WS_CTL) + CW_GRP + 128 * ((site) * 8 + ((int)blockIdx.x & 7)), 32u, wave0 * 64 + lane_id()); else xcd_barrier(bar, wave0 * 64 + lane_id()); } while (0)
    unsigned char* ws;

    STAMP(0);
    if (IN(0)) { for (int rep = 0; rep < (REP == 0 ? 2 : 1); ++rep) { FRAME_LOAD(); p0_prologue(F); if (REP == 0 && rep == 0) GRID_BAR(); } STAMP(1); }
    if (IN(1)) {
        for (int rep = 0; rep < (REP == 1 ? 2 : 1); ++rep) { FRAME_LOAD(); p0b_phase(F); if (REP == 1 && rep == 0) GRID_BAR(); }
        if (BOTH(1)) {
            FRAME_LOAD();
            if (wave0 == 0) { unsigned sp = 0u;
                while (__hip_atomic_load(F.ctl + CW_W0, __ATOMIC_RELAXED, __HIP_MEMORY_SCOPE_AGENT) < 64u && ++sp < (1u << 22)) __builtin_amdgcn_s_sleep(2);
                __builtin_amdgcn_fence(__ATOMIC_ACQUIRE, "agent"); asm volatile("s_waitcnt vmcnt(0)" ::: "memory"); }
            { const int ln = lane_id(); bool bad = false;
#pragma unroll
              for (int q = 0; q < 4; ++q) { const int i = ln + 64 * q;
                  const unsigned a = (i < (int)gridDim.x) ? __hip_atomic_load(F.ctl + CW_XCC + i, __ATOMIC_RELAXED, __HIP_MEMORY_SCOPE_AGENT) : 1u;
                  const unsigned r = (i < (int)gridDim.x) ? __hip_atomic_load(F.ctl + CW_XCC + (i & 7), __ATOMIC_RELAXED, __HIP_MEMORY_SCOPE_AGENT) : 1u;
                  bad = bad || (a != r) || (a == 0u); }
              light_ok = ((int)gridDim.x == 256) && (__builtin_amdgcn_ballot_w64(bad) == 0ull); }
            LIGHT_BAR(4);
        }
        STAMP(2);
    }
    if (IN(2)) {
        FRAME_LOAD(); ws = F.ws;
        LAS float* tab = (LAS float*)(F.lds + 131072);
        { const float* miscp = (const float*)(ws + WS_MISC); const float* qkg = kargs()->in[9];
          float tv[6]; const float qg = qkg[F.tid & 127];
#pragma unroll
          for (int k = 0; k < 6; ++k) tv[k] = miscp[MI_CS + F.tid + 512 * k];
#pragma unroll
          for (int k = 0; k < 4; ++k) tab[F.tid + 512 * k] = tv[k];
          if (F.tid < 128) tab[2048 + F.tid] = qg;
          tab[2176 + F.tid] = tv[4]; tab[2176 + 512 + F.tid] = tv[5];
          __syncthreads(); }
        P1Order S{F.G, (int)blockIdx.x}; EpiP1 E{tab};
        for (int rep = 0; rep < (REP == 2 ? 2 : 1); ++rep) { pg8::gemm_phase<EpiP1, P1Order>(F.lds, DM, S, E, wave0); if (REP == 2 && rep == 0) GRID_BAR(); }
        if ((int)blockIdx.x >= 208) { FRAME_LOAD(); weight_copies(F, 1, ((int)blockIdx.x - 208) * NWAVES + F.wave, 48 * NWAVES); }
        if (BOTH(2)) LIGHT_BAR(3);
        STAMP(3);
    }
    if (IN(3)) {
        FRAME_LOAD(); ws = F.ws;
        const int g = blockIdx.x & 7;
        const float lam = __uint_as_float(__hip_atomic_load((unsigned*)(F.misc + MI_SCAL), __ATOMIC_RELAXED, __HIP_MEMORY_SCOPE_AGENT));
        const float M2 = __uint_as_float(__hip_atomic_load((unsigned*)(F.misc + MI_SCAL + 1), __ATOMIC_RELAXED, __HIP_MEMORY_SCOPE_AGENT));
        for (int rep = 0; rep < ((REP == 3 || REP == 30 || REP == 31) ? 2 : (REP == 32 ? 1 + NDRY : 1)); ++rep) {
        const bool dry = (REP == 3 || REP == 30 || REP == 31) ? (rep == 0) : (REP == 32 ? rep < NDRY : false);
        unsigned acq_mask = 0u;
        bool have = false;
        constexpr bool EARLY = (REP < 0 || REP == 32);
        int first_out = 200;
        const int QOFF = EARLY ? ((int)gridDim.x + 7 - g) / 8 : 0;
        bool first = EARLY;
        for (;;) {
            if (!have && !first) {
                if (wave0 == 0 && lane_id() == 0) ((volatile LAS unsigned*)((LAS unsigned char*)lds_raw + LDSCTL_OFF))[16] = __hip_atomic_fetch_add((unsigned*)(kargs()->ws + WS_CTL) + CW_QUEUE + 64 * (g + 8 * rep), 1u, __ATOMIC_RELAXED, __HIP_MEMORY_SCOPE_AGENT);
                __syncthreads();
            }
            const int idx = first ? ((int)blockIdx.x >> 3) : (int)((volatile LAS unsigned*)((LAS unsigned char*)lds_raw + LDSCTL_OFF))[16] + QOFF;
            if (!have && !first) __syncthreads();
            first = false;
            have = EARLY;
            unsigned* qc = EARLY ? (unsigned*)(kargs()->ws + WS_CTL) + CW_QUEUE + 64 * (g + 8 * rep) : nullptr;
            if (idx >= 72) { first_out = idx; break; }
            if (REP == 30 && rep == 0 && idx < 8) { have = false; continue; }
            if (REP == 32 && dry && idx < 72) { have = false; continue; }
            if (REP == 31 && rep == 0 && idx >= 8) break;
            if (idx < 8) {
                const int cch = g * 8 + idx;
                { unsigned char* w2 = kargs()->ws;
                  hg::state_chain(cch >> 3, (cch >> 1) & 3, cch & 1, (const unsigned short*)(w2 + WS_LF), (const bf16_t*)(w2 + WS_HVT), (bf16_t*)(w2 + WS_ST), (LAS unsigned char*)lds_raw, wave0, qc); }
                if (wave0 == 0 && lane_id() == 0) { __builtin_amdgcn_fence(__ATOMIC_RELEASE, "agent"); asm volatile("s_waitcnt vmcnt(0)" ::: "memory");
                    __hip_atomic_store((unsigned*)(kargs()->ws + WS_CTL) + CW_FLAG + 64 * cch + 16 * rep, 1u, __ATOMIC_RELAXED, __HIP_MEMORY_SCOPE_AGENT); }
            } else {
                const int j = idx - 8; const int pair = g * 4 + (j >> 4), qb = j & 15;
                KArgsPtr ka2 = kargs(); unsigned char* w2 = ka2->ws;
                att::attn_unit(pair >> 2, pair & 3, qb, (bf16_t*)(w2 + WS_Y), (const bf16_t*)(w2 + WS_KC), (const bf16_t*)(w2 + WS_VT), (const bf16_t*)(w2 + WS_GA), ka2->in[11], lam, M2, (LAS unsigned char*)lds_raw, wave0, dry, qc);
            }
        }
        if (first_out < 200 && !((REP == 30 || REP == 31) && rep == 0)) {
            unsigned* qc = EARLY ? (unsigned*)(kargs()->ws + WS_CTL) + CW_QUEUE + 64 * (g + 8 * rep) : nullptr;
            hg::OutPre P; bool pre = false; int cur = first_out;
            { unsigned z0 = 0u; asm volatile("" : "+v"(z0));
#pragma unroll
              for (int j0 = 0; j0 < 8; ++j0) { P.fa[j0] = z0; P.fb[j0] = z0; P.fq[j0] = z0; P.sraw[j0 >> 2][j0 & 3] = (u32x4){z0, z0, z0, z0}; if (j0 < 2) P.vraw[j0] = (u32x4){z0, z0, z0, z0}; } }
            { const float* hg_g = kargs()->in[13]; if (wave0 < 2) ((LAS float*)((LAS unsigned char*)lds_raw + 156672))[wave0 * 64 + lane_id()] = hg_g[wave0 * 64 + lane_id()]; __syncthreads(); }
            for (;;) {
                const int j = cur - 72; const int hh = j >> 5, lc = j & 31;
                if (!((acq_mask >> hh) & 1u) && !(REP == 32 && dry)) {
                acq_mask |= 1u << hh;
                if (wave0 == 0) {
                    unsigned* f0 = (unsigned*)(kargs()->ws + WS_CTL) + CW_FLAG + 64 * (g * 8 + 2 * hh) + 16 * rep; unsigned sp = 0;
                    while ((__hip_atomic_load(f0, __ATOMIC_RELAXED, __HIP_MEMORY_SCOPE_AGENT) == 0u || __hip_atomic_load(f0 + 64, __ATOMIC_RELAXED, __HIP_MEMORY_SCOPE_AGENT) == 0u) && ++sp < (1u << 22)) __builtin_amdgcn_s_sleep(8);
                    __builtin_amdgcn_fence(__ATOMIC_ACQUIRE, "agent");
                    asm volatile("s_waitcnt vmcnt(0)" ::: "memory");
                }
                __syncthreads();
                }
                int nidx = -1; bool npre = false;
                hg::out_unit(g, hh, lc, (LAS unsigned char*)lds_raw, wave0, P, pre, acq_mask, QOFF, nidx, npre, dry, qc);
                if (!EARLY) {
                    if (wave0 == 0 && lane_id() == 0) ((volatile LAS unsigned*)((LAS unsigned char*)lds_raw + LDSCTL_OFF))[16] = __hip_atomic_fetch_add((unsigned*)(kargs()->ws + WS_CTL) + CW_QUEUE + 64 * (g + 8 * rep), 1u, __ATOMIC_RELAXED, __HIP_MEMORY_SCOPE_AGENT);
                    __syncthreads();
                    nidx = (int)((volatile LAS unsigned*)((LAS unsigned char*)lds_raw + LDSCTL_OFF))[16]; npre = false;
                    __syncthreads();
                }
                cur = nidx; pre = npre;
                if (cur >= 200) break;
            }
        }
        if (dry) GRID_BAR();
        }
        if (BOTH(3)) GRID_BAR();
        STAMP(4);
    }
    if (IN(5)) {
        FRAME_LOAD(); ws = F.ws;
        OutOrder<WS_Y, WS_WO0> S{F.G, (int)blockIdx.x}; EpiP4 E;
        for (int rep = 0; rep < (REP == 5 ? 2 : 1); ++rep) { pg8::gemm_phase<EpiP4, OutOrder<WS_Y, WS_WO0>>(F.lds, DM, S, E, wave0); if (REP == 5 && rep == 0) GRID_BAR(); }
        if (BOTH(5)) LIGHT_BAR(0);
        STAMP(6);
    }
    if (IN(6)) {
        FRAME_LOAD(); ws = F.ws;
        P5Order S{F.G, (int)blockIdx.x}; P5HalfOrder SH{F.G, (int)blockIdx.x};
        LAS float* rst = (LAS float*)(F.lds + 131072);
        int tpm = -1, tpn = -1, tpmh = -1;
        { pg8::Unit u0; if (S.next(0, u0)) tpm = u0.pm; if (SH.next(0, u0)) { tpn = u0.pn; tpmh = u0.pm; }
          const float* ssq1 = (const float*)(ws + WS_SSQ1); const float* bias1 = (const float*)(ws + WS_MISC) + MI_BIAS1;
          const int r = F.tid; const bool full = r < 256; const int blk = full ? tpm : tpn; const int blkc = blk < 0 ? 0 : blk;
          const size_t row = full ? (size_t)blkc * 256 + r : (size_t)blkc * 128 + ((r - 256) & 127);
          const f32x4* pp = (const f32x4*)(ssq1 + row * 16); const f32x4 qa = pp[0], qb = pp[1], qc4 = pp[2], qd = pp[3];
          const int bb = (tpm < 0 ? 0 : tpm) >> 3, bh = (tpn < 0 ? 0 : tpn) >> 4, pmh = tpmh < 0 ? 0 : tpmh;
          float bv[6];
#pragma unroll
          for (int k = 0; k < 6; ++k) bv[k] = bias1[bb * OIN + F.tid + 512 * k];
          const float bhv = bias1[bh * OIN + 3072 + pmh * 256 + (F.tid & 255)];
          if (F.tid < 384 && blk >= 0) rst[r] = rsqrtf((((qa.x + qa.y) + (qa.z + qa.w)) + ((qb.x + qb.y) + (qb.z + qb.w)) + ((qc4.x + qc4.y) + (qc4.z + qc4.w)) + ((qd.x + qd.y) + (qd.z + qd.w))) * (1.f / 1024.f) + EPS);
#pragma unroll
          for (int k = 0; k < 6; ++k) rst[384 + F.tid + 512 * k] = bv[k];
          if (F.tid < 256) rst[384 + 3072 + F.tid] = bhv;
          __syncthreads(); }
        EpiP5 E{rst, tpm};
        for (int rep = 0; rep < (REP == 6 ? 2 : 1); ++rep) {
            pg8::gemm_phase<EpiP5, P5Order>(F.lds, DM, S, E, wave0);
            { EpiP5H EH{rst + 256, tpn, tpmh}; pg8::gemm_phase<EpiP5H, P5HalfOrder, true>(F.lds, DM, SH, EH, wave0); }
            if (REP == 6 && rep == 0) GRID_BAR(); }
        if (BOTH(6)) LIGHT_BAR(1);
        STAMP(7);
    }
    if (IN(7)) {
        FRAME_LOAD(); ws = F.ws;
        for (int rep = 0; rep < (REP == 7 ? 2 : 1); ++rep) {
        const int uA = (F.vcu >> 5) * 64 + (F.vcu & 31), uB = uA + 32;
        const int row0 = (F.vcu * NWAVES + F.wave) * 8;
        GmlpRegs GR; ConvRegs CR;
        gmlp_load(GR, uA >> 6, (uA >> 2) & 15, uA & 3, (const bf16_t*)(ws + WS_GVT), (const float*)(ws + WS_GVSSQ), (const bf16_t*)(ws + WS_WS), (const bf16_t*)(ws + WS_UG), wave0);
        conv_load(CR, row0, (const bf16_t*)(ws + WS_BG), (const bf16_t*)(ws + WS_CH), F.lane);
        gmlp_unit(GR, uA >> 6, (uA >> 2) & 15, uA & 3, F.v_g, F.b_s, (bf16_t*)(ws + WS_Y), F.lds, wave0);
        gmlp_load(GR, uB >> 6, (uB >> 2) & 15, uB & 3, (const bf16_t*)(ws + WS_GVT), (const float*)(ws + WS_GVSSQ), (const bf16_t*)(ws + WS_WS), (const bf16_t*)(ws + WS_UG), wave0);
        conv_finish(CR, row0, F.conv_w, (bf16_t*)(ws + WS_Y), F.lane);
        gmlp_unit(GR, uB >> 6, (uB >> 2) & 15, uB & 3, F.v_g, F.b_s, (bf16_t*)(ws + WS_Y), F.lds, wave0);
        if (REP == 7 && rep == 0) GRID_BAR();
        }
        if (BOTH(7)) LIGHT_BAR(2);
        STAMP(8);
    }
    if (IN(8)) {
        FRAME_LOAD(); ws = F.ws;
        OutOrder<WS_Y, WS_WO1> S{F.G, (int)blockIdx.x}; EpiP7 E;
        pg8::gemm_phase<EpiP7, OutOrder<WS_Y, WS_WO1>>(F.lds, DM, S, E, wave0);
        STAMP(9);
    }
#undef IN
#undef BOTH
}

#if DIAG

#endif

extern "C" void kernel_launch(void* const* d_in, const int* in_sizes, int n_in, void* d_out, int out_size, void* d_ws, size_t ws_size, hipStream_t stream) {
    static int grid = 0;
    if (grid == 0) {
        int dev = 0, cus = 0;
        if (hipGetDevice(&dev) != hipSuccess || hipDeviceGetAttribute(&cus, hipDeviceAttributeMultiprocessorCount, dev) != hipSuccess) { fprintf(stderr, "kernel_launch: device query failed\n"); grid = -1; return; }
        if (hipFuncSetAttribute((const void*)mk_fwd, hipFuncAttributeMaxDynamicSharedMemorySize, LDS_BYTES) != hipSuccess) { fprintf(stderr, "kernel_launch: hipFuncSetAttribute failed\n"); grid = -1; return; }
        int per_cu = 0;
        if (hipOccupancyMaxActiveBlocksPerMultiprocessor(&per_cu, (const void*)mk_fwd, NTHR, LDS_BYTES) != hipSuccess || per_cu < 1) { fprintf(stderr, "kernel_launch: occupancy query says %d blocks/CU\n", per_cu); }
        (void)hipGetLastError();
        grid = cus;
        if (ws_size < WS_END) { fprintf(stderr, "kernel_launch: workspace too small\n"); grid = -1; return; }
    }
    if (grid < 0) return;
    (void)hipMemsetAsync((char*)d_ws + WS_CTL, 0, CTL_ZERO_BYTES, stream);
    Args a{};
    for (int i = 0; i < 20; ++i) a.in[i] = (const float*)d_in[i];
    a.out = (float*)d_out; a.ws = (unsigned char*)d_ws;
#ifdef OUT_SKIP
    a.dbg = OUT_SKIP;
#endif
#if DIAG
    diag_launch(a, grid, d_in, d_out, d_ws, stream);
#else
#if REP >= 91 && REP <= 98
    a.ph_lo = 0; a.ph_hi = REP - 90;
    hipLaunchKernelGGL(mk_fwd, dim3(grid), dim3(NTHR), LDS_BYTES, stream, a);
    (void)hipMemsetAsync((char*)d_ws + WS_CTL, 0, CTL_ZERO_BYTES, stream);
#endif
    a.ph_lo = 0; a.ph_hi = N_PHASES;
    hipLaunchKernelGGL(mk_fwd, dim3(grid), dim3(NTHR), LDS_BYTES, stream, a);
#endif
}
```

```cpp
#define DIAG 0
#define DSEL -1
#include <hip/hip_runtime.h>
#include <math.h>
#include <stdint.h>
#include <cstdio>

#define LAS __attribute__((address_space(3)))
#define GAS __attribute__((address_space(1)))
typedef unsigned short bf16_t;
typedef short bf16x8 __attribute__((ext_vector_type(8)));
typedef short s16x4 __attribute__((ext_vector_type(4)));
typedef float f32x2 __attribute__((ext_vector_type(2)));
typedef float f32x4 __attribute__((ext_vector_type(4)));
typedef float f32x16 __attribute__((ext_vector_type(16)));
typedef unsigned u32x2 __attribute__((ext_vector_type(2)));
typedef unsigned u32x4 __attribute__((ext_vector_type(4)));
typedef _Float16 f16x2_t __attribute__((ext_vector_type(2)));
typedef __bf16 bf16x2_t __attribute__((ext_vector_type(2)));

constexpr int DM = 1024, NB = 8, SEQ = 2048, CTX = 256, KV = SEQ + CTX  , M_TOK = NB * SEQ  , M_CTX = NB * CTX  ;
constexpr int EIN = 4608, OIN = 3584;
constexpr float EPS = 1e-6f;
constexpr float LOG2E = 1.4426950408889634f;
constexpr float LAM_INIT = 0.2f;

constexpr size_t MiB = 1u << 20;
constexpr size_t WS_CTL = 0, CTL_ZERO_BYTES = 1 * MiB;
constexpr size_t WS_MISC = 1 * MiB;
constexpr size_t WS_WT0 = 2 * MiB;
constexpr size_t WS_WO0 = 11 * MiB;
constexpr size_t WS_WT1 = 13 * MiB;
constexpr size_t WS_WO1 = 20 * MiB;
constexpr size_t WS_WS = 22 * MiB;
constexpr size_t WS_SSQ1 = 23 * MiB;
constexpr size_t WS_RA = 24 * MiB;
constexpr size_t WS_XN = WS_RA, WS_CN = WS_RA + 32 * MiB, WS_ST = WS_RA, WS_A1 = WS_RA, WS_X1B = WS_RA + 32 * MiB;
constexpr size_t WS_Y = 88 * MiB;
constexpr size_t WS_KC = 120 * MiB;
constexpr size_t WS_VT = 138 * MiB;
constexpr size_t WS_GA = 156 * MiB;
constexpr size_t WS_HVT = 172 * MiB;
constexpr size_t WS_LF = 190 * MiB;
constexpr size_t WS_GB = 226 * MiB;
constexpr size_t WS_END = 242 * MiB;
constexpr size_t WS_UG = 120 * MiB;
constexpr size_t WS_BG = 136 * MiB;
constexpr size_t WS_CH = 152 * MiB;
constexpr size_t WS_GVT = 168 * MiB;
constexpr size_t WS_GVSSQ = 186 * MiB;
constexpr int GVP = SEQ + 64;
constexpr int MI_MOD = 0;
constexpr int MI_CS = 55296, MI_SN = MI_CS + 1024, MI_LBV = MI_SN + 1024, MI_SCAL = MI_LBV + 1024, MI_BIAS1 = MI_SCAL + 64;
constexpr int CW_BAR = 4096;
constexpr int CW_QUEUE = 16384;
constexpr int CW_FLAG = 32768;
constexpr int CW_XCC = 45056;
constexpr int CW_UNCLEAN = 45056 + 1024;
constexpr int CW_GRP = 49152;
constexpr int CW_W0 = 40960 + 64;
constexpr int CW_ADA = 40960;

__device__ __forceinline__ unsigned cvt_pk_bf16(float lo, float hi) { f32x2 v = {lo, hi}; bf16x2_t b = __builtin_convertvector(v, bf16x2_t); return __builtin_bit_cast(unsigned, b); }
__device__ __forceinline__ unsigned cvt_pk_f16(float lo, float hi) { f32x2 v = {lo, hi}; f16x2_t b = __builtin_convertvector(v, f16x2_t); return __builtin_bit_cast(unsigned, b); }
__device__ __forceinline__ float bf2f(unsigned short h) { return __uint_as_float(((unsigned)h) << 16); }
__device__ __forceinline__ float bflo(unsigned w) { return __uint_as_float(w << 16); }
__device__ __forceinline__ float bfhi(unsigned w) { return __uint_as_float(w & 0xffff0000u); }
__device__ __forceinline__ float silu_fast(float v) { return v * __builtin_amdgcn_rcpf(1.f + __expf(-v)); }
__device__ __forceinline__ float gelu_erf(float v) { return 0.5f * v * (1.f + erff(v * 0.70710678118654752f)); }
__device__ __forceinline__ float wave_sum(float v) {
#pragma unroll
  for (int o = 1; o < 64; o <<= 1) v += __shfl_xor(v, o);
  return v;
}
__device__ __forceinline__ int lane_id() { int l = (int)__builtin_amdgcn_mbcnt_hi(~0u, __builtin_amdgcn_mbcnt_lo(~0u, 0u)); asm volatile("" : "+v"(l)); return l; }
__device__ __forceinline__ float shfl_xor_l(float v, int mask, int lane) { return __int_as_float(__builtin_amdgcn_ds_bpermute((lane ^ mask) << 2, __float_as_int(v))); }
#define LDS_WAIT() asm volatile("s_waitcnt lgkmcnt(0)" ::: "memory")
#define VM_WAIT() asm volatile("s_waitcnt vmcnt(0)" ::: "memory")

namespace pg8 {
constexpr int BM = 256, BK = 64, HALF = 128, HTB = HALF * BK * 2, STAGE_BYTES = 8 * HTB;
__host__ __device__ __forceinline__ int lds_byte(int r, int c) { const int st = (r >> 4) * 2 + (c >> 5), rr = r & 15, cc = c & 31, ob = rr * 64 + cc * 2; return st * 1024 + (ob ^ (((ob >> 9) & 1) << 5)); }
__host__ __device__ __forceinline__ void stage_rc(int b, int& R, int& C) { const int st = b / 1024, sb = b % 1024, swz = sb ^ (((sb >> 9) & 1) << 5); R = (st >> 1) * 16 + swz / 64; C = (st & 1) * 32 + (swz % 64) / 2; }
__host__ __device__ __forceinline__ int perm32(int rho) { const int n = rho >> 4, i = rho & 15; return 8 * (i >> 2) + 4 * n + (i & 3); }

struct Unit { const char* a; const char* b; int ty, pm, pn, aux; };

template <class Epi, class Sched, bool HALFN = false>
__device__ __forceinline__ void gemm_phase(LAS unsigned char* lds, const int K, const Sched& S, const Epi& E, const int wv) {
    const int lane = lane_id(), tid = wv * 64 + lane, wid = wv, wr = wid >> 2, wc = wid & 3, fr = lane & 15, fq = lane >> 4;
    const int nt = K / BK;
    unsigned voffA[2], voffB[2];
#pragma unroll
    for (int i = 0; i < 2; ++i) { int R, C; stage_rc(tid * 16 + i * 8192, R, C); const int Rb = (R & ~31) + perm32(R & 31);
        voffA[i] = (unsigned)(R * K + C) * 2u; voffB[i] = (unsigned)(Rb * K + C) * 2u; }
    const size_t kstep = (size_t)(BK * 2);
    const size_t hstep = (size_t)HALF * K * 2;
    const unsigned ldsw = (unsigned)wid * 1024u;
    const int aoff = lds_byte(wr * 64 + fr, fq * 8), boff = lds_byte(wc * 32 + fr, fq * 8);
#define PG8_SA(b, h) (((b) * 2 + (h)) * HTB)
#define PG8_SB(b, h) ((4 + (b) * 2 + (h)) * HTB)
#define PG8_STAGE(bufoff, gbase, voff) do { _Pragma("unroll") for (int _i = 0; _i < 2; ++_i) \
        __builtin_amdgcn_global_load_lds((const unsigned*)((const char*)(gbase) + (voff)[_i]), (LAS unsigned*)(lds + (bufoff) + ldsw + _i * 8192), 16, 0, 0); } while (0)
#define PG8_LDA(dst, b, h) do { _Pragma("unroll") for (int m = 0; m < 4; ++m) _Pragma("unroll") for (int k = 0; k < 2; ++k) dst[m][k] = *(const LAS bf16x8*)(lds + PG8_SA(b, h) + aoff + m * 2048 + k * 1024); } while (0)
#define PG8_LDB(dst, b, h) do { _Pragma("unroll") for (int n = 0; n < 2; ++n) _Pragma("unroll") for (int k = 0; k < 2; ++k) dst[n][k] = *(const LAS bf16x8*)(lds + PG8_SB(b, h) + boff + n * 2048 + k * 1024); } while (0)
#define PG8_MMA(ai, bj, At, Bt) do { __builtin_amdgcn_s_setprio(1); _Pragma("unroll") for (int m = 0; m < 4; ++m) _Pragma("unroll") for (int n = 0; n < 2; ++n) _Pragma("unroll") for (int k = 0; k < 2; ++k) \
        acc[ai][bj][m][n] = __builtin_amdgcn_mfma_f32_16x16x32_bf16(Bt[n][k], At[m][k], acc[ai][bj][m][n], 0, 0, 0); __builtin_amdgcn_s_setprio(0); } while (0)
#define PG8_WAIT_V(n) asm volatile("s_waitcnt vmcnt(" #n ")" ::: "memory")
#define PG8_WAIT_L(n) asm volatile("s_waitcnt lgkmcnt(" #n ")" ::: "memory")
#define PG8_BAR __builtin_amdgcn_s_barrier()
#define PG8_SCHED __builtin_amdgcn_sched_barrier(0)
    Unit cur, nxt; int ui = 0;
    if (!S.next(0, cur)) return;
    f32x4 acc[2][2][4][2];
#pragma unroll
    for (int a = 0; a < 2; ++a)
#pragma unroll
        for (int b = 0; b < 2; ++b)
#pragma unroll
            for (int m = 0; m < 4; ++m)
#pragma unroll
                for (int n = 0; n < 2; ++n) acc[a][b][m][n] = (f32x4){0.f, 0.f, 0.f, 0.f};
    bf16x8 At[4][2], B0[2][2], B1[2][2];
    const char* cA = cur.a; const char* cB = cur.b;
    PG8_STAGE(PG8_SB(0, 0), cB, voffB); if (!HALFN) PG8_STAGE(PG8_SB(0, 1), cB + hstep, voffB); PG8_STAGE(PG8_SA(0, 0), cA, voffA); PG8_STAGE(PG8_SA(0, 1), cA + hstep, voffA);
    if (wr == 1) PG8_BAR;
    PG8_WAIT_V(2); PG8_BAR;
    PG8_STAGE(PG8_SB(1, 0), cB + kstep, voffB); PG8_STAGE(PG8_SA(1, 0), cA + kstep, voffA); if (!HALFN) PG8_STAGE(PG8_SB(1, 1), cB + hstep + kstep, voffB);
    if (HALFN) PG8_WAIT_V(4); else PG8_WAIT_V(6); PG8_BAR;
    for (;;) {
        const bool has_next = S.next(ui + 1, nxt);
        const char* nA = has_next ? nxt.a : cA; const char* nB = has_next ? nxt.b : cB;
        for (int t = 0; t < nt; t += 2) {
            const bool last = (t == nt - 2);
            const char* a1 = cA + (size_t)(t + 1) * kstep;
            const char* a2 = last ? nA : cA + (size_t)(t + 2) * kstep; const char* b2 = last ? nB : cB + (size_t)(t + 2) * kstep;
            const char* a3 = a2 + kstep; const char* b3 = b2 + kstep;
#define PG8_WAIT_VK() do { if (HALFN) PG8_WAIT_V(6); else PG8_WAIT_V(8); } while (0)
            PG8_LDB(B0, 0, 0); if (!HALFN) PG8_LDB(B1, 0, 1); PG8_SCHED; PG8_LDA(At, 0, 0); PG8_STAGE(PG8_SA(1, 1), a1 + hstep, voffA);
            PG8_WAIT_VK(); PG8_WAIT_L(0); PG8_BAR; PG8_MMA(0, 0, At, B0); if (!HALFN) PG8_MMA(0, 1, At, B1); PG8_BAR; PG8_SCHED;
            PG8_LDA(At, 0, 1); PG8_STAGE(PG8_SB(0, 0), b2, voffB); if (!HALFN) PG8_STAGE(PG8_SB(0, 1), b2 + hstep, voffB); PG8_STAGE(PG8_SA(0, 0), a2, voffA);
            PG8_WAIT_VK(); PG8_WAIT_L(0); PG8_BAR; PG8_MMA(1, 0, At, B0); if (!HALFN) PG8_MMA(1, 1, At, B1); PG8_BAR; PG8_SCHED;
            PG8_LDB(B0, 1, 0); if (!HALFN) PG8_LDB(B1, 1, 1); PG8_SCHED; PG8_LDA(At, 1, 0); PG8_STAGE(PG8_SA(0, 1), a2 + hstep, voffA);
            PG8_WAIT_VK(); PG8_WAIT_L(0); PG8_BAR; PG8_MMA(0, 0, At, B0); if (!HALFN) PG8_MMA(0, 1, At, B1); PG8_BAR; PG8_SCHED;
            PG8_LDA(At, 1, 1); PG8_STAGE(PG8_SB(1, 0), b3, voffB); if (!HALFN) PG8_STAGE(PG8_SB(1, 1), b3 + hstep, voffB); PG8_STAGE(PG8_SA(1, 0), a3, voffA);
            PG8_WAIT_VK(); PG8_WAIT_L(0); PG8_BAR; PG8_MMA(1, 0, At, B0); if (!HALFN) PG8_MMA(1, 1, At, B1); PG8_BAR; PG8_SCHED;
#undef PG8_WAIT_VK
        }
        if (wr == 0) PG8_BAR;
        { int ln_ = (int)__builtin_amdgcn_mbcnt_hi(~0u, __builtin_amdgcn_mbcnt_lo(~0u, 0u)); asm volatile("" : "+v"(ln_));
          E(acc, cur, wr, wc, ln_ & 15, ln_ >> 4, ln_); }
        if (!has_next) break;
#pragma unroll
        for (int a = 0; a < 2; ++a)
#pragma unroll
            for (int b = 0; b < 2; ++b)
#pragma unroll
                for (int m = 0; m < 4; ++m)
#pragma unroll
                    for (int n = 0; n < 2; ++n) acc[a][b][m][n] = (f32x4){0.f, 0.f, 0.f, 0.f};
        cur = nxt; cA = nA; cB = nB; ++ui;
        if (wr == 1) PG8_BAR;
    }
    PG8_WAIT_V(0);
    PG8_BAR;
#undef PG8_SA
#undef PG8_SB
#undef PG8_STAGE
#undef PG8_LDA
#undef PG8_LDB
#undef PG8_MMA
#undef PG8_WAIT_V
#undef PG8_WAIT_L
#undef PG8_BAR
#undef PG8_SCHED
}
}

__device__ __forceinline__ void ticket_draw(unsigned* qctr, unsigned& tk) {
    const unsigned one = 1u;
    asm volatile("global_atomic_add %0, %1, %2, off sc0" : "=v"(tk) : "v"(qctr), "v"(one) : "memory");
}
__device__ __forceinline__ void ticket_wait(unsigned& tk) { asm volatile("s_waitcnt vmcnt(0)" : "+v"(tk) :: "memory"); }
__device__ __forceinline__ void group_barrier_light(unsigned* cnt, unsigned target, int tid) {
    asm volatile("s_waitcnt vmcnt(0)" ::: "memory");
    __syncthreads();
    if (tid == 0) {
        const unsigned old = __hip_atomic_fetch_add(cnt, 1u, __ATOMIC_RELAXED, __HIP_MEMORY_SCOPE_AGENT);
        if (old + 1u == target) __hip_atomic_store(cnt + 64, 1u, __ATOMIC_RELAXED, __HIP_MEMORY_SCOPE_AGENT);
        else { unsigned sp = 0u; while (__hip_atomic_load(cnt + 64, __ATOMIC_RELAXED, __HIP_MEMORY_SCOPE_AGENT) == 0u && ++sp < (1u << 22)) __builtin_amdgcn_s_sleep(1); }
        __builtin_amdgcn_fence(__ATOMIC_ACQUIRE, "agent");
        asm volatile("s_waitcnt vmcnt(0)" ::: "memory");
    }
    __syncthreads();
}
#define XB_TMO      128
#define XB_XCNT(j)  (256  + 64 * (j))
#define XB_XSUB(j)  (1280 + 64 * (j))
#define XB_XGEN(j)  (2304 + 64 * (j))
#define XB_TOP      3328
#define XB_TOPGEN   3392
#define XCD_BAR_WORDS 3456
#define XB_SPIN_CAP (1u << 18)
__device__ __forceinline__ unsigned xb_ld(unsigned* p)              { return __hip_atomic_load(p, __ATOMIC_RELAXED, __HIP_MEMORY_SCOPE_AGENT); }
__device__ __forceinline__ unsigned xb_add(unsigned* p, unsigned v) { return __hip_atomic_fetch_add(p, v, __ATOMIC_RELAXED, __HIP_MEMORY_SCOPE_AGENT); }
__device__ __forceinline__ unsigned xb_xcc_id() { return (unsigned)__builtin_amdgcn_s_getreg((3 << 11) | 20) & 0xFu; }
#define XB_SPIN(cond, bar) do { unsigned _sp = 0; while (cond) { __builtin_amdgcn_s_sleep(1); \
    if ((++_sp & 255u) == 0u) { if (xb_ld(&(bar)[XB_TMO])) break; if (_sp > XB_SPIN_CAP) { atomicAdd(&(bar)[XB_TMO], 1u); break; } } } } while (0)
struct XcdBarrier { unsigned* bar; unsigned x; volatile LAS unsigned* st; };
__device__ __forceinline__ XcdBarrier xcd_barrier_post(unsigned* bar, volatile LAS unsigned* st, int tid) {
    XcdBarrier b; b.bar = bar; b.x = xb_xcc_id(); b.st = st;
    if (tid == 0) (void)xb_add(&bar[XB_XCNT(b.x)], 1u);
    return b;
}
__device__ __forceinline__ void xcd_barrier_complete(unsigned* bar, unsigned x, unsigned& nloc, unsigned& nx) {
    const unsigned G = gridDim.x * gridDim.y * gridDim.z;
    unsigned sum, cnt, mine, sp = 0u;
    for (;;) {
        sum = 0u; cnt = 0u; mine = 0u;
#pragma unroll
        for (unsigned j = 0; j < 16; ++j) { const unsigned c = xb_ld(&bar[XB_XCNT(j)]); sum += c; cnt += (c > 0u) ? 1u : 0u; mine = (j == x) ? c : mine; }
        if (sum == G) break;
        __builtin_amdgcn_s_sleep(1);
        if ((++sp & 255u) == 0u) { if (xb_ld(&bar[XB_TMO])) break; if (sp > XB_SPIN_CAP) { atomicAdd(&bar[XB_TMO], 1u); break; } }
    }
    nloc = mine > 0u ? mine : 1u; nx = cnt > 0u ? cnt : 1u;
}
__device__ __forceinline__ void xcd_barrier(const XcdBarrier& b, int tid, const bool light = false) {
    asm volatile("s_waitcnt vmcnt(0)" ::: "memory");
    __syncthreads();
    if (tid == 0) {
        unsigned* bar = b.bar;
        __builtin_amdgcn_s_waitcnt(0);
        unsigned nloc = b.st[0], nx = b.st[1];
        if (nloc == 0u) { xcd_barrier_complete(bar, b.x, nloc, nx); b.st[0] = nloc; b.st[1] = nx; }
        const unsigned old = xb_add(&bar[XB_XSUB(b.x)], 1u);
        const unsigned gen = old / nloc;
        if (old + 1u == (gen + 1u) * nloc) {
            if (!light) __builtin_amdgcn_fence(__ATOMIC_RELEASE, "agent");
            asm volatile("s_waitcnt vmcnt(0)" ::: "memory");
            const unsigned og = xb_add(&bar[XB_TOP], 1u);
            const unsigned tg = og / nx;
            if (og + 1u == (tg + 1u) * nx) xb_add(&bar[XB_TOPGEN], 1u);
            else XB_SPIN(xb_ld(&bar[XB_TOPGEN]) == tg, bar);
            __builtin_amdgcn_fence(__ATOMIC_ACQUIRE, "agent");
            xb_add(&bar[XB_XGEN(b.x)], 1u);
            asm volatile("s_waitcnt vmcnt(0)" ::: "memory");
        } else {
            XB_SPIN(xb_ld(&bar[XB_XGEN(b.x)]) == gen, bar);
            __builtin_amdgcn_fence(__ATOMIC_ACQUIRE, "agent");
            asm volatile("s_waitcnt vmcnt(0)" ::: "memory");
        }
    }
    __syncthreads();
}
constexpr int NWAVES = 8, NTHR = 512;
constexpr int RING_BYTES = 131072;
constexpr int LDSX_OFF = RING_BYTES;
constexpr int LDSCTL_OFF = 162816;
constexpr int LDS_BYTES = 163840;

struct Args {
    const float* in[20]; float* out; unsigned char* ws; int ph_lo, ph_hi, dbg, pad;
};
typedef const __attribute__((address_space(4))) Args* KArgsPtr;
__device__ __forceinline__ KArgsPtr kargs() { KArgsPtr p = (KArgsPtr)__builtin_amdgcn_kernarg_segment_ptr(); asm volatile("" : "+s"(p)); return p; }
struct Frame {
    LAS unsigned char* lds;
    volatile LAS unsigned* MISC;
    unsigned* ctl;
    int tid, lane, wave, vcu, G;
    const float *x, *c, *ctx, *c_ctx, *norm_gain, *ada_w, *ada_b, *even_w_in, *even_w_out, *qk_gain, *lam_p, *subln_g, *lb_logits, *hgrn_g,
                *odd_w_in, *odd_w_out, *v_g, *w_s, *b_s, *conv_w;
    float* out; unsigned char* ws; float* misc;
};

__host__ __device__ __forceinline__ int srcmap0(int d) {
    if (d < 1024) { const int base = d < 512 ? 0 : 512; const int e = d & 511; const int pn = e >> 8, rho = e & 255, bj = rho >> 7, wc = (rho >> 5) & 3; return base + (4 * pn + wc) * 64 + 32 * bj + (rho & 31); }
    if (d < 1536) return 1536 + (d - 1024);
    if (d < 2048) return 2048 + (d - 1536);
    if (d < 2560) return 3072 + (d - 2048);
    if (d < 3072) return 3584 + (d - 2560);
    if (d < 3584) return 4096 + (d - 3072);
    if (d < 4096) return 1024 + (d - 3584);
    return 2560 + (d - 4096);
}
__host__ __device__ __forceinline__ int srcmap1(int d) {
    if (d < 1024) { const int t = d >> 8, rho = d & 255, bj = rho >> 7, o = rho & 127; return (bj ? 1024 : 0) + 128 * t + o; }
    if (d < 2048) { const int e = d - 1024; const int t = e >> 8, rho = e & 255, bj = rho >> 7, o = rho & 127; return (bj ? 3072 : 1536) + 128 * t + o; }
    if (d < 3072) { const int e = d - 2048; const int t = e >> 8, rho = e & 255, bj = rho >> 7, o = rho & 127; return (bj ? 2560 : 2048) + 128 * t + o; }
    return 512 + (d - 3072);
}

__device__ __forceinline__ void p0_transpose_item(const float* W, int K, int N, bf16_t* WT, int drow0, int n_src, int k0, LAS float* scr, int lane) {
    float tv[32];
#pragma unroll
    for (int i = 0; i < 32; ++i) { const int kk = 2 * i + (lane >> 5); tv[i] = W[(size_t)(k0 + kk) * N + n_src + (lane & 31)]; }
#pragma unroll
    for (int i = 0; i < 32; ++i) { const int kk = 2 * i + (lane >> 5); scr[kk * 33 + (lane & 31)] = tv[i]; }
    LDS_WAIT(); asm volatile("" ::: "memory");
    const int c = lane & 7;
#pragma unroll
    for (int j = 0; j < 4; ++j) { const int n = (lane >> 3) + 8 * j; const LAS float* s = scr + (8 * c) * 33 + n;
        u32x4 o; o.x = cvt_pk_bf16(s[0 * 33], s[1 * 33]); o.y = cvt_pk_bf16(s[2 * 33], s[3 * 33]); o.z = cvt_pk_bf16(s[4 * 33], s[5 * 33]); o.w = cvt_pk_bf16(s[6 * 33], s[7 * 33]);
        *(u32x4*)(WT + (size_t)(drow0 + n) * K + k0 + 8 * c) = o; }
    LDS_WAIT(); asm volatile("" ::: "memory");
}

__device__ __forceinline__ void weight_copies(Frame& F, int which, int gw, int NGW, int sub_lo = 0, int sub_hi = 1 << 30) {
    LAS float* scr = (LAS float*)(F.lds + F.wave * 16384);
    constexpr int I0 = 16 * (EIN / 32), I1 = 16 * 32, I2 = 16 * (OIN / 32), I3 = 16 * 32, I4 = 128;
    bf16_t* Wt0 = (bf16_t*)(F.ws + WS_WT0); bf16_t* Wo0 = (bf16_t*)(F.ws + WS_WO0); bf16_t* Wt1 = (bf16_t*)(F.ws + WS_WT1); bf16_t* Wo1 = (bf16_t*)(F.ws + WS_WO1); bf16_t* Wsb = (bf16_t*)(F.ws + WS_WS);
    const int lo = (which ? I0 + I1 : 0) + sub_lo, hi0 = which ? I0 + I1 + I2 + I3 + I4 : I0 + I1; const int hi = (lo - sub_lo + sub_hi < hi0) ? lo - sub_lo + sub_hi : hi0;
    for (int it = lo + gw; it < hi; it += NGW) {
        int r = it;
        if (r < I0) { const int kb = r / (EIN / 32), dg = r % (EIN / 32); p0_transpose_item(F.even_w_in, DM, EIN, Wt0, dg * 32, srcmap0(dg * 32), kb * 64, scr, F.lane); continue; } r -= I0;
        if (r < I1) { const int kb = r / 32, dg = r % 32; p0_transpose_item(F.even_w_out, DM, DM, Wo0, dg * 32, dg * 32, kb * 64, scr, F.lane); continue; } r -= I1;
        if (r < I2) { const int kb = r / (OIN / 32), dg = r % (OIN / 32); p0_transpose_item(F.odd_w_in, DM, OIN, Wt1, dg * 32, srcmap1(dg * 32), kb * 64, scr, F.lane); continue; } r -= I2;
        if (r < I3) { const int kb = r / 32, dg = r % 32; p0_transpose_item(F.odd_w_out, DM, DM, Wo1, dg * 32, dg * 32, kb * 64, scr, F.lane); continue; } r -= I3;
        { const int e0 = r * 512 + F.lane * 8; const f32x4 a = *(const f32x4*)(F.w_s + e0), b = *(const f32x4*)(F.w_s + e0 + 4);
          u32x4 o; o.x = cvt_pk_bf16(a.x, a.y); o.y = cvt_pk_bf16(a.z, a.w); o.z = cvt_pk_bf16(b.x, b.y); o.w = cvt_pk_bf16(b.z, b.w); *(u32x4*)(Wsb + e0) = o; }
    }
}
__device__ __forceinline__ void p0_prologue(Frame& F) {
    float* misc = F.misc;
    if (F.vcu < 192) {
        LAS float* sl = (LAS float*)F.lds;
        LAS float* red = (LAS float*)(F.lds + 36864);
        const int cc = F.tid & 31, kp = F.tid >> 5;
        const int gcol = F.vcu * 32 + cc;
        const int l = gcol / 3072, col = gcol % 3072;
        const float* w = F.ada_w + (size_t)l * 1024 * 3072 + col;
        float wv[64];
#pragma unroll
        for (int i = 0; i < 64; ++i) wv[i] = w[(size_t)(kp * 64 + i) * 3072];
        for (int i = F.tid; i < 9 * 1024; i += NTHR) { const int r = i >> 10, k = i & 1023; const float v = (r < 8) ? F.c[r * 1024 + k] : F.c_ctx[k]; sl[i] = v / (1.f + __expf(-v)); }
        __syncthreads();
#pragma unroll
        for (int r = 0; r < 9; ++r) {
            float a = 0.f;
#pragma unroll
            for (int i4 = 0; i4 < 16; ++i4) { const f32x4 sv = *(const LAS f32x4*)(sl + r * 1024 + kp * 64 + 4 * i4);
                a += sv.x * wv[4 * i4] + sv.y * wv[4 * i4 + 1] + sv.z * wv[4 * i4 + 2] + sv.w * wv[4 * i4 + 3]; }
            red[(kp * 9 + r) * 32 + cc] = a;
        }
        __syncthreads();
        if (F.tid < 9 * 32) { const int r = F.tid >> 5, c2 = F.tid & 31; const int gc = F.vcu * 32 + c2; const int l2 = gc / 3072, col2 = gc % 3072;
            float sacc = F.ada_b[l2 * 3072 + col2];
#pragma unroll
            for (int q = 0; q < 16; ++q) sacc += red[(q * 9 + r) * 32 + c2];
            misc[MI_MOD + (l2 * 9 + r) * 3072 + col2] = sacc; }
        asm volatile("s_waitcnt vmcnt(0)" ::: "memory");
        __syncthreads();
        if (F.tid == 0) { __builtin_amdgcn_fence(__ATOMIC_RELEASE, "agent"); __hip_atomic_fetch_add(F.ctl + CW_ADA, 1u, __ATOMIC_RELAXED, __HIP_MEMORY_SCOPE_AGENT); }
    }
    if (F.vcu == 192) {
        for (int i = F.tid; i < 1024; i += NTHR) { const int pos = i >> 4, f = i & 15; const float inv = powf(10000.f, -(float)f / 16.f); const float ang = (float)pos * inv;
            misc[MI_CS + i] = cosf(ang); misc[MI_SN + i] = sinf(ang); }
    }
    if (F.vcu == 193) {
        for (int i = F.tid; i < 1024; i += NTHR) { const int dir = i >> 9, ch = i & 511; const float l0 = F.lb_logits[(dir * 2 + 0) * 512 + ch], l1 = F.lb_logits[(dir * 2 + 1) * 512 + ch];
            const float mx = fmaxf(l0, l1); const float e0 = expf(l0 - mx), e1 = expf(l1 - mx); misc[MI_LBV + i] = e0 / (e0 + e1); }
        if (F.wave == 0) {
            const int i = F.lane;
            float a = F.lam_p[i] * F.lam_p[64 + i], b = F.lam_p[128 + i] * F.lam_p[192 + i], gq = fabsf(F.qk_gain[i]), gk = fabsf(F.qk_gain[64 + i]);
#pragma unroll
            for (int o = 1; o < 64; o <<= 1) { a += __shfl_xor(a, o); b += __shfl_xor(b, o); gq = fmaxf(gq, __shfl_xor(gq, o)); gk = fmaxf(gk, __shfl_xor(gk, o)); }
            if (i == 0) {
                misc[MI_SCAL + 0] = expf(a) - expf(b) + LAM_INIT;
                misc[MI_SCAL + 1] = 8.0f * gq * gk * LOG2E * 1.0001f + 0.01f;
            }
        }
    }
    if (F.vcu >= 194) weight_copies(F, 0, (F.vcu - 194) * NWAVES + F.wave, 62 * NWAVES);
    if (F.vcu >= 192) {
        asm volatile("s_waitcnt vmcnt(0)" ::: "memory");
        __syncthreads();
        if (F.tid == 0) { __builtin_amdgcn_fence(__ATOMIC_RELEASE, "agent"); __hip_atomic_fetch_add(F.ctl + CW_W0, 1u, __ATOMIC_RELAXED, __HIP_MEMORY_SCOPE_AGENT); }
    }
}

__device__ __forceinline__ void mod_rows3(Frame& F, int ma, int mb, int mc, bf16_t* XN, bf16_t* CN) {
    const float* misc = F.misc; const int lane = F.lane;
    f32x4 v[3][4];
#pragma unroll
    for (int r = 0; r < 3; ++r) { const int m = (r == 0) ? ma : (r == 1) ? mb : mc; const float* xrow = (m < M_TOK) ? F.x + (size_t)m * DM : F.ctx + (size_t)(m - M_TOK) * DM; const f32x4* xr = (const f32x4*)xrow + lane;
#pragma unroll
        for (int j = 0; j < 4; ++j) v[r][j] = xr[64 * j]; }
#pragma unroll
    for (int r = 0; r < 3; ++r) {
        const int m = (r == 0) ? ma : (r == 1) ? mb : mc;
        float s = 0.f;
#pragma unroll
        for (int j = 0; j < 4; ++j) s += (v[r][j].x * v[r][j].x + v[r][j].y * v[r][j].y) + (v[r][j].z * v[r][j].z + v[r][j].w * v[r][j].w);
        const float rstd = rsqrtf(wave_sum(s) * (1.f / DM) + EPS);
        const float* modrow = misc + MI_MOD + (0 * 9 + ((m < M_TOK) ? (m >> 11) : 8)) * 3072;
        bf16_t* orow = (m < M_TOK) ? XN + (size_t)m * DM : CN + (size_t)(m - M_TOK) * DM;
        u32x2* o8 = (u32x2*)orow + lane;
#pragma unroll
        for (int j = 0; j < 4; ++j) {
            const int col = 4 * lane + 256 * j;
            const f32x4 g = *(const f32x4*)(F.norm_gain + col), sh = *(const f32x4*)(modrow + col), sc = *(const f32x4*)(modrow + 1024 + col);
            const f32x4 o = v[r][j] * rstd * g * (sc + 1.f) + sh;
            u32x2 w; w.x = cvt_pk_bf16(o.x, o.y); w.y = cvt_pk_bf16(o.z, o.w); o8[64 * j] = w;
        }
    }
}
__device__ __forceinline__ void rows_load(Frame& F, int m, f32x4 (&v)[4]) {
    const float* xrow = (m < M_TOK) ? F.x + (size_t)m * DM : F.ctx + (size_t)(m - M_TOK) * DM; const f32x4* xr = (const f32x4*)xrow + F.lane;
#pragma unroll
    for (int j = 0; j < 4; ++j) v[j] = xr[64 * j];
}
__device__ __forceinline__ void mod_vecs(Frame& F, int modr, f32x4 (&Gm)[4], f32x4 (&Sh)[4]) {
    const float* modrow = F.misc + MI_MOD + (0 * 9 + modr) * 3072;
#pragma unroll
    for (int j = 0; j < 4; ++j) { const int col = 4 * F.lane + 256 * j;
        Gm[j] = *(const f32x4*)(F.norm_gain + col) * (*(const f32x4*)(modrow + 1024 + col) + 1.f); Sh[j] = *(const f32x4*)(modrow + col); }
}
__device__ __forceinline__ void row_proc(Frame& F, int m, const f32x4 (&v)[4], const f32x4 (&Gm)[4], const f32x4 (&Sh)[4], bf16_t* XN, bf16_t* CN) {
    float s = 0.f;
#pragma unroll
    for (int j = 0; j < 4; ++j) s += (v[j].x * v[j].x + v[j].y * v[j].y) + (v[j].z * v[j].z + v[j].w * v[j].w);
    const float rstd = rsqrtf(wave_sum(s) * (1.f / DM) + EPS);
    bf16_t* orow = (m < M_TOK) ? XN + (size_t)m * DM + (size_t)(m >> 11) * 2097152 : XN + (size_t)((m - M_TOK) >> 8) * 4194304 + 2097152 + (size_t)((m - M_TOK) & 255) * DM;
    u32x2* o8 = (u32x2*)orow + F.lane;
#pragma unroll
    for (int j = 0; j < 4; ++j) { const f32x4 o = v[j] * rstd * Gm[j] + Sh[j]; u32x2 w; w.x = cvt_pk_bf16(o.x, o.y); w.y = cvt_pk_bf16(o.z, o.w); o8[64 * j] = w; }
}
__device__ __forceinline__ void p0b_phase(Frame& F) {
    const float* misc = F.misc;
    bf16_t* XN = (bf16_t*)(F.ws + WS_XN); bf16_t* CN = (bf16_t*)(F.ws + WS_CN);
    const int gw0 = F.vcu * NWAVES + F.wave;
    f32x4 ra[3][4], rb[3][4];
#pragma unroll
    for (int r = 0; r < 3; ++r) { rows_load(F, 8 * gw0 + r, ra[r]); rows_load(F, 8 * gw0 + 3 + r, rb[r]); }
    const int cc = F.tid & 15, kp = F.tid >> 4;
    float wv[32];
    if (cc < 14) {
        const int d = F.vcu * 14 + cc; const int src = srcmap1(d & ~31) + (d & 31);
#pragma unroll
        for (int i = 0; i < 32; ++i) wv[i] = F.odd_w_in[(size_t)(kp * 32 + i) * OIN + src];
    } else {
#pragma unroll
        for (int i = 0; i < 32; ++i) wv[i] = 0.f;
    }
    if (F.wave == 0) { unsigned sp = 0u;
        while (__hip_atomic_load(F.ctl + CW_ADA, __ATOMIC_RELAXED, __HIP_MEMORY_SCOPE_AGENT) < 192u && ++sp < (1u << 22)) __builtin_amdgcn_s_sleep(2);
        __builtin_amdgcn_fence(__ATOMIC_ACQUIRE, "agent"); }
    __syncthreads();
    {
        const int gw = gw0;
        f32x4 Gm[4], Sh[4];
        mod_vecs(F, (8 * gw) >> 11, Gm, Sh);
#pragma unroll
        for (int r = 0; r < 3; ++r) row_proc(F, 8 * gw + r, ra[r], Gm, Sh, XN, CN);
        rows_load(F, 8 * gw + 6, ra[0]); rows_load(F, 8 * gw + 7, ra[1]); rows_load(F, M_TOK + gw, ra[2]);
        __builtin_amdgcn_sched_barrier(0);
#pragma unroll
        for (int r = 0; r < 3; ++r) row_proc(F, 8 * gw + 3 + r, rb[r], Gm, Sh, XN, CN);
        row_proc(F, 8 * gw + 6, ra[0], Gm, Sh, XN, CN); row_proc(F, 8 * gw + 7, ra[1], Gm, Sh, XN, CN);
        mod_vecs(F, 8, Gm, Sh);
        row_proc(F, M_TOK + gw, ra[2], Gm, Sh, XN, CN);
    }
    {
        LAS float* red = (LAS float*)F.lds;
        LAS float* shs = (LAS float*)(F.lds + 16384);
        float acc[8];
#pragma unroll
        for (int b = 0; b < 8; ++b) acc[b] = 0.f;
        { f32x4 sh4[4];
#pragma unroll
          for (int q = 0; q < 4; ++q) { const int i = F.tid + NTHR * q; const int b = i >> 8, c4 = i & 255; sh4[q] = *(const f32x4*)(misc + MI_MOD + (9 + b) * 3072 + 4 * c4); }
#pragma unroll
          for (int q = 0; q < 4; ++q) { const int i = F.tid + NTHR * q; const int b = i >> 8, c4 = i & 255; *(LAS f32x4*)(shs + b * 1024 + 4 * c4) = sh4[q]; } }
        __syncthreads();
#pragma unroll
        for (int b = 0; b < 8; ++b) {
#pragma unroll
            for (int i4 = 0; i4 < 8; ++i4) { const f32x4 sv = *(const LAS f32x4*)(shs + b * 1024 + kp * 32 + 4 * i4);
                acc[b] += sv.x * wv[4 * i4] + sv.y * wv[4 * i4 + 1] + sv.z * wv[4 * i4 + 2] + sv.w * wv[4 * i4 + 3]; }
        }
        __syncthreads();
#pragma unroll
        for (int b = 0; b < 8; ++b) red[(kp * 8 + b) * 16 + cc] = acc[b];
        __syncthreads();
        if (F.tid < 8 * 14) { const int b = F.tid / 14, c2 = F.tid % 14; float s = 0.f;
            for (int q = 0; q < 32; ++q) s += red[(q * 8 + b) * 16 + c2];
            F.misc[MI_BIAS1 + b * OIN + F.vcu * 14 + c2] = s; }
        __syncthreads();
    }
}

enum { T_Q = 0, T_K = 1, T_SILU = 2, T_PLAIN = 3, T_LF = 4, T_VT = 5 };
struct P1Order {
    int G, c;
    __device__ __forceinline__ bool next(int i, pg8::Unit& u) const {
        const int L = i * G + c;
        const char* wsb = (const char*)kargs()->ws; const char* XN = wsb + WS_XN; const char* CN = wsb + WS_CN; const char* Wt0 = wsb + WS_WT0;
        constexpr size_t TSTEP = (size_t)256 * DM * 2;
        if (L < 896) {
            constexpr int nwg = 896, nN = 14, q = nwg / 8;
            const int xcd = L % 8, offp = L / 8; const int wgid = xcd * q + offp;
            constexpr int nig = 8 * nN; const int gid = wgid / nig, fm = gid * 8;
            u.pm = fm + ((wgid % nig) % 8); u.pn = (wgid % nig) / 8;
            u.a = XN + (size_t)u.pm * TSTEP + (size_t)(u.pm >> 3) * (4u << 20); u.b = Wt0 + (size_t)u.pn * TSTEP; u.aux = 0;
            u.ty = (u.pn < 2) ? T_Q : (u.pn < 4) ? T_K : (u.pn < 6) ? T_SILU : (u.pn < 8) ? T_PLAIN : (u.pn < 12) ? T_LF : T_SILU;
            return true;
        }
        int r = L - 896;
        if (r < 256) { const int xcd = r % 8, j = r / 8; u.pn = xcd * 8 + j / 4; u.pm = j % 4; u.a = Wt0 + (size_t)(14 + u.pm) * TSTEP; u.b = XN + (size_t)u.pn * TSTEP + (size_t)(u.pn >> 3) * (4u << 20); u.ty = T_VT; u.aux = 0; return true; }
        r -= 256;
        if (r < 48) { const int pmc = r % 8, j = r / 8; const int pn = (j < 2) ? 2 + j : 6 + j;
            u.pm = pmc; u.pn = pn; u.a = XN + (size_t)pmc * (8u << 20) + (4u << 20); u.b = Wt0 + (size_t)pn * TSTEP; u.aux = 1; u.ty = (pn < 4) ? T_K : T_LF; return true; }
        r -= 48;
        if (r < 32) { u.pn = r % 8; u.pm = r / 8; u.a = Wt0 + (size_t)(14 + u.pm) * TSTEP; u.b = XN + (size_t)u.pn * (8u << 20) + (4u << 20); u.ty = T_VT; u.aux = 1; return true; }
        return false;
    }
};
struct EpiP1 {
    const LAS float* tab;
    __device__ __forceinline__ void operator()(const f32x4 (&acc)[2][2][4][2], const pg8::Unit& u, int wr, int wc, int fr, int fq, int lane) const {
        KArgsPtr ka = kargs(); unsigned char* wsb = ka->ws; const float* qk_gain = ka->in[9];
        bf16_t* Y = (bf16_t*)(wsb + WS_Y); bf16_t* Kc = (bf16_t*)(wsb + WS_KC); bf16_t* VT = (bf16_t*)(wsb + WS_VT); bf16_t* GA = (bf16_t*)(wsb + WS_GA); bf16_t* HVT = (bf16_t*)(wsb + WS_HVT); bf16_t* GB = (bf16_t*)(wsb + WS_GB);
        unsigned short* LF = (unsigned short*)(wsb + WS_LF); const float* miscp = (const float*)(wsb + WS_MISC); const float* CS = miscp + MI_CS; const float* SN = miscp + MI_SN; const float* LBV = miscp + MI_LBV;
        const int ty = u.ty, ctx = u.aux;
        if (ty == T_Q || ty == T_K) {
            const int seg = 4 * (u.pn & 1) + wc;
            const LAS float* gp = tab + 2048 + (ty == T_K ? 64 : 0) + 8 * fq;
            const f32x4 g00 = *(const LAS f32x4*)(gp), g01 = *(const LAS f32x4*)(gp + 4), g10 = *(const LAS f32x4*)(gp + 32), g11 = *(const LAS f32x4*)(gp + 36);
            const float osc = (ty == T_Q) ? 0.125f * LOG2E : 1.f;
#pragma unroll
            for (int ai = 0; ai < 2; ++ai)
#pragma unroll
                for (int m = 0; m < 4; ++m) {
                    const int rt = 128 * ai + 64 * wr + 16 * m + fr;
                    const int t = ((u.pm & 7) * 256 + rt);
                    float ss = 0.f;
#pragma unroll
                    for (int bj = 0; bj < 2; ++bj)
#pragma unroll
                        for (int n = 0; n < 2; ++n) { const f32x4 v = acc[ai][bj][m][n]; ss += (v.x * v.x + v.y * v.y) + (v.z * v.z + v.w * v.w); }
                    ss += __shfl_xor(ss, 16); ss += __shfl_xor(ss, 32);
                    const float rstd = rsqrtf(ss * (1.f / 64.f) + EPS);
                    f32x4 a0 = acc[ai][0][m][0] * rstd * g00, a1 = acc[ai][0][m][1] * rstd * g01, b0 = acc[ai][1][m][0] * rstd * g10, b1 = acc[ai][1][m][1] * rstd * g11;
                    if (!ctx) {
                        const int pos = (fq < 2) ? (t >> 6) : (t & 63);
                        const LAS float* cp = tab + pos * 16 + 8 * (fq & 1); const LAS float* sp = cp + 1024;
                        const f32x4 c0 = *(const LAS f32x4*)cp, c1 = *(const LAS f32x4*)(cp + 4), s0 = *(const LAS f32x4*)sp, s1 = *(const LAS f32x4*)(sp + 4);
                        const f32x4 o0 = a0 * c0 - b0 * s0, o1 = a1 * c1 - b1 * s1, p0 = a0 * s0 + b0 * c0, p1 = a1 * s1 + b1 * c1;
                        a0 = o0; a1 = o1; b0 = p0; b1 = p1;
                    }
                    a0 = a0 * osc; a1 = a1 * osc; b0 = b0 * osc; b1 = b1 * osc;
                    u32x4 w0, w1;
                    w0.x = cvt_pk_bf16(a0.x, a0.y); w0.y = cvt_pk_bf16(a0.z, a0.w); w0.z = cvt_pk_bf16(a1.x, a1.y); w0.w = cvt_pk_bf16(a1.z, a1.w);
                    w1.x = cvt_pk_bf16(b0.x, b0.y); w1.y = cvt_pk_bf16(b0.z, b0.w); w1.z = cvt_pk_bf16(b1.x, b1.y); w1.w = cvt_pk_bf16(b1.z, b1.w);
                    bf16_t* dst;
                    if (ty == T_Q) dst = Y + (size_t)(u.pm * 256 + rt) * 1024 + seg * 64 + 8 * fq;
                    else if (!ctx) dst = Kc + ((size_t)(u.pm >> 3) * KV + CTX + t) * 512 + seg * 64 + 8 * fq;
                    else dst = Kc + ((size_t)u.pm * KV + rt) * 512 + seg * 64 + 8 * fq;
                    *(u32x4*)dst = w0; *(u32x4*)(dst + 32) = w1;
                }
        } else if (ty == T_SILU || ty == T_PLAIN) {
            bf16_t* base; int pitch;
            if (ty == T_PLAIN) { base = Y + 512 + (u.pn - 6) * 256; pitch = 1024; }
            else if (u.pn < 6) { base = GA + (u.pn - 4) * 256; pitch = 512; }
            else { base = GB + (u.pn - 12) * 256; pitch = 512; }
#pragma unroll
            for (int ai = 0; ai < 2; ++ai)
#pragma unroll
                for (int m = 0; m < 4; ++m) {
                    const int rt = 128 * ai + 64 * wr + 16 * m + fr;
                    bf16_t* rowp = base + (size_t)(u.pm * 256 + rt) * pitch + 32 * wc + 8 * fq;
#pragma unroll
                    for (int bj = 0; bj < 2; ++bj) {
                        f32x4 v0 = acc[ai][bj][m][0], v1 = acc[ai][bj][m][1];
                        if (ty == T_SILU) { v0.x = silu_fast(v0.x); v0.y = silu_fast(v0.y); v0.z = silu_fast(v0.z); v0.w = silu_fast(v0.w); v1.x = silu_fast(v1.x); v1.y = silu_fast(v1.y); v1.z = silu_fast(v1.z); v1.w = silu_fast(v1.w); }
                        u32x4 w; w.x = cvt_pk_bf16(v0.x, v0.y); w.y = cvt_pk_bf16(v0.z, v0.w); w.z = cvt_pk_bf16(v1.x, v1.y); w.w = cvt_pk_bf16(v1.z, v1.w);
                        *(u32x4*)(rowp + 128 * bj) = w;
                    }
                }
        } else if (ty == T_LF) {
            const int dir = (u.pn >= 10) ? 1 : 0; const int pnr = (u.pn - 8) & 1;
            const int col0 = 256 * pnr + 32 * wc + 8 * fq;
            f32x4 lb[2][2];
#pragma unroll
            for (int bj = 0; bj < 2; ++bj)
#pragma unroll
                for (int n = 0; n < 2; ++n) lb[bj][n] = *(const LAS f32x4*)(tab + 2176 + dir * 512 + col0 + 128 * bj + 4 * n);
#pragma unroll
            for (int ai = 0; ai < 2; ++ai)
#pragma unroll
                for (int m = 0; m < 4; ++m) {
                    const int rt = 128 * ai + 64 * wr + 16 * m + fr;
                    size_t krow;
                    if (!ctx) krow = ((size_t)(dir * 8 + (u.pm >> 3)) * KV + CTX + (u.pm & 7) * 256 + rt);
                    else krow = ((size_t)(dir * 8 + u.pm) * KV + rt);
                    unsigned short* rowp = LF + krow * 512 + col0;
#pragma unroll
                    for (int bj = 0; bj < 2; ++bj) {
                        float o[8];
#pragma unroll
                        for (int n = 0; n < 2; ++n)
#pragma unroll
                            for (int j = 0; j < 4; ++j) { const float z = acc[ai][bj][m][n][j]; const float l = lb[bj][n][j]; const float f = l + (1.f - l) * __builtin_amdgcn_rcpf(1.f + __expf(-z)); o[4 * n + j] = __builtin_amdgcn_logf(f); }
                        u32x4 w; w.x = cvt_pk_f16(o[0], o[1]); w.y = cvt_pk_f16(o[2], o[3]); w.z = cvt_pk_f16(o[4], o[5]); w.w = cvt_pk_f16(o[6], o[7]);
                        *(u32x4*)(rowp + 128 * bj) = w;
                    }
                }
        } else {
#pragma unroll
            for (int ai = 0; ai < 2; ++ai)
#pragma unroll
                for (int m = 0; m < 4; ++m) {
                    const int f = u.pm * 256 + 128 * ai + 64 * wr + 16 * m + fr;
                    bf16_t* base = (f < 512) ? VT : HVT; const int hh = (f & 511) >> 7, dv = f & 127;
                    const int b = ctx ? u.pn : (u.pn >> 3);
                    const int key0 = ctx ? 0 : CTX + (u.pn & 7) * 256;
                    bf16_t* rowp = base + ((size_t)(b * 4 + hh) * 128 + dv) * KV + key0 + 32 * wc + 8 * fq;
#pragma unroll
                    for (int bj = 0; bj < 2; ++bj) {
                        const f32x4 v0 = acc[ai][bj][m][0], v1 = acc[ai][bj][m][1];
                        u32x4 w; w.x = cvt_pk_bf16(v0.x, v0.y); w.y = cvt_pk_bf16(v0.z, v0.w); w.z = cvt_pk_bf16(v1.x, v1.y); w.w = cvt_pk_bf16(v1.z, v1.w);
                        *(u32x4*)(rowp + 128 * bj) = w;
                    }
                }
        }
    }
};
namespace att {
constexpr int NSLOT = 4, SLOTB = 32768, VOFF = 16384, NT = KV / 64;
__device__ __forceinline__ void glds16s(const void* sbase, unsigned voff, unsigned lds_dst) {
    unsigned keep;
    asm volatile("s_mov_b32 %0, m0\n\ts_mov_b32 m0, %3\n\ts_nop 0\n\tglobal_load_lds_dwordx4 %1, %2\n\ts_mov_b32 m0, %0" : "=&s"(keep) : "v"(voff), "s"(sbase), "s"(lds_dst) : "memory");
}
__device__ __forceinline__ void glds16(const void* gsrc, unsigned lds_dst) {
    unsigned keep;
    asm volatile("s_mov_b32 %0, m0\n\ts_mov_b32 m0, %2\n\ts_nop 0\n\tglobal_load_lds_dwordx4 %1, off\n\ts_mov_b32 m0, %0" : "=&s"(keep) : "v"(gsrc), "s"(lds_dst) : "memory");
}
#define ATT_WAIT_BAR(N) asm volatile("s_waitcnt vmcnt(" #N ") lgkmcnt(0)\n\ts_barrier" ::: "memory")
__device__ __forceinline__ int crow(int r, int hi) { return (r & 3) + 8 * (r >> 2) + 4 * hi; }
#define MFMA32(a, b, c) __builtin_amdgcn_mfma_f32_32x32x16_bf16((a), (b), (c), 0, 0, 0)

__device__ __forceinline__ void attn_unit(int b, int h, int qb, bf16_t* Y, const bf16_t* Kc, const bf16_t* VT, const bf16_t* GA, const float* subln_g,
                                          float lam, float M2, LAS unsigned char* lds, const int wv, const bool dry = false, unsigned* qctr = nullptr) {
    const int lane = lane_id(), r32 = lane & 31, hi = lane >> 5;
    const int wid = wv;
    const int m = wid >> 2, qs = wid & 3;
    const unsigned lds0 = (unsigned)(uintptr_t)lds;
    const int tok0 = b * SEQ + qb * 128 + qs * 32;
    const bf16_t* Kb = Kc + (size_t)b * KV * 512 + h * 128;
    const bf16_t* Vb = VT + (size_t)(b * 4 + h) * 128 * KV;
    const int krow0 = 16 * (wid & 3) + (lane >> 3), krow1 = krow0 + 8;
    const bf16_t* ksrc0 = Kb + (size_t)krow0 * 512 + (wid >> 2) * 64 + 8 * ((lane & 7) ^ ((krow0 >> 1) & 7));
    const bf16_t* ksrc1 = Kb + (size_t)krow1 * 512 + (wid >> 2) * 64 + 8 * ((lane & 7) ^ ((krow1 >> 1) & 7));
    const int vrow0 = 16 * wid + (lane >> 3), vrow1 = vrow0 + 8;
    const bf16_t* vsrc0 = Vb + (size_t)vrow0 * KV + 8 * ((lane & 7) ^ ((vrow0 >> 1) & 7));
    const bf16_t* vsrc1 = Vb + (size_t)vrow1 * KV + 8 * ((lane & 7) ^ ((vrow1 >> 1) & 7));
    const unsigned kdst = lds0 + (2 * wid) * 1024, vdst = lds0 + VOFF + (2 * wid) * 1024;
#define ATT_DMA(t, slot) do { const unsigned so_ = (unsigned)(slot) * SLOTB; \
        glds16(ksrc0 + (size_t)(t) * 64 * 512, (unsigned)__builtin_amdgcn_readfirstlane(kdst + so_)); \
        glds16(ksrc1 + (size_t)(t) * 64 * 512, (unsigned)__builtin_amdgcn_readfirstlane(kdst + so_ + 1024)); \
        glds16(vsrc0 + (size_t)(t) * 64, (unsigned)__builtin_amdgcn_readfirstlane(vdst + so_)); \
        glds16(vsrc1 + (size_t)(t) * 64, (unsigned)__builtin_amdgcn_readfirstlane(vdst + so_ + 1024)); } while (0)
    const unsigned kvo0 = (unsigned)((const char*)ksrc0 - (const char*)Kb), kvo1 = (unsigned)((const char*)ksrc1 - (const char*)Kb);
    const unsigned vvo0 = (unsigned)((const char*)vsrc0 - (const char*)Vb), vvo1 = (unsigned)((const char*)vsrc1 - (const char*)Vb);
#define ATT_DMA1(t, slot, i) do { const unsigned so_ = (unsigned)(slot) * SLOTB; \
        if ((i) == 0) glds16s(Kb + (size_t)(t) * 64 * 512, kvo0, (unsigned)__builtin_amdgcn_readfirstlane(kdst + so_)); \
        if ((i) == 1) glds16s(Kb + (size_t)(t) * 64 * 512, kvo1, (unsigned)__builtin_amdgcn_readfirstlane(kdst + so_ + 1024)); \
        if ((i) == 2) glds16s(Vb + (size_t)(t) * 64, vvo0, (unsigned)__builtin_amdgcn_readfirstlane(vdst + so_)); \
        if ((i) == 3) glds16s(Vb + (size_t)(t) * 64, vvo1, (unsigned)__builtin_amdgcn_readfirstlane(vdst + so_ + 1024)); } while (0)
    bf16x8 qr[4];
    {
        const bf16_t* qp = Y + (size_t)(tok0 + r32) * 1024 + h * 128 + m * 64 + hi * 8;
#pragma unroll
        for (int d0 = 0; d0 < 4; ++d0) qr[d0] = *(const bf16x8*)(qp + d0 * 16);
    }
    __builtin_amdgcn_sched_barrier(0);
    ATT_DMA(0, 0);
    const int pi = (r32 & ~12) | ((r32 & 4) << 1) | ((r32 & 8) >> 1);
    int koff[4], voff[4];
#pragma unroll
    for (int d0 = 0; d0 < 4; ++d0) koff[d0] = m * 8192 + pi * 128 + (((2 * d0 + hi) ^ ((pi >> 1) & 7)) << 4);
    const int swz = (r32 >> 1) & 7;
#pragma unroll
    for (int s = 0; s < 4; ++s) voff[s] = VOFF + r32 * 128 + (((2 * s + hi) ^ swz) << 4);
    f32x16 o[4];
#pragma unroll
    for (int i = 0; i < 4; ++i)
#pragma unroll
        for (int r = 0; r < 16; ++r) o[i][r] = 0.f;
    float lsum = 0.f;
    f32x16 negm;
#pragma unroll
    for (int r = 0; r < 16; ++r) negm[r] = -M2;
    f32x16 pA0, pA1, pB0, pB1;
#define ATT_QK(N0, N1, sbk) do { N0 = negm; N1 = negm; \
        _Pragma("unroll") for (int d0 = 0; d0 < 4; ++d0) { \
            const bf16x8 k0_ = *(const LAS bf16x8*)((sbk) + koff[d0]); const bf16x8 k1_ = *(const LAS bf16x8*)((sbk) + koff[d0] + 4096); \
            N0 = MFMA32(k0_, qr[d0], N0); N1 = MFMA32(k1_, qr[d0], N1); } } while (0)
#define ATT_EXP(N0, N1) do { _Pragma("unroll") for (int r = 0; r < 16; ++r) { N0[r] = __builtin_amdgcn_exp2f(N0[r]); N1[r] = __builtin_amdgcn_exp2f(N1[r]); } } while (0)
#define ATT_PACK8(X, B) (u32x4){cvt_pk_bf16(X[B], X[B + 1]), cvt_pk_bf16(X[B + 2], X[B + 3]), cvt_pk_bf16(X[B + 4], X[B + 5]), cvt_pk_bf16(X[B + 6], X[B + 7])}
#define ATT_KRD(d0, half) (*(const LAS bf16x8*)(sbk_ + koff[d0] + (half) * 4096))
#define ATT_VRD(blk, s) (*(const LAS bf16x8*)(sbv_ + voff[s] + (blk) * 4096))
#define ATT_GAP() __builtin_amdgcn_sched_barrier(0)
#define ATT_E4(X, B) do { X[B] = __builtin_amdgcn_exp2f(X[B]); X[B + 1] = __builtin_amdgcn_exp2f(X[B + 1]); X[B + 2] = __builtin_amdgcn_exp2f(X[B + 2]); X[B + 3] = __builtin_amdgcn_exp2f(X[B + 3]); } while (0)
#define ATT_PVROW(blk, V0, V1, V2, V3, W0, W1, W2, W3, nb, F0, F1, F2, F3) do { \
        o[blk] = MFMA32(__builtin_bit_cast(bf16x8, pw0_), V0, o[blk]); if ((nb) < 4) W0 = ATT_VRD((nb) & 3, 0); F0; ATT_GAP(); \
        o[blk] = MFMA32(__builtin_bit_cast(bf16x8, pw1_), V1, o[blk]); if ((nb) < 4) W1 = ATT_VRD((nb) & 3, 1); F1; ATT_GAP(); \
        o[blk] = MFMA32(__builtin_bit_cast(bf16x8, pw2_), V2, o[blk]); if ((nb) < 4) W2 = ATT_VRD((nb) & 3, 2); F2; ATT_GAP(); \
        o[blk] = MFMA32(__builtin_bit_cast(bf16x8, pw3_), V3, o[blk]); if ((nb) < 4) W3 = ATT_VRD((nb) & 3, 3); F3; ATT_GAP(); } while (0)
#define ATT_S2(X, B) do { sacc_ += X[B]; sacc_ += X[B + 1]; } while (0)
#define ATT_STEP(N0, N1, P0, P1, t) do { \
        ATT_WAIT_BAR(4); const int tn_ = ((t) + 2 < NT) ? (t) + 2 : NT - 1;     \
        const LAS unsigned char* sbk_ = lds + ((t) & 3) * SLOTB; const LAS unsigned char* sbv_ = lds + (((t) - 1) & 3) * SLOTB; \
        bf16x8 ka_ = ATT_KRD(0, 0), kb_ = ATT_KRD(1, 0), kc_ = ATT_KRD(2, 0), kd_ = ATT_KRD(3, 0); \
        u32x4 pw0_, pw1_, pw2_, pw3_; bf16x8 ke_, kf_, kg_, kh_, va_, vb_, vc_, vd_, ve_, vf_, vg_, vh_; float sacc_ = 0.f; \
        ATT_GAP(); \
        N0 = MFMA32(ka_, qr[0], negm); pw0_ = ATT_PACK8(P0, 0); ke_ = ATT_KRD(0, 1); kf_ = ATT_KRD(1, 1); ATT_GAP(); \
        N0 = MFMA32(kb_, qr[1], N0);   pw1_ = ATT_PACK8(P0, 8); kg_ = ATT_KRD(2, 1); kh_ = ATT_KRD(3, 1); ATT_GAP(); \
        N0 = MFMA32(kc_, qr[2], N0);   pw2_ = ATT_PACK8(P1, 0); va_ = ATT_VRD(0, 0); vb_ = ATT_VRD(0, 1); ATT_GAP(); \
        N0 = MFMA32(kd_, qr[3], N0);   pw3_ = ATT_PACK8(P1, 8); vc_ = ATT_VRD(0, 2); vd_ = ATT_VRD(0, 3); ATT_GAP(); \
        N1 = MFMA32(ke_, qr[0], negm); ATT_S2(P0, 0); ATT_S2(P0, 2); ATT_S2(P0, 4); ATT_S2(P0, 6); ATT_GAP(); \
        N1 = MFMA32(kf_, qr[1], N1);   ATT_E4(N0, 0);  ATT_GAP(); \
        N1 = MFMA32(kg_, qr[2], N1);   ATT_E4(N0, 4);  ATT_GAP(); \
        N1 = MFMA32(kh_, qr[3], N1);   ATT_E4(N0, 8);  ATT_GAP(); \
        ATT_PVROW(0, va_, vb_, vc_, vd_, ve_, vf_, vg_, vh_, 1, ATT_E4(N0, 12), do { ATT_S2(P0, 8); ATT_S2(P0, 10); ATT_S2(P0, 12); ATT_S2(P0, 14); } while (0), ATT_E4(N1, 0), do { ATT_S2(P1, 0); ATT_S2(P1, 2); ATT_S2(P1, 4); } while (0)); \
        ATT_PVROW(1, ve_, vf_, vg_, vh_, va_, vb_, vc_, vd_, 2, ATT_E4(N1, 4), do { ATT_S2(P1, 6); ATT_S2(P1, 8); ATT_S2(P1, 10); } while (0), ATT_E4(N1, 8), do { ATT_S2(P1, 12); ATT_S2(P1, 14); } while (0)); \
        ATT_PVROW(2, va_, vb_, vc_, vd_, ve_, vf_, vg_, vh_, 3, ATT_E4(N1, 12), (void)0, (void)0, (void)0); \
        ATT_PVROW(3, ve_, vf_, vg_, vh_, va_, vb_, vc_, vd_, 4, ATT_DMA1(tn_, ((t) + 2) & 3, 0), ATT_DMA1(tn_, ((t) + 2) & 3, 1), ATT_DMA1(tn_, ((t) + 2) & 3, 2), ATT_DMA1(tn_, ((t) + 2) & 3, 3)); \
        lsum += sacc_; } while (0)
#define ATT_PV(O0, O1, sbv) do { float sa_ = 0.f, sb_ = 0.f; \
        _Pragma("unroll") for (int r = 0; r < 16; ++r) { sa_ += O0[r]; sb_ += O1[r]; } lsum += sa_ + sb_; \
        u32x4 pw_[4]; pw_[0] = ATT_PACK8(O0, 0); pw_[1] = ATT_PACK8(O0, 8); pw_[2] = ATT_PACK8(O1, 0); pw_[3] = ATT_PACK8(O1, 8); \
        _Pragma("unroll") for (int blk = 0; blk < 4; ++blk) _Pragma("unroll") for (int s = 0; s < 4; ++s) { \
            const bf16x8 vb_ = *(const LAS bf16x8*)((sbv) + voff[s] + blk * 4096); \
            o[blk] = MFMA32(__builtin_bit_cast(bf16x8, pw_[s]), vb_, o[blk]); } } while (0)
    ATT_WAIT_BAR(0);
#pragma unroll
    for (int d0 = 0; d0 < 4; ++d0) asm volatile("" : "+v"(qr[d0]));
    ATT_DMA(1, 1); ATT_DMA(2, 2);
    ATT_QK(pA0, pA1, lds); ATT_EXP(pA0, pA1);
    for (int t = 1; t + 1 < NT; t += 2) {
        ATT_STEP(pB0, pB1, pA0, pA1, t);
        ATT_STEP(pA0, pA1, pB0, pB1, t + 1);
    }
    unsigned tk;
    if (qctr != nullptr && wv == 0 && lane == 0) ticket_draw(qctr, tk);
    ATT_STEP(pB0, pB1, pA0, pA1, NT - 1);
    const int rowq = 16 * m + (lane >> 4), ch16 = lane & 15;
    u32x4 gav[4];
#pragma unroll
    for (int ps = 0; ps < 4; ++ps) gav[ps] = *(const u32x4*)(GA + (size_t)(tok0 + rowq + 4 * ps) * 512 + h * 128 + 8 * ch16);
    { const LAS unsigned char* sbv_ = lds + ((NT - 1) & 3) * SLOTB; ATT_PV(pB0, pB1, sbv_); }
#undef ATT_STEP
#undef ATT_PV
#undef ATT_EXP
#undef ATT_QK
#undef ATT_PVROW
#undef ATT_S2
#undef ATT_E4
#undef ATT_GAP
#undef ATT_KRD
#undef ATT_VRD
#undef ATT_PACK8
    lsum += shfl_xor_l(lsum, 32, lane);
    ATT_WAIT_BAR(0);
    LAS float* wl = (LAS float*)(lds + 131072) + wid * 32;
    LAS float* ex = (LAS float*)lds + qs * 4096;
    if (hi == 0) wl[r32] = lsum;
    LDS_WAIT();
    float rl[16];
#pragma unroll
    for (int r = 0; r < 16; ++r) rl[r] = __builtin_amdgcn_rcpf(wl[crow(r, hi)]) * (m ? lam : 1.f);
    if (m == 1) {
#pragma unroll
        for (int blk = 0; blk < 4; ++blk)
#pragma unroll
            for (int r = 0; r < 16; ++r) ex[crow(r, hi) * 128 + blk * 32 + r32] = o[blk][r] * rl[r];
    }
    ATT_WAIT_BAR(0);
    if (m == 0) {
        float ss[16];
#pragma unroll
        for (int r = 0; r < 16; ++r) ss[r] = 0.f;
#pragma unroll
        for (int blk = 0; blk < 4; ++blk)
#pragma unroll
            for (int r = 0; r < 16; ++r) { const float v = o[blk][r] * rl[r] - ex[crow(r, hi) * 128 + blk * 32 + r32]; o[blk][r] = v; ss[r] += v * v; }
#pragma unroll
        for (int r = 0; r < 16; ++r) {
            float s = ss[r];
            s += shfl_xor_l(s, 1, lane); s += shfl_xor_l(s, 2, lane); s += shfl_xor_l(s, 4, lane); s += shfl_xor_l(s, 8, lane); s += shfl_xor_l(s, 16, lane);
            ss[r] = rsqrtf(s * (1.f / 128.f) + EPS) * (1.f - LAM_INIT);
        }
#pragma unroll
        for (int blk = 0; blk < 4; ++blk) {
            const float g = subln_g[blk * 32 + r32];
#pragma unroll
            for (int r = 0; r < 16; ++r) ex[crow(r, hi) * 128 + blk * 32 + r32] = o[blk][r] * ss[r] * g;
        }
    }
    ATT_WAIT_BAR(0);
    {
#pragma unroll
        for (int ps = 0; ps < 4; ++ps) {
            const int row = rowq + 4 * ps;
            const f32x4 a = *(const LAS f32x4*)(ex + row * 128 + 8 * ch16), c = *(const LAS f32x4*)(ex + row * 128 + 8 * ch16 + 4);
            const u32x4 g4 = gav[ps];
            u32x4 w; w.x = cvt_pk_bf16(a.x * bflo(g4.x), a.y * bfhi(g4.x)); w.y = cvt_pk_bf16(a.z * bflo(g4.y), a.w * bfhi(g4.y));
            w.z = cvt_pk_bf16(c.x * bflo(g4.z), c.y * bfhi(g4.z)); w.w = cvt_pk_bf16(c.z * bflo(g4.w), c.w * bfhi(g4.w));
            if (!dry) *(u32x4*)(Y + (size_t)(tok0 + row) * 1024 + h * 128 + 8 * ch16) = w;
        }
    }
    if (qctr != nullptr && wv == 0 && lane == 0) { ticket_wait(tk); ((volatile LAS unsigned*)(lds + LDSCTL_OFF))[16] = tk; }
    ATT_WAIT_BAR(0);
#undef ATT_DMA
#undef ATT_DMA1
}
}
namespace hg {
#define HG_BAR() asm volatile("s_waitcnt vmcnt(0) lgkmcnt(0)\n\ts_barrier" ::: "memory")
#define HG_LBAR() asm volatile("s_waitcnt lgkmcnt(0)\n\ts_barrier" ::: "memory")
__device__ __forceinline__ float h2f(unsigned short h) { return (float)__builtin_bit_cast(_Float16, h); }
__device__ __forceinline__ int crow(int r, int hi) { return (r & 3) + 8 * (r >> 2) + 4 * hi; }
__device__ __forceinline__ int pi32(int x) { return (x & ~12) | ((x & 4) << 1) | ((x & 8) >> 1); }
__device__ __forceinline__ int sw64(int r, int c) { return r * 128 + ((c ^ ((r >> 1) & 7)) << 4); }
__device__ __forceinline__ int sw128(int r, int c) { return r * 256 + ((c ^ (r & 15)) << 4); }

__device__ __forceinline__ void state_chain(int b, int h, int dir, const unsigned short* LF, const bf16_t* HVT, bf16_t* ST, LAS unsigned char* lds, const int wv, unsigned* qctr = nullptr) {
    const int lane = lane_id(), tid = wv * 64 + lane, r32 = lane & 31, hi = lane >> 5;
    const int wid = wv;
    const int k = tid & 127, part = tid >> 7;
    const int vt = wid & 3, kh = wid >> 2;
    LAS unsigned char* KsT = lds;
    LAS float* dec = (LAS float*)(lds + 32768);
    LAS float* ptot = (LAS float*)(lds + 32768 + 1024);
    LAS unsigned char* stage = lds + 40960;
    const unsigned short* lfb = LF + ((size_t)(dir * 8 + b) * KV) * 512 + h * 128 + k;
    const bf16_t* vb = HVT + ((size_t)(b * 4 + h) * 128 + 32 * vt + r32) * KV + 8 * hi;
    f32x16 S[2];
#pragma unroll
    for (int i = 0; i < 2; ++i)
#pragma unroll
        for (int r = 0; r < 16; ++r) S[i][r] = 0.f;
    unsigned short lfr[16]; bf16x8 bv[4];
    auto ckof = [&](int n) { return dir ? (n < 4 ? 3 - n : 39 - n) : n; };
    {
        const int key0 = 64 * ckof(0);
#pragma unroll
        for (int j = 0; j < 16; ++j) lfr[j] = lfb[(size_t)(key0 + 16 * part + j) * 512];
#pragma unroll
        for (int s = 0; s < 4; ++s) bv[s] = *(const bf16x8*)(vb + key0 + 16 * s);
    }
    unsigned tk = 0u;
    for (int n = 0; n < 36; ++n) {
        const int p = n & 1, ck = ckof(n);
        if (n == 34 && qctr != nullptr && wv == 0 && lane == 0) tk = __hip_atomic_fetch_add(qctr, 1u, __ATOMIC_RELAXED, __HIP_MEMORY_SCOPE_AGENT);
        float lfv[16], c[16];
#pragma unroll
        for (int j = 0; j < 16; ++j) lfv[j] = h2f(lfr[j]);
        bf16x8 bcur[4];
#pragma unroll
        for (int s = 0; s < 4; ++s) bcur[s] = bv[s];
        if (n + 1 < 36) {
            const int key1 = 64 * ckof(n + 1);
#pragma unroll
            for (int j = 0; j < 16; ++j) lfr[j] = lfb[(size_t)(key1 + 16 * part + j) * 512];
#pragma unroll
            for (int s = 0; s < 4; ++s) bv[s] = *(const bf16x8*)(vb + key1 + 16 * s);
        }
        if (dir == 0) { float a = 0.f;
#pragma unroll
            for (int j = 0; j < 16; ++j) { a += lfv[j]; c[j] = a; } }
        else { float a = 0.f;
#pragma unroll
            for (int j = 15; j >= 0; --j) { a += lfv[j]; c[j] = a; } }
        const float T = dir ? c[0] : c[15];
        ptot[(p * 4 + part) * 128 + k] = T;
        HG_LBAR();
        float off = 0.f, gtot = 0.f;
        float pv4[4];
#pragma unroll
        for (int q = 0; q < 4; ++q) pv4[q] = ptot[(p * 4 + q) * 128 + k];
#pragma unroll
        for (int q = 0; q < 4; ++q) { gtot += pv4[q]; const bool take = dir ? (q > part) : (q < part); off += take ? pv4[q] : 0.f; }
        unsigned w[8];
#pragma unroll
        for (int j = 0; j < 16; j += 2) {
            const float k0 = (1.f - __builtin_amdgcn_exp2f(lfv[j])) * __builtin_amdgcn_exp2f(gtot - (c[j] + off));
            const float k1 = (1.f - __builtin_amdgcn_exp2f(lfv[j + 1])) * __builtin_amdgcn_exp2f(gtot - (c[j + 1] + off));
            w[j >> 1] = cvt_pk_bf16(k0, k1);
        }
        LAS unsigned char* kp = KsT + p * 16384;
        *(LAS u32x4*)(kp + sw64(k, 2 * part)) = (u32x4){w[0], w[1], w[2], w[3]};
        *(LAS u32x4*)(kp + sw64(k, 2 * part + 1)) = (u32x4){w[4], w[5], w[6], w[7]};
        if (part == 0) dec[p * 128 + k] = __builtin_amdgcn_exp2f(gtot);
        if (ck >= 4) {
#pragma unroll
            for (int kt = 0; kt < 2; ++kt)
#pragma unroll
                for (int g = 0; g < 4; ++g) {
                    u32x2 o; o.x = cvt_pk_bf16(S[kt][4 * g], S[kt][4 * g + 1]); o.y = cvt_pk_bf16(S[kt][4 * g + 2], S[kt][4 * g + 3]);
                    *(LAS u32x2*)(stage + sw128(32 * vt + r32, 8 * kh + 4 * kt + g) + 8 * hi) = o;
                }
        }
        HG_LBAR();
        if (ck >= 4) {
            bf16_t* sp = ST + ((size_t)((b * 4 + h) * 2 + dir) * 32 + (ck - 4)) * 16384;
            const int row = tid >> 2, q4 = tid & 3;
            u32x4 cv[4];
#pragma unroll
            for (int c = 0; c < 4; ++c) cv[c] = *(const LAS u32x4*)(stage + sw128(row, 4 * q4 + c));
#pragma unroll
            for (int c = 0; c < 4; ++c) *(u32x4*)(sp + row * 128 + (4 * q4 + c) * 8) = cv[c];
        }
        {
            bf16x8 af[2][4]; f32x4 dc[2][4];
#pragma unroll
            for (int kt = 0; kt < 2; ++kt) {
                const int krow = 32 * (2 * kh + kt);
#pragma unroll
                for (int g = 0; g < 4; ++g) dc[kt][g] = *(const LAS f32x4*)(dec + p * 128 + krow + 8 * g + 4 * hi);
#pragma unroll
                for (int s2 = 0; s2 < 4; ++s2) af[kt][s2] = *(const LAS bf16x8*)(kp + sw64(krow + r32, 2 * s2 + hi));
            }
#pragma unroll
            for (int kt = 0; kt < 2; ++kt) {
#pragma unroll
                for (int g = 0; g < 4; ++g) { S[kt][4 * g] *= dc[kt][g].x; S[kt][4 * g + 1] *= dc[kt][g].y; S[kt][4 * g + 2] *= dc[kt][g].z; S[kt][4 * g + 3] *= dc[kt][g].w; }
#pragma unroll
                for (int s2 = 0; s2 < 4; ++s2) S[kt] = __builtin_amdgcn_mfma_f32_32x32x16_bf16(af[kt][s2], bcur[s2], S[kt], 0, 0, 0);
            }
        }
    }
    if (qctr != nullptr && wv == 0 && lane == 0) ((volatile LAS unsigned*)(lds + LDSCTL_OFF))[16] = tk;
    HG_BAR();
}

struct OutPre { u32x4 sraw[2][4], vraw[2]; unsigned fa[8], fb[8], fq[8]; };
__device__ __forceinline__ void out_load(OutPre& P, int b, int h, int lc, const int wv) {
    unsigned char* wsb_ = kargs()->ws; const bf16_t* Y = (const bf16_t*)(wsb_ + WS_Y); const unsigned short* LF = (const unsigned short*)(wsb_ + WS_LF);
    const int tid = wv * 64 + lane_id();
    const int key0 = CTX + 64 * lc;
    const size_t tok0 = (size_t)b * SEQ + 64 * lc;
    { const bf16_t* ST = (const bf16_t*)(wsb_ + WS_ST); const bf16_t* HVT = (const bf16_t*)(wsb_ + WS_HVT);
      const int schunk = tid & 15, srow = tid >> 4;
#pragma unroll
      for (int dir = 0; dir < 2; ++dir) {
          const bf16_t* stp = ST + ((size_t)((b * 4 + h) * 2 + dir) * 32 + lc) * 16384;
#pragma unroll
          for (int i = 0; i < 4; ++i) P.sraw[dir][i] = *(const u32x4*)(stp + (size_t)(srow + 32 * i) * 128 + 8 * schunk);
      }
      const bf16_t* vtp = HVT + ((size_t)(b * 4 + h) * 128) * KV + key0;
#pragma unroll
      for (int i = 0; i < 2; ++i) P.vraw[i] = *(const u32x4*)(vtp + (size_t)((tid >> 3) + 64 * i) * KV + 8 * (tid & 7)); }
    const int kp2 = tid & 63, part8 = tid >> 6;
    const unsigned short* pf = LF + ((size_t)(0 * 8 + b) * KV + key0 + 8 * part8) * 512 + h * 128 + 2 * kp2;
    const unsigned short* pb = LF + ((size_t)(1 * 8 + b) * KV + key0 + 8 * part8) * 512 + h * 128 + 2 * kp2;
    const bf16_t* pq = Y + (tok0 + 8 * part8) * 1024 + 512 + h * 128 + 2 * kp2;
#pragma unroll
    for (int j = 0; j < 8; ++j) { P.fa[j] = *(const unsigned*)(pf + (size_t)j * 512); P.fb[j] = *(const unsigned*)(pb + (size_t)j * 512); P.fq[j] = *(const unsigned*)(pq + (size_t)j * 1024); }
}
__device__ __forceinline__ void out_settle(OutPre& P) {
#pragma unroll
    for (int d = 0; d < 2; ++d)
#pragma unroll
        for (int i = 0; i < 4; ++i) asm volatile("" : "+v"(P.sraw[d][i]));
    asm volatile("" : "+v"(P.vraw[0]), "+v"(P.vraw[1]));
#pragma unroll
    for (int j = 0; j < 8; ++j) asm volatile("" : "+v"(P.fa[j]), "+v"(P.fb[j]), "+v"(P.fq[j]));
}
__device__ __forceinline__ void out_unit(int b, int h, int lc, LAS unsigned char* lds, const int wv,
                                         OutPre& P, const bool pre_valid, const unsigned acq_mask, const int qoff, int& nidx, bool& npre, const bool dry = false, unsigned* qctr = nullptr) {
    const int lane = lane_id(), tid = wv * 64 + lane, r32 = lane & 31, hi = lane >> 5;
    const int wid = wv;
    const int tb = wid & 1, vt = wid >> 1;
    LAS unsigned char* STx = lds + 65536;
    LAS unsigned char* VTt = lds + 131072;
    LAS float* ptot = (LAS float*)(lds + 147456);
    LAS float* ssx = (LAS float*)(lds + 147456 + 8192);
    const size_t tok0 = (size_t)b * SEQ + 64 * lc;
    const int trow = 32 * tb + r32;
    const int schunk = tid & 15, srow = tid >> 4;
    if (!pre_valid) { out_load(P, b, h, lc, wv); asm volatile("s_waitcnt vmcnt(0)" ::: "memory"); out_settle(P); }
    unsigned tk;
    if (qctr != nullptr && wv == 0 && lane == 0) ticket_draw(qctr, tk);
    const int kp2 = tid & 63, part8 = tid >> 6;
    float lff[8][2], lfbw[8][2], qv[8][2];
#pragma unroll
    for (int j = 0; j < 8; ++j) {
        const unsigned a = P.fa[j], c2 = P.fb[j], d = P.fq[j];
        lff[j][0] = h2f((unsigned short)(a & 0xffffu)); lff[j][1] = h2f((unsigned short)(a >> 16));
        lfbw[j][0] = h2f((unsigned short)(c2 & 0xffffu)); lfbw[j][1] = h2f((unsigned short)(c2 >> 16));
        qv[j][0] = bflo(d); qv[j][1] = bfhi(d);
    }
    float cf[8][2], cb[8][2];
#pragma unroll
    for (int e = 0; e < 2; ++e) {
        float a = 0.f;
#pragma unroll
        for (int j = 0; j < 8; ++j) { a += lff[j][e]; cf[j][e] = a; }
        a = 0.f;
#pragma unroll
        for (int j = 7; j >= 0; --j) { a += lfbw[j][e]; cb[j][e] = a; }
    }
    *(LAS f32x2*)(ptot + (0 * 8 + part8) * 128 + 2 * kp2) = (f32x2){cf[7][0], cf[7][1]};
    *(LAS f32x2*)(ptot + (1 * 8 + part8) * 128 + 2 * kp2) = (f32x2){cb[0][0], cb[0][1]};
    HG_LBAR();
    f32x2 offf = {0.f, 0.f}, offb = {0.f, 0.f}, Rf = {0.f, 0.f}, Rb = {0.f, 0.f};
#pragma unroll
    for (int q = 0; q < 8; ++q) {
        const f32x2 pfq = *(const LAS f32x2*)(ptot + (0 * 8 + q) * 128 + 2 * kp2), pbq = *(const LAS f32x2*)(ptot + (1 * 8 + q) * 128 + 2 * kp2);
        if (q < 4) Rf += pfq; else Rb += pbq;
        offf += (q < part8) ? pfq : (f32x2){0.f, 0.f};
        offb += (q > part8) ? pbq : (f32x2){0.f, 0.f};
    }
#pragma unroll
    for (int j = 0; j < 8; ++j) {
        const int i = 8 * part8 + j;
        float v[4][2];
#pragma unroll
        for (int e = 0; e < 2; ++e) {
            const float gf = cf[j][e] + (e ? offf.y : offf.x), gb = cb[j][e] + (e ? offb.y : offb.x);
            const float kf = 1.f - __builtin_amdgcn_exp2f(lff[j][e]), kb = 1.f - __builtin_amdgcn_exp2f(lfbw[j][e]);
            const float df = fminf(fmaxf(gf - (e ? Rf.y : Rf.x), -100.f), 100.f), db = fminf(fmaxf(gb - (e ? Rb.y : Rb.x), -100.f), 100.f);
            const float q = qv[j][e];
            const float e1 = __builtin_amdgcn_exp2f(df), e2 = __builtin_amdgcn_exp2f(db);
            v[0][e] = q * e1; v[1][e] = kf * __builtin_amdgcn_rcpf(e1);
            v[2][e] = q * e2; v[3][e] = kb * __builtin_amdgcn_rcpf(e2);
        }
        const int o = sw128(i, kp2 >> 2) + (kp2 & 3) * 4;
#pragma unroll
        for (int mtx = 0; mtx < 4; ++mtx) *(LAS unsigned*)(lds + mtx * 16384 + o) = cvt_pk_bf16(v[mtx][0], v[mtx][1]);
    }
#pragma unroll
    for (int dir = 0; dir < 2; ++dir) {
        f32x4 ra = {0.f, 0.f, 0.f, 0.f}, rb2 = {0.f, 0.f, 0.f, 0.f};
#pragma unroll
        for (int q = 0; q < 4; ++q) { const LAS float* pp = ptot + (dir * 8 + 4 * dir + q) * 128 + 8 * schunk; ra += *(const LAS f32x4*)pp; rb2 += *(const LAS f32x4*)(pp + 4); }
        float er[8];
        er[0] = __builtin_amdgcn_exp2f(ra.x); er[1] = __builtin_amdgcn_exp2f(ra.y); er[2] = __builtin_amdgcn_exp2f(ra.z); er[3] = __builtin_amdgcn_exp2f(ra.w);
        er[4] = __builtin_amdgcn_exp2f(rb2.x); er[5] = __builtin_amdgcn_exp2f(rb2.y); er[6] = __builtin_amdgcn_exp2f(rb2.z); er[7] = __builtin_amdgcn_exp2f(rb2.w);
#pragma unroll
        for (int i = 0; i < 4; ++i) {
            const u32x4 r = P.sraw[dir][i]; u32x4 w;
            w.x = cvt_pk_bf16(bflo(r.x) * er[0], bfhi(r.x) * er[1]); w.y = cvt_pk_bf16(bflo(r.y) * er[2], bfhi(r.y) * er[3]);
            w.z = cvt_pk_bf16(bflo(r.z) * er[4], bfhi(r.z) * er[5]); w.w = cvt_pk_bf16(bflo(r.w) * er[6], bfhi(r.w) * er[7]);
            *(LAS u32x4*)(STx + dir * 32768 + sw128(srow + 32 * i, schunk)) = w;
        }
    }
#pragma unroll
    for (int i = 0; i < 2; ++i) *(LAS u32x4*)(VTt + sw64((tid >> 3) + 64 * i, tid & 7)) = P.vraw[i];
    if (qctr != nullptr && wv == 0 && lane == 0) { ticket_wait(tk); ((volatile LAS unsigned*)(lds + LDSCTL_OFF))[16] = tk; }
    HG_LBAR();
    u32x4 gbv[2];
#pragma unroll
    for (int i = 0; i < 2; ++i) gbv[i] = *(const u32x4*)((const bf16_t*)(kargs()->ws + WS_GB) + (tok0 + (tid >> 4) + 32 * i) * 512 + h * 128 + 8 * (tid & 15));
    nidx = -1; npre = false;
    if (qctr != nullptr) {
        nidx = (int)((volatile LAS unsigned*)(lds + LDSCTL_OFF))[16] + qoff;
        if (nidx >= 72 && nidx < 200) { const int nh = (nidx - 72) >> 5, nlc = (nidx - 72) & 31;
            if ((acq_mask >> nh) & 1u) { out_load(P, b, nh, nlc, wv); npre = true; } }
    }
    f32x16 o;
#pragma unroll
    for (int r = 0; r < 16; ++r) o[r] = 0.f;
    const int prow = pi32(r32), vrow = 32 * vt + r32;
    bf16x8 vd[2], vo[2];
#pragma unroll
    for (int s2 = 0; s2 < 2; ++s2) { vd[s2] = *(const LAS bf16x8*)(VTt + sw64(vrow, 4 * tb + 2 * s2 + hi)); vo[s2] = *(const LAS bf16x8*)(VTt + sw64(vrow, 4 * (1 - tb) + 2 * s2 + hi)); }
#pragma unroll
    for (int dir = 0; dir < 2; ++dir) {
        const LAS unsigned char* Qx = lds + (2 * dir + 0) * 16384; const LAS unsigned char* Kx = lds + (2 * dir + 1) * 16384; const LAS unsigned char* Sx = STx + dir * 32768;
        bf16x8 qf[8], kd[8], sf[8];
#pragma unroll
        for (int ks = 0; ks < 8; ++ks) { qf[ks] = *(const LAS bf16x8*)(Qx + sw128(trow, 2 * ks + hi)); kd[ks] = *(const LAS bf16x8*)(Kx + sw128(32 * tb + prow, 2 * ks + hi)); }
#pragma unroll
        for (int ks = 0; ks < 8; ++ks) sf[ks] = *(const LAS bf16x8*)(Sx + sw128(vrow, 2 * ks + hi));
        f32x16 at;
#pragma unroll
        for (int r = 0; r < 16; ++r) at[r] = 0.f;
#pragma unroll
        for (int ks = 0; ks < 8; ++ks) at = __builtin_amdgcn_mfma_f32_32x32x16_bf16(kd[ks], qf[ks], at, 0, 0, 0);
#pragma unroll
        for (int r = 0; r < 16; ++r) { const int sl = 16 * (r >> 3) + 8 * hi + (r & 7); const bool keep = dir ? (sl >= r32) : (sl <= r32); at[r] = keep ? at[r] : 0.f; }
#pragma unroll
        for (int s2 = 0; s2 < 2; ++s2) {
            const u32x4 pw = (u32x4){cvt_pk_bf16(at[8 * s2], at[8 * s2 + 1]), cvt_pk_bf16(at[8 * s2 + 2], at[8 * s2 + 3]), cvt_pk_bf16(at[8 * s2 + 4], at[8 * s2 + 5]), cvt_pk_bf16(at[8 * s2 + 6], at[8 * s2 + 7])};
            o = __builtin_amdgcn_mfma_f32_32x32x16_bf16(vd[s2], __builtin_bit_cast(bf16x8, pw), o, 0, 0, 0);
        }
        if (dir != tb) {
#pragma unroll
            for (int ks = 0; ks < 8; ++ks) kd[ks] = *(const LAS bf16x8*)(Kx + sw128(32 * (1 - tb) + prow, 2 * ks + hi));
#pragma unroll
            for (int r = 0; r < 16; ++r) at[r] = 0.f;
#pragma unroll
            for (int ks = 0; ks < 8; ++ks) at = __builtin_amdgcn_mfma_f32_32x32x16_bf16(kd[ks], qf[ks], at, 0, 0, 0);
#pragma unroll
            for (int s2 = 0; s2 < 2; ++s2) {
                const u32x4 pw = (u32x4){cvt_pk_bf16(at[8 * s2], at[8 * s2 + 1]), cvt_pk_bf16(at[8 * s2 + 2], at[8 * s2 + 3]), cvt_pk_bf16(at[8 * s2 + 4], at[8 * s2 + 5]), cvt_pk_bf16(at[8 * s2 + 6], at[8 * s2 + 7])};
                o = __builtin_amdgcn_mfma_f32_32x32x16_bf16(vo[s2], __builtin_bit_cast(bf16x8, pw), o, 0, 0, 0);
            }
        }
#pragma unroll
        for (int ks = 0; ks < 8; ++ks) o = __builtin_amdgcn_mfma_f32_32x32x16_bf16(sf[ks], qf[ks], o, 0, 0, 0);
    }
    float ss = 0.f;
#pragma unroll
    for (int r = 0; r < 16; ++r) ss += o[r] * o[r];
    ss += shfl_xor_l(ss, 32, lane);
    if (hi == 0) ssx[vt * 64 + trow] = ss;
    HG_LBAR();
    const float tot = ssx[trow] + ssx[64 + trow] + ssx[128 + trow] + ssx[192 + trow];
    const float rstd = rsqrtf(tot * (1.f / 128.f) + EPS);
    LAS float* og = (LAS float*)lds;
#pragma unroll
    for (int g = 0; g < 4; ++g) {
        const int v = 32 * vt + 8 * g + 4 * hi;
        const f32x4 gn = *(const LAS f32x4*)((const LAS float*)(lds + 156672) + v);
        *(LAS f32x4*)(og + trow * 132 + v) = (f32x4){o[4 * g] * rstd * gn.x, o[4 * g + 1] * rstd * gn.y, o[4 * g + 2] * rstd * gn.z, o[4 * g + 3] * rstd * gn.w};
    }
    HG_LBAR();
#pragma unroll
    for (int i = 0; i < 2; ++i) {
        const int row = (tid >> 4) + 32 * i, ch = tid & 15;
        const f32x4 a = *(const LAS f32x4*)(og + row * 132 + 8 * ch), c = *(const LAS f32x4*)(og + row * 132 + 8 * ch + 4);
        const u32x4 g4 = gbv[i];
        u32x4 w; w.x = cvt_pk_bf16(a.x * bflo(g4.x), a.y * bfhi(g4.x)); w.y = cvt_pk_bf16(a.z * bflo(g4.y), a.w * bfhi(g4.y));
        w.z = cvt_pk_bf16(c.x * bflo(g4.z), c.y * bfhi(g4.z)); w.w = cvt_pk_bf16(c.z * bflo(g4.w), c.w * bfhi(g4.w));
        if (!dry) *(u32x4*)((bf16_t*)(kargs()->ws + WS_Y) + (tok0 + row) * 1024 + 512 + h * 128 + 8 * ch) = w;
    }
    HG_BAR();
    if (npre) out_settle(P);
}
}
template <size_t OFFA, size_t OFFB> struct OutOrder {
    int G, c;
    __device__ __forceinline__ bool next(int i, pg8::Unit& u) const {
        const int L = i * G + c; if (L >= 256) return false;
        const char* wsb = (const char*)kargs()->ws; const char* A = wsb + OFFA; const char* Bt = wsb + OFFB;
        constexpr size_t TSTEP = (size_t)256 * DM * 2;
        const int xcd = L % 8, offp = L / 8; const int wgid = xcd * 32 + offp;
        u.pm = xcd * 8 + (wgid % 32) % 8; u.pn = (wgid % 32) / 8; u.a = A + (size_t)u.pm * TSTEP; u.b = Bt + (size_t)u.pn * TSTEP; u.ty = 0; u.aux = 0; return true;
    }
};
struct EpiP4 {
    __device__ __forceinline__ void operator()(const f32x4 (&acc)[2][2][4][2], const pg8::Unit& u, int wr, int wc, int fr, int fq, int lane) const {
        KArgsPtr ka = kargs(); unsigned char* wsb = ka->ws; const float* x = ka->in[0]; bf16_t* x1b = (bf16_t*)(wsb + WS_X1B); const float* gain1 = ka->in[4] + 1024;
        bf16_t* A1 = (bf16_t*)(wsb + WS_A1); float* SSQ1 = (float*)(wsb + WS_SSQ1); const float* mod = (const float*)(wsb + WS_MISC) + MI_MOD;
        const int b = u.pm >> 3;
        const int col0 = 256 * u.pn + 32 * wc + 8 * fq;
        f32x4 gt[2][2], gm[2][2];
#pragma unroll
        for (int bj = 0; bj < 2; ++bj)
#pragma unroll
            for (int n = 0; n < 2; ++n) { const int c = col0 + 128 * bj + 4 * n;
                gt[bj][n] = *(const f32x4*)(mod + (0 * 9 + b) * 3072 + 2048 + c);
                gm[bj][n] = *(const f32x4*)(gain1 + c) * (*(const f32x4*)(mod + (9 + b) * 3072 + 1024 + c) + 1.f); }
        const float* xbase = x + ((size_t)u.pm * 256 + 64 * wr + fr) * 1024 + col0;
        f32x4 xr[3][4];
#define P4_LDX(it) do { const float* xp_ = xbase + (size_t)(128 * ((it) >> 2) + 16 * ((it) & 3)) * 1024; \
            xr[(it) % 3][0] = *(const f32x4*)(xp_); xr[(it) % 3][1] = *(const f32x4*)(xp_ + 4); xr[(it) % 3][2] = *(const f32x4*)(xp_ + 128); xr[(it) % 3][3] = *(const f32x4*)(xp_ + 132); } while (0)
        P4_LDX(0); P4_LDX(1);
#pragma unroll
        for (int it = 0; it < 8; ++it) {
            if (it + 2 < 8) P4_LDX(it + 2);
            __builtin_amdgcn_sched_barrier(0);
            const int ai = it >> 2, m = it & 3;
            {
                const size_t row = (size_t)u.pm * 256 + 128 * ai + 64 * wr + 16 * m + fr;
                float ss = 0.f;
#pragma unroll
                for (int bj = 0; bj < 2; ++bj) {
                    const size_t o = row * 1024 + col0 + 128 * bj;
                    const f32x4 xa = xr[it % 3][2 * bj], xb = xr[it % 3][2 * bj + 1];
                    const f32x4 v0 = xa + gt[bj][0] * acc[ai][bj][m][0], v1 = xb + gt[bj][1] * acc[ai][bj][m][1];
                    { u32x4 xw; xw.x = cvt_pk_bf16(v0.x, v0.y); xw.y = cvt_pk_bf16(v0.z, v0.w); xw.z = cvt_pk_bf16(v1.x, v1.y); xw.w = cvt_pk_bf16(v1.z, v1.w); *(u32x4*)(x1b + o) = xw; }
                    ss += (v0.x * v0.x + v0.y * v0.y) + (v0.z * v0.z + v0.w * v0.w) + (v1.x * v1.x + v1.y * v1.y) + (v1.z * v1.z + v1.w * v1.w);
                    const f32x4 a0 = v0 * gm[bj][0], a1 = v1 * gm[bj][1];
                    u32x4 w; w.x = cvt_pk_bf16(a0.x, a0.y); w.y = cvt_pk_bf16(a0.z, a0.w); w.z = cvt_pk_bf16(a1.x, a1.y); w.w = cvt_pk_bf16(a1.z, a1.w);
                    *(u32x4*)(A1 + o) = w;
                }
                ss += __shfl_xor(ss, 16); ss += __shfl_xor(ss, 32);
                if (fq == 0) SSQ1[row * 16 + u.pn * 4 + wc] = ss;
            }
            __builtin_amdgcn_sched_barrier(0);
        }
#undef P4_LDX
    }
};
struct EpiP7 {
    __device__ __forceinline__ void operator()(const f32x4 (&acc)[2][2][4][2], const pg8::Unit& u, int wr, int wc, int fr, int fq, int lane) const {
        KArgsPtr ka = kargs(); float* outp = ka->out; const bf16_t* x1b = (const bf16_t*)(ka->ws + WS_X1B); const float* mod = (const float*)(ka->ws + WS_MISC) + MI_MOD;
        const int b = u.pm >> 3;
        const int col0 = 256 * u.pn + 32 * wc + 8 * fq;
        f32x4 gt[2][2];
#pragma unroll
        for (int bj = 0; bj < 2; ++bj)
#pragma unroll
            for (int n = 0; n < 2; ++n) gt[bj][n] = *(const f32x4*)(mod + (9 + b) * 3072 + 2048 + col0 + 128 * bj + 4 * n);
        u32x4 xq[8][2];
#pragma unroll
        for (int it = 0; it < 8; ++it)
#pragma unroll
            for (int bj = 0; bj < 2; ++bj) xq[it][bj] = *(const u32x4*)(x1b + ((size_t)u.pm * 256 + 128 * (it >> 2) + 64 * wr + 16 * (it & 3) + fr) * 1024 + col0 + 128 * bj);
        __builtin_amdgcn_sched_barrier(0);
#pragma unroll
        for (int ai = 0; ai < 2; ++ai)
#pragma unroll
            for (int m = 0; m < 4; ++m) {
                const size_t row = (size_t)u.pm * 256 + 128 * ai + 64 * wr + 16 * m + fr;
#pragma unroll
                for (int bj = 0; bj < 2; ++bj) {
                    const size_t o = row * 1024 + col0 + 128 * bj;
                    const u32x4 xw = xq[ai * 4 + m][bj];
                    const f32x4 xa = (f32x4){bflo(xw.x), bfhi(xw.x), bflo(xw.y), bfhi(xw.y)}, xb = (f32x4){bflo(xw.z), bfhi(xw.z), bflo(xw.w), bfhi(xw.w)};
                    *(f32x4*)(outp + o) = xa + gt[bj][0] * acc[ai][bj][m][0]; *(f32x4*)(outp + o + 4) = xb + gt[bj][1] * acc[ai][bj][m][1];
                }
            }
    }
};

struct P5Order {
    int G, c;
    __device__ __forceinline__ bool next(int i, pg8::Unit& u) const {
        const int L = i * G + c; if (L >= 768) return false;
        const char* wsb = (const char*)kargs()->ws; const char* A1 = wsb + WS_A1; const char* Wt1 = wsb + WS_WT1;
        constexpr size_t TSTEP = (size_t)256 * DM * 2;
        const int xcd = L % 8, offp = L / 8; const int wgid = xcd * 96 + offp;
        u.pm = xcd * 8 + (wgid % 96) % 8; u.pn = (wgid % 96) / 8; u.a = A1 + (size_t)u.pm * TSTEP; u.b = Wt1 + (size_t)u.pn * TSTEP; u.ty = 0; u.aux = 0; return true;
    }
};
struct P5HalfOrder {
    int G, c;
    __device__ __forceinline__ bool next(int i, pg8::Unit& u) const {
        const int L = i * G + c; if (L >= 256) return false;
        const char* wsb = (const char*)kargs()->ws; const char* A1 = wsb + WS_A1; const char* Wt1 = wsb + WS_WT1;
        constexpr size_t TSTEP = (size_t)256 * DM * 2;
        const int xcd = L % 8, j = L / 8; u.pn = xcd * 16 + j / 2; u.pm = j % 2;
        u.a = Wt1 + (size_t)(12 + u.pm) * TSTEP; u.b = A1 + (size_t)u.pn * (TSTEP / 2); u.ty = 1; u.aux = 0; return true;
    }
};
__device__ __forceinline__ float gelu_as(float v) {
    const float av = fabsf(v), t = __builtin_amdgcn_rcpf(av * 0.2316418882f + 1.0f);
    float q = t * 0.5307027145f + (-0.7265760135f); q = q * t + 0.7107068705f; q = q * t + (-0.142248368f); q = q * t + 0.127414796f; q = q * t;
    const float e = __builtin_amdgcn_exp2f((v * v) * (-0.72134752044f));
    const float mm = v * (q * e);
    return v < 0.f ? mm : v - mm;
}
__device__ __forceinline__ float rstd16(const float* SSQ1, size_t row) {
    const f32x4* p = (const f32x4*)(SSQ1 + row * 16);
    const f32x4 a = p[0], b = p[1], c = p[2], d = p[3];
    const float s = ((a.x + a.y) + (a.z + a.w)) + ((b.x + b.y) + (b.z + b.w)) + ((c.x + c.y) + (c.z + c.w)) + ((d.x + d.y) + (d.z + d.w));
    return rsqrtf(s * (1.f / 1024.f) + EPS);
}
struct EpiP5 {
    const LAS float* rst; int tpm;
    __device__ __forceinline__ void operator()(const f32x4 (&acc)[2][2][4][2], const pg8::Unit& u, int wr, int wc, int fr, int fq, int lane) const {
        unsigned char* wsb = kargs()->ws; bf16_t* UG = (bf16_t*)(wsb + WS_UG); bf16_t* GVT = (bf16_t*)(wsb + WS_GVT); float* GVSSQ = (float*)(wsb + WS_GVSSQ);
        const float* ssq1 = (const float*)(wsb + WS_SSQ1); const float* bias1 = (const float*)(wsb + WS_MISC) + MI_BIAS1;
        if (u.ty == 0) {
            const int b = u.pm >> 3;
            const int kind = u.pn >> 2, pq = u.pn & 3;
            const float* bp = bias1 + b * OIN + 256 * u.pn + 32 * wc + 8 * fq;
            bf16_t* base = UG + (size_t)kind * (8u << 20) + 128 * pq + 32 * wc + 8 * fq;
#pragma unroll
            for (int ai = 0; ai < 2; ++ai)
#pragma unroll
                for (int m = 0; m < 4; ++m) {
                    const size_t row = (size_t)u.pm * 256 + 128 * ai + 64 * wr + 16 * m + fr;
                    float rs = (u.pm == tpm) ? rst[128 * ai + 64 * wr + 16 * m + fr] : rstd16(ssq1, row); asm volatile("" : "+v"(rs));
                    f32x4 b00, b01, b10, b11;
                    if (u.pm == tpm) { const LAS float* bl = rst + 384 + 256 * u.pn + 32 * wc + 8 * fq; b00 = *(const LAS f32x4*)(bl); b01 = *(const LAS f32x4*)(bl + 4); b10 = *(const LAS f32x4*)(bl + 128); b11 = *(const LAS f32x4*)(bl + 132); }
                    else { b00 = *(const f32x4*)(bp); b01 = *(const f32x4*)(bp + 4); b10 = *(const f32x4*)(bp + 128); b11 = *(const f32x4*)(bp + 132); }
                    const f32x4 p0 = acc[ai][0][m][0] * rs + b00, p1 = acc[ai][0][m][1] * rs + b01, q0 = acc[ai][1][m][0] * rs + b10, q1 = acc[ai][1][m][1] * rs + b11;
                    float o[8];
#pragma unroll
                    for (int j = 0; j < 4; ++j) {
                        if (kind == 0) { o[j] = gelu_as(p0[j]) * silu_fast(q0[j]); o[4 + j] = gelu_as(p1[j]) * silu_fast(q1[j]); }
                        else if (kind == 1) { o[j] = p0[j] * silu_fast(q0[j]); o[4 + j] = p1[j] * silu_fast(q1[j]); }
                        else { o[j] = p0[j] * q0[j]; o[4 + j] = p1[j] * q1[j]; }
                    }
                    u32x4 w; w.x = cvt_pk_bf16(o[0], o[1]); w.y = cvt_pk_bf16(o[2], o[3]); w.z = cvt_pk_bf16(o[4], o[5]); w.w = cvt_pk_bf16(o[6], o[7]);
                    *(u32x4*)(base + row * 512) = w;
                    __builtin_amdgcn_sched_barrier(0);
                }
        }
    }
};
struct EpiP5H {
    const LAS float* rsth; int tpn, tpmh;
    __device__ __forceinline__ void operator()(const f32x4 (&acc)[2][2][4][2], const pg8::Unit& u, int wr, int wc, int fr, int fq, int lane) const {
        unsigned char* wsb = kargs()->ws; bf16_t* GVT = (bf16_t*)(wsb + WS_GVT); float* GVSSQ = (float*)(wsb + WS_GVSSQ);
        const float* ssq1 = (const float*)(wsb + WS_SSQ1); const float* bias1 = (const float*)(wsb + WS_MISC) + MI_BIAS1;
        {
            const int b = u.pn >> 4;
            { constexpr int bj = 0;
                int opq = 0; asm volatile("" : "+s"(opq));
                const size_t tokc = (size_t)u.pn * 128 + 32 * wc + 8 * fq + opq;
                float rs[8], gs[8];
                if (u.pn == tpn) {
#pragma unroll
                    for (int e = 0; e < 8; ++e) { rs[e] = rsth[32 * wc + 8 * fq + e]; gs[e] = 0.f; }
                } else {
#pragma unroll
                for (int e = 0; e < 8; ++e) { rs[e] = rstd16(ssq1, tokc + e); gs[e] = 0.f; asm volatile("" : "+v"(rs[e])); __builtin_amdgcn_sched_barrier(0); }
                }
#pragma unroll
                for (int ai = 0; ai < 2; ++ai)
#pragma unroll
                    for (int m = 0; m < 4; ++m) {
                        const int f = u.pm * 256 + 128 * ai + 64 * wr + 16 * m + fr + opq;
                        const float bias = (u.pn == tpn && u.pm == tpmh) ? rsth[128 + 3072 + 128 * ai + 64 * wr + 16 * m + fr] : bias1[b * OIN + 3072 + f];
                        bf16_t* rowp = GVT + ((size_t)(b * 4 + (f >> 7)) * 128 + (f & 127)) * GVP + (u.pn & 15) * 128 + 32 * wc + 8 * fq;
                        float o[8];
#pragma unroll
                        for (int n = 0; n < 2; ++n)
#pragma unroll
                            for (int j = 0; j < 4; ++j) { const float gv = gelu_as(acc[ai][bj][m][n][j] * rs[4 * n + j] + bias); o[4 * n + j] = gv; gs[4 * n + j] += gv * gv; }
                        u32x4 w; w.x = cvt_pk_bf16(o[0], o[1]); w.y = cvt_pk_bf16(o[2], o[3]); w.z = cvt_pk_bf16(o[4], o[5]); w.w = cvt_pk_bf16(o[6], o[7]);
                        *(u32x4*)(rowp) = w;
                        __builtin_amdgcn_sched_barrier(0);
                    }
#pragma unroll
                for (int e = 0; e < 8; ++e) {
                    float s = gs[e];
                    s += __shfl_xor(s, 1); s += __shfl_xor(s, 2); s += __shfl_xor(s, 4); s += __shfl_xor(s, 8);
                    if (fr == 0) GVSSQ[(tokc + e) * 4 + u.pm * 2 + wr] = s;
                    __builtin_amdgcn_sched_barrier(0);
                }
            }
        }
    }
};

__device__ __forceinline__ int gsw(int r, int c) { return r * 256 + ((c ^ (r & 15)) << 4); }
struct GmlpRegs { u32x4 ta[4], tw[4], tu[4]; f32x4 ssq; };
__device__ __forceinline__ void gmlp_load(GmlpRegs& R, int b, int ch, int g, const bf16_t* GVT, const float* GVSSQ, const bf16_t* Wsb, const bf16_t* UG, const int wv) {
    const int lane = lane_id(), tid = wv * 64 + lane;
    const size_t tokc = (size_t)b * SEQ + ch * 128;
    const int chunk = tid & 15, rb = tid >> 4;
#pragma unroll
    for (int i = 0; i < 4; ++i) { const int row = rb + 32 * i;
        R.ta[i] = *(const u32x4*)(GVT + ((size_t)(b * 4 + g) * 128 + row) * GVP + ch * 128 + 8 * chunk);
        R.tw[i] = *(const u32x4*)(Wsb + ((size_t)g * 128 + row) * 128 + 8 * chunk);
        R.tu[i] = *(const u32x4*)(UG + (tokc + row) * 512 + g * 128 + 8 * chunk); }
    R.ssq = *(const f32x4*)(GVSSQ + (tokc + (tid & 127)) * 4);
}
__device__ __forceinline__ void gmlp_unit(const GmlpRegs& R, int b, int ch, int g, const float* v_g, const float* b_s, bf16_t* Y1, LAS unsigned char* lds, const int wv) {
    const int lane = lane_id(), tid = wv * 64 + lane, r32 = lane & 31, hi = lane >> 5;
    const int wid = wv;
    const int dt = wid & 3, th = wid >> 2;
    LAS unsigned char* At = lds; LAS unsigned char* Wt = lds + 32768; LAS unsigned char* Ut = lds + 65536;
    LAS float* rsd = (LAS float*)(lds + 98304);
    const size_t tokc = (size_t)b * SEQ + ch * 128;
    {
        const int chunk = tid & 15, rb = tid >> 4;
        if (tid < 128) { const f32x4 p = R.ssq; rsd[tid] = rsqrtf(((p.x + p.y) + (p.z + p.w)) * (1.f / 512.f) + EPS); }
#pragma unroll
        for (int i = 0; i < 4; ++i) { const int row = rb + 32 * i; *(LAS u32x4*)(At + gsw(row, chunk)) = R.ta[i]; *(LAS u32x4*)(Wt + gsw(row, chunk)) = R.tw[i]; *(LAS u32x4*)(Ut + gsw(row, chunk)) = R.tu[i]; }
    }
    float bsf[2]; f32x4 vgf[4];
#pragma unroll
    for (int tt = 0; tt < 2; ++tt) bsf[tt] = b_s[g * 128 + 32 * (2 * th + tt) + r32];
#pragma unroll
    for (int q = 0; q < 4; ++q) vgf[q] = *(const f32x4*)(v_g + g * 128 + 32 * dt + 8 * q + 4 * hi);
    asm volatile("s_waitcnt lgkmcnt(0)\n\ts_barrier" ::: "memory");
    f32x16 acc[2];
#pragma unroll
    for (int i = 0; i < 2; ++i)
#pragma unroll
        for (int r = 0; r < 16; ++r) acc[i][r] = 0.f;
    bf16x8 af[8]; u32x4 wf[2][8];
#pragma unroll
    for (int ks = 0; ks < 8; ++ks) { af[ks] = *(const LAS bf16x8*)(At + gsw(32 * dt + r32, 2 * ks + hi));
#pragma unroll
        for (int tt = 0; tt < 2; ++tt) wf[tt][ks] = *(const LAS u32x4*)(Wt + gsw(32 * (2 * th + tt) + r32, 2 * ks + hi)); }
#pragma unroll
    for (int ks = 0; ks < 8; ++ks) {
        const f32x4 r0 = *(const LAS f32x4*)(rsd + 16 * ks + 8 * hi), r1 = *(const LAS f32x4*)(rsd + 16 * ks + 8 * hi + 4);
#pragma unroll
        for (int tt = 0; tt < 2; ++tt) {
            const u32x4 wv4 = wf[tt][ks];
            u32x4 ws2;
            ws2.x = cvt_pk_bf16(bflo(wv4.x) * r0.x, bfhi(wv4.x) * r0.y); ws2.y = cvt_pk_bf16(bflo(wv4.y) * r0.z, bfhi(wv4.y) * r0.w);
            ws2.z = cvt_pk_bf16(bflo(wv4.z) * r1.x, bfhi(wv4.z) * r1.y); ws2.w = cvt_pk_bf16(bflo(wv4.w) * r1.z, bfhi(wv4.w) * r1.w);
            acc[tt] = __builtin_amdgcn_mfma_f32_32x32x16_bf16(af[ks], __builtin_bit_cast(bf16x8, ws2), acc[tt], 0, 0, 0);
        }
    }
#pragma unroll
    for (int tt = 0; tt < 2; ++tt) {
        const int t = 32 * (2 * th + tt) + r32;
        const float bs = bsf[tt];
#pragma unroll
        for (int q = 0; q < 4; ++q) {
            LAS u32x2* up = (LAS u32x2*)(Ut + gsw(t, 4 * dt + q) + 8 * hi);
            const f32x4 vg = vgf[q];
            const u32x2 ug = *up;
            u32x2 w;
            w.x = cvt_pk_bf16(bflo(ug.x) * (vg.x * acc[tt][4 * q] + bs), bfhi(ug.x) * (vg.y * acc[tt][4 * q + 1] + bs));
            w.y = cvt_pk_bf16(bflo(ug.y) * (vg.z * acc[tt][4 * q + 2] + bs), bfhi(ug.y) * (vg.w * acc[tt][4 * q + 3] + bs));
            *up = w;
        }
    }
    asm volatile("s_waitcnt lgkmcnt(0)\n\ts_barrier" ::: "memory");
    {
        const int chunk = tid & 15, rb = tid >> 4;
#pragma unroll
        for (int i = 0; i < 4; ++i) { const int row = rb + 32 * i; *(u32x4*)(Y1 + (tokc + row) * 1024 + g * 128 + 8 * chunk) = *(const LAS u32x4*)(Ut + gsw(row, chunk)); }
    }
    asm volatile("s_waitcnt lgkmcnt(0)\n\ts_barrier" ::: "memory");
}
struct ConvRegs { u32x4 chv[10], bgv[8]; };
__device__ __forceinline__ void conv_load(ConvRegs& R, int row0, const bf16_t* BG, const bf16_t* CH, int lane) {
    const bool top = (row0 & 2047) == 0, bot = ((row0 + 7) & 2047) == 2047;
    R.chv[0] = *(const u32x4*)(CH + (size_t)(top ? row0 : row0 - 1) * 512 + 8 * lane);
#pragma unroll
    for (int i = 0; i < 8; ++i) { R.chv[i + 1] = *(const u32x4*)(CH + (size_t)(row0 + i) * 512 + 8 * lane); R.bgv[i] = *(const u32x4*)(BG + (size_t)(row0 + i) * 512 + 8 * lane); }
    R.chv[9] = *(const u32x4*)(CH + (size_t)(bot ? row0 + 7 : row0 + 8) * 512 + 8 * lane);
}
__device__ __forceinline__ void conv_finish(const ConvRegs& R, int row0, const float* conv_w, bf16_t* Y1, int lane) {
    const bool top = (row0 & 2047) == 0, bot = ((row0 + 7) & 2047) == 2047;
    float w[3][8];
#pragma unroll
    for (int j = 0; j < 3; ++j) { const f32x4 a = *(const f32x4*)(conv_w + j * 512 + 8 * lane), bq = *(const f32x4*)(conv_w + j * 512 + 8 * lane + 4);
        w[j][0] = a.x; w[j][1] = a.y; w[j][2] = a.z; w[j][3] = a.w; w[j][4] = bq.x; w[j][5] = bq.y; w[j][6] = bq.z; w[j][7] = bq.w; }
#pragma unroll
    for (int i = 0; i < 8; ++i) {
        float o[8];
#pragma unroll
        for (int e = 0; e < 4; ++e) {
            const unsigned pw = (i == 0 && top) ? 0u : R.chv[i][e], cw = R.chv[i + 1][e], nw = (i == 7 && bot) ? 0u : R.chv[i + 2][e], bw = R.bgv[i][e];
            o[2 * e] = bflo(bw) * (w[0][2 * e] * bflo(pw) + w[1][2 * e] * bflo(cw) + w[2][2 * e] * bflo(nw));
            o[2 * e + 1] = bfhi(bw) * (w[0][2 * e + 1] * bfhi(pw) + w[1][2 * e + 1] * bfhi(cw) + w[2][2 * e + 1] * bfhi(nw));
        }
        u32x4 wv; wv.x = cvt_pk_bf16(o[0], o[1]); wv.y = cvt_pk_bf16(o[2], o[3]); wv.z = cvt_pk_bf16(o[4], o[5]); wv.w = cvt_pk_bf16(o[6], o[7]);
        *(u32x4*)(Y1 + (size_t)(row0 + i) * 1024 + 512 + 8 * lane) = wv;
    }
}
#ifndef DIAG
#define DIAG 0
#endif
constexpr int N_PHASES = 9;
#ifndef REP
#define REP -1
#endif
#ifndef NDRY
#define NDRY 1
#endif

__global__ void __launch_bounds__(NTHR, 2) mk_fwd(Args args) {
    extern __shared__ __attribute__((aligned(16))) unsigned char lds_raw[];
    Frame F;
#define FRAME_LOAD() do { KArgsPtr ka_ = kargs(); \
    F.lds = (LAS unsigned char*)lds_raw; F.MISC = (volatile LAS unsigned*)(F.lds + LDSCTL_OFF); \
    F.wave = wave0; F.lane = lane_id(); F.tid = wave0 * 64 + F.lane; \
    F.G = gridDim.x; { const int bx = blockIdx.x; F.vcu = (F.G % 8 == 0) ? (bx % 8) * (F.G / 8) + bx / 8 : bx; } \
    F.ws = ka_->ws; F.ctl = (unsigned*)(F.ws + WS_CTL); F.misc = (float*)(F.ws + WS_MISC); F.out = ka_->out; \
    F.x = ka_->in[0]; F.c = ka_->in[1]; F.ctx = ka_->in[2]; F.c_ctx = ka_->in[3]; F.norm_gain = ka_->in[4]; F.ada_w = ka_->in[5]; F.ada_b = ka_->in[6]; \
    F.even_w_in = ka_->in[7]; F.even_w_out = ka_->in[8]; F.qk_gain = ka_->in[9]; F.lam_p = ka_->in[10]; F.subln_g = ka_->in[11]; F.lb_logits = ka_->in[12]; F.hgrn_g = ka_->in[13]; \
    F.odd_w_in = ka_->in[14]; F.odd_w_out = ka_->in[15]; F.v_g = ka_->in[16]; F.w_s = ka_->in[17]; F.b_s = ka_->in[18]; F.conv_w = ka_->in[19]; } while (0)
    const int wave0 = __builtin_amdgcn_readfirstlane(threadIdx.x >> 6);
    FRAME_LOAD();
    for (int u = F.tid; u < (LDS_BYTES - LDSCTL_OFF) / 4; u += NTHR) ((LAS unsigned*)(F.lds + LDSCTL_OFF))[u] = 0u;
    __syncthreads();
    XcdBarrier bar = xcd_barrier_post(F.ctl + CW_BAR, F.MISC + 8, F.tid);
    if (F.tid == 0) __hip_atomic_store(F.ctl + CW_XCC + (int)blockIdx.x, xb_xcc_id() + 1u, __ATOMIC_RELAXED, __HIP_MEMORY_SCOPE_AGENT);
    bool light_ok = false;
    const int lo = args.ph_lo, hi = args.ph_hi;
#ifdef ONLYPH
#define IN(k) ((k) == ONLYPH && lo <= (k) && (k) < hi)
#else
#define IN(k) (lo <= (k) && (k) < hi)
#endif
#define BOTH(k) (IN(k) && IN((k) + 1))
#if DIAG == 10
#define STAMP(k) do { if (blockIdx.x == 0 && wave0 == 0 && lane_id() == 0) ((unsigned long long*)(kargs()->ws + WS_CTL + 900000))[k] = __builtin_amdgcn_s_memrealtime(); } while (0)
#else
#define STAMP(k) do {} while (0)
#endif
#define GRID_BAR() xcd_barrier(bar, wave0 * 64 + lane_id())
#define LIGHT_BAR(site) do { if (light_ok) group_barrier_light((unsigned*)(kargs()->ws + WS_CTL) + CW_GRP + 128 * ((site) * 8 + ((int)blockIdx.x & 7)), 32u, wave0 * 64 + lane_id()); else xcd_barrier(bar, wave0 * 64 + lane_id()); } while (0)
    unsigned char* ws;

    STAMP(0);
    if (IN(0)) { for (int rep = 0; rep < (REP == 0 ? 2 : 1); ++rep) { FRAME_LOAD(); p0_prologue(F); if (REP == 0 && rep == 0) GRID_BAR(); } STAMP(1); }
    if (IN(1)) {
        for (int rep = 0; rep < (REP == 1 ? 2 : 1); ++rep) { FRAME_LOAD(); p0b_phase(F); if (REP == 1 && rep == 0) GRID_BAR(); }
        if (BOTH(1)) {
            FRAME_LOAD();
            if (wave0 == 0) { unsigned sp = 0u;
                while (__hip_atomic_load(F.ctl + CW_W0, __ATOMIC_RELAXED, __HIP_MEMORY_SCOPE_AGENT) < 64u && ++sp < (1u << 22)) __builtin_amdgcn_s_sleep(2);
                __builtin_amdgcn_fence(__ATOMIC_ACQUIRE, "agent"); asm volatile("s_waitcnt vmcnt(0)" ::: "memory"); }
            { const int ln = lane_id(); bool bad = false;
#pragma unroll
              for (int q = 0; q < 4; ++q) { const int i = ln + 64 * q;
                  const unsigned a = (i < (int)gridDim.x) ? __hip_atomic_load(F.ctl + CW_XCC + i, __ATOMIC_RELAXED, __HIP_MEMORY_SCOPE_AGENT) : 1u;
                  const unsigned r = (i < (int)gridDim.x) ? __hip_atomic_load(F.ctl + CW_XCC + (i & 7), __ATOMIC_RELAXED, __HIP_MEMORY_SCOPE_AGENT) : 1u;
                  bad = bad || (a != r) || (a == 0u); }
              light_ok = ((int)gridDim.x == 256) && (__builtin_amdgcn_ballot_w64(bad) == 0ull); }
            LIGHT_BAR(4);
        }
        STAMP(2);
    }
    if (IN(2)) {
        FRAME_LOAD(); ws = F.ws;
        LAS float* tab = (LAS float*)(F.lds + 131072);
        { const float* miscp = (const float*)(ws + WS_MISC); const float* qkg = kargs()->in[9];
          float tv[6]; const float qg = qkg[F.tid & 127];
#pragma unroll
          for (int k = 0; k < 6; ++k) tv[k] = miscp[MI_CS + F.tid + 512 * k];
#pragma unroll
          for (int k = 0; k < 4; ++k) tab[F.tid + 512 * k] = tv[k];
          if (F.tid < 128) tab[2048 + F.tid] = qg;
          tab[2176 + F.tid] = tv[4]; tab[2176 + 512 + F.tid] = tv[5];
          __syncthreads(); }
        P1Order S{F.G, (int)blockIdx.x}; EpiP1 E{tab};
        for (int rep = 0; rep < (REP == 2 ? 2 : 1); ++rep) { pg8::gemm_phase<EpiP1, P1Order>(F.lds, DM, S, E, wave0); if (REP == 2 && rep == 0) GRID_BAR(); }
        if ((int)blockIdx.x >= 208) { FRAME_LOAD(); weight_copies(F, 1, ((int)blockIdx.x - 208) * NWAVES + F.wave, 48 * NWAVES); }
        if (BOTH(2)) LIGHT_BAR(3);
        STAMP(3);
    }
    if (IN(3)) {
        FRAME_LOAD(); ws = F.ws;
        const int g = blockIdx.x & 7;
        const float lam = __uint_as_float(__hip_atomic_load((unsigned*)(F.misc + MI_SCAL), __ATOMIC_RELAXED, __HIP_MEMORY_SCOPE_AGENT));
        const float M2 = __uint_as_float(__hip_atomic_load((unsigned*)(F.misc + MI_SCAL + 1), __ATOMIC_RELAXED, __HIP_MEMORY_SCOPE_AGENT));
        for (int rep = 0; rep < ((REP == 3 || REP == 30 || REP == 31) ? 2 : (REP == 32 ? 1 + NDRY : 1)); ++rep) {
        const bool dry = (REP == 3 || REP == 30 || REP == 31) ? (rep == 0) : (REP == 32 ? rep < NDRY : false);
        unsigned acq_mask = 0u;
        bool have = false;
        constexpr bool EARLY = (REP < 0 || REP == 32);
        int first_out = 200;
        const int QOFF = EARLY ? ((int)gridDim.x + 7 - g) / 8 : 0;
        bool first = EARLY;
        for (;;) {
            if (!have && !first) {
                if (wave0 == 0 && lane_id() == 0) ((volatile LAS unsigned*)((LAS unsigned char*)lds_raw + LDSCTL_OFF))[16] = __hip_atomic_fetch_add((unsigned*)(kargs()->ws + WS_CTL) + CW_QUEUE + 64 * (g + 8 * rep), 1u, __ATOMIC_RELAXED, __HIP_MEMORY_SCOPE_AGENT);
                __syncthreads();
            }
            const int idx = first ? ((int)blockIdx.x >> 3) : (int)((volatile LAS unsigned*)((LAS unsigned char*)lds_raw + LDSCTL_OFF))[16] + QOFF;
            if (!have && !first) __syncthreads();
            first = false;
            have = EARLY;
            unsigned* qc = EARLY ? (unsigned*)(kargs()->ws + WS_CTL) + CW_QUEUE + 64 * (g + 8 * rep) : nullptr;
            if (idx >= 72) { first_out = idx; break; }
            if (REP == 30 && rep == 0 && idx < 8) { have = false; continue; }
            if (REP == 32 && dry && idx < 72) { have = false; continue; }
            if (REP == 31 && rep == 0 && idx >= 8) break;
            if (idx < 8) {
                const int cch = g * 8 + idx;
                { unsigned char* w2 = kargs()->ws;
                  hg::state_chain(cch >> 3, (cch >> 1) & 3, cch & 1, (const unsigned short*)(w2 + WS_LF), (const bf16_t*)(w2 + WS_HVT), (bf16_t*)(w2 + WS_ST), (LAS unsigned char*)lds_raw, wave0, qc); }
                if (wave0 == 0 && lane_id() == 0) { __builtin_amdgcn_fence(__ATOMIC_RELEASE, "agent"); asm volatile("s_waitcnt vmcnt(0)" ::: "memory");
                    __hip_atomic_store((unsigned*)(kargs()->ws + WS_CTL) + CW_FLAG + 64 * cch + 16 * rep, 1u, __ATOMIC_RELAXED, __HIP_MEMORY_SCOPE_AGENT); }
            } else {
                const int j = idx - 8; const int pair = g * 4 + (j >> 4), qb = j & 15;
                KArgsPtr ka2 = kargs(); unsigned char* w2 = ka2->ws;
                att::attn_unit(pair >> 2, pair & 3, qb, (bf16_t*)(w2 + WS_Y), (const bf16_t*)(w2 + WS_KC), (const bf16_t*)(w2 + WS_VT), (const bf16_t*)(w2 + WS_GA), ka2->in[11], lam, M2, (LAS unsigned char*)lds_raw, wave0, dry, qc);
            }
        }
        if (first_out < 200 && !((REP == 30 || REP == 31) && rep == 0)) {
            unsigned* qc = EARLY ? (unsigned*)(kargs()->ws + WS_CTL) + CW_QUEUE + 64 * (g + 8 * rep) : nullptr;
            hg::OutPre P; bool pre = false; int cur = first_out;
            { unsigned z0 = 0u; asm volatile("" : "+v"(z0));
#pragma unroll
              for (int j0 = 0; j0 < 8; ++j0) { P.fa[j0] = z0; P.fb[j0] = z0; P.fq[j0] = z0; P.sraw[j0 >> 2][j0 & 3] = (u32x4){z0, z0, z0, z0}; if (j0 < 2) P.vraw[j0] = (u32x4){z0, z0, z0, z0}; } }
            { const float* hg_g = kargs()->in[13]; if (wave0 < 2) ((LAS float*)((LAS unsigned char*)lds_raw + 156672))[wave0 * 64 + lane_id()] = hg_g[wave0 * 64 + lane_id()]; __syncthreads(); }
            for (;;) {
                const int j = cur - 72; const int hh = j >> 5, lc = j & 31;
                if (!((acq_mask >> hh) & 1u) && !(REP == 32 && dry)) {
                acq_mask |= 1u << hh;
                if (wave0 == 0) {
                    unsigned* f0 = (unsigned*)(kargs()->ws + WS_CTL) + CW_FLAG + 64 * (g * 8 + 2 * hh) + 16 * rep; unsigned sp = 0;
                    while ((__hip_atomic_load(f0, __ATOMIC_RELAXED, __HIP_MEMORY_SCOPE_AGENT) == 0u || __hip_atomic_load(f0 + 64, __ATOMIC_RELAXED, __HIP_MEMORY_SCOPE_AGENT) == 0u) && ++sp < (1u << 22)) __builtin_amdgcn_s_sleep(8);
                    __builtin_amdgcn_fence(__ATOMIC_ACQUIRE, "agent");
                    asm volatile("s_waitcnt vmcnt(0)" ::: "memory");
                }
                __syncthreads();
                }
                int nidx = -1; bool npre = false;
                hg::out_unit(g, hh, lc, (LAS unsigned char*)lds_raw, wave0, P, pre, acq_mask, QOFF, nidx, npre, dry, qc);
                if (!EARLY) {
                    if (wave0 == 0 && lane_id() == 0) ((volatile LAS unsigned*)((LAS unsigned char*)lds_raw + LDSCTL_OFF))[16] = __hip_atomic_fetch_add((unsigned*)(kargs()->ws + WS_CTL) + CW_QUEUE + 64 * (g + 8 * rep), 1u, __ATOMIC_RELAXED, __HIP_MEMORY_SCOPE_AGENT);
                    __syncthreads();
                    nidx = (int)((volatile LAS unsigned*)((LAS unsigned char*)lds_raw + LDSCTL_OFF))[16]; npre = false;
                    __syncthreads();
                }
                cur = nidx; pre = npre;
                if (cur >= 200) break;
            }
        }
        if (dry) GRID_BAR();
        }
        if (BOTH(3)) GRID_BAR();
        STAMP(4);
    }
    if (IN(5)) {
        FRAME_LOAD(); ws = F.ws;
        OutOrder<WS_Y, WS_WO0> S{F.G, (int)blockIdx.x}; EpiP4 E;
        for (int rep = 0; rep < (REP == 5 ? 2 : 1); ++rep) { pg8::gemm_phase<EpiP4, OutOrder<WS_Y, WS_WO0>>(F.lds, DM, S, E, wave0); if (REP == 5 && rep == 0) GRID_BAR(); }
        if (BOTH(5)) LIGHT_BAR(0);
        STAMP(6);
    }
    if (IN(6)) {
        FRAME_LOAD(); ws = F.ws;
        P5Order S{F.G, (int)blockIdx.x}; P5HalfOrder SH{F.G, (int)blockIdx.x};
        LAS float* rst = (LAS float*)(F.lds + 131072);
        int tpm = -1, tpn = -1, tpmh = -1;
        { pg8::Unit u0; if (S.next(0, u0)) tpm = u0.pm; if (SH.next(0, u0)) { tpn = u0.pn; tpmh = u0.pm; }
          const float* ssq1 = (const float*)(ws + WS_SSQ1); const float* bias1 = (const float*)(ws + WS_MISC) + MI_BIAS1;
          const int r = F.tid; const bool full = r < 256; const int blk = full ? tpm : tpn; const int blkc = blk < 0 ? 0 : blk;
          const size_t row = full ? (size_t)blkc * 256 + r : (size_t)blkc * 128 + ((r - 256) & 127);
          const f32x4* pp = (const f32x4*)(ssq1 + row * 16); const f32x4 qa = pp[0], qb = pp[1], qc4 = pp[2], qd = pp[3];
          const int bb = (tpm < 0 ? 0 : tpm) >> 3, bh = (tpn < 0 ? 0 : tpn) >> 4, pmh = tpmh < 0 ? 0 : tpmh;
          float bv[6];
#pragma unroll
          for (int k = 0; k < 6; ++k) bv[k] = bias1[bb * OIN + F.tid + 512 * k];
          const float bhv = bias1[bh * OIN + 3072 + pmh * 256 + (F.tid & 255)];
          if (F.tid < 384 && blk >= 0) rst[r] = rsqrtf((((qa.x + qa.y) + (qa.z + qa.w)) + ((qb.x + qb.y) + (qb.z + qb.w)) + ((qc4.x + qc4.y) + (qc4.z + qc4.w)) + ((qd.x + qd.y) + (qd.z + qd.w))) * (1.f / 1024.f) + EPS);
#pragma unroll
          for (int k = 0; k < 6; ++k) rst[384 + F.tid + 512 * k] = bv[k];
          if (F.tid < 256) rst[384 + 3072 + F.tid] = bhv;
          __syncthreads(); }
        EpiP5 E{rst, tpm};
        for (int rep = 0; rep < (REP == 6 ? 2 : 1); ++rep) {
            pg8::gemm_phase<EpiP5, P5Order>(F.lds, DM, S, E, wave0);
            { EpiP5H EH{rst + 256, tpn, tpmh}; pg8::gemm_phase<EpiP5H, P5HalfOrder, true>(F.lds, DM, SH, EH, wave0); }
            if (REP == 6 && rep == 0) GRID_BAR(); }
        if (BOTH(6)) LIGHT_BAR(1);
        STAMP(7);
    }
    if (IN(7)) {
        FRAME_LOAD(); ws = F.ws;
        for (int rep = 0; rep < (REP == 7 ? 2 : 1); ++rep) {
        const int uA = (F.vcu >> 5) * 64 + (F.vcu & 31), uB = uA + 32;
        const int row0 = (F.vcu * NWAVES + F.wave) * 8;
        GmlpRegs GR; ConvRegs CR;
        gmlp_load(GR, uA >> 6, (uA >> 2) & 15, uA & 3, (const bf16_t*)(ws + WS_GVT), (const float*)(ws + WS_GVSSQ), (const bf16_t*)(ws + WS_WS), (const bf16_t*)(ws + WS_UG), wave0);
        conv_load(CR, row0, (const bf16_t*)(ws + WS_BG), (const bf16_t*)(ws + WS_CH), F.lane);
        gmlp_unit(GR, uA >> 6, (uA >> 2) & 15, uA & 3, F.v_g, F.b_s, (bf16_t*)(ws + WS_Y), F.lds, wave0);
        gmlp_load(GR, uB >> 6, (uB >> 2) & 15, uB & 3, (const bf16_t*)(ws + WS_GVT), (const float*)(ws + WS_GVSSQ), (const bf16_t*)(ws + WS_WS), (const bf16_t*)(ws + WS_UG), wave0);
        conv_finish(CR, row0, F.conv_w, (bf16_t*)(ws + WS_Y), F.lane);
        gmlp_unit(GR, uB >> 6, (uB >> 2) & 15, uB & 3, F.v_g, F.b_s, (bf16_t*)(ws + WS_Y), F.lds, wave0);
        if (REP == 7 && rep == 0) GRID_BAR();
        }
        if (BOTH(7)) LIGHT_BAR(2);
        STAMP(8);
    }
    if (IN(8)) {
        FRAME_LOAD(); ws = F.ws;
        OutOrder<WS_Y, WS_WO1> S{F.G, (int)blockIdx.x}; EpiP7 E;
        pg8::gemm_phase<EpiP7, OutOrder<WS_Y, WS_WO1>>(F.lds, DM, S, E, wave0);
        STAMP(9);
    }
#undef IN
#undef BOTH
}

#if DIAG

#endif

extern "C" void kernel_launch(void* const* d_in, const int* in_sizes, int n_in, void* d_out, int out_size, void* d_ws, size_t ws_size, hipStream_t stream) {
    static int grid = 0;
    if (grid == 0) {
        int dev = 0, cus = 0;
        if (hipGetDevice(&dev) != hipSuccess || hipDeviceGetAttribute(&cus, hipDeviceAttributeMultiprocessorCount, dev) != hipSuccess) { fprintf(stderr, "kernel_launch: device query failed\n"); grid = -1; return; }
        if (hipFuncSetAttribute((const void*)mk_fwd, hipFuncAttributeMaxDynamicSharedMemorySize, LDS_BYTES) != hipSuccess) { fprintf(stderr, "kernel_launch: hipFuncSetAttribute failed\n"); grid = -1; return; }
        int per_cu = 0;
        if (hipOccupancyMaxActiveBlocksPerMultiprocessor(&per_cu, (const void*)mk_fwd, NTHR, LDS_BYTES) != hipSuccess || per_cu < 1) { fprintf(stderr, "kernel_launch: occupancy query says %d blocks/CU\n", per_cu); }
        (void)hipGetLastError();
        grid = cus;
        if (ws_size < WS_END) { fprintf(stderr, "kernel_launch: workspace too small\n"); grid = -1; return; }
    }
    if (grid < 0) return;
    (void)hipMemsetAsync((char*)d_ws + WS_CTL, 0, CTL_ZERO_BYTES, stream);
    Args a{};
    for (int i = 0; i < 20; ++i) a.in[i] = (const float*)d_in[i];
    a.out = (float*)d_out; a.ws = (unsigned char*)d_ws;
#ifdef OUT_SKIP
    a.dbg = OUT_SKIP;
#endif
#if DIAG
    diag_launch(a, grid, d_in, d_out, d_ws, stream);
#else
#if REP >= 91 && REP <= 98
    a.ph_lo = 0; a.ph_hi = REP - 90;
    hipLaunchKernelGGL(mk_fwd, dim3(grid), dim3(NTHR), LDS_BYTES, stream, a);
    (void)hipMemsetAsync((char*)d_ws + WS_CTL, 0, CTL_ZERO_BYTES, stream);
#endif
    a.ph_lo = 0; a.ph_hi = N_PHASES;
    hipLaunchKernelGGL(mk_fwd, dim3(grid), dim3(NTHR), LDS_BYTES, stream, a);
#endif
}
```

```cpp
#define DIAG 0
#define DSEL -1
#include <hip/hip_runtime.h>
#include <math.h>
#include <stdint.h>
#include <cstdio>

#define LAS __attribute__((address_space(3)))
#define GAS __attribute__((address_space(1)))
typedef unsigned short bf16_t;
typedef short bf16x8 __attribute__((ext_vector_type(8)));
typedef short s16x4 __attribute__((ext_vector_type(4)));
typedef float f32x2 __attribute__((ext_vector_type(2)));
typedef float f32x4 __attribute__((ext_vector_type(4)));
typedef float f32x16 __attribute__((ext_vector_type(16)));
typedef unsigned u32x2 __attribute__((ext_vector_type(2)));
typedef unsigned u32x4 __attribute__((ext_vector_type(4)));
typedef _Float16 f16x2_t __attribute__((ext_vector_type(2)));
typedef __bf16 bf16x2_t __attribute__((ext_vector_type(2)));

constexpr int DM = 1024, NB = 8, SEQ = 2048, CTX = 256, KV = SEQ + CTX  , M_TOK = NB * SEQ  , M_CTX = NB * CTX  ;
constexpr int EIN = 4608, OIN = 3584;
constexpr float EPS = 1e-6f;
constexpr float LOG2E = 1.4426950408889634f;
constexpr float LAM_INIT = 0.2f;

constexpr size_t MiB = 1u << 20;
constexpr size_t WS_CTL = 0, CTL_ZERO_BYTES = 1 * MiB;
constexpr size_t WS_MISC = 1 * MiB;
constexpr size_t WS_WT0 = 2 * MiB;
constexpr size_t WS_WO0 = 11 * MiB;
constexpr size_t WS_WT1 = 13 * MiB;
constexpr size_t WS_WO1 = 20 * MiB;
constexpr size_t WS_WS = 22 * MiB;
constexpr size_t WS_SSQ1 = 23 * MiB;
constexpr size_t WS_RA = 24 * MiB;
constexpr size_t WS_XN = WS_RA, WS_CN = WS_RA + 32 * MiB, WS_ST = WS_RA, WS_A1 = WS_RA, WS_X1B = WS_RA + 32 * MiB;
constexpr size_t WS_Y = 88 * MiB;
constexpr size_t WS_KC = 120 * MiB;
constexpr size_t WS_VT = 138 * MiB;
constexpr size_t WS_GA = 156 * MiB;
constexpr size_t WS_HVT = 172 * MiB;
constexpr size_t WS_LF = 190 * MiB;
constexpr size_t WS_GB = 226 * MiB;
constexpr size_t WS_END = 242 * MiB;
constexpr size_t WS_UG = WS_GA;
constexpr size_t WS_BG = WS_GB;
constexpr size_t WS_CH = WS_KC;
constexpr size_t WS_GVT = WS_VT;
constexpr size_t WS_GVSSQ = WS_HVT;
constexpr int GVP = SEQ + 64;
constexpr int L1X_CH = 2304 * 512 - 2048 * 512, L1X_GVT = 4 * 128 * 2304 - 4 * 128 * GVP, L1X_SSQ = (4 * 128 * 2304) / 2 - 2048 * 4;
constexpr int MI_MOD = 0;
constexpr int MI_CS = 55296, MI_SN = MI_CS + 1024, MI_LBV = MI_SN + 1024, MI_SCAL = MI_LBV + 1024, MI_BIAS1 = MI_SCAL + 64;
constexpr int CW_BAR = 4096;
constexpr int CW_QUEUE = 16384;
constexpr int CW_FLAG = 32768;
constexpr int CW_XCC = 45056;
constexpr int CW_UNCLEAN = 45056 + 1024;
constexpr int CW_GRP = 49152;
constexpr int CW_W0 = 40960 + 64;
constexpr int CW_W1 = 40960 + 128;
constexpr int CW_B1 = 40960 + 192;
constexpr int CW_ADA = 40960;

__device__ __forceinline__ unsigned cvt_pk_bf16(float lo, float hi) { f32x2 v = {lo, hi}; bf16x2_t b = __builtin_convertvector(v, bf16x2_t); return __builtin_bit_cast(unsigned, b); }
__device__ __forceinline__ unsigned cvt_pk_f16(float lo, float hi) { f32x2 v = {lo, hi}; f16x2_t b = __builtin_convertvector(v, f16x2_t); return __builtin_bit_cast(unsigned, b); }
__device__ __forceinline__ float bf2f(unsigned short h) { return __uint_as_float(((unsigned)h) << 16); }
__device__ __forceinline__ float bflo(unsigned w) { return __uint_as_float(w << 16); }
__device__ __forceinline__ float bfhi(unsigned w) { return __uint_as_float(w & 0xffff0000u); }
__device__ __forceinline__ float silu_fast(float v) { return v * __builtin_amdgcn_rcpf(1.f + __expf(-v)); }
__device__ __forceinline__ float gelu_erf(float v) { return 0.5f * v * (1.f + erff(v * 0.70710678118654752f)); }
__device__ __forceinline__ float wave_sum(float v) {
#pragma unroll
  for (int o = 1; o < 64; o <<= 1) v += __shfl_xor(v, o);
  return v;
}
__device__ __forceinline__ int lane_id() { int l = (int)__builtin_amdgcn_mbcnt_hi(~0u, __builtin_amdgcn_mbcnt_lo(~0u, 0u)); asm volatile("" : "+v"(l)); return l; }
__device__ __forceinline__ float shfl_xor_l(float v, int mask, int lane) { return __int_as_float(__builtin_amdgcn_ds_bpermute((lane ^ mask) << 2, __float_as_int(v))); }
#define LDS_WAIT() asm volatile("s_waitcnt lgkmcnt(0)" ::: "memory")
#define VM_WAIT() asm volatile("s_waitcnt vmcnt(0)" ::: "memory")

namespace pg8 {
constexpr int BM = 256, BK = 64, HALF = 128, HTB = HALF * BK * 2, STAGE_BYTES = 8 * HTB;
__host__ __device__ __forceinline__ int lds_byte(int r, int c) { const int st = (r >> 4) * 2 + (c >> 5), rr = r & 15, cc = c & 31, ob = rr * 64 + cc * 2; return st * 1024 + (ob ^ (((ob >> 9) & 1) << 5)); }
__host__ __device__ __forceinline__ void stage_rc(int b, int& R, int& C) { const int st = b / 1024, sb = b % 1024, swz = sb ^ (((sb >> 9) & 1) << 5); R = (st >> 1) * 16 + swz / 64; C = (st & 1) * 32 + (swz % 64) / 2; }
__host__ __device__ __forceinline__ int perm32(int rho) { const int n = rho >> 4, i = rho & 15; return 8 * (i >> 2) + 4 * n + (i & 3); }

struct Unit { const char* a; const char* b; int ty, pm, pn, aux; };

template <class Epi, class Sched, bool HALFN = false>
__device__ __forceinline__ void gemm_phase(LAS unsigned char* lds, const int K, const Sched& S, const Epi& E, const int wv) {
    const int lane = lane_id(), tid = wv * 64 + lane, wid = wv, wr = wid >> 2, wc = wid & 3, fr = lane & 15, fq = lane >> 4;
    const int nt = K / BK;
    unsigned voffA[2], voffB[2];
#pragma unroll
    for (int i = 0; i < 2; ++i) { int R, C; stage_rc(tid * 16 + i * 8192, R, C); const int Rb = (R & ~31) + perm32(R & 31);
        voffA[i] = (unsigned)(R * K + C) * 2u; voffB[i] = (unsigned)(Rb * K + C) * 2u; }
    const size_t kstep = (size_t)(BK * 2);
    const size_t hstep = (size_t)HALF * K * 2;
    const unsigned ldsw = (unsigned)wid * 1024u;
    const int aoff = lds_byte(wr * 64 + fr, fq * 8), boff = lds_byte(wc * 32 + fr, fq * 8);
#define PG8_SA(b, h) (((b) * 2 + (h)) * HTB)
#define PG8_SB(b, h) ((4 + (b) * 2 + (h)) * HTB)
#define PG8_STAGE(bufoff, gbase, voff) do { _Pragma("unroll") for (int _i = 0; _i < 2; ++_i) \
        __builtin_amdgcn_global_load_lds((const unsigned*)((const char*)(gbase) + (voff)[_i]), (LAS unsigned*)(lds + (bufoff) + ldsw + _i * 8192), 16, 0, 0); } while (0)
#define PG8_LDA(dst, b, h) do { _Pragma("unroll") for (int m = 0; m < 4; ++m) _Pragma("unroll") for (int k = 0; k < 2; ++k) dst[m][k] = *(const LAS bf16x8*)(lds + PG8_SA(b, h) + aoff + m * 2048 + k * 1024); } while (0)
#define PG8_LDB(dst, b, h) do { _Pragma("unroll") for (int n = 0; n < 2; ++n) _Pragma("unroll") for (int k = 0; k < 2; ++k) dst[n][k] = *(const LAS bf16x8*)(lds + PG8_SB(b, h) + boff + n * 2048 + k * 1024); } while (0)
#define PG8_MMA(ai, bj, At, Bt) do { __builtin_amdgcn_s_setprio(1); _Pragma("unroll") for (int m = 0; m < 4; ++m) _Pragma("unroll") for (int n = 0; n < 2; ++n) _Pragma("unroll") for (int k = 0; k < 2; ++k) \
        acc[ai][bj][m][n] = __builtin_amdgcn_mfma_f32_16x16x32_bf16(Bt[n][k], At[m][k], acc[ai][bj][m][n], 0, 0, 0); __builtin_amdgcn_s_setprio(0); } while (0)
#define PG8_WAIT_V(n) asm volatile("s_waitcnt vmcnt(" #n ")" ::: "memory")
#define PG8_WAIT_L(n) asm volatile("s_waitcnt lgkmcnt(" #n ")" ::: "memory")
#define PG8_BAR __builtin_amdgcn_s_barrier()
#define PG8_SCHED __builtin_amdgcn_sched_barrier(0)
    Unit cur, nxt; int ui = 0;
    if (!S.next(0, cur)) return;
    f32x4 acc[2][2][4][2];
#pragma unroll
    for (int a = 0; a < 2; ++a)
#pragma unroll
        for (int b = 0; b < 2; ++b)
#pragma unroll
            for (int m = 0; m < 4; ++m)
#pragma unroll
                for (int n = 0; n < 2; ++n) acc[a][b][m][n] = (f32x4){0.f, 0.f, 0.f, 0.f};
    bf16x8 At[4][2], B0[2][2], B1[2][2];
    const char* cA = cur.a; const char* cB = cur.b;
    PG8_STAGE(PG8_SB(0, 0), cB, voffB); if (!HALFN) PG8_STAGE(PG8_SB(0, 1), cB + hstep, voffB); PG8_STAGE(PG8_SA(0, 0), cA, voffA); PG8_STAGE(PG8_SA(0, 1), cA + hstep, voffA);
    if (wr == 1) PG8_BAR;
    PG8_WAIT_V(2); PG8_BAR;
    PG8_STAGE(PG8_SB(1, 0), cB + kstep, voffB); PG8_STAGE(PG8_SA(1, 0), cA + kstep, voffA); if (!HALFN) PG8_STAGE(PG8_SB(1, 1), cB + hstep + kstep, voffB);
    if (HALFN) PG8_WAIT_V(4); else PG8_WAIT_V(6); PG8_BAR;
    for (;;) {
        const bool has_next = S.next(ui + 1, nxt);
        const char* nA = has_next ? nxt.a : cA; const char* nB = has_next ? nxt.b : cB;
        for (int t = 0; t < nt; t += 2) {
            const bool last = (t == nt - 2);
            const char* a1 = cA + (size_t)(t + 1) * kstep;
            const char* a2 = last ? nA : cA + (size_t)(t + 2) * kstep; const char* b2 = last ? nB : cB + (size_t)(t + 2) * kstep;
            const char* a3 = a2 + kstep; const char* b3 = b2 + kstep;
#define PG8_WAIT_VK() do { if (HALFN) PG8_WAIT_V(6); else PG8_WAIT_V(8); } while (0)
            PG8_LDB(B0, 0, 0); if (!HALFN) PG8_LDB(B1, 0, 1); PG8_SCHED; PG8_LDA(At, 0, 0); PG8_STAGE(PG8_SA(1, 1), a1 + hstep, voffA);
            PG8_WAIT_VK(); PG8_WAIT_L(0); PG8_BAR; PG8_MMA(0, 0, At, B0); if (!HALFN) PG8_MMA(0, 1, At, B1); PG8_BAR; PG8_SCHED;
            PG8_LDA(At, 0, 1); PG8_STAGE(PG8_SB(0, 0), b2, voffB); if (!HALFN) PG8_STAGE(PG8_SB(0, 1), b2 + hstep, voffB); PG8_STAGE(PG8_SA(0, 0), a2, voffA);
            PG8_WAIT_VK(); PG8_WAIT_L(0); PG8_BAR; PG8_MMA(1, 0, At, B0); if (!HALFN) PG8_MMA(1, 1, At, B1); PG8_BAR; PG8_SCHED;
            PG8_LDB(B0, 1, 0); if (!HALFN) PG8_LDB(B1, 1, 1); PG8_SCHED; PG8_LDA(At, 1, 0); PG8_STAGE(PG8_SA(0, 1), a2 + hstep, voffA);
            PG8_WAIT_VK(); PG8_WAIT_L(0); PG8_BAR; PG8_MMA(0, 0, At, B0); if (!HALFN) PG8_MMA(0, 1, At, B1); PG8_BAR; PG8_SCHED;
            PG8_LDA(At, 1, 1); PG8_STAGE(PG8_SB(1, 0), b3, voffB); if (!HALFN) PG8_STAGE(PG8_SB(1, 1), b3 + hstep, voffB); PG8_STAGE(PG8_SA(1, 0), a3, voffA);
            PG8_WAIT_VK(); PG8_WAIT_L(0); PG8_BAR; PG8_MMA(1, 0, At, B0); if (!HALFN) PG8_MMA(1, 1, At, B1); PG8_BAR; PG8_SCHED;
#undef PG8_WAIT_VK
        }
        if (wr == 0) PG8_BAR;
        { int ln_ = (int)__builtin_amdgcn_mbcnt_hi(~0u, __builtin_amdgcn_mbcnt_lo(~0u, 0u)); asm volatile("" : "+v"(ln_));
          E(acc, cur, wr, wc, ln_ & 15, ln_ >> 4, ln_); }
        if (!has_next) break;
#pragma unroll
        for (int a = 0; a < 2; ++a)
#pragma unroll
            for (int b = 0; b < 2; ++b)
#pragma unroll
                for (int m = 0; m < 4; ++m)
#pragma unroll
                    for (int n = 0; n < 2; ++n) acc[a][b][m][n] = (f32x4){0.f, 0.f, 0.f, 0.f};
        cur = nxt; cA = nA; cB = nB; ++ui;
        if (wr == 1) PG8_BAR;
    }
    PG8_WAIT_V(0);
    PG8_BAR;
#undef PG8_SA
#undef PG8_SB
#undef PG8_STAGE
#undef PG8_LDA
#undef PG8_LDB
#undef PG8_MMA
#undef PG8_WAIT_V
#undef PG8_WAIT_L
#undef PG8_BAR
#undef PG8_SCHED
}
}

__device__ __forceinline__ void ticket_draw(unsigned* qctr, unsigned& tk) {
    const unsigned one = 1u;
    asm volatile("global_atomic_add %0, %1, %2, off sc0" : "=v"(tk) : "v"(qctr), "v"(one) : "memory");
}
__device__ __forceinline__ void ticket_wait(unsigned& tk) { asm volatile("s_waitcnt vmcnt(0)" : "+v"(tk) :: "memory"); }
__device__ __forceinline__ void group_barrier_light(unsigned* cnt, unsigned target, int tid) {
    asm volatile("s_waitcnt vmcnt(0)" ::: "memory");
    __syncthreads();
    if (tid == 0) {
        const unsigned old = __hip_atomic_fetch_add(cnt, 1u, __ATOMIC_RELAXED, __HIP_MEMORY_SCOPE_AGENT);
        if (old + 1u == target) __hip_atomic_store(cnt + 64, 1u, __ATOMIC_RELAXED, __HIP_MEMORY_SCOPE_AGENT);
        else { unsigned sp = 0u; while (__hip_atomic_load(cnt + 64, __ATOMIC_RELAXED, __HIP_MEMORY_SCOPE_AGENT) == 0u && ++sp < (1u << 22)) __builtin_amdgcn_s_sleep(1); }
        __builtin_amdgcn_fence(__ATOMIC_ACQUIRE, "agent");
        asm volatile("s_waitcnt vmcnt(0)" ::: "memory");
    }
    __syncthreads();
}
#define XB_TMO      128
#define XB_XCNT(j)  (256  + 64 * (j))
#define XB_XSUB(j)  (1280 + 64 * (j))
#define XB_XGEN(j)  (2304 + 64 * (j))
#define XB_TOP      3328
#define XB_TOPGEN   3392
#define XCD_BAR_WORDS 3456
#define XB_SPIN_CAP (1u << 18)
__device__ __forceinline__ unsigned xb_ld(unsigned* p)              { return __hip_atomic_load(p, __ATOMIC_RELAXED, __HIP_MEMORY_SCOPE_AGENT); }
__device__ __forceinline__ unsigned xb_add(unsigned* p, unsigned v) { return __hip_atomic_fetch_add(p, v, __ATOMIC_RELAXED, __HIP_MEMORY_SCOPE_AGENT); }
__device__ __forceinline__ unsigned xb_xcc_id() { return (unsigned)__builtin_amdgcn_s_getreg((3 << 11) | 20) & 0xFu; }
#define XB_SPIN(cond, bar) do { unsigned _sp = 0; while (cond) { __builtin_amdgcn_s_sleep(1); \
    if ((++_sp & 255u) == 0u) { if (xb_ld(&(bar)[XB_TMO])) break; if (_sp > XB_SPIN_CAP) { atomicAdd(&(bar)[XB_TMO], 1u); break; } } } } while (0)
struct XcdBarrier { unsigned* bar; unsigned x; volatile LAS unsigned* st; };
__device__ __forceinline__ XcdBarrier xcd_barrier_post(unsigned* bar, volatile LAS unsigned* st, int tid) {
    XcdBarrier b; b.bar = bar; b.x = xb_xcc_id(); b.st = st;
    if (tid == 0) (void)xb_add(&bar[XB_XCNT(b.x)], 1u);
    return b;
}
__device__ __forceinline__ void xcd_barrier_complete(unsigned* bar, unsigned x, unsigned& nloc, unsigned& nx) {
    const unsigned G = gridDim.x * gridDim.y * gridDim.z;
    unsigned sum, cnt, mine, sp = 0u;
    for (;;) {
        sum = 0u; cnt = 0u; mine = 0u;
#pragma unroll
        for (unsigned j = 0; j < 16; ++j) { const unsigned c = xb_ld(&bar[XB_XCNT(j)]); sum += c; cnt += (c > 0u) ? 1u : 0u; mine = (j == x) ? c : mine; }
        if (sum == G) break;
        __builtin_amdgcn_s_sleep(1);
        if ((++sp & 255u) == 0u) { if (xb_ld(&bar[XB_TMO])) break; if (sp > XB_SPIN_CAP) { atomicAdd(&bar[XB_TMO], 1u); break; } }
    }
    nloc = mine > 0u ? mine : 1u; nx = cnt > 0u ? cnt : 1u;
}
__device__ __forceinline__ void xcd_barrier(const XcdBarrier& b, int tid, const bool light = false) {
    asm volatile("s_waitcnt vmcnt(0)" ::: "memory");
    __syncthreads();
    if (tid == 0) {
        unsigned* bar = b.bar;
        __builtin_amdgcn_s_waitcnt(0);
        unsigned nloc = b.st[0], nx = b.st[1];
        if (nloc == 0u) { xcd_barrier_complete(bar, b.x, nloc, nx); b.st[0] = nloc; b.st[1] = nx; }
        const unsigned old = xb_add(&bar[XB_XSUB(b.x)], 1u);
        const unsigned gen = old / nloc;
        if (old + 1u == (gen + 1u) * nloc) {
            if (!light) __builtin_amdgcn_fence(__ATOMIC_RELEASE, "agent");
            asm volatile("s_waitcnt vmcnt(0)" ::: "memory");
            const unsigned og = xb_add(&bar[XB_TOP], 1u);
            const unsigned tg = og / nx;
            if (og + 1u == (tg + 1u) * nx) xb_add(&bar[XB_TOPGEN], 1u);
            else XB_SPIN(xb_ld(&bar[XB_TOPGEN]) == tg, bar);
            __builtin_amdgcn_fence(__ATOMIC_ACQUIRE, "agent");
            xb_add(&bar[XB_XGEN(b.x)], 1u);
            asm volatile("s_waitcnt vmcnt(0)" ::: "memory");
        } else {
            XB_SPIN(xb_ld(&bar[XB_XGEN(b.x)]) == gen, bar);
            __builtin_amdgcn_fence(__ATOMIC_ACQUIRE, "agent");
            asm volatile("s_waitcnt vmcnt(0)" ::: "memory");
        }
    }
    __syncthreads();
}
constexpr int NWAVES = 8, NTHR = 512;
constexpr int RING_BYTES = 131072;
constexpr int LDSX_OFF = RING_BYTES;
constexpr int LDSCTL_OFF = 162816;
constexpr int LDS_BYTES = 163840;

struct Args {
    const float* in[20]; float* out; unsigned char* ws; int ph_lo, ph_hi, dbg, pad;
};
typedef const __attribute__((address_space(4))) Args* KArgsPtr;
__device__ __forceinline__ KArgsPtr kargs() { KArgsPtr p = (KArgsPtr)__builtin_amdgcn_kernarg_segment_ptr(); asm volatile("" : "+s"(p)); return p; }
struct Frame {
    LAS unsigned char* lds;
    volatile LAS unsigned* MISC;
    unsigned* ctl;
    int tid, lane, wave, vcu, G;
    const float *x, *c, *ctx, *c_ctx, *norm_gain, *ada_w, *ada_b, *even_w_in, *even_w_out, *qk_gain, *lam_p, *subln_g, *lb_logits, *hgrn_g,
                *odd_w_in, *odd_w_out, *v_g, *w_s, *b_s, *conv_w;
    float* out; unsigned char* ws; float* misc;
};

__host__ __device__ __forceinline__ int srcmap0(int d) {
    if (d < 1024) { const int base = d < 512 ? 0 : 512; const int e = d & 511; const int pn = e >> 8, rho = e & 255, bj = rho >> 7, wc = (rho >> 5) & 3; return base + (4 * pn + wc) * 64 + 32 * bj + (rho & 31); }
    if (d < 1536) return 1536 + (d - 1024);
    if (d < 2048) return 2048 + (d - 1536);
    if (d < 2560) return 3072 + (d - 2048);
    if (d < 3072) return 3584 + (d - 2560);
    if (d < 3584) return 4096 + (d - 3072);
    if (d < 4096) return 1024 + (d - 3584);
    return 2560 + (d - 4096);
}
__host__ __device__ __forceinline__ int srcmap1(int d) {
    if (d < 1024) { const int t = d >> 8, rho = d & 255, bj = rho >> 7, o = rho & 127; return (bj ? 1024 : 0) + 128 * t + o; }
    if (d < 2048) { const int e = d - 1024; const int t = e >> 8, rho = e & 255, bj = rho >> 7, o = rho & 127; return (bj ? 3072 : 1536) + 128 * t + o; }
    if (d < 3072) { const int e = d - 2048; const int t = e >> 8, rho = e & 255, bj = rho >> 7, o = rho & 127; return (bj ? 2560 : 2048) + 128 * t + o; }
    return 512 + (d - 3072);
}

__device__ __forceinline__ void p0_transpose_item(const float* W, int K, int N, bf16_t* WT, int drow0, int n_src, int k0, LAS float* scr, int lane) {
    float tv[32];
#pragma unroll
    for (int i = 0; i < 32; ++i) { const int kk = 2 * i + (lane >> 5); tv[i] = __builtin_nontemporal_load(W + (size_t)(k0 + kk) * N + n_src + (lane & 31)); }
#pragma unroll
    for (int i = 0; i < 32; ++i) { const int kk = 2 * i + (lane >> 5); scr[kk * 33 + (lane & 31)] = tv[i]; }
    LDS_WAIT(); asm volatile("" ::: "memory");
    const int c = lane & 7;
#pragma unroll
    for (int j = 0; j < 4; ++j) { const int n = (lane >> 3) + 8 * j; const LAS float* s = scr + (8 * c) * 33 + n;
        u32x4 o; o.x = cvt_pk_bf16(s[0 * 33], s[1 * 33]); o.y = cvt_pk_bf16(s[2 * 33], s[3 * 33]); o.z = cvt_pk_bf16(s[4 * 33], s[5 * 33]); o.w = cvt_pk_bf16(s[6 * 33], s[7 * 33]);
        *(u32x4*)(WT + (size_t)(drow0 + n) * K + k0 + 8 * c) = o; }
    LDS_WAIT(); asm volatile("" ::: "memory");
}

__device__ __forceinline__ void weight_copies(Frame& F, int which, int gw, int NGW, int sub_lo = 0, int sub_hi = 1 << 30) {
    LAS float* scr = (LAS float*)(F.lds + F.wave * 16384);
    constexpr int I0 = 16 * (EIN / 32), I1 = 16 * 32, I2 = 16 * (OIN / 32), I3 = 16 * 32, I4 = 128;
    bf16_t* Wt0 = (bf16_t*)(F.ws + WS_WT0); bf16_t* Wo0 = (bf16_t*)(F.ws + WS_WO0); bf16_t* Wt1 = (bf16_t*)(F.ws + WS_WT1); bf16_t* Wo1 = (bf16_t*)(F.ws + WS_WO1); bf16_t* Wsb = (bf16_t*)(F.ws + WS_WS);
    const int lo = (which ? I0 + I1 : 0) + sub_lo, hi0 = which ? I0 + I1 + I2 + I3 + I4 : I0 + I1; const int hi = (lo - sub_lo + sub_hi < hi0) ? lo - sub_lo + sub_hi : hi0;
    for (int it = lo + gw; it < hi; it += NGW) {
        int r = it;
        if (r < I0) { const int kb = r / (EIN / 32), dg = r % (EIN / 32); p0_transpose_item(F.even_w_in, DM, EIN, Wt0, dg * 32, srcmap0(dg * 32), kb * 64, scr, F.lane); continue; } r -= I0;
        if (r < I1) { const int kb = r / 32, dg = r % 32; p0_transpose_item(F.even_w_out, DM, DM, Wo0, dg * 32, dg * 32, kb * 64, scr, F.lane); continue; } r -= I1;
        if (r < I2) { const int kb = r / (OIN / 32), dg = r % (OIN / 32); p0_transpose_item(F.odd_w_in, DM, OIN, Wt1, dg * 32, srcmap1(dg * 32), kb * 64, scr, F.lane); continue; } r -= I2;
        if (r < I3) { const int kb = r / 32, dg = r % 32; p0_transpose_item(F.odd_w_out, DM, DM, Wo1, dg * 32, dg * 32, kb * 64, scr, F.lane); continue; } r -= I3;
        { const int e0 = r * 512 + F.lane * 8; const f32x4 a = __builtin_nontemporal_load((const f32x4*)(F.w_s + e0)), b = __builtin_nontemporal_load((const f32x4*)(F.w_s + e0 + 4));
          u32x4 o; o.x = cvt_pk_bf16(a.x, a.y); o.y = cvt_pk_bf16(a.z, a.w); o.z = cvt_pk_bf16(b.x, b.y); o.w = cvt_pk_bf16(b.z, b.w); *(u32x4*)(Wsb + e0) = o; }
    }
}
__device__ __forceinline__ void tr0_decode(Frame& F, int it, const float*& W, bf16_t*& WT, int& N, int& drow0, int& n_src, int& k0) {
    constexpr int I0 = 16 * (EIN / 32);
    const bool first = it < I0; const int r = first ? it : it - I0; const int per = first ? EIN / 32 : 32;
    const int kb = r / per, dg = r % per;
    W = first ? F.even_w_in : F.even_w_out; WT = (bf16_t*)(F.ws + (first ? WS_WT0 : WS_WO0)); N = first ? EIN : DM;
    drow0 = dg * 32; n_src = first ? srcmap0(dg * 32) : dg * 32; k0 = kb * 64;
}
__device__ __forceinline__ void tr0_load(Frame& F, int it, float (&tv)[32]) {
    const float* W; bf16_t* WT; int N, drow0, n_src, k0; tr0_decode(F, it, W, WT, N, drow0, n_src, k0);
#pragma unroll
    for (int i = 0; i < 32; ++i) { const int kk = 2 * i + (F.lane >> 5); tv[i] = __builtin_nontemporal_load(W + (size_t)(k0 + kk) * N + n_src + (F.lane & 31)); }
}
__device__ __forceinline__ void tr0_finish(Frame& F, int it, const float (&tv)[32]) {
    const float* W; bf16_t* WT; int N, drow0, n_src, k0; tr0_decode(F, it, W, WT, N, drow0, n_src, k0);
    LAS float* scr = (LAS float*)(F.lds + F.wave * 16384); const int lane = F.lane;
#pragma unroll
    for (int i = 0; i < 32; ++i) { const int kk = 2 * i + (lane >> 5); scr[kk * 33 + (lane & 31)] = tv[i]; }
    LDS_WAIT(); asm volatile("" ::: "memory");
    const int c = lane & 7;
#pragma unroll
    for (int j = 0; j < 4; ++j) { const int n = (lane >> 3) + 8 * j; const LAS float* sp = scr + (8 * c) * 33 + n;
        u32x4 o; o.x = cvt_pk_bf16(sp[0 * 33], sp[1 * 33]); o.y = cvt_pk_bf16(sp[2 * 33], sp[3 * 33]); o.z = cvt_pk_bf16(sp[4 * 33], sp[5 * 33]); o.w = cvt_pk_bf16(sp[6 * 33], sp[7 * 33]);
        *(u32x4*)(WT + (size_t)(drow0 + n) * DM + k0 + 8 * c) = o; }
    LDS_WAIT(); asm volatile("" ::: "memory");
}
__device__ __forceinline__ void p0_prologue(Frame& F) {
    float* misc = F.misc;
    if (F.vcu < 192) {
        LAS float* sl = (LAS float*)F.lds;
        LAS float* red = (LAS float*)(F.lds + 36864);
        const int cc = F.tid & 31, kp = F.tid >> 5;
        const int gcol = F.vcu * 32 + cc;
        const int l = gcol / 3072, col = gcol % 3072;
        const float* w = F.ada_w + (size_t)l * 1024 * 3072 + col;
        const int cit = 1280 + F.vcu * NWAVES + F.wave;
        float ctv[32];
        tr0_load(F, cit, ctv);
        float wv[64];
#pragma unroll
        for (int i = 0; i < 64; ++i) wv[i] = __builtin_nontemporal_load(w + (size_t)(kp * 64 + i) * 3072);
        for (int i = F.tid; i < 9 * 1024; i += NTHR) { const int r = i >> 10, k = i & 1023; const float v = (r < 8) ? F.c[r * 1024 + k] : F.c_ctx[k]; sl[i] = v / (1.f + __expf(-v)); }
        __syncthreads();
#pragma unroll
        for (int r = 0; r < 9; ++r) {
            float a = 0.f;
#pragma unroll
            for (int i4 = 0; i4 < 16; ++i4) { const f32x4 sv = *(const LAS f32x4*)(sl + r * 1024 + kp * 64 + 4 * i4);
                a += sv.x * wv[4 * i4] + sv.y * wv[4 * i4 + 1] + sv.z * wv[4 * i4 + 2] + sv.w * wv[4 * i4 + 3]; }
            red[(kp * 9 + r) * 32 + cc] = a;
        }
        __syncthreads();
        if (F.tid < 9 * 32) { const int r = F.tid >> 5, c2 = F.tid & 31; const int gc = F.vcu * 32 + c2; const int l2 = gc / 3072, col2 = gc % 3072;
            float sacc = F.ada_b[l2 * 3072 + col2];
#pragma unroll
            for (int q = 0; q < 16; ++q) sacc += red[(q * 9 + r) * 32 + c2];
            misc[MI_MOD + (l2 * 9 + r) * 3072 + col2] = sacc; }
        __syncthreads();
        tr0_finish(F, cit, ctv);
        asm volatile("s_waitcnt vmcnt(0)" ::: "memory");
        __syncthreads();
        if (F.tid == 0) { __builtin_amdgcn_fence(__ATOMIC_RELEASE, "agent"); __hip_atomic_fetch_add(F.ctl + CW_ADA, 1u, __ATOMIC_RELAXED, __HIP_MEMORY_SCOPE_AGENT);
            __hip_atomic_fetch_add(F.ctl + CW_W0, 1u, __ATOMIC_RELAXED, __HIP_MEMORY_SCOPE_AGENT); }
    }
    if (F.vcu == 192) {
        for (int i = F.tid; i < 1024; i += NTHR) { const int pos = i >> 4, f = i & 15; const float inv = powf(10000.f, -(float)f / 16.f); const float ang = (float)pos * inv;
            misc[MI_CS + i] = cosf(ang); misc[MI_SN + i] = sinf(ang); }
    }
    if (F.vcu == 193) {
        for (int i = F.tid; i < 1024; i += NTHR) { const int dir = i >> 9, ch = i & 511; const float l0 = F.lb_logits[(dir * 2 + 0) * 512 + ch], l1 = F.lb_logits[(dir * 2 + 1) * 512 + ch];
            const float mx = fmaxf(l0, l1); const float e0 = expf(l0 - mx), e1 = expf(l1 - mx); misc[MI_LBV + i] = e0 / (e0 + e1); }
        if (F.wave == 0) {
            const int i = F.lane;
            float a = F.lam_p[i] * F.lam_p[64 + i], b = F.lam_p[128 + i] * F.lam_p[192 + i], gq = fabsf(F.qk_gain[i]), gk = fabsf(F.qk_gain[64 + i]);
#pragma unroll
            for (int o = 1; o < 64; o <<= 1) { a += __shfl_xor(a, o); b += __shfl_xor(b, o); gq = fmaxf(gq, __shfl_xor(gq, o)); gk = fmaxf(gk, __shfl_xor(gk, o)); }
            if (i == 0) {
                misc[MI_SCAL + 0] = expf(a) - expf(b) + LAM_INIT;
                misc[MI_SCAL + 1] = 8.0f * gq * gk * LOG2E * 1.0001f + 0.01f;
            }
        }
    }
    if (F.vcu >= 194) {
        const int gwc = (F.vcu - 194) * NWAVES + F.wave; bf16_t* Wsb = (bf16_t*)(F.ws + WS_WS);
        for (int r = gwc; r < 128; r += 62 * NWAVES) {
            const int e0 = r * 512 + F.lane * 8; const f32x4 a = __builtin_nontemporal_load((const f32x4*)(F.w_s + e0)), b = __builtin_nontemporal_load((const f32x4*)(F.w_s + e0 + 4));
            u32x4 o; o.x = cvt_pk_bf16(a.x, a.y); o.y = cvt_pk_bf16(a.z, a.w); o.z = cvt_pk_bf16(b.x, b.y); o.w = cvt_pk_bf16(b.z, b.w); *(u32x4*)(Wsb + e0) = o; }
    }
    if (F.vcu >= 194) weight_copies(F, 0, (F.vcu - 194) * NWAVES + F.wave, 62 * NWAVES, 0, 1280);
    if (F.vcu >= 192) {
        asm volatile("s_waitcnt vmcnt(0)" ::: "memory");
        __syncthreads();
        if (F.tid == 0) { __builtin_amdgcn_fence(__ATOMIC_RELEASE, "agent"); __hip_atomic_fetch_add(F.ctl + CW_W0, 1u, __ATOMIC_RELAXED, __HIP_MEMORY_SCOPE_AGENT); }
    }
}

__device__ __forceinline__ void mod_rows3(Frame& F, int ma, int mb, int mc, bf16_t* XN, bf16_t* CN) {
    const float* misc = F.misc; const int lane = F.lane;
    f32x4 v[3][4];
#pragma unroll
    for (int r = 0; r < 3; ++r) { const int m = (r == 0) ? ma : (r == 1) ? mb : mc; const float* xrow = (m < M_TOK) ? F.x + (size_t)m * DM : F.ctx + (size_t)(m - M_TOK) * DM; const f32x4* xr = (const f32x4*)xrow + lane;
#pragma unroll
        for (int j = 0; j < 4; ++j) v[r][j] = xr[64 * j]; }
#pragma unroll
    for (int r = 0; r < 3; ++r) {
        const int m = (r == 0) ? ma : (r == 1) ? mb : mc;
        float s = 0.f;
#pragma unroll
        for (int j = 0; j < 4; ++j) s += (v[r][j].x * v[r][j].x + v[r][j].y * v[r][j].y) + (v[r][j].z * v[r][j].z + v[r][j].w * v[r][j].w);
        const float rstd = rsqrtf(wave_sum(s) * (1.f / DM) + EPS);
        const float* modrow = misc + MI_MOD + (0 * 9 + ((m < M_TOK) ? (m >> 11) : 8)) * 3072;
        bf16_t* orow = (m < M_TOK) ? XN + (size_t)m * DM : CN + (size_t)(m - M_TOK) * DM;
        u32x2* o8 = (u32x2*)orow + lane;
#pragma unroll
        for (int j = 0; j < 4; ++j) {
            const int col = 4 * lane + 256 * j;
            const f32x4 g = *(const f32x4*)(F.norm_gain + col), sh = *(const f32x4*)(modrow + col), sc = *(const f32x4*)(modrow + 1024 + col);
            const f32x4 o = v[r][j] * rstd * g * (sc + 1.f) + sh;
            u32x2 w; w.x = cvt_pk_bf16(o.x, o.y); w.y = cvt_pk_bf16(o.z, o.w); o8[64 * j] = w;
        }
    }
}
__device__ __forceinline__ void rows_load(Frame& F, int m, f32x4 (&v)[4]) {
    const float* xrow = (m < M_TOK) ? F.x + (size_t)m * DM : F.ctx + (size_t)(m - M_TOK) * DM; const f32x4* xr = (const f32x4*)xrow + F.lane;
#pragma unroll
    for (int j = 0; j < 4; ++j) v[j] = __builtin_nontemporal_load(xr + 64 * j);
}
__device__ __forceinline__ void mod_vecs(Frame& F, int modr, f32x4 (&Gm)[4], f32x4 (&Sh)[4]) {
    const float* modrow = F.misc + MI_MOD + (0 * 9 + modr) * 3072;
#pragma unroll
    for (int j = 0; j < 4; ++j) { const int col = 4 * F.lane + 256 * j;
        Gm[j] = *(const f32x4*)(F.norm_gain + col) * (*(const f32x4*)(modrow + 1024 + col) + 1.f); Sh[j] = *(const f32x4*)(modrow + col); }
}
__device__ __forceinline__ void row_proc(Frame& F, int m, const f32x4 (&v)[4], const f32x4 (&Gm)[4], const f32x4 (&Sh)[4], bf16_t* XN, bf16_t* CN) {
    float s = 0.f;
#pragma unroll
    for (int j = 0; j < 4; ++j) s += (v[j].x * v[j].x + v[j].y * v[j].y) + (v[j].z * v[j].z + v[j].w * v[j].w);
    const float rstd = rsqrtf(wave_sum(s) * (1.f / DM) + EPS);
    bf16_t* orow = (m < M_TOK) ? XN + (size_t)m * DM + (size_t)(m >> 11) * 2097152 : XN + (size_t)((m - M_TOK) >> 8) * 4194304 + 2097152 + (size_t)((m - M_TOK) & 255) * DM;
    u32x2* o8 = (u32x2*)orow + F.lane;
#pragma unroll
    for (int j = 0; j < 4; ++j) { const f32x4 o = v[j] * rstd * Gm[j] + Sh[j]; u32x2 w; w.x = cvt_pk_bf16(o.x, o.y); w.y = cvt_pk_bf16(o.z, o.w); o8[64 * j] = w; }
}
__device__ __forceinline__ void p0b_phase(Frame& F) {
    const float* misc = F.misc;
    bf16_t* XN = (bf16_t*)(F.ws + WS_XN); bf16_t* CN = (bf16_t*)(F.ws + WS_CN);
    const int gw0 = F.vcu * NWAVES + F.wave;
    f32x4 ra[3][4], rb[3][4];
#pragma unroll
    for (int r = 0; r < 3; ++r) { rows_load(F, 8 * gw0 + r, ra[r]); rows_load(F, 8 * gw0 + 3 + r, rb[r]); }
    const bool bias_wg = ((int)blockIdx.x & 1) == 0;
    const int bias_k = (((int)blockIdx.x & 7) >> 1) * 32 + ((int)blockIdx.x >> 3);
    const int cc = F.tid & 15, kp = F.tid >> 4;
    float wv[32];
    if (bias_wg && cc < 14) {
        const int d = (2 * bias_k) * 14 + cc; const int src = srcmap1(d & ~31) + (d & 31);
#pragma unroll
        for (int i = 0; i < 32; ++i) wv[i] = __builtin_nontemporal_load(F.odd_w_in + (size_t)(kp * 32 + i) * OIN + src);
    } else {
#pragma unroll
        for (int i = 0; i < 32; ++i) wv[i] = 0.f;
    }
    float wv2[32];
    if (bias_wg && cc < 14) {
        const int d = (2 * bias_k + 1) * 14 + cc; const int src = srcmap1(d & ~31) + (d & 31);
#pragma unroll
        for (int i = 0; i < 32; ++i) wv2[i] = __builtin_nontemporal_load(F.odd_w_in + (size_t)(kp * 32 + i) * OIN + src);
    } else {
#pragma unroll
        for (int i = 0; i < 32; ++i) wv2[i] = 0.f;
    }
    if (F.wave == 0) { unsigned sp = 0u;
        while (__hip_atomic_load(F.ctl + CW_ADA, __ATOMIC_RELAXED, __HIP_MEMORY_SCOPE_AGENT) < 192u && ++sp < (1u << 22)) __builtin_amdgcn_s_sleep(2);
        __builtin_amdgcn_fence(__ATOMIC_ACQUIRE, "agent"); }
    __syncthreads();
    {
        const int gw = gw0;
        f32x4 Gm[4], Sh[4];
        mod_vecs(F, (8 * gw) >> 11, Gm, Sh);
#pragma unroll
        for (int r = 0; r < 3; ++r) row_proc(F, 8 * gw + r, ra[r], Gm, Sh, XN, CN);
        rows_load(F, 8 * gw + 6, ra[0]); rows_load(F, 8 * gw + 7, ra[1]); rows_load(F, M_TOK + gw, ra[2]);
        __builtin_amdgcn_sched_barrier(0);
#pragma unroll
        for (int r = 0; r < 3; ++r) row_proc(F, 8 * gw + 3 + r, rb[r], Gm, Sh, XN, CN);
        row_proc(F, 8 * gw + 6, ra[0], Gm, Sh, XN, CN); row_proc(F, 8 * gw + 7, ra[1], Gm, Sh, XN, CN);
        mod_vecs(F, 8, Gm, Sh);
        row_proc(F, M_TOK + gw, ra[2], Gm, Sh, XN, CN);
    }
    if (bias_wg) {
        LAS float* red = (LAS float*)F.lds;
        LAS float* shs = (LAS float*)(F.lds + 16384);
        { f32x4 sh4[4];
#pragma unroll
          for (int q = 0; q < 4; ++q) { const int i = F.tid + NTHR * q; const int b = i >> 8, c4 = i & 255; sh4[q] = *(const f32x4*)(misc + MI_MOD + (9 + b) * 3072 + 4 * c4); }
#pragma unroll
          for (int q = 0; q < 4; ++q) { const int i = F.tid + NTHR * q; const int b = i >> 8, c4 = i & 255; *(LAS f32x4*)(shs + b * 1024 + 4 * c4) = sh4[q]; } }
        __syncthreads();
        for (int pass = 0; pass < 2; ++pass) {
            const int chunk = 2 * bias_k + pass;
            if (pass == 1) {
#pragma unroll
                for (int i = 0; i < 32; ++i) wv[i] = wv2[i];
            }
            float acc[8];
#pragma unroll
            for (int b = 0; b < 8; ++b) acc[b] = 0.f;
#pragma unroll
            for (int b = 0; b < 8; ++b) {
#pragma unroll
                for (int i4 = 0; i4 < 8; ++i4) { const f32x4 sv = *(const LAS f32x4*)(shs + b * 1024 + kp * 32 + 4 * i4);
                    acc[b] += sv.x * wv[4 * i4] + sv.y * wv[4 * i4 + 1] + sv.z * wv[4 * i4 + 2] + sv.w * wv[4 * i4 + 3]; }
            }
#pragma unroll
            for (int b = 0; b < 8; ++b) red[(kp * 8 + b) * 16 + cc] = acc[b];
            __syncthreads();
            if (F.tid < 8 * 14) { const int b = F.tid / 14, c2 = F.tid % 14; float sm = 0.f;
                for (int q = 0; q < 32; ++q) sm += red[(q * 8 + b) * 16 + c2];
                __hip_atomic_store(F.misc + MI_BIAS1 + b * OIN + chunk * 14 + c2, sm, __ATOMIC_RELAXED, __HIP_MEMORY_SCOPE_AGENT); }
            __syncthreads();
        }
        asm volatile("s_waitcnt vmcnt(0)" ::: "memory");
        __syncthreads();
        if (F.tid == 0) (void)__hip_atomic_fetch_add(F.ctl + CW_B1, 1u, __ATOMIC_RELAXED, __HIP_MEMORY_SCOPE_AGENT);
    }
}

enum { T_Q = 0, T_K = 1, T_SILU = 2, T_PLAIN = 3, T_LF = 4, T_VT = 5 };
struct P1Order {
    int G, c;
    __device__ __forceinline__ bool next(int i, pg8::Unit& u) const {
        const int L = i * G + c;
        const char* wsb = (const char*)kargs()->ws; const char* XN = wsb + WS_XN; const char* CN = wsb + WS_CN; const char* Wt0 = wsb + WS_WT0;
        constexpr size_t TSTEP = (size_t)256 * DM * 2;
        if (L < 896) {
            constexpr int nwg = 896, nN = 14, q = nwg / 8;
            const int xcd = L % 8, offp = L / 8; const int wgid = xcd * q + offp;
            constexpr int nig = 8 * nN; const int gid = wgid / nig, fm = gid * 8;
            u.pm = fm + ((wgid % nig) % 8); u.pn = (wgid % nig) / 8;
            u.a = XN + (size_t)u.pm * TSTEP + (size_t)(u.pm >> 3) * (4u << 20); u.b = Wt0 + (size_t)u.pn * TSTEP; u.aux = 0;
            u.ty = (u.pn < 2) ? T_Q : (u.pn < 4) ? T_K : (u.pn < 6) ? T_SILU : (u.pn < 8) ? T_PLAIN : (u.pn < 12) ? T_LF : T_SILU;
            return true;
        }
        int r = L - 896;
        if (r < 256) { const int xcd = r % 8, j = r / 8; u.pn = xcd * 8 + j / 4; u.pm = j % 4; u.a = Wt0 + (size_t)(14 + u.pm) * TSTEP; u.b = XN + (size_t)u.pn * TSTEP + (size_t)(u.pn >> 3) * (4u << 20); u.ty = T_VT; u.aux = 0; return true; }
        r -= 256;
        if (r < 48) { const int pmc = r % 8, j = r / 8; const int pn = (j < 2) ? 2 + j : 6 + j;
            u.pm = pmc; u.pn = pn; u.a = XN + (size_t)pmc * (8u << 20) + (4u << 20); u.b = Wt0 + (size_t)pn * TSTEP; u.aux = 1; u.ty = (pn < 4) ? T_K : T_LF; return true; }
        r -= 48;
        if (r < 32) { u.pn = r % 8; u.pm = r / 8; u.a = Wt0 + (size_t)(14 + u.pm) * TSTEP; u.b = XN + (size_t)u.pn * (8u << 20) + (4u << 20); u.ty = T_VT; u.aux = 1; return true; }
        return false;
    }
};
struct EpiP1 {
    const LAS float* tab;
    __device__ __forceinline__ void operator()(const f32x4 (&acc)[2][2][4][2], const pg8::Unit& u, int wr, int wc, int fr, int fq, int lane) const {
        KArgsPtr ka = kargs(); unsigned char* wsb = ka->ws; const float* qk_gain = ka->in[9];
        bf16_t* Y = (bf16_t*)(wsb + WS_Y); bf16_t* Kc = (bf16_t*)(wsb + WS_KC); bf16_t* VT = (bf16_t*)(wsb + WS_VT); bf16_t* GA = (bf16_t*)(wsb + WS_GA); bf16_t* HVT = (bf16_t*)(wsb + WS_HVT); bf16_t* GB = (bf16_t*)(wsb + WS_GB);
        unsigned short* LF = (unsigned short*)(wsb + WS_LF); const float* miscp = (const float*)(wsb + WS_MISC); const float* CS = miscp + MI_CS; const float* SN = miscp + MI_SN; const float* LBV = miscp + MI_LBV;
        const int ty = u.ty, ctx = u.aux;
        if (ty == T_Q || ty == T_K) {
            const int seg = 4 * (u.pn & 1) + wc;
            const LAS float* gp = tab + 2048 + (ty == T_K ? 64 : 0) + 8 * fq;
            const float osc = (ty == T_Q) ? 0.125f * LOG2E : 1.f;
            const f32x4 g00 = *(const LAS f32x4*)(gp) * osc, g01 = *(const LAS f32x4*)(gp + 4) * osc, g10 = *(const LAS f32x4*)(gp + 32) * osc, g11 = *(const LAS f32x4*)(gp + 36) * osc;
#pragma unroll
            for (int ai = 0; ai < 2; ++ai)
#pragma unroll
                for (int m = 0; m < 4; ++m) {
                    const int rt = 128 * ai + 64 * wr + 16 * m + fr;
                    const int t = ((u.pm & 7) * 256 + rt);
                    float ss = 0.f;
#pragma unroll
                    for (int bj = 0; bj < 2; ++bj)
#pragma unroll
                        for (int n = 0; n < 2; ++n) { const f32x4 v = acc[ai][bj][m][n]; ss += (v.x * v.x + v.y * v.y) + (v.z * v.z + v.w * v.w); }
                    ss += __shfl_xor(ss, 16); ss += __shfl_xor(ss, 32);
                    const float rstd = rsqrtf(ss * (1.f / 64.f) + EPS);
                    f32x4 a0 = acc[ai][0][m][0] * rstd * g00, a1 = acc[ai][0][m][1] * rstd * g01, b0 = acc[ai][1][m][0] * rstd * g10, b1 = acc[ai][1][m][1] * rstd * g11;
                    if (!ctx) {
                        const int pos = (fq < 2) ? (t >> 6) : (t & 63);
                        const LAS float* cp = tab + pos * 16 + 8 * (fq & 1); const LAS float* sp = cp + 1024;
                        const f32x4 c0 = *(const LAS f32x4*)cp, c1 = *(const LAS f32x4*)(cp + 4), s0 = *(const LAS f32x4*)sp, s1 = *(const LAS f32x4*)(sp + 4);
                        const f32x4 o0 = a0 * c0 - b0 * s0, o1 = a1 * c1 - b1 * s1, p0 = a0 * s0 + b0 * c0, p1 = a1 * s1 + b1 * c1;
                        a0 = o0; a1 = o1; b0 = p0; b1 = p1;
                    }
                    u32x4 w0, w1;
                    w0.x = cvt_pk_bf16(a0.x, a0.y); w0.y = cvt_pk_bf16(a0.z, a0.w); w0.z = cvt_pk_bf16(a1.x, a1.y); w0.w = cvt_pk_bf16(a1.z, a1.w);
                    w1.x = cvt_pk_bf16(b0.x, b0.y); w1.y = cvt_pk_bf16(b0.z, b0.w); w1.z = cvt_pk_bf16(b1.x, b1.y); w1.w = cvt_pk_bf16(b1.z, b1.w);
                    bf16_t* dst;
                    if (ty == T_Q) dst = Y + (size_t)(u.pm * 256 + rt) * 1024 + seg * 64 + 8 * fq;
                    else if (!ctx) dst = Kc + ((size_t)(u.pm >> 3) * KV + CTX + t) * 512 + seg * 64 + 8 * fq;
                    else dst = Kc + ((size_t)u.pm * KV + rt) * 512 + seg * 64 + 8 * fq;
                    *(u32x4*)dst = w0; *(u32x4*)(dst + 32) = w1;
                }
        } else if (ty == T_SILU || ty == T_PLAIN) {
            bf16_t* base; int pitch;
            if (ty == T_PLAIN) { base = Y + 512 + (u.pn - 6) * 256; pitch = 1024; }
            else if (u.pn < 6) { base = GA + (u.pn - 4) * 256; pitch = 512; }
            else { base = GB + (u.pn - 12) * 256; pitch = 512; }
#pragma unroll
            for (int ai = 0; ai < 2; ++ai)
#pragma unroll
                for (int m = 0; m < 4; ++m) {
                    const int rt = 128 * ai + 64 * wr + 16 * m + fr;
                    bf16_t* rowp = base + (size_t)(u.pm * 256 + rt) * pitch + 32 * wc + 8 * fq;
#pragma unroll
                    for (int bj = 0; bj < 2; ++bj) {
                        f32x4 v0 = acc[ai][bj][m][0], v1 = acc[ai][bj][m][1];
                        if (ty == T_SILU) { v0.x = silu_fast(v0.x); v0.y = silu_fast(v0.y); v0.z = silu_fast(v0.z); v0.w = silu_fast(v0.w); v1.x = silu_fast(v1.x); v1.y = silu_fast(v1.y); v1.z = silu_fast(v1.z); v1.w = silu_fast(v1.w); }
                        u32x4 w; w.x = cvt_pk_bf16(v0.x, v0.y); w.y = cvt_pk_bf16(v0.z, v0.w); w.z = cvt_pk_bf16(v1.x, v1.y); w.w = cvt_pk_bf16(v1.z, v1.w);
                        *(u32x4*)(rowp + 128 * bj) = w;
                    }
                }
        } else if (ty == T_LF) {
            const int dir = (u.pn >= 10) ? 1 : 0; const int pnr = (u.pn - 8) & 1;
            const int col0 = 256 * pnr + 32 * wc + 8 * fq;
            f32x4 lb[2][2];
#pragma unroll
            for (int bj = 0; bj < 2; ++bj)
#pragma unroll
                for (int n = 0; n < 2; ++n) lb[bj][n] = *(const LAS f32x4*)(tab + 2176 + dir * 512 + col0 + 128 * bj + 4 * n);
#pragma unroll
            for (int ai = 0; ai < 2; ++ai)
#pragma unroll
                for (int m = 0; m < 4; ++m) {
                    const int rt = 128 * ai + 64 * wr + 16 * m + fr;
                    size_t krow;
                    if (!ctx) krow = ((size_t)(dir * 8 + (u.pm >> 3)) * KV + CTX + (u.pm & 7) * 256 + rt);
                    else krow = ((size_t)(dir * 8 + u.pm) * KV + rt);
                    unsigned short* rowp = LF + krow * 512 + col0;
#pragma unroll
                    for (int bj = 0; bj < 2; ++bj) {
                        float o[8];
#pragma unroll
                        for (int n = 0; n < 2; ++n)
#pragma unroll
                            for (int j = 0; j < 4; ++j) { const float z = acc[ai][bj][m][n][j]; const float l = lb[bj][n][j]; const float f = l + (1.f - l) * __builtin_amdgcn_rcpf(1.f + __expf(-z)); o[4 * n + j] = __builtin_amdgcn_logf(f); }
                        u32x4 w; w.x = cvt_pk_f16(o[0], o[1]); w.y = cvt_pk_f16(o[2], o[3]); w.z = cvt_pk_f16(o[4], o[5]); w.w = cvt_pk_f16(o[6], o[7]);
                        *(u32x4*)(rowp + 128 * bj) = w;
                    }
                }
        } else {
#pragma unroll
            for (int ai = 0; ai < 2; ++ai)
#pragma unroll
                for (int m = 0; m < 4; ++m) {
                    const int f = u.pm * 256 + 128 * ai + 64 * wr + 16 * m + fr;
                    bf16_t* base = (f < 512) ? VT : HVT; const int hh = (f & 511) >> 7, dv = f & 127;
                    const int b = ctx ? u.pn : (u.pn >> 3);
                    const int key0 = ctx ? 0 : CTX + (u.pn & 7) * 256;
                    bf16_t* rowp = base + ((size_t)(b * 4 + hh) * 128 + dv) * KV + key0 + 32 * wc + 8 * fq;
#pragma unroll
                    for (int bj = 0; bj < 2; ++bj) {
                        const f32x4 v0 = acc[ai][bj][m][0], v1 = acc[ai][bj][m][1];
                        u32x4 w; w.x = cvt_pk_bf16(v0.x, v0.y); w.y = cvt_pk_bf16(v0.z, v0.w); w.z = cvt_pk_bf16(v1.x, v1.y); w.w = cvt_pk_bf16(v1.z, v1.w);
                        *(u32x4*)(rowp + 128 * bj) = w;
                    }
                }
        }
    }
};
namespace att {
constexpr int NSLOT = 4, SLOTB = 32768, VOFF = 16384, NT = KV / 64;
__device__ __forceinline__ void glds16s(const void* sbase, unsigned voff, unsigned lds_dst) {
    unsigned keep;
    asm volatile("s_mov_b32 %0, m0\n\ts_mov_b32 m0, %3\n\ts_nop 0\n\tglobal_load_lds_dwordx4 %1, %2\n\ts_mov_b32 m0, %0" : "=&s"(keep) : "v"(voff), "s"(sbase), "s"(lds_dst) : "memory");
}
__device__ __forceinline__ void glds16(const void* gsrc, unsigned lds_dst) {
    unsigned keep;
    asm volatile("s_mov_b32 %0, m0\n\ts_mov_b32 m0, %2\n\ts_nop 0\n\tglobal_load_lds_dwordx4 %1, off\n\ts_mov_b32 m0, %0" : "=&s"(keep) : "v"(gsrc), "s"(lds_dst) : "memory");
}
#define ATT_WAIT_BAR(N) asm volatile("s_waitcnt vmcnt(" #N ") lgkmcnt(0)\n\ts_barrier" ::: "memory")
__device__ __forceinline__ int crow(int r, int hi) { return (r & 3) + 8 * (r >> 2) + 4 * hi; }
#define MFMA32(a, b, c) __builtin_amdgcn_mfma_f32_32x32x16_bf16((a), (b), (c), 0, 0, 0)

__device__ __forceinline__ void attn_unit(int b, int h, int qb, bf16_t* Y, const bf16_t* Kc, const bf16_t* VT, const bf16_t* GA, const float* subln_g,
                                          float lam, float M2, LAS unsigned char* lds, const int wv, const bool dry = false, unsigned* qctr = nullptr) {
    const int lane = lane_id(), r32 = lane & 31, hi = lane >> 5;
    const int wid = wv;
    const int m = wid >> 2, qs = wid & 3;
    const unsigned lds0 = (unsigned)(uintptr_t)lds;
    const int tok0 = b * SEQ + qb * 128 + qs * 32;
    const bf16_t* Kb = Kc + (size_t)b * KV * 512 + h * 128;
    const bf16_t* Vb = VT + (size_t)(b * 4 + h) * 128 * KV;
    const int krow0 = 16 * (wid & 3) + (lane >> 3), krow1 = krow0 + 8;
    const bf16_t* ksrc0 = Kb + (size_t)krow0 * 512 + (wid >> 2) * 64 + 8 * ((lane & 7) ^ ((krow0 >> 1) & 7));
    const bf16_t* ksrc1 = Kb + (size_t)krow1 * 512 + (wid >> 2) * 64 + 8 * ((lane & 7) ^ ((krow1 >> 1) & 7));
    const int vrow0 = 16 * wid + (lane >> 3), vrow1 = vrow0 + 8;
    const bf16_t* vsrc0 = Vb + (size_t)vrow0 * KV + 8 * ((lane & 7) ^ ((vrow0 >> 1) & 7));
    const bf16_t* vsrc1 = Vb + (size_t)vrow1 * KV + 8 * ((lane & 7) ^ ((vrow1 >> 1) & 7));
    const unsigned kdst = lds0 + (2 * wid) * 1024, vdst = lds0 + VOFF + (2 * wid) * 1024;
#define ATT_DMA(t, slot) do { const unsigned so_ = (unsigned)(slot) * SLOTB; \
        glds16(ksrc0 + (size_t)(t) * 64 * 512, (unsigned)__builtin_amdgcn_readfirstlane(kdst + so_)); \
        glds16(ksrc1 + (size_t)(t) * 64 * 512, (unsigned)__builtin_amdgcn_readfirstlane(kdst + so_ + 1024)); \
        glds16(vsrc0 + (size_t)(t) * 64, (unsigned)__builtin_amdgcn_readfirstlane(vdst + so_)); \
        glds16(vsrc1 + (size_t)(t) * 64, (unsigned)__builtin_amdgcn_readfirstlane(vdst + so_ + 1024)); } while (0)
    const unsigned kvo0 = (unsigned)((const char*)ksrc0 - (const char*)Kb), kvo1 = (unsigned)((const char*)ksrc1 - (const char*)Kb);
    const unsigned vvo0 = (unsigned)((const char*)vsrc0 - (const char*)Vb), vvo1 = (unsigned)((const char*)vsrc1 - (const char*)Vb);
#define ATT_DMA1(t, slot, i) do { const unsigned so_ = (unsigned)(slot) * SLOTB; \
        if ((i) == 0) glds16s(Kb + (size_t)(t) * 64 * 512, kvo0, (unsigned)__builtin_amdgcn_readfirstlane(kdst + so_)); \
        if ((i) == 1) glds16s(Kb + (size_t)(t) * 64 * 512, kvo1, (unsigned)__builtin_amdgcn_readfirstlane(kdst + so_ + 1024)); \
        if ((i) == 2) glds16s(Vb + (size_t)(t) * 64, vvo0, (unsigned)__builtin_amdgcn_readfirstlane(vdst + so_)); \
        if ((i) == 3) glds16s(Vb + (size_t)(t) * 64, vvo1, (unsigned)__builtin_amdgcn_readfirstlane(vdst + so_ + 1024)); } while (0)
    bf16x8 qr[4];
    {
        const bf16_t* qp = Y + (size_t)(tok0 + r32) * 1024 + h * 128 + m * 64 + hi * 8;
#pragma unroll
        for (int d0 = 0; d0 < 4; ++d0) qr[d0] = *(const bf16x8*)(qp + d0 * 16);
    }
    __builtin_amdgcn_sched_barrier(0);
    ATT_DMA(0, 0);
    const int pi = (r32 & ~12) | ((r32 & 4) << 1) | ((r32 & 8) >> 1);
    int koff[4], voff[4];
#pragma unroll
    for (int d0 = 0; d0 < 4; ++d0) koff[d0] = m * 8192 + pi * 128 + (((2 * d0 + hi) ^ ((pi >> 1) & 7)) << 4);
    const int swz = (r32 >> 1) & 7;
#pragma unroll
    for (int s = 0; s < 4; ++s) voff[s] = VOFF + r32 * 128 + (((2 * s + hi) ^ swz) << 4);
    f32x16 o[4];
#pragma unroll
    for (int i = 0; i < 4; ++i)
#pragma unroll
        for (int r = 0; r < 16; ++r) o[i][r] = 0.f;
    float lsum = 0.f;
    f32x16 negm;
#pragma unroll
    for (int r = 0; r < 16; ++r) negm[r] = -M2;
    f32x16 pA0, pA1, pB0, pB1;
#define ATT_QK(N0, N1, sbk) do { N0 = negm; N1 = negm; \
        _Pragma("unroll") for (int d0 = 0; d0 < 4; ++d0) { \
            const bf16x8 k0_ = *(const LAS bf16x8*)((sbk) + koff[d0]); const bf16x8 k1_ = *(const LAS bf16x8*)((sbk) + koff[d0] + 4096); \
            N0 = MFMA32(k0_, qr[d0], N0); N1 = MFMA32(k1_, qr[d0], N1); } } while (0)
#define ATT_EXP(N0, N1) do { _Pragma("unroll") for (int r = 0; r < 16; ++r) { N0[r] = __builtin_amdgcn_exp2f(N0[r]); N1[r] = __builtin_amdgcn_exp2f(N1[r]); } } while (0)
#define ATT_PACK8(X, B) (u32x4){cvt_pk_bf16(X[B], X[B + 1]), cvt_pk_bf16(X[B + 2], X[B + 3]), cvt_pk_bf16(X[B + 4], X[B + 5]), cvt_pk_bf16(X[B + 6], X[B + 7])}
#define ATT_KRD(d0, half) (*(const LAS bf16x8*)(sbk_ + koff[d0] + (half) * 4096))
#define ATT_VRD(blk, s) (*(const LAS bf16x8*)(sbv_ + voff[s] + (blk) * 4096))
#define ATT_GAP() __builtin_amdgcn_sched_barrier(0)
#define ATT_E4(X, B) do { X[B] = __builtin_amdgcn_exp2f(X[B]); X[B + 1] = __builtin_amdgcn_exp2f(X[B + 1]); X[B + 2] = __builtin_amdgcn_exp2f(X[B + 2]); X[B + 3] = __builtin_amdgcn_exp2f(X[B + 3]); } while (0)
#define ATT_PVROW(blk, V0, V1, V2, V3, W0, W1, W2, W3, nb, F0, F1, F2, F3) do { \
        o[blk] = MFMA32(__builtin_bit_cast(bf16x8, pw0_), V0, o[blk]); if ((nb) < 4) W0 = ATT_VRD((nb) & 3, 0); F0; ATT_GAP(); \
        o[blk] = MFMA32(__builtin_bit_cast(bf16x8, pw1_), V1, o[blk]); if ((nb) < 4) W1 = ATT_VRD((nb) & 3, 1); F1; ATT_GAP(); \
        o[blk] = MFMA32(__builtin_bit_cast(bf16x8, pw2_), V2, o[blk]); if ((nb) < 4) W2 = ATT_VRD((nb) & 3, 2); F2; ATT_GAP(); \
        o[blk] = MFMA32(__builtin_bit_cast(bf16x8, pw3_), V3, o[blk]); if ((nb) < 4) W3 = ATT_VRD((nb) & 3, 3); F3; ATT_GAP(); } while (0)
#define ATT_S2(X, B) do { sacc_ += X[B]; sacc_ += X[B + 1]; } while (0)
#define ATT_STEP(N0, N1, P0, P1, t) do { \
        ATT_WAIT_BAR(4); const int tn_ = ((t) + 2 < NT) ? (t) + 2 : NT - 1;     \
        const LAS unsigned char* sbk_ = lds + ((t) & 3) * SLOTB; const LAS unsigned char* sbv_ = lds + (((t) - 1) & 3) * SLOTB; \
        bf16x8 ka_ = ATT_KRD(0, 0), kb_ = ATT_KRD(1, 0), kc_ = ATT_KRD(2, 0), kd_ = ATT_KRD(3, 0); \
        u32x4 pw0_, pw1_, pw2_, pw3_; bf16x8 ke_, kf_, kg_, kh_, va_, vb_, vc_, vd_, ve_, vf_, vg_, vh_; float sacc_ = 0.f; \
        ATT_GAP(); \
        N0 = MFMA32(ka_, qr[0], negm); pw0_ = ATT_PACK8(P0, 0); ke_ = ATT_KRD(0, 1); kf_ = ATT_KRD(1, 1); ATT_GAP(); \
        N0 = MFMA32(kb_, qr[1], N0);   pw1_ = ATT_PACK8(P0, 8); kg_ = ATT_KRD(2, 1); kh_ = ATT_KRD(3, 1); ATT_GAP(); \
        N0 = MFMA32(kc_, qr[2], N0);   pw2_ = ATT_PACK8(P1, 0); va_ = ATT_VRD(0, 0); vb_ = ATT_VRD(0, 1); ATT_GAP(); \
        N0 = MFMA32(kd_, qr[3], N0);   pw3_ = ATT_PACK8(P1, 8); vc_ = ATT_VRD(0, 2); vd_ = ATT_VRD(0, 3); ATT_GAP(); \
        N1 = MFMA32(ke_, qr[0], negm); ATT_S2(P0, 0); ATT_S2(P0, 2); ATT_S2(P0, 4); ATT_S2(P0, 6); ATT_GAP(); \
        N1 = MFMA32(kf_, qr[1], N1);   ATT_E4(N0, 0);  ATT_GAP(); \
        N1 = MFMA32(kg_, qr[2], N1);   ATT_E4(N0, 4);  ATT_GAP(); \
        N1 = MFMA32(kh_, qr[3], N1);   ATT_E4(N0, 8);  ATT_GAP(); \
        ATT_PVROW(0, va_, vb_, vc_, vd_, ve_, vf_, vg_, vh_, 1, ATT_E4(N0, 12), do { ATT_S2(P0, 8); ATT_S2(P0, 10); ATT_S2(P0, 12); ATT_S2(P0, 14); } while (0), ATT_E4(N1, 0), do { ATT_S2(P1, 0); ATT_S2(P1, 2); ATT_S2(P1, 4); } while (0)); \
        ATT_PVROW(1, ve_, vf_, vg_, vh_, va_, vb_, vc_, vd_, 2, ATT_E4(N1, 4), do { ATT_S2(P1, 6); ATT_S2(P1, 8); ATT_S2(P1, 10); } while (0), ATT_E4(N1, 8), do { ATT_S2(P1, 12); ATT_S2(P1, 14); } while (0)); \
        ATT_PVROW(2, va_, vb_, vc_, vd_, ve_, vf_, vg_, vh_, 3, ATT_E4(N1, 12), (void)0, (void)0, (void)0); \
        ATT_PVROW(3, ve_, vf_, vg_, vh_, va_, vb_, vc_, vd_, 4, ATT_DMA1(tn_, ((t) + 2) & 3, 0), ATT_DMA1(tn_, ((t) + 2) & 3, 1), ATT_DMA1(tn_, ((t) + 2) & 3, 2), ATT_DMA1(tn_, ((t) + 2) & 3, 3)); \
        lsum += sacc_; } while (0)
#define ATT_PV(O0, O1, sbv) do { float sa_ = 0.f, sb_ = 0.f; \
        _Pragma("unroll") for (int r = 0; r < 16; ++r) { sa_ += O0[r]; sb_ += O1[r]; } lsum += sa_ + sb_; \
        u32x4 pw_[4]; pw_[0] = ATT_PACK8(O0, 0); pw_[1] = ATT_PACK8(O0, 8); pw_[2] = ATT_PACK8(O1, 0); pw_[3] = ATT_PACK8(O1, 8); \
        _Pragma("unroll") for (int blk = 0; blk < 4; ++blk) _Pragma("unroll") for (int s = 0; s < 4; ++s) { \
            const bf16x8 vb_ = *(const LAS bf16x8*)((sbv) + voff[s] + blk * 4096); \
            o[blk] = MFMA32(__builtin_bit_cast(bf16x8, pw_[s]), vb_, o[blk]); } } while (0)
    ATT_WAIT_BAR(0);
#pragma unroll
    for (int d0 = 0; d0 < 4; ++d0) asm volatile("" : "+v"(qr[d0]));
    ATT_DMA(1, 1); ATT_DMA(2, 2);
    ATT_QK(pA0, pA1, lds); ATT_EXP(pA0, pA1);
    for (int t = 1; t + 1 < NT; t += 2) {
        ATT_STEP(pB0, pB1, pA0, pA1, t);
        ATT_STEP(pA0, pA1, pB0, pB1, t + 1);
    }
    unsigned tk;
    if (qctr != nullptr && wv == 0 && lane == 0) ticket_draw(qctr, tk);
    ATT_STEP(pB0, pB1, pA0, pA1, NT - 1);
    const int rowq = 16 * m + (lane >> 4), ch16 = lane & 15;
    u32x4 gav[4];
#pragma unroll
    for (int ps = 0; ps < 4; ++ps) gav[ps] = *(const u32x4*)(GA + (size_t)(tok0 + rowq + 4 * ps) * 512 + h * 128 + 8 * ch16);
    { const LAS unsigned char* sbv_ = lds + ((NT - 1) & 3) * SLOTB; ATT_PV(pB0, pB1, sbv_); }
#undef ATT_STEP
#undef ATT_PV
#undef ATT_EXP
#undef ATT_QK
#undef ATT_PVROW
#undef ATT_S2
#undef ATT_E4
#undef ATT_GAP
#undef ATT_KRD
#undef ATT_VRD
#undef ATT_PACK8
    lsum += shfl_xor_l(lsum, 32, lane);
    ATT_WAIT_BAR(0);
    if (qctr != nullptr && wv == 0 && lane == 0) { asm volatile("" : "+v"(tk)); ((volatile LAS unsigned*)(lds + LDSCTL_OFF))[16] = tk; }
    LAS float* wl = (LAS float*)(lds + 131072) + wid * 32;
    LAS float* ex = (LAS float*)(lds + 65536) + qs * 4096;
    if (hi == 0) wl[r32] = lsum;
    LDS_WAIT();
    float rl[16];
#pragma unroll
    for (int r = 0; r < 16; ++r) rl[r] = __builtin_amdgcn_rcpf(wl[crow(r, hi)]) * (m ? lam : 1.f);
    if (m == 1) {
#pragma unroll
        for (int blk = 0; blk < 4; ++blk)
#pragma unroll
            for (int r = 0; r < 16; ++r) ex[crow(r, hi) * 128 + blk * 32 + r32] = o[blk][r] * rl[r];
    }
    ATT_WAIT_BAR(0);
    if (m == 0) {
        float ss[16];
#pragma unroll
        for (int r = 0; r < 16; ++r) ss[r] = 0.f;
#pragma unroll
        for (int blk = 0; blk < 4; ++blk)
#pragma unroll
            for (int r = 0; r < 16; ++r) { const float v = o[blk][r] * rl[r] - ex[crow(r, hi) * 128 + blk * 32 + r32]; o[blk][r] = v; ss[r] += v * v; }
#pragma unroll
        for (int r = 0; r < 16; ++r) {
            float s = ss[r];
            s += shfl_xor_l(s, 1, lane); s += shfl_xor_l(s, 2, lane); s += shfl_xor_l(s, 4, lane); s += shfl_xor_l(s, 8, lane); s += shfl_xor_l(s, 16, lane);
            ss[r] = rsqrtf(s * (1.f / 128.f) + EPS) * (1.f - LAM_INIT);
        }
#pragma unroll
        for (int blk = 0; blk < 4; ++blk) {
            const float g = subln_g[blk * 32 + r32];
#pragma unroll
            for (int r = 0; r < 16; ++r) ex[crow(r, hi) * 128 + blk * 32 + r32] = o[blk][r] * ss[r] * g;
        }
    }
    ATT_WAIT_BAR(0);
    {
#pragma unroll
        for (int ps = 0; ps < 4; ++ps) {
            const int row = rowq + 4 * ps;
            const f32x4 a = *(const LAS f32x4*)(ex + row * 128 + 8 * ch16), c = *(const LAS f32x4*)(ex + row * 128 + 8 * ch16 + 4);
            const u32x4 g4 = gav[ps];
            u32x4 w; w.x = cvt_pk_bf16(a.x * bflo(g4.x), a.y * bfhi(g4.x)); w.y = cvt_pk_bf16(a.z * bflo(g4.y), a.w * bfhi(g4.y));
            w.z = cvt_pk_bf16(c.x * bflo(g4.z), c.y * bfhi(g4.z)); w.w = cvt_pk_bf16(c.z * bflo(g4.w), c.w * bfhi(g4.w));
            if (!dry) *(u32x4*)(Y + (size_t)(tok0 + row) * 1024 + h * 128 + 8 * ch16) = w;
        }
    }
#undef ATT_DMA
#undef ATT_DMA1
}
}
namespace hg {
#define HG_BAR() asm volatile("s_waitcnt vmcnt(0) lgkmcnt(0)\n\ts_barrier" ::: "memory")
#define HG_LBAR() asm volatile("s_waitcnt lgkmcnt(0)\n\ts_barrier" ::: "memory")
__device__ __forceinline__ float h2f(unsigned short h) { return (float)__builtin_bit_cast(_Float16, h); }
__device__ __forceinline__ int crow(int r, int hi) { return (r & 3) + 8 * (r >> 2) + 4 * hi; }
__device__ __forceinline__ int pi32(int x) { return (x & ~12) | ((x & 4) << 1) | ((x & 8) >> 1); }
__device__ __forceinline__ int sw64(int r, int c) { return r * 128 + ((c ^ ((r >> 1) & 7)) << 4); }
__device__ __forceinline__ int sw128(int r, int c) { return r * 256 + ((c ^ (r & 15)) << 4); }

__device__ __forceinline__ unsigned pk4_fp8(float a, float b, float c, float d) {
    int w = __builtin_amdgcn_cvt_pk_fp8_f32(a, b, 0, false); w = __builtin_amdgcn_cvt_pk_fp8_f32(c, d, w, true); return (unsigned)w; }
__device__ __forceinline__ void state_chain(int b, int h, int dir, const unsigned short* LF, const bf16_t* HVT, bf16_t* ST, LAS unsigned char* lds, const int wv, unsigned* qctr = nullptr) {
    const int lane = lane_id(), tid = wv * 64 + lane, r32 = lane & 31, hi = lane >> 5;
    const int wid = wv;
    const int k = tid & 127, part = tid >> 7;
    const int vt = wid & 3, kh = wid >> 2;
    LAS unsigned char* KsT = lds;
    LAS float* dec = (LAS float*)(lds + 32768);
    LAS float* ptot = (LAS float*)(lds + 32768 + 1024);
    LAS unsigned char* stage = lds + 40960;
    const unsigned short* lfb = LF + ((size_t)(dir * 8 + b) * KV) * 512 + h * 128 + k;
    const bf16_t* vb = HVT + ((size_t)(b * 4 + h) * 128 + 32 * vt + r32) * KV + 8 * hi;
    f32x16 S[2];
#pragma unroll
    for (int i = 0; i < 2; ++i)
#pragma unroll
        for (int r = 0; r < 16; ++r) S[i][r] = 0.f;
    unsigned short lfr[16]; bf16x8 bv[4];
    auto ckof = [&](int n) { return dir ? (n < 4 ? 3 - n : 39 - n) : n; };
    {
        const int key0 = 64 * ckof(0);
#pragma unroll
        for (int j = 0; j < 16; ++j) lfr[j] = lfb[(size_t)(key0 + 16 * part + j) * 512];
#pragma unroll
        for (int s = 0; s < 4; ++s) bv[s] = *(const bf16x8*)(vb + key0 + 16 * s);
    }
    unsigned tk = 0u;
    for (int n = 0; n < 36; ++n) {
        const int p = n & 1, ck = ckof(n);
        if (n == 34 && qctr != nullptr && wv == 0 && lane == 0) tk = __hip_atomic_fetch_add(qctr, 1u, __ATOMIC_RELAXED, __HIP_MEMORY_SCOPE_AGENT);
        float lfv[16], c[16];
#pragma unroll
        for (int j = 0; j < 16; ++j) lfv[j] = h2f(lfr[j]);
        bf16x8 bcur[4];
#pragma unroll
        for (int s = 0; s < 4; ++s) bcur[s] = bv[s];
        if (n + 1 < 36) {
            const int key1 = 64 * ckof(n + 1);
#pragma unroll
            for (int j = 0; j < 16; ++j) lfr[j] = lfb[(size_t)(key1 + 16 * part + j) * 512];
#pragma unroll
            for (int s = 0; s < 4; ++s) bv[s] = *(const bf16x8*)(vb + key1 + 16 * s);
        }
        if (dir == 0) { float a = 0.f;
#pragma unroll
            for (int j = 0; j < 16; ++j) { a += lfv[j]; c[j] = a; } }
        else { float a = 0.f;
#pragma unroll
            for (int j = 15; j >= 0; --j) { a += lfv[j]; c[j] = a; } }
        const float T = dir ? c[0] : c[15];
        ptot[(p * 4 + part) * 128 + k] = T;
        HG_LBAR();
        float off = 0.f, gtot = 0.f;
        float pv4[4];
#pragma unroll
        for (int q = 0; q < 4; ++q) pv4[q] = ptot[(p * 4 + q) * 128 + k];
#pragma unroll
        for (int q = 0; q < 4; ++q) { gtot += pv4[q]; const bool take = dir ? (q > part) : (q < part); off += take ? pv4[q] : 0.f; }
        unsigned w[8];
#pragma unroll
        for (int j = 0; j < 16; j += 2) {
            const float k0 = (1.f - __builtin_amdgcn_exp2f(lfv[j])) * __builtin_amdgcn_exp2f(gtot - (c[j] + off));
            const float k1 = (1.f - __builtin_amdgcn_exp2f(lfv[j + 1])) * __builtin_amdgcn_exp2f(gtot - (c[j + 1] + off));
            w[j >> 1] = cvt_pk_bf16(k0, k1);
        }
        LAS unsigned char* kp = KsT + p * 16384;
        *(LAS u32x4*)(kp + sw64(k, 2 * part)) = (u32x4){w[0], w[1], w[2], w[3]};
        *(LAS u32x4*)(kp + sw64(k, 2 * part + 1)) = (u32x4){w[4], w[5], w[6], w[7]};
        if (part == 0) dec[p * 128 + k] = __builtin_amdgcn_exp2f(gtot);
        if (ck >= 4) {
#pragma unroll
            for (int kt = 0; kt < 2; ++kt)
#pragma unroll
                for (int g = 0; g < 4; ++g)
                    *(LAS unsigned*)(stage + sw64(32 * vt + r32, 4 * kh + 2 * kt + (g >> 1)) + 8 * (g & 1) + 4 * hi) = pk4_fp8(S[kt][4 * g], S[kt][4 * g + 1], S[kt][4 * g + 2], S[kt][4 * g + 3]);
        }
        HG_LBAR();
        if (ck >= 4) {
            unsigned char* sp = (unsigned char*)ST + (size_t)b * (8u << 20) + ((size_t)((h * 2 + dir) * 32 + (ck - 4))) * 16384;
            const int row = tid >> 2, q4 = tid & 3;
            u32x4 cv[2];
#pragma unroll
            for (int c = 0; c < 2; ++c) cv[c] = *(const LAS u32x4*)(stage + sw64(row, 2 * q4 + c));
#pragma unroll
            for (int c = 0; c < 2; ++c) *(u32x4*)(sp + row * 128 + (2 * q4 + c) * 16) = cv[c];
        }
        {
            bf16x8 af[2][4]; f32x4 dc[2][4];
#pragma unroll
            for (int kt = 0; kt < 2; ++kt) {
                const int krow = 32 * (2 * kh + kt);
#pragma unroll
                for (int g = 0; g < 4; ++g) dc[kt][g] = *(const LAS f32x4*)(dec + p * 128 + krow + 8 * g + 4 * hi);
#pragma unroll
                for (int s2 = 0; s2 < 4; ++s2) af[kt][s2] = *(const LAS bf16x8*)(kp + sw64(krow + r32, 2 * s2 + hi));
            }
#pragma unroll
            for (int kt = 0; kt < 2; ++kt) {
#pragma unroll
                for (int g = 0; g < 4; ++g) { S[kt][4 * g] *= dc[kt][g].x; S[kt][4 * g + 1] *= dc[kt][g].y; S[kt][4 * g + 2] *= dc[kt][g].z; S[kt][4 * g + 3] *= dc[kt][g].w; }
#pragma unroll
                for (int s2 = 0; s2 < 4; ++s2) S[kt] = __builtin_amdgcn_mfma_f32_32x32x16_bf16(af[kt][s2], bcur[s2], S[kt], 0, 0, 0);
            }
        }
    }
    if (qctr != nullptr && wv == 0 && lane == 0) ((volatile LAS unsigned*)(lds + LDSCTL_OFF))[16] = tk;
    HG_BAR();
}

struct OutPre { u32x4 sraw[2][2], vraw[2]; unsigned fa[8], fb[8], fq[8]; };
__device__ __forceinline__ void out_load(OutPre& P, int b, int h, int lc, const int wv) {
    unsigned char* wsb_ = kargs()->ws; const bf16_t* Y = (const bf16_t*)(wsb_ + WS_Y); const unsigned short* LF = (const unsigned short*)(wsb_ + WS_LF);
    const int tid = wv * 64 + lane_id();
    const int key0 = CTX + 64 * lc;
    const size_t tok0 = (size_t)b * SEQ + 64 * lc;
    { const bf16_t* ST = (const bf16_t*)(wsb_ + WS_ST); const bf16_t* HVT = (const bf16_t*)(wsb_ + WS_HVT);
      const int schunk = tid & 7, srow = tid >> 3;
#pragma unroll
      for (int dir = 0; dir < 2; ++dir) {
          const unsigned char* stp = (const unsigned char*)ST + (size_t)b * (8u << 20) + ((size_t)((h * 2 + dir) * 32 + lc)) * 16384;
#pragma unroll
          for (int i = 0; i < 2; ++i) P.sraw[dir][i] = __builtin_nontemporal_load((const u32x4*)(stp + (size_t)(srow + 64 * i) * 128 + 16 * schunk));
      }
      const bf16_t* vtp = HVT + ((size_t)(b * 4 + h) * 128) * KV + key0;
#pragma unroll
      for (int i = 0; i < 2; ++i) P.vraw[i] = *(const u32x4*)(vtp + (size_t)((tid >> 3) + 64 * i) * KV + 8 * (tid & 7)); }
    const int kp2 = tid & 63, part8 = tid >> 6;
    const unsigned short* pf = LF + ((size_t)(0 * 8 + b) * KV + key0 + 8 * part8) * 512 + h * 128 + 2 * kp2;
    const unsigned short* pb = LF + ((size_t)(1 * 8 + b) * KV + key0 + 8 * part8) * 512 + h * 128 + 2 * kp2;
    const bf16_t* pq = Y + (tok0 + 8 * part8) * 1024 + 512 + h * 128 + 2 * kp2;
#pragma unroll
    for (int j = 0; j < 8; ++j) { P.fa[j] = *(const unsigned*)(pf + (size_t)j * 512); P.fb[j] = *(const unsigned*)(pb + (size_t)j * 512); P.fq[j] = *(const unsigned*)(pq + (size_t)j * 1024); }
}
__device__ __forceinline__ void out_settle(OutPre& P) {
#pragma unroll
    for (int d = 0; d < 2; ++d)
#pragma unroll
        for (int i = 0; i < 2; ++i) asm volatile("" : "+v"(P.sraw[d][i]));
    asm volatile("" : "+v"(P.vraw[0]), "+v"(P.vraw[1]));
#pragma unroll
    for (int j = 0; j < 8; ++j) asm volatile("" : "+v"(P.fa[j]), "+v"(P.fb[j]), "+v"(P.fq[j]));
}
__device__ __forceinline__ void out_unit(int b, int h, int lc, LAS unsigned char* lds, const int wv,
                                         OutPre& P, const bool pre_valid, const unsigned acq_mask, const int qoff, int& nidx, bool& npre, const bool dry = false, unsigned* qctr = nullptr) {
    const int lane = lane_id(), tid = wv * 64 + lane, r32 = lane & 31, hi = lane >> 5;
    const int wid = wv;
    const int tb = wid & 1, vt = wid >> 1;
    LAS unsigned char* STx = lds + 65536;
    LAS unsigned char* VTt = lds + 131072;
    LAS float* ptot = (LAS float*)(lds + 147456);
    LAS float* ssx = (LAS float*)(lds + 147456 + 8192);
    const size_t tok0 = (size_t)b * SEQ + 64 * lc;
    const int trow = 32 * tb + r32;
    const int schunk = tid & 15, srow = tid >> 4;
    if (!pre_valid) { out_load(P, b, h, lc, wv); asm volatile("s_waitcnt vmcnt(0)" ::: "memory"); out_settle(P); }
    unsigned tk;
    if (qctr != nullptr && wv == 0 && lane == 0) ticket_draw(qctr, tk);
    const int kp2 = tid & 63, part8 = tid >> 6;
    float lff[8][2], lfbw[8][2], qv[8][2];
#pragma unroll
    for (int j = 0; j < 8; ++j) {
        const unsigned a = P.fa[j], c2 = P.fb[j], d = P.fq[j];
        lff[j][0] = h2f((unsigned short)(a & 0xffffu)); lff[j][1] = h2f((unsigned short)(a >> 16));
        lfbw[j][0] = h2f((unsigned short)(c2 & 0xffffu)); lfbw[j][1] = h2f((unsigned short)(c2 >> 16));
        qv[j][0] = bflo(d); qv[j][1] = bfhi(d);
    }
    float cf[8][2], cb[8][2];
#pragma unroll
    for (int e = 0; e < 2; ++e) {
        float a = 0.f;
#pragma unroll
        for (int j = 0; j < 8; ++j) { a += lff[j][e]; cf[j][e] = a; }
        a = 0.f;
#pragma unroll
        for (int j = 7; j >= 0; --j) { a += lfbw[j][e]; cb[j][e] = a; }
    }
    *(LAS f32x2*)(ptot + (0 * 8 + part8) * 128 + 2 * kp2) = (f32x2){cf[7][0], cf[7][1]};
    *(LAS f32x2*)(ptot + (1 * 8 + part8) * 128 + 2 * kp2) = (f32x2){cb[0][0], cb[0][1]};
    HG_LBAR();
    f32x2 offf = {0.f, 0.f}, offb = {0.f, 0.f}, Rf = {0.f, 0.f}, Rb = {0.f, 0.f};
#pragma unroll
    for (int q = 0; q < 8; ++q) {
        const f32x2 pfq = *(const LAS f32x2*)(ptot + (0 * 8 + q) * 128 + 2 * kp2), pbq = *(const LAS f32x2*)(ptot + (1 * 8 + q) * 128 + 2 * kp2);
        if (q < 4) Rf += pfq; else Rb += pbq;
        offf += (q < part8) ? pfq : (f32x2){0.f, 0.f};
        offb += (q > part8) ? pbq : (f32x2){0.f, 0.f};
    }
#pragma unroll
    for (int j = 0; j < 8; ++j) {
        const int i = 8 * part8 + j;
        float v[4][2];
#pragma unroll
        for (int e = 0; e < 2; ++e) {
            const float gf = cf[j][e] + (e ? offf.y : offf.x), gb = cb[j][e] + (e ? offb.y : offb.x);
            const float kf = 1.f - __builtin_amdgcn_exp2f(lff[j][e]), kb = 1.f - __builtin_amdgcn_exp2f(lfbw[j][e]);
            const float df = fminf(fmaxf(gf - (e ? Rf.y : Rf.x), -100.f), 100.f), db = fminf(fmaxf(gb - (e ? Rb.y : Rb.x), -100.f), 100.f);
            const float q = qv[j][e];
            const float e1 = __builtin_amdgcn_exp2f(df), e2 = __builtin_amdgcn_exp2f(db);
            v[0][e] = q * e1; v[1][e] = kf * __builtin_amdgcn_rcpf(e1);
            v[2][e] = q * e2; v[3][e] = kb * __builtin_amdgcn_rcpf(e2);
        }
        const int o = sw128(i, kp2 >> 2) + (kp2 & 3) * 4;
#pragma unroll
        for (int mtx = 0; mtx < 4; ++mtx) *(LAS unsigned*)(lds + mtx * 16384 + o) = cvt_pk_bf16(v[mtx][0], v[mtx][1]);
    }
    {
    const int sch8 = tid & 7, srw8 = tid >> 3;
#pragma unroll
    for (int dir = 0; dir < 2; ++dir) {
        f32x4 r4[4];
#pragma unroll
        for (int j4 = 0; j4 < 4; ++j4) r4[j4] = (f32x4){0.f, 0.f, 0.f, 0.f};
#pragma unroll
        for (int q = 0; q < 4; ++q) { const LAS float* pp = ptot + (dir * 8 + 4 * dir + q) * 128 + 16 * sch8;
#pragma unroll
            for (int j4 = 0; j4 < 4; ++j4) r4[j4] += *(const LAS f32x4*)(pp + 4 * j4); }
        float er[16];
#pragma unroll
        for (int j4 = 0; j4 < 4; ++j4) { er[4 * j4] = __builtin_amdgcn_exp2f(r4[j4].x); er[4 * j4 + 1] = __builtin_amdgcn_exp2f(r4[j4].y); er[4 * j4 + 2] = __builtin_amdgcn_exp2f(r4[j4].z); er[4 * j4 + 3] = __builtin_amdgcn_exp2f(r4[j4].w); }
#pragma unroll
        for (int i = 0; i < 2; ++i) {
            const u32x4 r = P.sraw[dir][i];
            const f32x2 a0 = __builtin_amdgcn_cvt_pk_f32_fp8((int)r.x, false), a1 = __builtin_amdgcn_cvt_pk_f32_fp8((int)r.x, true), a2 = __builtin_amdgcn_cvt_pk_f32_fp8((int)r.y, false), a3 = __builtin_amdgcn_cvt_pk_f32_fp8((int)r.y, true);
            const f32x2 a4 = __builtin_amdgcn_cvt_pk_f32_fp8((int)r.z, false), a5 = __builtin_amdgcn_cvt_pk_f32_fp8((int)r.z, true), a6 = __builtin_amdgcn_cvt_pk_f32_fp8((int)r.w, false), a7 = __builtin_amdgcn_cvt_pk_f32_fp8((int)r.w, true);
            u32x4 w0, w1;
            w0.x = cvt_pk_bf16(a0.x * er[0], a0.y * er[1]); w0.y = cvt_pk_bf16(a1.x * er[2], a1.y * er[3]); w0.z = cvt_pk_bf16(a2.x * er[4], a2.y * er[5]); w0.w = cvt_pk_bf16(a3.x * er[6], a3.y * er[7]);
            w1.x = cvt_pk_bf16(a4.x * er[8], a4.y * er[9]); w1.y = cvt_pk_bf16(a5.x * er[10], a5.y * er[11]); w1.z = cvt_pk_bf16(a6.x * er[12], a6.y * er[13]); w1.w = cvt_pk_bf16(a7.x * er[14], a7.y * er[15]);
            *(LAS u32x4*)(STx + dir * 32768 + sw128(srw8 + 64 * i, 2 * sch8)) = w0;
            *(LAS u32x4*)(STx + dir * 32768 + sw128(srw8 + 64 * i, 2 * sch8 + 1)) = w1;
        }
    }
    }
#pragma unroll
    for (int i = 0; i < 2; ++i) *(LAS u32x4*)(VTt + sw64((tid >> 3) + 64 * i, tid & 7)) = P.vraw[i];
    if (qctr != nullptr && wv == 0 && lane == 0) { ticket_wait(tk); ((volatile LAS unsigned*)(lds + LDSCTL_OFF))[16] = tk; }
    HG_LBAR();
    u32x4 gbv[2];
#pragma unroll
    for (int i = 0; i < 2; ++i) gbv[i] = *(const u32x4*)((const bf16_t*)(kargs()->ws + WS_GB) + (tok0 + (tid >> 4) + 32 * i) * 512 + h * 128 + 8 * (tid & 15));
    nidx = -1; npre = false;
    if (qctr != nullptr) {
        nidx = (int)((volatile LAS unsigned*)(lds + LDSCTL_OFF))[16] + qoff;
        if (nidx >= 72 && nidx < 200) { const int nh = (nidx - 72) >> 5, nlc = (nidx - 72) & 31;
            if ((acq_mask >> nh) & 1u) { out_load(P, b, nh, nlc, wv); npre = true; } }
    }
    f32x16 o;
#pragma unroll
    for (int r = 0; r < 16; ++r) o[r] = 0.f;
    const int prow = pi32(r32), vrow = 32 * vt + r32;
    bf16x8 vd[2], vo[2];
#pragma unroll
    for (int s2 = 0; s2 < 2; ++s2) { vd[s2] = *(const LAS bf16x8*)(VTt + sw64(vrow, 4 * tb + 2 * s2 + hi)); vo[s2] = *(const LAS bf16x8*)(VTt + sw64(vrow, 4 * (1 - tb) + 2 * s2 + hi)); }
#pragma unroll
    for (int dir = 0; dir < 2; ++dir) {
        const LAS unsigned char* Qx = lds + (2 * dir + 0) * 16384; const LAS unsigned char* Kx = lds + (2 * dir + 1) * 16384; const LAS unsigned char* Sx = STx + dir * 32768;
        bf16x8 qf[8], kd[8], sf[8];
#pragma unroll
        for (int ks = 0; ks < 8; ++ks) { qf[ks] = *(const LAS bf16x8*)(Qx + sw128(trow, 2 * ks + hi)); kd[ks] = *(const LAS bf16x8*)(Kx + sw128(32 * tb + prow, 2 * ks + hi)); }
#pragma unroll
        for (int ks = 0; ks < 8; ++ks) sf[ks] = *(const LAS bf16x8*)(Sx + sw128(vrow, 2 * ks + hi));
        f32x16 at;
#pragma unroll
        for (int r = 0; r < 16; ++r) at[r] = 0.f;
#pragma unroll
        for (int ks = 0; ks < 8; ++ks) at = __builtin_amdgcn_mfma_f32_32x32x16_bf16(kd[ks], qf[ks], at, 0, 0, 0);
#pragma unroll
        for (int r = 0; r < 16; ++r) { const int sl = 16 * (r >> 3) + 8 * hi + (r & 7); const bool keep = dir ? (sl >= r32) : (sl <= r32); at[r] = keep ? at[r] : 0.f; }
#pragma unroll
        for (int s2 = 0; s2 < 2; ++s2) {
            const u32x4 pw = (u32x4){cvt_pk_bf16(at[8 * s2], at[8 * s2 + 1]), cvt_pk_bf16(at[8 * s2 + 2], at[8 * s2 + 3]), cvt_pk_bf16(at[8 * s2 + 4], at[8 * s2 + 5]), cvt_pk_bf16(at[8 * s2 + 6], at[8 * s2 + 7])};
            o = __builtin_amdgcn_mfma_f32_32x32x16_bf16(vd[s2], __builtin_bit_cast(bf16x8, pw), o, 0, 0, 0);
        }
        if (dir != tb) {
#pragma unroll
            for (int ks = 0; ks < 8; ++ks) kd[ks] = *(const LAS bf16x8*)(Kx + sw128(32 * (1 - tb) + prow, 2 * ks + hi));
#pragma unroll
            for (int r = 0; r < 16; ++r) at[r] = 0.f;
#pragma unroll
            for (int ks = 0; ks < 8; ++ks) at = __builtin_amdgcn_mfma_f32_32x32x16_bf16(kd[ks], qf[ks], at, 0, 0, 0);
#pragma unroll
            for (int s2 = 0; s2 < 2; ++s2) {
                const u32x4 pw = (u32x4){cvt_pk_bf16(at[8 * s2], at[8 * s2 + 1]), cvt_pk_bf16(at[8 * s2 + 2], at[8 * s2 + 3]), cvt_pk_bf16(at[8 * s2 + 4], at[8 * s2 + 5]), cvt_pk_bf16(at[8 * s2 + 6], at[8 * s2 + 7])};
                o = __builtin_amdgcn_mfma_f32_32x32x16_bf16(vo[s2], __builtin_bit_cast(bf16x8, pw), o, 0, 0, 0);
            }
        }
#pragma unroll
        for (int ks = 0; ks < 8; ++ks) o = __builtin_amdgcn_mfma_f32_32x32x16_bf16(sf[ks], qf[ks], o, 0, 0, 0);
    }
    float ss = 0.f;
#pragma unroll
    for (int r = 0; r < 16; ++r) ss += o[r] * o[r];
    ss += shfl_xor_l(ss, 32, lane);
    if (hi == 0) ssx[vt * 64 + trow] = ss;
    HG_LBAR();
    const float tot = ssx[trow] + ssx[64 + trow] + ssx[128 + trow] + ssx[192 + trow];
    const float rstd = rsqrtf(tot * (1.f / 128.f) + EPS);
    LAS float* og = (LAS float*)lds;
#pragma unroll
    for (int g = 0; g < 4; ++g) {
        const int v = 32 * vt + 8 * g + 4 * hi;
        const f32x4 gn = *(const LAS f32x4*)((const LAS float*)(lds + 156672) + v);
        *(LAS f32x4*)(og + trow * 132 + v) = (f32x4){o[4 * g] * rstd * gn.x, o[4 * g + 1] * rstd * gn.y, o[4 * g + 2] * rstd * gn.z, o[4 * g + 3] * rstd * gn.w};
    }
    HG_LBAR();
#pragma unroll
    for (int i = 0; i < 2; ++i) {
        const int row = (tid >> 4) + 32 * i, ch = tid & 15;
        const f32x4 a = *(const LAS f32x4*)(og + row * 132 + 8 * ch), c = *(const LAS f32x4*)(og + row * 132 + 8 * ch + 4);
        const u32x4 g4 = gbv[i];
        u32x4 w; w.x = cvt_pk_bf16(a.x * bflo(g4.x), a.y * bfhi(g4.x)); w.y = cvt_pk_bf16(a.z * bflo(g4.y), a.w * bfhi(g4.y));
        w.z = cvt_pk_bf16(c.x * bflo(g4.z), c.y * bfhi(g4.z)); w.w = cvt_pk_bf16(c.z * bflo(g4.w), c.w * bfhi(g4.w));
        if (!dry) *(u32x4*)((bf16_t*)(kargs()->ws + WS_Y) + (tok0 + row) * 1024 + 512 + h * 128 + 8 * ch) = w;
    }
    if (dry) asm volatile("s_waitcnt vmcnt(0)" ::: "memory"); else asm volatile("s_waitcnt vmcnt(2)" ::: "memory");
    if (npre) out_settle(P);
}
}
template <size_t OFFA, size_t OFFB> struct OutOrder {
    int G, c;
    __device__ __forceinline__ bool next(int i, pg8::Unit& u) const {
        const int L = i * G + c; if (L >= 256) return false;
        const char* wsb = (const char*)kargs()->ws; const char* A = wsb + OFFA; const char* Bt = wsb + OFFB;
        constexpr size_t TSTEP = (size_t)256 * DM * 2;
        const int xcd = L % 8, offp = L / 8; const int wgid = xcd * 32 + offp;
        u.pm = xcd * 8 + (wgid % 32) % 8; u.pn = (wgid % 32) / 8; u.a = A + (size_t)u.pm * TSTEP; u.b = Bt + (size_t)u.pn * TSTEP; u.ty = 0; u.aux = 0; return true;
    }
};
__device__ __forceinline__ f32x4 gm_guard(f32x4 g) { const float t = 8.67361738e-19f;
    g.x = (fabsf(g.x) < t) ? t : g.x; g.y = (fabsf(g.y) < t) ? t : g.y; g.z = (fabsf(g.z) < t) ? t : g.z; g.w = (fabsf(g.w) < t) ? t : g.w; return g; }
struct EpiP4 {
    __device__ __forceinline__ void operator()(const f32x4 (&acc)[2][2][4][2], const pg8::Unit& u, int wr, int wc, int fr, int fq, int lane) const {
        KArgsPtr ka = kargs(); unsigned char* wsb = ka->ws; const float* x = ka->in[0]; const float* gain1 = ka->in[4] + 1024;
        bf16_t* A1 = (bf16_t*)(wsb + WS_RA) + (size_t)(u.pm >> 3) * 2097152; float* SSQ1 = (float*)(wsb + WS_SSQ1); const float* mod = (const float*)(wsb + WS_MISC) + MI_MOD;
        const int b = u.pm >> 3;
        const int col0 = 256 * u.pn + 32 * wc + 8 * fq;
        f32x4 gt[2][2], gm[2][2];
#pragma unroll
        for (int bj = 0; bj < 2; ++bj)
#pragma unroll
            for (int n = 0; n < 2; ++n) { const int c = col0 + 128 * bj + 4 * n;
                gt[bj][n] = *(const f32x4*)(mod + (0 * 9 + b) * 3072 + 2048 + c);
                gm[bj][n] = gm_guard(*(const f32x4*)(gain1 + c) * (*(const f32x4*)(mod + (9 + b) * 3072 + 1024 + c) + 1.f)); }
        const float* xbase = x + ((size_t)u.pm * 256 + 64 * wr + fr) * 1024 + col0;
        f32x4 xr[3][4];
#define P4_LDX(it) do { const float* xp_ = xbase + (size_t)(128 * ((it) >> 2) + 16 * ((it) & 3)) * 1024; \
            xr[(it) % 3][0] = __builtin_nontemporal_load((const f32x4*)(xp_)); xr[(it) % 3][1] = __builtin_nontemporal_load((const f32x4*)(xp_ + 4)); xr[(it) % 3][2] = __builtin_nontemporal_load((const f32x4*)(xp_ + 128)); xr[(it) % 3][3] = __builtin_nontemporal_load((const f32x4*)(xp_ + 132)); } while (0)
        P4_LDX(0); P4_LDX(1);
#pragma unroll
        for (int it = 0; it < 8; ++it) {
            if (it + 2 < 8) P4_LDX(it + 2);
            __builtin_amdgcn_sched_barrier(0);
            const int ai = it >> 2, m = it & 3;
            {
                const size_t row = (size_t)u.pm * 256 + 128 * ai + 64 * wr + 16 * m + fr;
                float ss = 0.f;
#pragma unroll
                for (int bj = 0; bj < 2; ++bj) {
                    const size_t o = row * 1024 + col0 + 128 * bj;
                    const f32x4 xa = xr[it % 3][2 * bj], xb = xr[it % 3][2 * bj + 1];
                    const f32x4 v0 = xa + gt[bj][0] * acc[ai][bj][m][0], v1 = xb + gt[bj][1] * acc[ai][bj][m][1];
                    ss += (v0.x * v0.x + v0.y * v0.y) + (v0.z * v0.z + v0.w * v0.w) + (v1.x * v1.x + v1.y * v1.y) + (v1.z * v1.z + v1.w * v1.w);
                    const f32x4 a0 = v0 * gm[bj][0], a1 = v1 * gm[bj][1];
                    u32x4 w; w.x = cvt_pk_bf16(a0.x, a0.y); w.y = cvt_pk_bf16(a0.z, a0.w); w.z = cvt_pk_bf16(a1.x, a1.y); w.w = cvt_pk_bf16(a1.z, a1.w);
                    *(u32x4*)(A1 + o) = w;
                }
                ss += __shfl_xor(ss, 16); ss += __shfl_xor(ss, 32);
                if (fq == 0) SSQ1[row * 16 + u.pn * 4 + wc] = ss;
            }
            __builtin_amdgcn_sched_barrier(0);
        }
#undef P4_LDX
    }
};
struct EpiP7 {
    __device__ __forceinline__ void operator()(const f32x4 (&acc)[2][2][4][2], const pg8::Unit& u, int wr, int wc, int fr, int fq, int lane) const {
        KArgsPtr ka = kargs(); float* outp = ka->out; const bf16_t* x1b = (const bf16_t*)(ka->ws + WS_RA) + (size_t)(u.pm >> 3) * 2097152; const float* mod = (const float*)(ka->ws + WS_MISC) + MI_MOD; const float* gain1 = ka->in[4] + 1024;
        const int b = u.pm >> 3;
        const int col0 = 256 * u.pn + 32 * wc + 8 * fq;
        f32x4 gt[2][2], rg[2][2];
#pragma unroll
        for (int bj = 0; bj < 2; ++bj)
#pragma unroll
            for (int n = 0; n < 2; ++n) { const int c = col0 + 128 * bj + 4 * n; gt[bj][n] = *(const f32x4*)(mod + (9 + b) * 3072 + 2048 + c);
                const f32x4 gm = gm_guard(*(const f32x4*)(gain1 + c) * (*(const f32x4*)(mod + (9 + b) * 3072 + 1024 + c) + 1.f)); rg[bj][n] = (f32x4){1.f / gm.x, 1.f / gm.y, 1.f / gm.z, 1.f / gm.w}; }
        u32x4 xq[8][2];
#pragma unroll
        for (int it = 0; it < 8; ++it)
#pragma unroll
            for (int bj = 0; bj < 2; ++bj) xq[it][bj] = __builtin_nontemporal_load((const u32x4*)(x1b + ((size_t)u.pm * 256 + 128 * (it >> 2) + 64 * wr + 16 * (it & 3) + fr) * 1024 + col0 + 128 * bj));
        __builtin_amdgcn_sched_barrier(0);
#pragma unroll
        for (int ai = 0; ai < 2; ++ai)
#pragma unroll
            for (int m = 0; m < 4; ++m) {
                const size_t row = (size_t)u.pm * 256 + 128 * ai + 64 * wr + 16 * m + fr;
#pragma unroll
                for (int bj = 0; bj < 2; ++bj) {
                    const size_t o = row * 1024 + col0 + 128 * bj;
                    const u32x4 xw = xq[ai * 4 + m][bj];
                    const f32x4 xa = (f32x4){bflo(xw.x), bfhi(xw.x), bflo(xw.y), bfhi(xw.y)}, xb = (f32x4){bflo(xw.z), bfhi(xw.z), bflo(xw.w), bfhi(xw.w)};
                    *(f32x4*)(outp + o) = xa * rg[bj][0] + gt[bj][0] * acc[ai][bj][m][0]; *(f32x4*)(outp + o + 4) = xb * rg[bj][1] + gt[bj][1] * acc[ai][bj][m][1];
                }
            }
    }
};

struct P5Order {
    int G, c;
    __device__ __forceinline__ bool next(int i, pg8::Unit& u) const {
        const int L = i * G + c; if (L >= 768) return false;
        const char* wsb = (const char*)kargs()->ws; const char* A1 = wsb + WS_A1; const char* Wt1 = wsb + WS_WT1;
        constexpr size_t TSTEP = (size_t)256 * DM * 2;
        const int xcd = L % 8, offp = L / 8; const int wgid = xcd * 96 + offp;
        u.pm = xcd * 8 + (wgid % 96) % 8; u.pn = (wgid % 96) / 8; u.a = A1 + (size_t)u.pm * TSTEP + (size_t)(u.pm >> 3) * (4u << 20); u.b = Wt1 + (size_t)u.pn * TSTEP; u.ty = 0; u.aux = 0; return true;
    }
};
struct P5HalfOrder {
    int G, c;
    __device__ __forceinline__ bool next(int i, pg8::Unit& u) const {
        const int L = i * G + c; if (L >= 256) return false;
        const char* wsb = (const char*)kargs()->ws; const char* A1 = wsb + WS_A1; const char* Wt1 = wsb + WS_WT1;
        constexpr size_t TSTEP = (size_t)256 * DM * 2;
        const int xcd = L % 8, j = L / 8; u.pn = xcd * 16 + j / 2; u.pm = j % 2;
        u.a = Wt1 + (size_t)(12 + u.pm) * TSTEP; u.b = A1 + (size_t)u.pn * (TSTEP / 2) + (size_t)(u.pn >> 4) * (4u << 20); u.ty = 1; u.aux = 0; return true;
    }
};
__device__ __forceinline__ float gelu_as(float v) {
    const float av = fabsf(v), t = __builtin_amdgcn_rcpf(av * 0.2316418882f + 1.0f);
    float q = t * 0.5307027145f + (-0.7265760135f); q = q * t + 0.7107068705f; q = q * t + (-0.142248368f); q = q * t + 0.127414796f; q = q * t;
    const float e = __builtin_amdgcn_exp2f((v * v) * (-0.72134752044f));
    return fmaf(-av, q * e, fmaxf(v, 0.f));
}
__device__ __forceinline__ float rstd16(const float* SSQ1, size_t row) {
    const f32x4* p = (const f32x4*)(SSQ1 + row * 16);
    const f32x4 a = p[0], b = p[1], c = p[2], d = p[3];
    const float s = ((a.x + a.y) + (a.z + a.w)) + ((b.x + b.y) + (b.z + b.w)) + ((c.x + c.y) + (c.z + c.w)) + ((d.x + d.y) + (d.z + d.w));
    return rsqrtf(s * (1.f / 1024.f) + EPS);
}
struct EpiP5 {
    const LAS float* rst; int tpm;
    __device__ __forceinline__ void operator()(const f32x4 (&acc)[2][2][4][2], const pg8::Unit& u, int wr, int wc, int fr, int fq, int lane) const {
        unsigned char* wsb = kargs()->ws; bf16_t* UG = (bf16_t*)(wsb + WS_UG); bf16_t* GVT = (bf16_t*)(wsb + WS_GVT); float* GVSSQ = (float*)(wsb + WS_GVSSQ);
        const float* ssq1 = (const float*)(wsb + WS_SSQ1); const float* bias1 = (const float*)(wsb + WS_MISC) + MI_BIAS1;
        if (u.ty == 0) {
            const int b = u.pm >> 3;
            const int kind = u.pn >> 2, pq = u.pn & 3;
            const float* bp = bias1 + b * OIN + 256 * u.pn + 32 * wc + 8 * fq;
            const size_t boff = (kind == 0) ? WS_UG : (kind == 1) ? WS_BG : WS_CH + (size_t)b * (2 * L1X_CH);
            bf16_t* base = (bf16_t*)(wsb + boff) + 128 * pq + 32 * wc + 8 * fq;
#pragma unroll
            for (int ai = 0; ai < 2; ++ai)
#pragma unroll
                for (int m = 0; m < 4; ++m) {
                    const size_t row = (size_t)u.pm * 256 + 128 * ai + 64 * wr + 16 * m + fr;
                    float rs = (u.pm == tpm) ? rst[128 * ai + 64 * wr + 16 * m + fr] : rstd16(ssq1, row); asm volatile("" : "+v"(rs));
                    f32x4 b00, b01, b10, b11;
                    if (u.pm == tpm) { const LAS float* bl = rst + 384 + 256 * u.pn + 32 * wc + 8 * fq; b00 = *(const LAS f32x4*)(bl); b01 = *(const LAS f32x4*)(bl + 4); b10 = *(const LAS f32x4*)(bl + 128); b11 = *(const LAS f32x4*)(bl + 132); }
                    else { b00 = *(const f32x4*)(bp); b01 = *(const f32x4*)(bp + 4); b10 = *(const f32x4*)(bp + 128); b11 = *(const f32x4*)(bp + 132); }
                    const f32x4 p0 = acc[ai][0][m][0] * rs + b00, p1 = acc[ai][0][m][1] * rs + b01, q0 = acc[ai][1][m][0] * rs + b10, q1 = acc[ai][1][m][1] * rs + b11;
                    float o[8];
#pragma unroll
                    for (int j = 0; j < 4; ++j) {
                        if (kind == 0) { o[j] = gelu_as(p0[j]) * silu_fast(q0[j]); o[4 + j] = gelu_as(p1[j]) * silu_fast(q1[j]); }
                        else if (kind == 1) { o[j] = p0[j] * silu_fast(q0[j]); o[4 + j] = p1[j] * silu_fast(q1[j]); }
                        else { o[j] = p0[j] * q0[j]; o[4 + j] = p1[j] * q1[j]; }
                    }
                    u32x4 w; w.x = cvt_pk_bf16(o[0], o[1]); w.y = cvt_pk_bf16(o[2], o[3]); w.z = cvt_pk_bf16(o[4], o[5]); w.w = cvt_pk_bf16(o[6], o[7]);
                    *(u32x4*)(base + row * 512) = w;
                    __builtin_amdgcn_sched_barrier(0);
                }
        }
    }
};
struct EpiP5H {
    const LAS float* rsth; int tpn, tpmh;
    __device__ __forceinline__ void operator()(const f32x4 (&acc)[2][2][4][2], const pg8::Unit& u, int wr, int wc, int fr, int fq, int lane) const {
        unsigned char* wsb = kargs()->ws; bf16_t* GVT = (bf16_t*)(wsb + WS_GVT); float* GVSSQ = (float*)(wsb + WS_GVSSQ);
        const float* ssq1 = (const float*)(wsb + WS_SSQ1); const float* bias1 = (const float*)(wsb + WS_MISC) + MI_BIAS1;
        {
            const int b = u.pn >> 4;
            { constexpr int bj = 0;
                int opq = 0; asm volatile("" : "+s"(opq));
                const size_t tokc = (size_t)u.pn * 128 + 32 * wc + 8 * fq + opq;
                float rs[8], gs[8];
                if (u.pn == tpn) {
#pragma unroll
                    for (int e = 0; e < 8; ++e) { rs[e] = rsth[32 * wc + 8 * fq + e]; gs[e] = 0.f; }
                } else {
#pragma unroll
                for (int e = 0; e < 8; ++e) { rs[e] = rstd16(ssq1, tokc + e); gs[e] = 0.f; asm volatile("" : "+v"(rs[e])); __builtin_amdgcn_sched_barrier(0); }
                }
#pragma unroll
                for (int ai = 0; ai < 2; ++ai)
#pragma unroll
                    for (int m = 0; m < 4; ++m) {
                        const int f = u.pm * 256 + 128 * ai + 64 * wr + 16 * m + fr + opq;
                        const float bias = (u.pn == tpn && u.pm == tpmh) ? rsth[128 + 3072 + 128 * ai + 64 * wr + 16 * m + fr] : bias1[b * OIN + 3072 + f];
                        bf16_t* rowp = GVT + (size_t)b * L1X_GVT + ((size_t)(b * 4 + (f >> 7)) * 128 + (f & 127)) * GVP + (u.pn & 15) * 128 + 32 * wc + 8 * fq;
                        float o[8];
#pragma unroll
                        for (int n = 0; n < 2; ++n)
#pragma unroll
                            for (int j = 0; j < 4; ++j) { const float gv = gelu_as(acc[ai][bj][m][n][j] * rs[4 * n + j] + bias); o[4 * n + j] = gv; gs[4 * n + j] += gv * gv; }
                        u32x4 w; w.x = cvt_pk_bf16(o[0], o[1]); w.y = cvt_pk_bf16(o[2], o[3]); w.z = cvt_pk_bf16(o[4], o[5]); w.w = cvt_pk_bf16(o[6], o[7]);
                        *(u32x4*)(rowp) = w;
                        __builtin_amdgcn_sched_barrier(0);
                    }
#pragma unroll
                for (int e = 0; e < 8; ++e) {
                    float s = gs[e];
                    s += __shfl_xor(s, 1); s += __shfl_xor(s, 2); s += __shfl_xor(s, 4); s += __shfl_xor(s, 8);
                    if (fr == 0) GVSSQ[(size_t)b * L1X_SSQ + (tokc + e) * 4 + u.pm * 2 + wr] = s;
                    __builtin_amdgcn_sched_barrier(0);
                }
            }
        }
    }
};

__device__ __forceinline__ int gsw(int r, int c) { return r * 256 + ((c ^ (r & 15)) << 4); }
struct GmlpRegs { u32x4 ta[4], tw[4], tu[4]; f32x4 ssq; };
__device__ __forceinline__ void gmlp_load(GmlpRegs& R, int b, int ch, int g, const bf16_t* GVT, const float* GVSSQ, const bf16_t* Wsb, const bf16_t* UG, const int wv) {
    const int lane = lane_id(), tid = wv * 64 + lane;
    const size_t tokc = (size_t)b * SEQ + ch * 128;
    const int chunk = tid & 15, rb = tid >> 4;
#pragma unroll
    for (int i = 0; i < 4; ++i) { const int row = rb + 32 * i;
        R.ta[i] = __builtin_nontemporal_load((const u32x4*)(GVT + (size_t)b * L1X_GVT + ((size_t)(b * 4 + g) * 128 + row) * GVP + ch * 128 + 8 * chunk));
        R.tw[i] = *(const u32x4*)(Wsb + ((size_t)g * 128 + row) * 128 + 8 * chunk);
        R.tu[i] = __builtin_nontemporal_load((const u32x4*)(UG + (tokc + row) * 512 + g * 128 + 8 * chunk)); }
    R.ssq = *(const f32x4*)(GVSSQ + (size_t)b * L1X_SSQ + (tokc + (tid & 127)) * 4);
}
__device__ __forceinline__ void gmlp_unit(const GmlpRegs& R, int b, int ch, int g, const float* v_g, const float* b_s, bf16_t* Y1, LAS unsigned char* lds, const int wv) {
    const int lane = lane_id(), tid = wv * 64 + lane, r32 = lane & 31, hi = lane >> 5;
    const int wid = wv;
    const int dt = wid & 3, th = wid >> 2;
    LAS unsigned char* At = lds; LAS unsigned char* Wt = lds + 32768; LAS unsigned char* Ut = lds + 65536;
    LAS float* rsd = (LAS float*)(lds + 98304);
    const size_t tokc = (size_t)b * SEQ + ch * 128;
    {
        const int chunk = tid & 15, rb = tid >> 4;
        if (tid < 128) { const f32x4 p = R.ssq; rsd[tid] = rsqrtf(((p.x + p.y) + (p.z + p.w)) * (1.f / 512.f) + EPS); }
#pragma unroll
        for (int i = 0; i < 4; ++i) { const int row = rb + 32 * i; *(LAS u32x4*)(At + gsw(row, chunk)) = R.ta[i]; *(LAS u32x4*)(Wt + gsw(row, chunk)) = R.tw[i]; *(LAS u32x4*)(Ut + gsw(row, chunk)) = R.tu[i]; }
    }
    float bsf[2]; f32x4 vgf[4];
#pragma unroll
    for (int tt = 0; tt < 2; ++tt) bsf[tt] = b_s[g * 128 + 32 * (2 * th + tt) + r32];
#pragma unroll
    for (int q = 0; q < 4; ++q) vgf[q] = *(const f32x4*)(v_g + g * 128 + 32 * dt + 8 * q + 4 * hi);
    asm volatile("s_waitcnt lgkmcnt(0)\n\ts_barrier" ::: "memory");
    f32x16 acc[2];
#pragma unroll
    for (int i = 0; i < 2; ++i)
#pragma unroll
        for (int r = 0; r < 16; ++r) acc[i][r] = 0.f;
    bf16x8 af[8]; u32x4 wf[2][8];
#pragma unroll
    for (int ks = 0; ks < 8; ++ks) { af[ks] = *(const LAS bf16x8*)(At + gsw(32 * dt + r32, 2 * ks + hi));
#pragma unroll
        for (int tt = 0; tt < 2; ++tt) wf[tt][ks] = *(const LAS u32x4*)(Wt + gsw(32 * (2 * th + tt) + r32, 2 * ks + hi)); }
#pragma unroll
    for (int ks = 0; ks < 8; ++ks) {
        const f32x4 r0 = *(const LAS f32x4*)(rsd + 16 * ks + 8 * hi), r1 = *(const LAS f32x4*)(rsd + 16 * ks + 8 * hi + 4);
#pragma unroll
        for (int tt = 0; tt < 2; ++tt) {
            const u32x4 wv4 = wf[tt][ks];
            u32x4 ws2;
            ws2.x = cvt_pk_bf16(bflo(wv4.x) * r0.x, bfhi(wv4.x) * r0.y); ws2.y = cvt_pk_bf16(bflo(wv4.y) * r0.z, bfhi(wv4.y) * r0.w);
            ws2.z = cvt_pk_bf16(bflo(wv4.z) * r1.x, bfhi(wv4.z) * r1.y); ws2.w = cvt_pk_bf16(bflo(wv4.w) * r1.z, bfhi(wv4.w) * r1.w);
            acc[tt] = __builtin_amdgcn_mfma_f32_32x32x16_bf16(af[ks], __builtin_bit_cast(bf16x8, ws2), acc[tt], 0, 0, 0);
        }
    }
#pragma unroll
    for (int tt = 0; tt < 2; ++tt) {
        const int t = 32 * (2 * th + tt) + r32;
        const float bs = bsf[tt];
#pragma unroll
        for (int q = 0; q < 4; ++q) {
            LAS u32x2* up = (LAS u32x2*)(Ut + gsw(t, 4 * dt + q) + 8 * hi);
            const f32x4 vg = vgf[q];
            const u32x2 ug = *up;
            u32x2 w;
            w.x = cvt_pk_bf16(bflo(ug.x) * (vg.x * acc[tt][4 * q] + bs), bfhi(ug.x) * (vg.y * acc[tt][4 * q + 1] + bs));
            w.y = cvt_pk_bf16(bflo(ug.y) * (vg.z * acc[tt][4 * q + 2] + bs), bfhi(ug.y) * (vg.w * acc[tt][4 * q + 3] + bs));
            *up = w;
        }
    }
    asm volatile("s_waitcnt lgkmcnt(0)\n\ts_barrier" ::: "memory");
    {
        const int chunk = tid & 15, rb = tid >> 4;
#pragma unroll
        for (int i = 0; i < 4; ++i) { const int row = rb + 32 * i; *(u32x4*)(Y1 + (tokc + row) * 1024 + g * 128 + 8 * chunk) = *(const LAS u32x4*)(Ut + gsw(row, chunk)); }
    }
    asm volatile("s_waitcnt lgkmcnt(0)\n\ts_barrier" ::: "memory");
}
struct ConvRegs { u32x4 chv[10], bgv[8]; };
__device__ __forceinline__ void conv_load(ConvRegs& R, int row0, const bf16_t* BG, const bf16_t* CH, int lane) {
    const bool top = (row0 & 2047) == 0, bot = ((row0 + 7) & 2047) == 2047;
    CH += (size_t)(row0 >> 11) * L1X_CH;
    R.chv[0] = __builtin_nontemporal_load((const u32x4*)(CH + (size_t)(top ? row0 : row0 - 1) * 512 + 8 * lane));
#pragma unroll
    for (int i = 0; i < 8; ++i) { R.chv[i + 1] = __builtin_nontemporal_load((const u32x4*)(CH + (size_t)(row0 + i) * 512 + 8 * lane)); R.bgv[i] = __builtin_nontemporal_load((const u32x4*)(BG + (size_t)(row0 + i) * 512 + 8 * lane)); }
    R.chv[9] = __builtin_nontemporal_load((const u32x4*)(CH + (size_t)(bot ? row0 + 7 : row0 + 8) * 512 + 8 * lane));
}
__device__ __forceinline__ void conv_finish(const ConvRegs& R, int row0, const float* conv_w, bf16_t* Y1, int lane) {
    const bool top = (row0 & 2047) == 0, bot = ((row0 + 7) & 2047) == 2047;
    float w[3][8];
#pragma unroll
    for (int j = 0; j < 3; ++j) { const f32x4 a = *(const f32x4*)(conv_w + j * 512 + 8 * lane), bq = *(const f32x4*)(conv_w + j * 512 + 8 * lane + 4);
        w[j][0] = a.x; w[j][1] = a.y; w[j][2] = a.z; w[j][3] = a.w; w[j][4] = bq.x; w[j][5] = bq.y; w[j][6] = bq.z; w[j][7] = bq.w; }
#pragma unroll
    for (int i = 0; i < 8; ++i) {
        float o[8];
#pragma unroll
        for (int e = 0; e < 4; ++e) {
            const unsigned pw = (i == 0 && top) ? 0u : R.chv[i][e], cw = R.chv[i + 1][e], nw = (i == 7 && bot) ? 0u : R.chv[i + 2][e], bw = R.bgv[i][e];
            o[2 * e] = bflo(bw) * (w[0][2 * e] * bflo(pw) + w[1][2 * e] * bflo(cw) + w[2][2 * e] * bflo(nw));
            o[2 * e + 1] = bfhi(bw) * (w[0][2 * e + 1] * bfhi(pw) + w[1][2 * e + 1] * bfhi(cw) + w[2][2 * e + 1] * bfhi(nw));
        }
        u32x4 wv; wv.x = cvt_pk_bf16(o[0], o[1]); wv.y = cvt_pk_bf16(o[2], o[3]); wv.z = cvt_pk_bf16(o[4], o[5]); wv.w = cvt_pk_bf16(o[6], o[7]);
        *(u32x4*)(Y1 + (size_t)(row0 + i) * 1024 + 512 + 8 * lane) = wv;
    }
}
#ifndef DIAG
#define DIAG 0
#endif
constexpr int N_PHASES = 9;
#ifndef REP
#define REP -1
#endif
#ifndef NDRY
#define NDRY 1
#endif

__global__ void __launch_bounds__(NTHR, 2) mk_fwd(Args args) {
    extern __shared__ __attribute__((aligned(16))) unsigned char lds_raw[];
    Frame F;
#define FRAME_LOAD() do { KArgsPtr ka_ = kargs(); \
    F.lds = (LAS unsigned char*)lds_raw; F.MISC = (volatile LAS unsigned*)(F.lds + LDSCTL_OFF); \
    F.wave = wave0; F.lane = lane_id(); F.tid = wave0 * 64 + F.lane; \
    F.G = gridDim.x; { const int bx = blockIdx.x; F.vcu = (F.G % 8 == 0) ? (bx % 8) * (F.G / 8) + bx / 8 : bx; } \
    F.ws = ka_->ws; F.ctl = (unsigned*)(F.ws + WS_CTL); F.misc = (float*)(F.ws + WS_MISC); F.out = ka_->out; \
    F.x = ka_->in[0]; F.c = ka_->in[1]; F.ctx = ka_->in[2]; F.c_ctx = ka_->in[3]; F.norm_gain = ka_->in[4]; F.ada_w = ka_->in[5]; F.ada_b = ka_->in[6]; \
    F.even_w_in = ka_->in[7]; F.even_w_out = ka_->in[8]; F.qk_gain = ka_->in[9]; F.lam_p = ka_->in[10]; F.subln_g = ka_->in[11]; F.lb_logits = ka_->in[12]; F.hgrn_g = ka_->in[13]; \
    F.odd_w_in = ka_->in[14]; F.odd_w_out = ka_->in[15]; F.v_g = ka_->in[16]; F.w_s = ka_->in[17]; F.b_s = ka_->in[18]; F.conv_w = ka_->in[19]; } while (0)
    const int wave0 = __builtin_amdgcn_readfirstlane(threadIdx.x >> 6);
    FRAME_LOAD();
    for (int u = F.tid; u < (LDS_BYTES - LDSCTL_OFF) / 4; u += NTHR) ((LAS unsigned*)(F.lds + LDSCTL_OFF))[u] = 0u;
    __syncthreads();
    XcdBarrier bar = xcd_barrier_post(F.ctl + CW_BAR, F.MISC + 8, F.tid);
    if (F.tid == 0) __hip_atomic_store(F.ctl + CW_XCC + (int)blockIdx.x, xb_xcc_id() + 1u, __ATOMIC_RELAXED, __HIP_MEMORY_SCOPE_AGENT);
    bool light_ok = false;
    const int lo = args.ph_lo, hi = args.ph_hi;
#ifdef ONLYPH
#define IN(k) ((k) == ONLYPH && lo <= (k) && (k) < hi)
#else
#define IN(k) (lo <= (k) && (k) < hi)
#endif
#define BOTH(k) (IN(k) && IN((k) + 1))
#if DIAG == 10
#define STAMP(k) do { if (blockIdx.x == 0 && wave0 == 0 && lane_id() == 0) ((unsigned long long*)(kargs()->ws + WS_CTL + 900000))[k] = __builtin_amdgcn_s_memrealtime(); } while (0)
#else
#define STAMP(k) do {} while (0)
#endif
#define GRID_BAR() xcd_barrier(bar, wave0 * 64 + lane_id())
#define LIGHT_BAR(site) do { if (light_ok) group_barrier_light((unsigned*)(kargs()->ws + WS_CTL) + CW_GRP + 128 * ((site) * 8 + ((int)blockIdx.x & 7)), 32u, wave0 * 64 + lane_id()); else xcd_barrier(bar, wave0 * 64 + lane_id()); } while (0)
    unsigned char* ws;

    STAMP(0);
    if (IN(0)) { for (int rep = 0; rep < (REP == 0 ? 2 : 1); ++rep) { FRAME_LOAD(); p0_prologue(F); if (REP == 0 && rep == 0) GRID_BAR(); } STAMP(1); }
    if (IN(1)) {
        for (int rep = 0; rep < (REP == 1 ? 2 : 1); ++rep) { FRAME_LOAD(); p0b_phase(F); if (REP == 1 && rep == 0) GRID_BAR(); }
        if (BOTH(1)) {
            FRAME_LOAD();
            if (wave0 == 0) { unsigned sp = 0u;
                while (__hip_atomic_load(F.ctl + CW_W0, __ATOMIC_RELAXED, __HIP_MEMORY_SCOPE_AGENT) < 256u && ++sp < (1u << 22)) __builtin_amdgcn_s_sleep(2);
                __builtin_amdgcn_fence(__ATOMIC_ACQUIRE, "agent"); asm volatile("s_waitcnt vmcnt(0)" ::: "memory"); }
            { const int ln = lane_id(); bool bad = false;
#pragma unroll
              for (int q = 0; q < 4; ++q) { const int i = ln + 64 * q;
                  const unsigned a = (i < (int)gridDim.x) ? __hip_atomic_load(F.ctl + CW_XCC + i, __ATOMIC_RELAXED, __HIP_MEMORY_SCOPE_AGENT) : 1u;
                  const unsigned r = (i < (int)gridDim.x) ? __hip_atomic_load(F.ctl + CW_XCC + (i & 7), __ATOMIC_RELAXED, __HIP_MEMORY_SCOPE_AGENT) : 1u;
                  bad = bad || (a != r) || (a == 0u); }
              light_ok = ((int)gridDim.x == 256) && (__builtin_amdgcn_ballot_w64(bad) == 0ull); }
            LIGHT_BAR(4);
        }
        STAMP(2);
    }
    if (IN(2)) {
        FRAME_LOAD(); ws = F.ws;
        LAS float* tab = (LAS float*)(F.lds + 131072);
        { const float* miscp = (const float*)(ws + WS_MISC); const float* qkg = kargs()->in[9];
          float tv[6]; const float qg = qkg[F.tid & 127];
#pragma unroll
          for (int k = 0; k < 6; ++k) tv[k] = miscp[MI_CS + F.tid + 512 * k];
#pragma unroll
          for (int k = 0; k < 4; ++k) tab[F.tid + 512 * k] = tv[k];
          if (F.tid < 128) tab[2048 + F.tid] = qg;
          tab[2176 + F.tid] = tv[4]; tab[2176 + 512 + F.tid] = tv[5];
          __syncthreads(); }
        P1Order S{F.G, (int)blockIdx.x}; EpiP1 E{tab};
        for (int rep = 0; rep < (REP == 2 ? 2 : 1); ++rep) { pg8::gemm_phase<EpiP1, P1Order>(F.lds, DM, S, E, wave0); if (REP == 2 && rep == 0) GRID_BAR(); }
        if ((int)blockIdx.x >= 208) { FRAME_LOAD(); weight_copies(F, 1, ((int)blockIdx.x - 208) * NWAVES + F.wave, 48 * NWAVES, 0, 2304);
            asm volatile("s_waitcnt vmcnt(0)" ::: "memory"); __syncthreads();
            if (F.tid == 0) { __builtin_amdgcn_fence(__ATOMIC_RELEASE, "agent"); (void)__hip_atomic_fetch_add(F.ctl + CW_W1, 1u, __ATOMIC_RELAXED, __HIP_MEMORY_SCOPE_AGENT); } }
        if (BOTH(2)) LIGHT_BAR(3);
        STAMP(3);
    }
    if (IN(3)) {
        FRAME_LOAD(); ws = F.ws;
        const int g = blockIdx.x & 7;
        const float lam = __uint_as_float(__hip_atomic_load((unsigned*)(F.misc + MI_SCAL), __ATOMIC_RELAXED, __HIP_MEMORY_SCOPE_AGENT));
        const float M2 = __uint_as_float(__hip_atomic_load((unsigned*)(F.misc + MI_SCAL + 1), __ATOMIC_RELAXED, __HIP_MEMORY_SCOPE_AGENT));
        for (int rep = 0; rep < ((REP == 3 || REP == 30 || REP == 31) ? 2 : (REP == 32 ? 1 + NDRY : 1)); ++rep) {
        const bool dry = (REP == 3 || REP == 30 || REP == 31) ? (rep == 0) : (REP == 32 ? rep < NDRY : false);
        unsigned acq_mask = 0u;
        bool have = false;
        constexpr bool EARLY = (REP < 0 || REP == 32);
        int first_out = 200;
        const int QOFF = EARLY ? ((int)gridDim.x + 7 - g) / 8 : 0;
        bool first = EARLY;
        for (;;) {
            if (!have && !first) {
                if (wave0 == 0 && lane_id() == 0) ((volatile LAS unsigned*)((LAS unsigned char*)lds_raw + LDSCTL_OFF))[16] = __hip_atomic_fetch_add((unsigned*)(kargs()->ws + WS_CTL) + CW_QUEUE + 64 * (g + 8 * rep), 1u, __ATOMIC_RELAXED, __HIP_MEMORY_SCOPE_AGENT);
                __syncthreads();
            }
            const int idx = first ? ((int)blockIdx.x >> 3) : (int)((volatile LAS unsigned*)((LAS unsigned char*)lds_raw + LDSCTL_OFF))[16] + QOFF;
            if (!have && !first) __syncthreads();
            first = false;
            have = EARLY;
            unsigned* qc = EARLY ? (unsigned*)(kargs()->ws + WS_CTL) + CW_QUEUE + 64 * (g + 8 * rep) : nullptr;
            if (idx >= 72) { first_out = idx; break; }
            if (REP == 30 && rep == 0 && idx < 8) { have = false; continue; }
            if (REP == 32 && dry && idx < 72) { have = false; continue; }
            if (REP == 31 && rep == 0 && idx >= 8) break;
            if (idx < 8) {
                const int cch = g * 8 + idx;
                { unsigned char* w2 = kargs()->ws;
                  hg::state_chain(cch >> 3, (cch >> 1) & 3, cch & 1, (const unsigned short*)(w2 + WS_LF), (const bf16_t*)(w2 + WS_HVT), (bf16_t*)(w2 + WS_ST), (LAS unsigned char*)lds_raw, wave0, qc); }
                if (wave0 == 0 && lane_id() == 0) { __builtin_amdgcn_fence(__ATOMIC_RELEASE, "agent"); asm volatile("s_waitcnt vmcnt(0)" ::: "memory");
                    __hip_atomic_store((unsigned*)(kargs()->ws + WS_CTL) + CW_FLAG + 64 * cch + 16 * rep, 1u, __ATOMIC_RELAXED, __HIP_MEMORY_SCOPE_AGENT); }
            } else {
                const int j = idx - 8; const int pair = g * 4 + (j >> 4), qb = j & 15;
                KArgsPtr ka2 = kargs(); unsigned char* w2 = ka2->ws;
                att::attn_unit(pair >> 2, pair & 3, qb, (bf16_t*)(w2 + WS_Y), (const bf16_t*)(w2 + WS_KC), (const bf16_t*)(w2 + WS_VT), (const bf16_t*)(w2 + WS_GA), ka2->in[11], lam, M2, (LAS unsigned char*)lds_raw, wave0, dry, qc);
            }
        }
        if (first_out < 200 && !((REP == 30 || REP == 31) && rep == 0)) {
            unsigned* qc = EARLY ? (unsigned*)(kargs()->ws + WS_CTL) + CW_QUEUE + 64 * (g + 8 * rep) : nullptr;
            hg::OutPre P; bool pre = false; int cur = first_out;
            { unsigned z0 = 0u; asm volatile("" : "+v"(z0));
#pragma unroll
              for (int j0 = 0; j0 < 8; ++j0) { P.fa[j0] = z0; P.fb[j0] = z0; P.fq[j0] = z0; if (j0 < 4) P.sraw[j0 >> 1][j0 & 1] = (u32x4){z0, z0, z0, z0}; if (j0 < 2) P.vraw[j0] = (u32x4){z0, z0, z0, z0}; } }
            { const float* hg_g = kargs()->in[13]; if (wave0 < 2) ((LAS float*)((LAS unsigned char*)lds_raw + 156672))[wave0 * 64 + lane_id()] = hg_g[wave0 * 64 + lane_id()]; __syncthreads(); }
            for (;;) {
                const int j = cur - 72; const int hh = j >> 5, lc = j & 31;
                if (!((acq_mask >> hh) & 1u) && !(REP == 32 && dry)) {
                acq_mask |= 1u << hh;
                if (wave0 == 0) {
                    unsigned* f0 = (unsigned*)(kargs()->ws + WS_CTL) + CW_FLAG + 64 * (g * 8 + 2 * hh) + 16 * rep; unsigned sp = 0;
                    while ((__hip_atomic_load(f0, __ATOMIC_RELAXED, __HIP_MEMORY_SCOPE_AGENT) == 0u || __hip_atomic_load(f0 + 64, __ATOMIC_RELAXED, __HIP_MEMORY_SCOPE_AGENT) == 0u) && ++sp < (1u << 22)) __builtin_amdgcn_s_sleep(8);
                    __builtin_amdgcn_fence(__ATOMIC_ACQUIRE, "agent");
                    asm volatile("s_waitcnt vmcnt(0)" ::: "memory");
                }
                __syncthreads();
                }
                int nidx = -1; bool npre = false;
                hg::out_unit(g, hh, lc, (LAS unsigned char*)lds_raw, wave0, P, pre, acq_mask, QOFF, nidx, npre, dry, qc);
                if (!EARLY) {
                    if (wave0 == 0 && lane_id() == 0) ((volatile LAS unsigned*)((LAS unsigned char*)lds_raw + LDSCTL_OFF))[16] = __hip_atomic_fetch_add((unsigned*)(kargs()->ws + WS_CTL) + CW_QUEUE + 64 * (g + 8 * rep), 1u, __ATOMIC_RELAXED, __HIP_MEMORY_SCOPE_AGENT);
                    __syncthreads();
                    nidx = (int)((volatile LAS unsigned*)((LAS unsigned char*)lds_raw + LDSCTL_OFF))[16]; npre = false;
                    __syncthreads();
                }
                cur = nidx; pre = npre;
                if (cur >= 200) break;
            }
        }
        if (dry) GRID_BAR();
        }
        if (BOTH(3)) LIGHT_BAR(5);
        STAMP(4);
    }
    if (IN(5)) {
        FRAME_LOAD(); ws = F.ws;
        OutOrder<WS_Y, WS_WO0> S{F.G, (int)blockIdx.x}; EpiP4 E;
        for (int rep = 0; rep < (REP == 5 ? 2 : 1); ++rep) { pg8::gemm_phase<EpiP4, OutOrder<WS_Y, WS_WO0>>(F.lds, DM, S, E, wave0); if (REP == 5 && rep == 0) GRID_BAR(); }
        if (BOTH(5)) LIGHT_BAR(0);
        STAMP(6);
    }
    if (IN(6)) {
        FRAME_LOAD(); ws = F.ws;
        P5Order S{F.G, (int)blockIdx.x}; P5HalfOrder SH{F.G, (int)blockIdx.x};
        if (wave0 == 0) { unsigned sp = 0u;
            while ((__hip_atomic_load(F.ctl + CW_W1, __ATOMIC_RELAXED, __HIP_MEMORY_SCOPE_AGENT) < 48u || __hip_atomic_load(F.ctl + CW_B1, __ATOMIC_RELAXED, __HIP_MEMORY_SCOPE_AGENT) < 128u) && ++sp < (1u << 22)) __builtin_amdgcn_s_sleep(2);
            __builtin_amdgcn_fence(__ATOMIC_ACQUIRE, "agent"); asm volatile("s_waitcnt vmcnt(0)" ::: "memory"); }
        __syncthreads();
        LAS float* rst = (LAS float*)(F.lds + 131072);
        int tpm = -1, tpn = -1, tpmh = -1;
        { pg8::Unit u0; if (S.next(0, u0)) tpm = u0.pm; if (SH.next(0, u0)) { tpn = u0.pn; tpmh = u0.pm; }
          const float* ssq1 = (const float*)(ws + WS_SSQ1); const float* bias1 = (const float*)(ws + WS_MISC) + MI_BIAS1;
          const int r = F.tid; const bool full = r < 256; const int blk = full ? tpm : tpn; const int blkc = blk < 0 ? 0 : blk;
          const size_t row = full ? (size_t)blkc * 256 + r : (size_t)blkc * 128 + ((r - 256) & 127);
          const f32x4* pp = (const f32x4*)(ssq1 + row * 16); const f32x4 qa = pp[0], qb = pp[1], qc4 = pp[2], qd = pp[3];
          const int bb = (tpm < 0 ? 0 : tpm) >> 3, bh = (tpn < 0 ? 0 : tpn) >> 4, pmh = tpmh < 0 ? 0 : tpmh;
          float bv[6];
#pragma unroll
          for (int k = 0; k < 6; ++k) bv[k] = bias1[bb * OIN + F.tid + 512 * k];
          const float bhv = bias1[bh * OIN + 3072 + pmh * 256 + (F.tid & 255)];
          if (F.tid < 384 && blk >= 0) rst[r] = rsqrtf((((qa.x + qa.y) + (qa.z + qa.w)) + ((qb.x + qb.y) + (qb.z + qb.w)) + ((qc4.x + qc4.y) + (qc4.z + qc4.w)) + ((qd.x + qd.y) + (qd.z + qd.w))) * (1.f / 1024.f) + EPS);
#pragma unroll
          for (int k = 0; k < 6; ++k) rst[384 + F.tid + 512 * k] = bv[k];
          if (F.tid < 256) rst[384 + 3072 + F.tid] = bhv;
          __syncthreads(); }
        EpiP5 E{rst, tpm};
        for (int rep = 0; rep < (REP == 6 ? 2 : 1); ++rep) {
            pg8::gemm_phase<EpiP5, P5Order>(F.lds, DM, S, E, wave0);
            { EpiP5H EH{rst + 256, tpn, tpmh}; pg8::gemm_phase<EpiP5H, P5HalfOrder, true>(F.lds, DM, SH, EH, wave0); }
            if (REP == 6 && rep == 0) GRID_BAR(); }
        if (BOTH(6)) LIGHT_BAR(1);
        STAMP(7);
    }
    if (IN(7)) {
        FRAME_LOAD(); ws = F.ws;
        for (int rep = 0; rep < (REP == 7 ? 2 : 1); ++rep) {
        const int uA = (F.vcu >> 5) * 64 + (F.vcu & 31), uB = uA + 32;
        const int row0 = (F.vcu * NWAVES + F.wave) * 8;
        GmlpRegs GR; ConvRegs CR;
        gmlp_load(GR, uA >> 6, (uA >> 2) & 15, uA & 3, (const bf16_t*)(ws + WS_GVT), (const float*)(ws + WS_GVSSQ), (const bf16_t*)(ws + WS_WS), (const bf16_t*)(ws + WS_UG), wave0);
        conv_load(CR, row0, (const bf16_t*)(ws + WS_BG), (const bf16_t*)(ws + WS_CH), F.lane);
        gmlp_unit(GR, uA >> 6, (uA >> 2) & 15, uA & 3, F.v_g, F.b_s, (bf16_t*)(ws + WS_Y), F.lds, wave0);
        gmlp_load(GR, uB >> 6, (uB >> 2) & 15, uB & 3, (const bf16_t*)(ws + WS_GVT), (const float*)(ws + WS_GVSSQ), (const bf16_t*)(ws + WS_WS), (const bf16_t*)(ws + WS_UG), wave0);
        conv_finish(CR, row0, F.conv_w, (bf16_t*)(ws + WS_Y), F.lane);
        gmlp_unit(GR, uB >> 6, (uB >> 2) & 15, uB & 3, F.v_g, F.b_s, (bf16_t*)(ws + WS_Y), F.lds, wave0);
        if (REP == 7 && rep == 0) GRID_BAR();
        }
        if (BOTH(7)) LIGHT_BAR(2);
        STAMP(8);
    }
    if (IN(8)) {
        FRAME_LOAD(); ws = F.ws;
        OutOrder<WS_Y, WS_WO1> S{F.G, (int)blockIdx.x}; EpiP7 E;
        pg8::gemm_phase<EpiP7, OutOrder<WS_Y, WS_WO1>>(F.lds, DM, S, E, wave0);
        STAMP(9);
    }
#undef IN
#undef BOTH
}

#if DIAG

#endif

extern "C" void kernel_launch(void* const* d_in, const int* in_sizes, int n_in, void* d_out, int out_size, void* d_ws, size_t ws_size, hipStream_t stream) {
    static int grid = 0;
    if (grid == 0) {
        int dev = 0, cus = 0;
        if (hipGetDevice(&dev) != hipSuccess || hipDeviceGetAttribute(&cus, hipDeviceAttributeMultiprocessorCount, dev) != hipSuccess) { fprintf(stderr, "kernel_launch: device query failed\n"); grid = -1; return; }
        if (hipFuncSetAttribute((const void*)mk_fwd, hipFuncAttributeMaxDynamicSharedMemorySize, LDS_BYTES) != hipSuccess) { fprintf(stderr, "kernel_launch: hipFuncSetAttribute failed\n"); grid = -1; return; }
        int per_cu = 0;
        if (hipOccupancyMaxActiveBlocksPerMultiprocessor(&per_cu, (const void*)mk_fwd, NTHR, LDS_BYTES) != hipSuccess || per_cu < 1) { fprintf(stderr, "kernel_launch: occupancy query says %d blocks/CU\n", per_cu); }
        (void)hipGetLastError();
        grid = cus;
        if (ws_size < WS_END) { fprintf(stderr, "kernel_launch: workspace too small\n"); grid = -1; return; }
    }
    if (grid < 0) return;
    (void)hipMemsetAsync((char*)d_ws + WS_CTL, 0, CTL_ZERO_BYTES, stream);
    Args a{};
    for (int i = 0; i < 20; ++i) a.in[i] = (const float*)d_in[i];
    a.out = (float*)d_out; a.ws = (unsigned char*)d_ws;
#ifdef OUT_SKIP
    a.dbg = OUT_SKIP;
#endif
#if DIAG
    diag_launch(a, grid, d_in, d_out, d_ws, stream);
#else
#if REP >= 91 && REP <= 98
    a.ph_lo = 0; a.ph_hi = REP - 90;
    hipLaunchKernelGGL(mk_fwd, dim3(grid), dim3(NTHR), LDS_BYTES, stream, a);
    (void)hipMemsetAsync((char*)d_ws + WS_CTL, 0, CTL_ZERO_BYTES, stream);
#endif
    a.ph_lo = 0; a.ph_hi = N_PHASES;
    hipLaunchKernelGGL(mk_fwd, dim3(grid), dim3(NTHR), LDS_BYTES, stream, a);
#endif
}
```
